# Optimizing an MI355X kernel written in HIP

```python
import math
import jax, jax.numpy as jnp
from jax import lax
import numpy as np

D_MODEL = 1024
BATCH = 4
SEQ = 4096
DEPTH = 4
DEC_BATCH = 128
DEC_SEQ = 1
PAST_LEN = 8192
PAGE_SIZE = 128

N_A_LAYERS = DEPTH // 2
N_B_LAYERS = DEPTH - N_A_LAYERS
HG_HEADS = 8
HG_DK = D_MODEL // HG_HEADS
HG_DV = D_MODEL // HG_HEADS
HG_CHUNK = 64
N_Q_HEADS = 16
N_KV_HEADS = 4
GROUP = N_Q_HEADS // N_KV_HEADS
HEAD_DIM = D_MODEL // N_Q_HEADS
WINDOW = 128
D_FF = 4 * D_MODEL
ROPE_THETA = 10000.0
EPS = 1e-6
ATTN_SCALE = 1.0 / math.sqrt(HEAD_DIM)

kernel_name = "yoco_hgrn2_swa_sink_decoder_step"

F32 = jnp.float32


def _rms_norm(x, g):
    xf = x.astype(F32)
    y = xf * lax.rsqrt(jnp.mean(xf * xf, axis=-1, keepdims=True) + EPS)
    return (y * g.astype(F32)).astype(x.dtype)


def _ada(c, w, b):
    return (jax.nn.silu(c) @ w + b)[:, None, :]


def _rope(x, pos):
    half = HEAD_DIM // 2
    inv = ROPE_THETA ** (-jnp.arange(half, dtype=F32) / half)
    ang = pos.astype(F32)[:, None] * inv[None, :]
    cos = jnp.cos(ang)[None, :, None, :]
    sin = jnp.sin(ang)[None, :, None, :]
    xf = x.astype(F32)
    x1, x2 = xf[..., :half], xf[..., half:]
    return jnp.concatenate([x1 * cos - x2 * sin, x2 * cos + x1 * sin], axis=-1).astype(x.dtype)


def _hgrn2_scan(q, k, v, logf, s0):
    b, L = q.shape[:2]
    C = HG_CHUNK if L % HG_CHUNK == 0 else L
    n = L // C

    def to_chunks(t):
        return t.astype(F32).reshape(b, n, C, HG_HEADS, t.shape[-1]).transpose(1, 0, 3, 2, 4)

    qc, kc, vc, gc = to_chunks(q), to_chunks(k), to_chunks(v), to_chunks(logf)
    causal = jnp.tril(jnp.ones((C, C), dtype=bool))[:, :, None]

    def step(S, inp):
        qi, ki, vi, gi = inp
        cum = jnp.cumsum(gi, axis=-2)
        diff = cum[..., :, None, :] - cum[..., None, :, :]
        decay = jnp.exp(jnp.where(causal, diff, -jnp.inf))
        att = jnp.einsum('bhtd,bhsd,bhtsd->bhts', qi, ki, decay)
        o = (jnp.einsum('bhts,bhsv->bhtv', att, vi)
             + jnp.einsum('bhtd,bhdv->bhtv', qi * jnp.exp(cum), S))
        last = cum[..., -1:, :]
        S_new = (jnp.exp(last[..., 0, :])[..., None] * S
                 + jnp.einsum('bhsd,bhsv->bhdv', ki * jnp.exp(last - cum), vi))
        return S_new, o

    S_fin, o = lax.scan(step, s0.astype(F32), (qc, kc, vc, gc))
    o = o.transpose(1, 0, 3, 2, 4).reshape(b, L, HG_HEADS, HG_DV)
    return o, S_fin


def _hgrn2(h, s0, w_in, w_out, lb, gn_g):
    b, L, _ = h.shape
    q, f, i, g = jnp.split(h @ w_in, 4, axis=-1)
    q = jax.nn.silu(q)
    fg = lb + (1.0 - lb) * jax.nn.sigmoid(f.astype(F32))
    heads = lambda t: t.reshape(b, L, HG_HEADS, -1)
    o, S = _hgrn2_scan(heads(q), heads(1.0 - fg), heads(i), heads(jnp.log(fg)), s0)
    o = _rms_norm(o, gn_g) * jax.nn.silu(heads(g).astype(F32))
    return o.reshape(b, L, D_MODEL).astype(h.dtype) @ w_out, S


def _sink_softmax(s, sinks):
    sk = jnp.broadcast_to(sinks.astype(F32).reshape(N_KV_HEADS, GROUP, 1, 1), s.shape[:-1] + (1,))
    p = jax.nn.softmax(jnp.concatenate([s, sk], axis=-1), axis=-1)
    return p[..., :-1]


def _swa_prompt(q, k, v, sinks):
    b, L = q.shape[:2]
    nb = L // WINDOW
    qb = q.reshape(b, nb, WINDOW, N_KV_HEADS, GROUP, HEAD_DIM).astype(F32)

    def band(t):
        tp = jnp.concatenate([jnp.zeros_like(t[:, :WINDOW]), t], axis=1)
        tb = tp.reshape(b, nb + 1, WINDOW, N_KV_HEADS, HEAD_DIM)
        return jnp.concatenate([tb[:, :-1], tb[:, 1:]], axis=2).astype(F32)

    kb, vb = band(k), band(v)
    s = jnp.einsum('bnqkgd,bnjkd->bnkgqj', qb, kb) * ATTN_SCALE
    qi = jnp.arange(WINDOW)[:, None] + WINDOW
    kj = jnp.arange(2 * WINDOW)[None, :]
    rel = qi - kj
    valid = (rel >= 0) & (rel < WINDOW)
    not_first = (jnp.arange(nb) > 0)[:, None, None]
    valid = valid[None] & (not_first | (kj >= WINDOW)[None])
    s = jnp.where(valid[None, :, None, None], s, -jnp.inf)
    p = _sink_softmax(s, sinks)
    o = jnp.einsum('bnkgqj,bnjkd->bnqkgd', p, vb)
    return o.reshape(b, L, N_Q_HEADS * HEAD_DIM)


def _swa_sample(q, k_all, v_all, sinks):
    b, T = q.shape[:2]
    qpos = PAST_LEN + jnp.arange(T)
    kpos = PAST_LEN - WINDOW + jnp.arange(WINDOW + T)
    rel = qpos[:, None] - kpos[None, :]
    valid = (rel >= 0) & (rel < WINDOW)
    qg = q.reshape(b, T, N_KV_HEADS, GROUP, HEAD_DIM).astype(F32)
    s = jnp.einsum('bqkgd,bjkd->bkgqj', qg, k_all.astype(F32)) * ATTN_SCALE
    s = jnp.where(valid, s, -jnp.inf)
    p = _sink_softmax(s, sinks)
    o = jnp.einsum('bkgqj,bjkd->bqkgd', p, v_all.astype(F32))
    return o.reshape(b, T, N_Q_HEADS * HEAD_DIM)


def _trunk(x, c, pos, hg_s0, cache_k, cache_v, P):
    (w_ada, b_ada, norm1_g, norm2_g, hg_w_in, hg_w_out, hg_lb, hg_gn_g,
     kv_w_ada, kv_b_ada, kv_norm_g, w_kv, k_norm_g,
     w_q, q_norm_g, sinks, w_o, w_up, w_down) = P
    b, L, _ = x.shape
    hg_states = []
    k_all = v_all = k_state = v_state = None
    for l in range(DEPTH):
        sh1, sc1, g1, sh2, sc2, g2 = jnp.split(_ada(c, w_ada[l], b_ada[l]), 6, axis=-1)
        if l == N_A_LAYERS:
            sh, sc = jnp.split(_ada(c, kv_w_ada, kv_b_ada), 2, axis=-1)
            hk = _rms_norm(x, kv_norm_g) * (1 + sc) + sh
            k_new, v_new = jnp.split(hk @ w_kv, 2, axis=-1)
            k_new = _rope(_rms_norm(k_new.reshape(b, L, N_KV_HEADS, HEAD_DIM), k_norm_g), pos)
            v_new = v_new.reshape(b, L, N_KV_HEADS, HEAD_DIM)
            if cache_k is None:
                k_all, v_all = k_new, v_new
            else:
                k_all = jnp.concatenate([cache_k.astype(k_new.dtype), k_new], axis=1)
                v_all = jnp.concatenate([cache_v.astype(v_new.dtype), v_new], axis=1)
            k_state, v_state = k_all[:, -WINDOW:], v_all[:, -WINDOW:]
        h = _rms_norm(x, norm1_g[l]) * (1 + sc1) + sh1
        if l < N_A_LAYERS:
            mix, S = _hgrn2(h, hg_s0[l], hg_w_in[l], hg_w_out[l], hg_lb[l], hg_gn_g[l])
            hg_states.append(S.astype(x.dtype))
        else:
            j = l - N_A_LAYERS
            q = _rope(_rms_norm((h @ w_q[j]).reshape(b, L, N_Q_HEADS, HEAD_DIM), q_norm_g[j]), pos)
            if cache_k is None:
                att = _swa_prompt(q, k_all, v_all, sinks[j])
            else:
                att = _swa_sample(q, k_all, v_all, sinks[j])
            mix = att.astype(x.dtype) @ w_o[j]
        x = x + g1 * mix
        h2 = _rms_norm(x, norm2_g[l]) * (1 + sc2) + sh2
        x = x + g2 * (jnp.square(jax.nn.relu(h2 @ w_up[l])) @ w_down[l])
    return x, jnp.stack(hg_states), k_state, v_state


def setup_inputs(seed: int = 0) -> dict:
    key = jax.random.key(seed)
    ks = jax.random.split(key, 32)
    n = lambda k, shape, s: jax.random.normal(k, shape, dtype=F32) * s
    D = D_MODEL
    return {
        "x_prompt": n(ks[0], (BATCH, SEQ, D), 1.0),
        "x_sample": n(ks[1], (DEC_BATCH, DEC_SEQ, D), 1.0),
        "c_prompt": n(ks[2], (BATCH, D), 1.0),
        "c_sample": n(ks[3], (DEC_BATCH, D), 1.0),
        "state_hgrn": n(ks[4], (N_A_LAYERS, DEC_BATCH, HG_HEADS, HG_DK, HG_DV), 0.3),
        "cache_k": n(ks[5], (DEC_BATCH, WINDOW, N_KV_HEADS, HEAD_DIM), 1.0),
        "cache_v": n(ks[6], (DEC_BATCH, WINDOW, N_KV_HEADS, HEAD_DIM), 1.0),
        "w_ada": n(ks[7], (DEPTH, D, 6 * D), 0.5 * D ** -0.5),
        "b_ada": n(ks[8], (DEPTH, 6 * D), 0.02),
        "norm1_g": 1.0 + n(ks[9], (DEPTH, D), 0.02),
        "norm2_g": 1.0 + n(ks[10], (DEPTH, D), 0.02),
        "hg_w_in": n(ks[11], (N_A_LAYERS, D, 4 * D), D ** -0.5),
        "hg_w_out": n(ks[12], (N_A_LAYERS, D, D), D ** -0.5),
        "hg_lower_bounds": n(ks[13], (N_A_LAYERS, D), 0.1),
        "hg_gn_g": 1.0 + n(ks[14], (N_A_LAYERS, HG_DV), 0.02),
        "kv_w_ada": n(ks[15], (D, 2 * D), 0.5 * D ** -0.5),
        "kv_b_ada": n(ks[16], (2 * D,), 0.02),
        "kv_norm_g": 1.0 + n(ks[17], (D,), 0.02),
        "w_kv": n(ks[18], (D, 2 * N_KV_HEADS * HEAD_DIM), D ** -0.5),
        "k_norm_g": 1.0 + n(ks[19], (HEAD_DIM,), 0.02),
        "w_q": n(ks[20], (N_B_LAYERS, D, N_Q_HEADS * HEAD_DIM), D ** -0.5),
        "q_norm_g": 1.0 + n(ks[21], (N_B_LAYERS, HEAD_DIM), 0.02),
        "sinks": n(ks[22], (N_B_LAYERS, N_Q_HEADS), 0.5),
        "w_o": n(ks[23], (N_B_LAYERS, N_Q_HEADS * HEAD_DIM, D), (N_Q_HEADS * HEAD_DIM) ** -0.5),
        "w_up": n(ks[24], (DEPTH, D, D_FF), D ** -0.5),
        "w_down": n(ks[25], (DEPTH, D_FF, D), D_FF ** -0.5),
    }


def reference(x_prompt, x_sample, c_prompt, c_sample, state_hgrn, cache_k, cache_v,
              w_ada, b_ada, norm1_g, norm2_g, hg_w_in, hg_w_out, hg_lower_bounds, hg_gn_g,
              kv_w_ada, kv_b_ada, kv_norm_g, w_kv, k_norm_g,
              w_q, q_norm_g, sinks, w_o, w_up, w_down):
    sm = jax.nn.softmax(hg_lower_bounds.astype(F32), axis=0)
    hg_lb = jnp.cumsum(sm, axis=0) - sm[0]
    P = (w_ada, b_ada, norm1_g, norm2_g, hg_w_in, hg_w_out, hg_lb, hg_gn_g,
         kv_w_ada, kv_b_ada, kv_norm_g, w_kv, k_norm_g,
         w_q, q_norm_g, sinks, w_o, w_up, w_down)
    bp, Lp, _ = x_prompt.shape
    s0_prompt = jnp.zeros((N_A_LAYERS, bp, HG_HEADS, HG_DK, HG_DV), dtype=x_prompt.dtype)
    y_prompt, hg_p, k_p, v_p = _trunk(x_prompt, c_prompt, jnp.arange(Lp), s0_prompt,
                                      None, None, P)
    Ls = x_sample.shape[1]
    y_sample, hg_s, k_s, v_s = _trunk(x_sample, c_sample, PAST_LEN + jnp.arange(Ls), state_hgrn,
                                      cache_k, cache_v, P)
    return (y_prompt, y_sample, hg_p, k_p, v_p, hg_s, k_s, v_s)
```

```cpp
#include <hip/hip_runtime.h>
#include <hip/hip_cooperative_groups.h>
#include <cstdio>
#include <cstdint>
namespace cg = cooperative_groups;

#define DI __device__ __forceinline__
typedef unsigned short bf16_t;
typedef short bf16x8 __attribute__((ext_vector_type(8)));
typedef float f32x4 __attribute__((ext_vector_type(4)));
typedef float f32x2 __attribute__((ext_vector_type(2)));
typedef float f32x16 __attribute__((ext_vector_type(16)));
typedef unsigned u32x4 __attribute__((ext_vector_type(4)));
typedef unsigned u32x2 __attribute__((ext_vector_type(2)));
#define LAS __attribute__((address_space(3)))

constexpr int D = 1024, FF = 4096, TP = 16384, TS = 128, T = TP + TS, TPAD = 16640, SEQ = 4096;
constexpr int NMOD = 132, MODW = 4 * 6144 + 2048;
constexpr float EPS = 1e-6f;
constexpr int NTHREADS = 512, NWAVES = 8;
constexpr int LDS_BYTES = 131072 + 16;

constexpr size_t O_Y = 0;
constexpr size_t O_HGP = (size_t)T * D;
constexpr size_t O_KP = O_HGP + (size_t)2 * 4 * 8 * 128 * 128;
constexpr size_t O_VP = O_KP + (size_t)4 * 128 * 4 * 64;
constexpr size_t O_HGS = O_VP + (size_t)4 * 128 * 4 * 64;
constexpr size_t O_KS = O_HGS + (size_t)2 * 128 * 8 * 128 * 128;
constexpr size_t O_VS = O_KS + (size_t)128 * 128 * 4 * 64;

constexpr size_t SZ_ACT = (size_t)TPAD * D * 2;
constexpr size_t OFF_WIN = 0;
constexpr size_t OFF_WOUT = OFF_WIN + (size_t)2 * 4096 * 1024 * 2;
constexpr size_t OFF_WKV = OFF_WOUT + (size_t)2 * 1024 * 1024 * 2;
constexpr size_t OFF_WQ = OFF_WKV + (size_t)512 * 1024 * 2;
constexpr size_t OFF_WO = OFF_WQ + (size_t)2 * 1024 * 1024 * 2;
constexpr size_t OFF_WUP = OFF_WO + (size_t)2 * 1024 * 1024 * 2;
constexpr size_t OFF_WDN = OFF_WUP + (size_t)4 * 4096 * 1024 * 2;
constexpr size_t OFF_MODS = OFF_WDN + (size_t)4 * 4096 * 1024 * 2;
constexpr size_t OFF_TAB = OFF_MODS + (((size_t)NMOD * MODW * 4 + 4095) & ~(size_t)4095);
constexpr size_t OFF_H = OFF_TAB + (((size_t)4097 * 64 * 4 + 4095) & ~(size_t)4095);
constexpr size_t OFF_ON = OFF_H + SZ_ACT;
constexpr size_t OFF_U = OFF_ON + SZ_ACT;
constexpr size_t OFF_X = OFF_U + 4 * SZ_ACT;
constexpr size_t OFF_BAR = OFF_X + 4 * SZ_ACT;
constexpr size_t BAR_BYTES = 16384;
constexpr size_t OFF_RSS = OFF_BAR + BAR_BYTES;
constexpr size_t ZERO_BYTES = BAR_BYTES + (size_t)9 * T * 4;
constexpr size_t OFF_ASH = OFF_BAR + ((ZERO_BYTES + 4095) & ~(size_t)4095);
constexpr size_t OFF_BIAS = OFF_ASH + (size_t)9 * 256 * 1024 * 2;
constexpr size_t WS_NEED = OFF_BIAS + (size_t)132 * 27136 * 4;

struct P {
  const float *x_prompt, *x_sample, *c_prompt, *c_sample, *state_hgrn, *cache_k, *cache_v;
  const float *w_ada, *b_ada, *norm1_g, *norm2_g, *hg_w_in, *hg_w_out, *hg_lbp, *hg_gn_g;
  const float *kv_w_ada, *kv_b_ada, *kv_norm_g, *w_kv, *k_norm_g, *w_q, *q_norm_g, *sinks, *w_o, *w_up, *w_down;
  float* out; unsigned char* ws;
};

typedef const P __attribute__((address_space(4)))* KP;
DI KP kp_get() { KP q = (KP)__builtin_amdgcn_kernarg_segment_ptr(); asm volatile("" : "+s"(q)); return q; }
DI int tid_get() { int t = threadIdx.x; asm volatile("" : "+v"(t)); return t; }
DI unsigned f2bf(float f) { unsigned u = __float_as_uint(f); return (u + 0x7fffu + ((u >> 16) & 1u)) >> 16; }
typedef __bf16 bf16x2_n __attribute__((ext_vector_type(2)));
DI unsigned pk2(float lo, float hi) { return __builtin_bit_cast(unsigned, __builtin_convertvector((f32x2){lo, hi}, bf16x2_n)); }
DI float bf2f(unsigned b) { return __uint_as_float(b << 16); }
DI float silu_f(float x) { return x * __builtin_amdgcn_rcpf(1.f + __expf(-x)); }
DI int modrow(int r) { return r < TP ? (r >> 12) : (4 + r - TP); }
DI int crow(int reg, int h) { return (reg & 3) + 8 * (reg >> 2) + 4 * h; }

constexpr int BM = 256, BK = 64, HALF = 128, HTB = HALF * BK * 2;
DI int lds_byte(int r, int c) { const int st = (r >> 4) * 2 + (c >> 5), rr = r & 15, cc = c & 31, ob = rr * 64 + cc * 2; return st * 1024 + (ob ^ (((ob >> 9) & 1) << 5)); }
DI void stage_rc(int b, int& R, int& C) { const int st = b / 1024, sb = b % 1024, swz = sb ^ (((sb >> 9) & 1) << 5); R = (st >> 1) * 16 + swz / 64; C = (st & 1) * 32 + (swz % 64) / 2; }

enum { EPI_ADA = 0, EPI_HGIN = 1, EPI_RESID = 2, EPI_UP = 3, EPI_QRAW = 4, EPI_KVRAW = 5, EPI_NOP = 6, EPI_BIAS = 7 };
struct GemmJob { const bf16_t* A; const bf16_t* Bt; int nM, nN, K, epi; };
struct EpiArgs {
  float* f0; const float* f1; float* f2; bf16_t* b0; bf16_t* b1; bf16_t* b2; bf16_t* b3; int layer; int first;
  const float* rss; const float* bias; const float* bias1; int bN, bN1;
  float* rss_out; const float* ng; const float* nsc; bf16_t* yout; const float* ngkv; const float* nsckv; bf16_t* ykv;
  bf16_t* ash;
};
DI int site_N(const int s) { return (s == 2 || s == 3) ? 1024 : (s == 4 ? 512 : 4096); }
DI int site_prefN(const int s) { return s == 0 ? 0 : s == 1 ? 4096 : s == 2 ? 8192 : s == 3 ? 9216 : s == 4 ? 10240 : 10752 + (s - 5) * 4096; }

DI void tile_of(int L, int nM, int nN, int& pm, int& pn) {
  const int nwg = nM * nN; int wgid = L;
  { const int q = nwg / 8, r = nwg % 8, xcd = wgid % 8, off = wgid / 8; wgid = (xcd < r ? xcd * (q + 1) : r * (q + 1) + (xcd - r) * q) + off; }
  const int nig = 8 * nN, gid = wgid / nig, fm = gid * 8, gsz = (nM - fm) < 8 ? (nM - fm) : 8;
  pm = fm + ((wgid % nig) % gsz); pn = (wgid % nig) / gsz;
}

DI void epi_frag(KP p, const int epi, const EpiArgs& E, const int r, const int c, const f32x4 vin) {
  if (epi == EPI_NOP) return;
  f32x4 v = vin;
  if (epi == EPI_HGIN || epi == EPI_UP || epi == EPI_QRAW || epi == EPI_KVRAW) {
    const float rstd = rsqrtf(E.rss[r] * (1.f / D) + EPS);
    const float* bp = ((epi == EPI_KVRAW) ? E.bias1 + (size_t)modrow(r) * E.bN1 : E.bias + (size_t)modrow(r) * E.bN) + c;
    v = v * rstd + *(const f32x4*)bp; }
  if (epi == EPI_HGIN) {
    const int sec = c >> 10, cc = c & 1023; const size_t o = (size_t)r * D + cc;
    if (sec == 1) { f32x4 lb = (f32x4){0.f, 0.f, 0.f, 0.f};
      if (E.layer == 1) { const f32x4 l0 = *(const f32x4*)(p->hg_lbp + cc), l1 = *(const f32x4*)(p->hg_lbp + D + cc);
#pragma unroll
        for (int j = 0; j < 4; ++j) lb[j] = __builtin_amdgcn_rcpf(1.f + __expf(l0[j] - l1[j])); }
      f32x4 lf; float kk[4];
#pragma unroll
      for (int j = 0; j < 4; ++j) { const float sg = __builtin_amdgcn_rcpf(1.f + __expf(-v[j])); const float fg = lb[j] + (1.f - lb[j]) * sg; lf[j] = __logf(fg); kk[j] = (1.f - lb[j]) * (1.f - sg); }
      *(f32x4*)(E.f0 + o) = lf; *(u32x2*)(E.b1 + o) = (u32x2){pk2(kk[0], kk[1]), pk2(kk[2], kk[3])};
    } else if (sec == 2) { *(u32x2*)(E.b2 + o) = (u32x2){pk2(v[0], v[1]), pk2(v[2], v[3])};
    } else { bf16_t* dst = (sec == 0) ? E.b0 : E.b3; *(u32x2*)(dst + o) = (u32x2){pk2(silu_f(v[0]), silu_f(v[1])), pk2(silu_f(v[2]), silu_f(v[3]))}; }
  } else if (epi == EPI_RESID) {
    const float* xin = E.first ? (r < TP ? p->x_prompt + (size_t)r * D : p->x_sample + (size_t)(r - TP) * D) : (E.f0 + (size_t)r * D);
    const size_t mo = (size_t)modrow(r) * MODW;
    const f32x4 xv = *(const f32x4*)(xin + c), gv = *(const f32x4*)(E.f1 + mo + c);
    const f32x4 yn = xv + gv * v;
    *(f32x4*)(E.f0 + (size_t)r * D + c) = yn;
    if (E.yout) {
      const f32x4 g = *(const f32x4*)(E.ng + c), sc = *(const f32x4*)(E.nsc + mo + c); const f32x4 y = yn * g * (sc + 1.f);
      *(u32x2*)(E.yout + (size_t)r * D + c) = (u32x2){pk2(y[0], y[1]), pk2(y[2], y[3])};
      if (E.ykv) { const f32x4 g2 = *(const f32x4*)(E.ngkv + c), sc2 = *(const f32x4*)(E.nsckv + mo + c); const f32x4 y2 = yn * g2 * (sc2 + 1.f);
        *(u32x2*)(E.ykv + (size_t)r * D + c) = (u32x2){pk2(y2[0], y2[1]), pk2(y2[2], y2[3])}; }
      float ss = yn[0] * yn[0] + yn[1] * yn[1] + yn[2] * yn[2] + yn[3] * yn[3];
      ss += __shfl_xor(ss, 1); ss += __shfl_xor(ss, 2);
      if ((tid_get() & 3) == 0) atomicAdd(E.rss_out + r, ss); }
  } else if (epi == EPI_UP) {
    f32x4 u;
#pragma unroll
    for (int j = 0; j < 4; ++j) { const float t = fmaxf(v[j], 0.f); u[j] = t * t; }
    *(u32x2*)(E.b0 + (size_t)r * FF + c) = (u32x2){pk2(u[0], u[1]), pk2(u[2], u[3])};
  } else if (epi == EPI_QRAW) { *(u32x2*)(E.b1 + (size_t)r * D + c) = (u32x2){pk2(v[0], v[1]), pk2(v[2], v[3])};
  } else if (epi == EPI_KVRAW) { *(f32x4*)(E.f2 + (size_t)r * 512 + c) = v; }
}

DI void epi_frag8(KP p, const int epi, const EpiArgs& E, const int r, const int c, const f32x4 v0, const f32x4 v1, const f32x4 lbA = (f32x4){0.f, 0.f, 0.f, 0.f}, const f32x4 lbB = (f32x4){0.f, 0.f, 0.f, 0.f}) {
  if (epi == EPI_NOP) return;
  if (epi == EPI_ADA) { if (r < NMOD) { const float* bp = (c < 24576) ? (p->b_ada + c) : (p->kv_b_ada + (c - 24576)); float* o = E.f0 + (size_t)r * MODW + c;
      const f32x4 m0 = v0 + *(const f32x4*)bp, m1 = v1 + *(const f32x4*)(bp + 4);
      *(f32x4*)o = m0; *(f32x4*)(o + 4) = m1;
      int site = -1;
      if (c < 24576) { const int l = c / 6144, part = (c - l * 6144) >> 10; site = (part == 0) ? l : (part == 3 ? 5 + l : -1); } else if (c < 25600) site = 4;
      if (site >= 0) *(u32x4*)(E.ash + ((size_t)site * 256 + r) * 1024 + (c & 1023)) = (u32x4){pk2(m0[0], m0[1]), pk2(m0[2], m0[3]), pk2(m1[0], m1[1]), pk2(m1[2], m1[3])}; }
  } else if (epi == EPI_HGIN) {
    const int sec = c >> 10, cc = c & 1023; const size_t o = (size_t)r * D + cc;
    if (sec == 1) { float lb[8];
#pragma unroll
      for (int j = 0; j < 4; ++j) { lb[j] = lbA[j]; lb[4 + j] = lbB[j]; }
      float lf[8], kk[8];
#pragma unroll
      for (int j = 0; j < 8; ++j) { const float x = (j < 4) ? v0[j & 3] : v1[j & 3]; const float sg = __builtin_amdgcn_rcpf(1.f + __expf(-x)); const float fg = lb[j] + (1.f - lb[j]) * sg;
        lf[j] = __logf(fg); kk[j] = (1.f - lb[j]) * (1.f - sg); }
      *(f32x4*)(E.f0 + o) = (f32x4){lf[0], lf[1], lf[2], lf[3]}; *(f32x4*)(E.f0 + o + 4) = (f32x4){lf[4], lf[5], lf[6], lf[7]};
      *(u32x4*)(E.b1 + o) = (u32x4){pk2(kk[0], kk[1]), pk2(kk[2], kk[3]), pk2(kk[4], kk[5]), pk2(kk[6], kk[7])};
    } else if (sec == 2) { *(u32x4*)(E.b2 + o) = (u32x4){pk2(v0[0], v0[1]), pk2(v0[2], v0[3]), pk2(v1[0], v1[1]), pk2(v1[2], v1[3])};
    } else { bf16_t* dst = (sec == 0) ? E.b0 : E.b3;
      *(u32x4*)(dst + o) = (u32x4){pk2(silu_f(v0[0]), silu_f(v0[1])), pk2(silu_f(v0[2]), silu_f(v0[3])), pk2(silu_f(v1[0]), silu_f(v1[1])), pk2(silu_f(v1[2]), silu_f(v1[3]))}; }
  } else if (epi == EPI_RESID) {
    const float* xin = E.first ? (r < TP ? p->x_prompt + (size_t)r * D : p->x_sample + (size_t)(r - TP) * D) : (E.f0 + (size_t)r * D);
    const size_t mo = (size_t)modrow(r) * MODW;
    const float* gm = E.f1 + mo + c; float* o = E.f0 + (size_t)r * D + c;
    const f32x4 xa = *(const f32x4*)(xin + c), xb = *(const f32x4*)(xin + c + 4), ga = *(const f32x4*)gm, gb = *(const f32x4*)(gm + 4);
    const f32x4 ya = xa + ga * v0, yb = xb + gb * v1;
    *(f32x4*)o = ya; *(f32x4*)(o + 4) = yb;
    if (E.yout) {
      const f32x4 g0 = *(const f32x4*)(E.ng + c), g1 = *(const f32x4*)(E.ng + c + 4), s0 = *(const f32x4*)(E.nsc + mo + c), s1 = *(const f32x4*)(E.nsc + mo + c + 4);
      const f32x4 y0 = ya * g0 * (s0 + 1.f), y1 = yb * g1 * (s1 + 1.f);
      *(u32x4*)(E.yout + (size_t)r * D + c) = (u32x4){pk2(y0[0], y0[1]), pk2(y0[2], y0[3]), pk2(y1[0], y1[1]), pk2(y1[2], y1[3])};
      if (E.ykv) { const f32x4 h0 = *(const f32x4*)(E.ngkv + c), h1 = *(const f32x4*)(E.ngkv + c + 4), t0 = *(const f32x4*)(E.nsckv + mo + c), t1 = *(const f32x4*)(E.nsckv + mo + c + 4);
        const f32x4 z0 = ya * h0 * (t0 + 1.f), z1 = yb * h1 * (t1 + 1.f);
        *(u32x4*)(E.ykv + (size_t)r * D + c) = (u32x4){pk2(z0[0], z0[1]), pk2(z0[2], z0[3]), pk2(z1[0], z1[1]), pk2(z1[2], z1[3])}; }
      float ss = ya[0] * ya[0] + ya[1] * ya[1] + ya[2] * ya[2] + ya[3] * ya[3] + yb[0] * yb[0] + yb[1] * yb[1] + yb[2] * yb[2] + yb[3] * yb[3];
      ss += __shfl_xor(ss, 16); ss += __shfl_xor(ss, 32);
      if ((tid_get() & 63) < 16) atomicAdd(E.rss_out + r, ss); }
  } else if (epi == EPI_UP) {
    float u[8];
#pragma unroll
    for (int j = 0; j < 8; ++j) { const float t = fmaxf((j < 4) ? v0[j & 3] : v1[j & 3], 0.f); u[j] = t * t; }
    *(u32x4*)(E.b0 + (size_t)r * FF + c) = (u32x4){pk2(u[0], u[1]), pk2(u[2], u[3]), pk2(u[4], u[5]), pk2(u[6], u[7])};
  } else if (epi == EPI_QRAW) { *(u32x4*)(E.b1 + (size_t)r * D + c) = (u32x4){pk2(v0[0], v0[1]), pk2(v0[2], v0[3]), pk2(v1[0], v1[1]), pk2(v1[2], v1[3])};
  } else { float* o = E.f2 + (size_t)r * 512 + c; *(f32x4*)o = v0; *(f32x4*)(o + 4) = v1; }
}

DI void skinny_unit(KP p, unsigned char* shm, const bf16_t* A, const bf16_t* Bt, const int K, const int n0, const int epi, const EpiArgs& E) {
  const int tid = tid_get(), lane = tid & 63, wave = tid >> 6, fr = lane & 15, fq = lane >> 4;
  const int ks = K >> 3;
  const bf16_t* ap = A + (size_t)(TP + fr) * K + wave * ks + fq * 8;
  const bf16_t* bp = Bt + (size_t)(n0 + fr) * K + wave * ks + fq * 8;
  f32x4 acc[8];
#pragma unroll
  for (int mb = 0; mb < 8; ++mb) acc[mb] = (f32x4){0.f, 0.f, 0.f, 0.f};
#pragma unroll 2
  for (int k = 0; k < ks; k += 32) { const bf16x8 b = *(const bf16x8*)(bp + k);
#pragma unroll
    for (int mb = 0; mb < 8; ++mb) { const bf16x8 a = *(const bf16x8*)(ap + (size_t)mb * 16 * K + k); acc[mb] = __builtin_amdgcn_mfma_f32_16x16x32_bf16(b, a, acc[mb], 0, 0, 0); } }
  float* red = (float*)shm;
#pragma unroll
  for (int mb = 0; mb < 8; ++mb) *(f32x4*)(red + wave * 2048 + (mb * 16 + fr) * 16 + fq * 4) = acc[mb];
  __syncthreads();
  { const int row = tid >> 2, c4 = (tid & 3) * 4; f32x4 sum = (f32x4){0.f, 0.f, 0.f, 0.f};
#pragma unroll
    for (int w = 0; w < 8; ++w) sum += *(const f32x4*)(red + w * 2048 + row * 16 + c4);
    epi_frag(p, epi, E, TP + row, n0 + c4, sum); }
  __syncthreads();
}

DI void bias_unit(unsigned char* shm, const bf16_t* A, const bf16_t* Bt, float* out, const int N, const int n0) {
  const int tid = tid_get(), lane = tid & 63, wave = tid >> 6, fr = lane & 15, fq = lane >> 4;
  const bf16_t* ap = A + (size_t)fr * 1024 + wave * 128 + fq * 8;
  const bf16_t* bp = Bt + (size_t)(n0 + fr) * 1024 + wave * 128 + fq * 8;
  f32x4 acc[9];
#pragma unroll
  for (int mb = 0; mb < 9; ++mb) acc[mb] = (f32x4){0.f, 0.f, 0.f, 0.f};
#pragma unroll 2
  for (int k = 0; k < 128; k += 32) { const bf16x8 b = *(const bf16x8*)(bp + k);
#pragma unroll
    for (int mb = 0; mb < 9; ++mb) { const bf16x8 a = *(const bf16x8*)(ap + (size_t)mb * 16 * 1024 + k); acc[mb] = __builtin_amdgcn_mfma_f32_16x16x32_bf16(b, a, acc[mb], 0, 0, 0); } }
  float* red = (float*)shm;
#pragma unroll
  for (int mb = 0; mb < 9; ++mb) *(f32x4*)(red + wave * 2304 + (mb * 16 + fr) * 16 + fq * 4) = acc[mb];
  __syncthreads();
#pragma unroll 1
  for (int e = tid; e < 576; e += NTHREADS) { const int row = e >> 2, c4 = (e & 3) * 4; f32x4 sum = (f32x4){0.f, 0.f, 0.f, 0.f};
#pragma unroll
    for (int w = 0; w < 8; ++w) sum += *(const f32x4*)(red + w * 2304 + row * 16 + c4);
    if (row < NMOD) *(f32x4*)(out + (size_t)row * N + n0 + c4) = sum; }
  __syncthreads();
}

DI int perm32(int rho) { const int n = rho >> 4, i = rho & 15; return 8 * (i >> 2) + 4 * n + (i & 3); }
struct UnitD { const char* A; const char* B; int pm, pn, epi; float* ob; int on; };
DI void unit_of(const int L, const GemmJob& j0, const GemmJob& j1, const int n0, const size_t tstep, UnitD& u) {
  if (j0.epi == EPI_BIAS) {
    const int st = L < 16 ? 0 : L < 32 ? 1 : L < 36 ? 2 : L < 40 ? 3 : L < 42 ? 4 : 5 + (L - 42) / 16;
    const int lb = st == 0 ? 0 : st == 1 ? 16 : st == 2 ? 32 : st == 3 ? 36 : st == 4 ? 40 : 42 + (st - 5) * 16;
    const unsigned char* wsb = (const unsigned char*)j0.Bt;
    const bf16_t* Bt = (st < 2) ? (const bf16_t*)(wsb + OFF_WIN) + (size_t)st * 4096 * D : (st < 4) ? (const bf16_t*)(wsb + OFF_WQ) + (size_t)(st - 2) * D * D
                     : (st == 4) ? (const bf16_t*)(wsb + OFF_WKV) : (const bf16_t*)(wsb + OFF_WUP) + (size_t)(st - 5) * D * FF;
    u.pm = 0; u.pn = L - lb; u.epi = EPI_BIAS; u.A = (const char*)(j0.A + (size_t)st * 256 * 1024); u.B = (const char*)Bt + (size_t)u.pn * tstep;
    u.ob = (float*)j1.A + (size_t)132 * site_prefN(st); u.on = site_N(st); return; }
  const bool second = (L >= n0); int pm, pn; tile_of(second ? L - n0 : L, second ? j1.nM : j0.nM, second ? j1.nN : j0.nN, pm, pn);
  u.pm = pm; u.pn = pn; u.epi = second ? j1.epi : j0.epi;
  u.A = (const char*)(second ? j1.A : j0.A) + (size_t)pm * tstep; u.B = (const char*)(second ? j1.Bt : j0.Bt) + (size_t)pn * tstep;
}
DI void gemm_phase(KP p, LAS unsigned char* lds, unsigned char* shm, const GemmJob& j0, const GemmJob& j1, const int njobs, const EpiArgs& E, const int skinny) {
  const int tid = tid_get(), wid = __builtin_amdgcn_readfirstlane(tid >> 6), lane = tid & 63, wr = wid >> 2, wc = wid & 3, fr = lane & 15, fq = lane >> 4;
  const int K = j0.K, nt = K / BK;
  const int n0 = j0.nM * j0.nN, n1 = (njobs > 1) ? j1.nM * j1.nN : 0, ntl = n0 + n1;
  if ((int)blockIdx.x < ntl) {
    unsigned voffA[2], voffB[2];
#pragma unroll
    for (int i = 0; i < 2; ++i) { int R, C; stage_rc(tid * 16 + i * 8192, R, C); const int Rb = (R & ~31) + perm32(R & 31);
      voffA[i] = (unsigned)(R * K + C) * 2u; voffB[i] = (unsigned)(Rb * K + C) * 2u; }
    const size_t kstep = (size_t)(BK * 2), hstep = (size_t)HALF * K * 2, tstep = 2 * hstep;
    const unsigned ldsw = (unsigned)wid * 1024u;
    const int aoff = lds_byte(wr * 64 + fr, fq * 8), boff = lds_byte(wc * 32 + fr, fq * 8);
#define G_SA(b, h) (((b) * 2 + (h)) * HTB)
#define G_SB(b, h) ((4 + (b) * 2 + (h)) * HTB)
#define G_STAGE(bufoff, gbase, voff) do { _Pragma("unroll") for (int _i = 0; _i < 2; ++_i) \
      __builtin_amdgcn_global_load_lds((const unsigned*)((const char*)(gbase) + (voff)[_i]), (LAS unsigned*)(lds + (bufoff) + ldsw + _i * 8192), 16, 0, 0); } while (0)
#define G_LDA(dst, b, h) do { _Pragma("unroll") for (int m = 0; m < 4; ++m) _Pragma("unroll") for (int k = 0; k < 2; ++k) dst[m][k] = *(const LAS bf16x8*)(lds + G_SA(b, h) + aoff + m * 2048 + k * 1024); } while (0)
#define G_LDB(dst, b, h) do { _Pragma("unroll") for (int n = 0; n < 2; ++n) _Pragma("unroll") for (int k = 0; k < 2; ++k) dst[n][k] = *(const LAS bf16x8*)(lds + G_SB(b, h) + boff + n * 2048 + k * 1024); } while (0)
#define G_MMA(ai, bj, At, Bt) do { __builtin_amdgcn_s_setprio(1); _Pragma("unroll") for (int m = 0; m < 4; ++m) _Pragma("unroll") for (int n = 0; n < 2; ++n) _Pragma("unroll") for (int k = 0; k < 2; ++k) \
      acc[ai][bj][m][n] = __builtin_amdgcn_mfma_f32_16x16x32_bf16(Bt[n][k], At[m][k], acc[ai][bj][m][n], 0, 0, 0); __builtin_amdgcn_s_setprio(0); } while (0)
#define G_WAIT_V(n) asm volatile("s_waitcnt vmcnt(" #n ")" ::: "memory")
#define G_WAIT_L(n) asm volatile("s_waitcnt lgkmcnt(" #n ")" ::: "memory")
#define G_BAR __builtin_amdgcn_s_barrier()
#define G_SCHED __builtin_amdgcn_sched_barrier(0)
    int L = blockIdx.x;
    UnitD cur, nxt; unit_of(L, j0, j1, n0, tstep, cur);
    f32x4 acc[2][2][4][2];
#pragma unroll
    for (int a = 0; a < 2; ++a)
#pragma unroll
      for (int b = 0; b < 2; ++b)
#pragma unroll
        for (int m = 0; m < 4; ++m)
#pragma unroll
          for (int n = 0; n < 2; ++n) acc[a][b][m][n] = (f32x4){0.f, 0.f, 0.f, 0.f};
    bf16x8 At[4][2], B0[2][2], B1[2][2];
    const char* cA = cur.A; const char* cB = cur.B;
    G_STAGE(G_SB(0, 0), cB, voffB); G_STAGE(G_SB(0, 1), cB + hstep, voffB); G_STAGE(G_SA(0, 0), cA, voffA); G_STAGE(G_SA(0, 1), cA + hstep, voffA);
    if (wr == 1) G_BAR;
    G_WAIT_V(2); G_BAR;
    G_STAGE(G_SB(1, 0), cB + kstep, voffB); G_STAGE(G_SA(1, 0), cA + kstep, voffA); G_STAGE(G_SB(1, 1), cB + hstep + kstep, voffB);
    G_WAIT_V(6); G_BAR;
#pragma unroll 1
    for (;;) {
      const int Ln = L + (int)gridDim.x; const bool has_next = (Ln < ntl);
      if (has_next) unit_of(Ln, j0, j1, n0, tstep, nxt);
      const char* nA = has_next ? nxt.A : cA; const char* nB = has_next ? nxt.B : cB;
#pragma unroll 1
      for (int t = 0; t < nt; t += 2) {
        const bool last = (t == nt - 2);
        const char* a1 = cA + (size_t)(t + 1) * kstep;
        const char* a2 = last ? nA : cA + (size_t)(t + 2) * kstep; const char* b2 = last ? nB : cB + (size_t)(t + 2) * kstep;
        const char* a3 = a2 + kstep; const char* b3 = b2 + kstep;
        G_LDB(B0, 0, 0); G_LDB(B1, 0, 1); G_SCHED; G_LDA(At, 0, 0); G_STAGE(G_SA(1, 1), a1 + hstep, voffA);
        G_WAIT_V(8); G_WAIT_L(0); G_BAR; G_MMA(0, 0, At, B0); G_MMA(0, 1, At, B1); G_BAR; G_SCHED;
        G_LDA(At, 0, 1); G_STAGE(G_SB(0, 0), b2, voffB); G_STAGE(G_SB(0, 1), b2 + hstep, voffB); G_STAGE(G_SA(0, 0), a2, voffA);
        G_WAIT_V(8); G_WAIT_L(0); G_BAR; G_MMA(1, 0, At, B0); G_MMA(1, 1, At, B1); G_BAR; G_SCHED;
        G_LDB(B0, 1, 0); G_LDB(B1, 1, 1); G_SCHED; G_LDA(At, 1, 0); G_STAGE(G_SA(0, 1), a2 + hstep, voffA);
        G_WAIT_V(8); G_WAIT_L(0); G_BAR; G_MMA(0, 0, At, B0); G_MMA(0, 1, At, B1); G_BAR; G_SCHED;
        G_LDA(At, 1, 1); G_STAGE(G_SB(1, 0), b3, voffB); G_STAGE(G_SB(1, 1), b3 + hstep, voffB); G_STAGE(G_SA(1, 0), a3, voffA);
        G_WAIT_V(8); G_WAIT_L(0); G_BAR; G_MMA(1, 0, At, B0); G_MMA(1, 1, At, B1); G_BAR; G_SCHED;
      }
      if (wr == 0) G_BAR;
      { const int r0 = cur.pm * BM + wr * 64 + fr, c0 = cur.pn * BM + wc * 32 + fq * 8; const int epi = cur.epi;
#define EPI_LOOP(MODE) { _Pragma("unroll") for (int ai = 0; ai < 2; ++ai) _Pragma("unroll") for (int m = 0; m < 4; ++m) _Pragma("unroll") for (int bj = 0; bj < 2; ++bj) \
          epi_frag8(p, MODE, E, r0 + ai * 128 + m * 16, c0 + bj * 128, acc[ai][bj][m][0], acc[ai][bj][m][1]); }
        if (epi == EPI_ADA) EPI_LOOP(EPI_ADA)
        else if (epi == EPI_BIAS) {
#pragma unroll
          for (int ai = 0; ai < 2; ++ai)
#pragma unroll
            for (int m = 0; m < 4; ++m) { const int r = r0 + ai * 128 + m * 16; if (r < NMOD) {
#pragma unroll
              for (int bj = 0; bj < 2; ++bj) { float* o = cur.ob + (size_t)r * cur.on + (c0 + bj * 128); *(f32x4*)o = acc[ai][bj][m][0]; *(f32x4*)(o + 4) = acc[ai][bj][m][1]; } } }
        } else if (epi == EPI_RESID) {
          const size_t mo = (size_t)modrow(r0) * MODW;
#pragma unroll
          for (int bj = 0; bj < 2; ++bj) { const int c = c0 + bj * 128;
            const f32x4 ga = *(const f32x4*)(E.f1 + mo + c), gb = *(const f32x4*)(E.f1 + mo + c + 4);
            f32x4 m0 = (f32x4){0.f, 0.f, 0.f, 0.f}, m1 = m0, k0 = m0, k1 = m0;
            if (E.yout) { const f32x4 g0 = *(const f32x4*)(E.ng + c), g1 = *(const f32x4*)(E.ng + c + 4), s0 = *(const f32x4*)(E.nsc + mo + c), s1 = *(const f32x4*)(E.nsc + mo + c + 4);
              m0 = g0 * (s0 + 1.f); m1 = g1 * (s1 + 1.f);
              if (E.ykv) { const f32x4 h0 = *(const f32x4*)(E.ngkv + c), h1 = *(const f32x4*)(E.ngkv + c + 4), t0 = *(const f32x4*)(E.nsckv + mo + c), t1 = *(const f32x4*)(E.nsckv + mo + c + 4);
                k0 = h0 * (t0 + 1.f); k1 = h1 * (t1 + 1.f); } }
#pragma unroll
            for (int ah = 0; ah < 2; ++ah) { const int ai = ah, mb = 0;
              f32x4 ya[4], yb[4];
              const float* xbase = E.first ? p->x_prompt : E.f0;
#pragma unroll
              for (int m = mb; m < mb + 4; ++m) { const unsigned off = (unsigned)(r0 + ai * 128 + m * 16) * (unsigned)D + (unsigned)c;
                ya[m] = *(const f32x4*)(xbase + off); yb[m] = *(const f32x4*)(xbase + off + 4); }
#pragma unroll
              for (int m = mb; m < mb + 4; ++m) { const int r = r0 + ai * 128 + m * 16; const unsigned off = (unsigned)r * (unsigned)D + (unsigned)c;
                const f32x4 xa = ya[m] + ga * acc[ai][bj][m][0], xb = yb[m] + gb * acc[ai][bj][m][1];
                *(f32x4*)(E.f0 + off) = xa; *(f32x4*)(E.f0 + off + 4) = xb;
                if (E.yout) { const f32x4 y0 = xa * m0, y1 = xb * m1;
                  *(u32x4*)(E.yout + off) = (u32x4){pk2(y0[0], y0[1]), pk2(y0[2], y0[3]), pk2(y1[0], y1[1]), pk2(y1[2], y1[3])};
                  if (E.ykv) { const f32x4 z0 = xa * k0, z1 = xb * k1;
                    *(u32x4*)(E.ykv + off) = (u32x4){pk2(z0[0], z0[1]), pk2(z0[2], z0[3]), pk2(z1[0], z1[1]), pk2(z1[2], z1[3])}; }
                  float ss = xa[0] * xa[0] + xa[1] * xa[1] + xa[2] * xa[2] + xa[3] * xa[3] + xb[0] * xb[0] + xb[1] * xb[1] + xb[2] * xb[2] + xb[3] * xb[3];
                  ss += __shfl_xor(ss, 16); ss += __shfl_xor(ss, 32);
                  if (fq == 0) atomicAdd(E.rss_out + (unsigned)r, ss); } } } }
        } else if (epi != EPI_NOP) {
          float rstd8[8];
#pragma unroll
          for (int q = 0; q < 8; ++q) rstd8[q] = rsqrtf(E.rss[r0 + (q >> 2) * 128 + (q & 3) * 16] * (1.f / D) + EPS);
          const float* bb = (epi == EPI_KVRAW) ? E.bias1 + (size_t)modrow(r0) * E.bN1 : E.bias + (size_t)modrow(r0) * E.bN;
          f32x4 bv[2][2], lbv[2][2];
#pragma unroll
          for (int bj = 0; bj < 2; ++bj) { const int c = c0 + bj * 128; bv[bj][0] = *(const f32x4*)(bb + c); bv[bj][1] = *(const f32x4*)(bb + c + 4);
            lbv[bj][0] = (f32x4){0.f, 0.f, 0.f, 0.f}; lbv[bj][1] = (f32x4){0.f, 0.f, 0.f, 0.f};
            if (epi == EPI_HGIN && (c >> 10) == 1 && E.layer == 1) { const int cc = c & 1023;
              const f32x4 l0 = *(const f32x4*)(p->hg_lbp + cc), l1 = *(const f32x4*)(p->hg_lbp + D + cc), l2 = *(const f32x4*)(p->hg_lbp + cc + 4), l3 = *(const f32x4*)(p->hg_lbp + D + cc + 4);
#pragma unroll
              for (int jj = 0; jj < 4; ++jj) { lbv[bj][0][jj] = __builtin_amdgcn_rcpf(1.f + __expf(l0[jj] - l1[jj])); lbv[bj][1][jj] = __builtin_amdgcn_rcpf(1.f + __expf(l2[jj] - l3[jj])); } } }
#define CONS_LOOP(MODE) { _Pragma("unroll") for (int ai = 0; ai < 2; ++ai) _Pragma("unroll") for (int m = 0; m < 4; ++m) _Pragma("unroll") for (int bj = 0; bj < 2; ++bj) \
            epi_frag8(p, MODE, E, r0 + ai * 128 + m * 16, c0 + bj * 128, acc[ai][bj][m][0] * rstd8[ai * 4 + m] + bv[bj][0], acc[ai][bj][m][1] * rstd8[ai * 4 + m] + bv[bj][1], lbv[bj][0], lbv[bj][1]); }
          if (epi == EPI_HGIN) CONS_LOOP(EPI_HGIN) else if (epi == EPI_UP) CONS_LOOP(EPI_UP) else if (epi == EPI_QRAW) CONS_LOOP(EPI_QRAW) else CONS_LOOP(EPI_KVRAW)
        }
      }
      if (!has_next) break;
#pragma unroll
      for (int a = 0; a < 2; ++a)
#pragma unroll
        for (int b = 0; b < 2; ++b)
#pragma unroll
          for (int m = 0; m < 4; ++m)
#pragma unroll
            for (int n = 0; n < 2; ++n) acc[a][b][m][n] = (f32x4){0.f, 0.f, 0.f, 0.f};
      cur = nxt; cA = nA; cB = nB; L = Ln;
      if (wr == 1) G_BAR;
    }
    G_WAIT_V(0);
    G_BAR;
  }
  if (skinny) {
    __syncthreads();
    const int u0 = j0.nN * 16, u1 = (njobs > 1) ? j1.nN * 16 : 0;
#pragma unroll 1
    for (int u = (int)gridDim.x - 1 - (int)blockIdx.x; u < u0 + u1; u += gridDim.x) {
      const bool second = (u >= u0);
      skinny_unit(p, shm, second ? j1.A : j0.A, second ? j1.Bt : j0.Bt, second ? j1.K : j0.K, (second ? u - u0 : u) * 16, second ? j1.epi : j0.epi, E);
    }
  }
}

__device__ const float INVF[32] = {1.000000000e+00f, 7.498942614e-01f, 5.623413324e-01f, 4.216965139e-01f, 3.162277639e-01f, 2.371373773e-01f, 1.778279394e-01f, 1.333521307e-01f, 1.000000015e-01f, 7.498941571e-02f, 5.623413250e-02f, 4.216965288e-02f, 3.162277490e-02f, 2.371373773e-02f, 1.778279431e-02f, 1.333521493e-02f, 9.999999776e-03f, 7.498941850e-03f, 5.623413250e-03f, 4.216964822e-03f, 3.162277630e-03f, 2.371373586e-03f, 1.778279431e-03f, 1.333521446e-03f, 1.000000047e-03f, 7.498942432e-04f, 5.623413017e-04f, 4.216965172e-04f, 3.162277571e-04f, 2.371373703e-04f, 1.778279402e-04f, 1.333521504e-04f};
DI void transpose_item(const float* W, int K, int N, bf16_t* WT, int row_off, float* scr, int item, int lane) {
  const int nblk = N / 32, kb = item / nblk, nb = item % nblk, k0 = 64 * kb, n0 = 32 * nb;
#pragma unroll 8
  for (int i = 0; i < 32; ++i) { const int kk = 2 * i + (lane >> 5); scr[kk * 33 + (lane & 31)] = W[(size_t)(k0 + kk) * N + n0 + (lane & 31)]; }
  asm volatile("s_waitcnt lgkmcnt(0)" ::: "memory");
  const int c = lane & 7;
#pragma unroll
  for (int j = 0; j < 4; ++j) { const int n = (lane >> 3) + 8 * j; const float* s = scr + (8 * c) * 33 + n;
    u32x4 o; o.x = pk2(s[0 * 33], s[1 * 33]); o.y = pk2(s[2 * 33], s[3 * 33]); o.z = pk2(s[4 * 33], s[5 * 33]); o.w = pk2(s[6 * 33], s[7 * 33]);
    *(u32x4*)(WT + (size_t)(row_off + n0 + n) * K + k0 + 8 * c) = o; }
  asm volatile("s_waitcnt lgkmcnt(0)" ::: "memory");
}

DI void prep_phase(KP p, unsigned char* shm) {
  const int tid = tid_get(), lane = tid & 63, wave = tid >> 6;
  const int gw = blockIdx.x * NWAVES + wave, NGW = gridDim.x * NWAVES;
  float* scr = (float*)(shm + wave * 16384);
  unsigned char* ws = p->ws;
  int base = 0;
  for (int mi = 0; mi < 22; ++mi) {
    const float* W; int K, N, row_off; bf16_t* WT;
    if (mi < 2) { W = p->hg_w_in + (size_t)mi * D * 4096; K = D; N = 4096; WT = (bf16_t*)(ws + OFF_WIN) + (size_t)mi * 4096 * D; row_off = 0; }
    else if (mi < 4) { W = p->hg_w_out + (size_t)(mi - 2) * D * D; K = D; N = D; WT = (bf16_t*)(ws + OFF_WOUT) + (size_t)(mi - 2) * D * D; row_off = 0; }
    else if (mi < 5) { W = p->w_kv; K = D; N = 512; WT = (bf16_t*)(ws + OFF_WKV); row_off = 0; }
    else if (mi < 7) { W = p->w_q + (size_t)(mi - 5) * D * D; K = D; N = D; WT = (bf16_t*)(ws + OFF_WQ) + (size_t)(mi - 5) * D * D; row_off = 0; }
    else if (mi < 9) { W = p->w_o + (size_t)(mi - 7) * D * D; K = D; N = D; WT = (bf16_t*)(ws + OFF_WO) + (size_t)(mi - 7) * D * D; row_off = 0; }
    else if (mi < 13) { W = p->w_up + (size_t)(mi - 9) * D * FF; K = D; N = FF; WT = (bf16_t*)(ws + OFF_WUP) + (size_t)(mi - 9) * D * FF; row_off = 0; }
    else if (mi < 17) { W = p->w_down + (size_t)(mi - 13) * D * FF; K = FF; N = D; WT = (bf16_t*)(ws + OFF_WDN) + (size_t)(mi - 13) * D * FF; row_off = 0; }
    else if (mi < 21) { W = p->w_ada + (size_t)(mi - 17) * D * 6144; K = D; N = 6144; WT = (bf16_t*)(ws + OFF_X); row_off = (mi - 17) * 6144; }
    else { W = p->kv_w_ada; K = D; N = 2048; WT = (bf16_t*)(ws + OFF_X); row_off = 24576; }
    const int nitems = (K / 64) * (N / 32);
    int first = (gw - (base % NGW) + NGW) % NGW;
    for (int it = first; it < nitems; it += NGW) transpose_item(W, K, N, WT, row_off, scr, it, lane);
    base += nitems;
  }
  bf16_t* Ac = (bf16_t*)(ws + OFF_X + (size_t)MODW * D * 2);
  const int gt = blockIdx.x * NTHREADS + tid, NGT = gridDim.x * NTHREADS;
  for (int e = gt; e < 256 * D / 2; e += NGT) { const int r = e / (D / 2), c = (e % (D / 2)) * 2; float a = 0.f, b = 0.f;
    if (r < NMOD) { const float* cp = (r < 4) ? p->c_prompt + (size_t)r * D : p->c_sample + (size_t)(r - 4) * D; a = silu_f(cp[c]); b = silu_f(cp[c + 1]); }
    *(unsigned*)(Ac + (size_t)r * D + c) = pk2(a, b); }
  float* tab = (float*)(ws + OFF_TAB);
  for (int e = gt; e < 4097 * 32; e += NGT) { const int pi = e >> 5, i = e & 31; const float pos = (pi < 4096) ? (float)pi : 8192.f;
    const float ang = pos * INVF[i]; float sn, cs; sincosf(ang, &sn, &cs);
    tab[pi * 64 + i] = cs; tab[pi * 64 + 32 + i] = sn; }
}

DI void init_rows(KP p, unsigned* ctr) {
  const int tid = tid_get(); const int lane = tid & 63;
  unsigned char* ws = p->ws; const float* mods = (const float*)(ws + OFF_MODS); bf16_t* yout = (bf16_t*)(ws + OFF_H); float* rss = (float*)(ws + OFF_RSS);
  const float* g = p->norm1_g; const float* msc = mods + 1024;
#pragma unroll 1
  for (;;) {
    unsigned cidx = 0; if (lane == 0) cidx = __hip_atomic_fetch_add(ctr, 1u, __ATOMIC_RELAXED, __HIP_MEMORY_SCOPE_AGENT);
    cidx = __builtin_amdgcn_readfirstlane(cidx);
    if (cidx >= (unsigned)(T / 8)) break;
#pragma unroll 1
    for (int hh = 0; hh < 2; ++hh) { const int rb = (int)cidx * 8 + hh * 4;
      f32x4 v[4][4];
#pragma unroll
      for (int q = 0; q < 4; ++q) { const int r = rb + q; const float* xr = (r < TP) ? p->x_prompt + (size_t)r * D : p->x_sample + (size_t)(r - TP) * D;
#pragma unroll
        for (int jj = 0; jj < 4; ++jj) v[q][jj] = *(const f32x4*)(xr + lane * 4 + 256 * jj); }
#pragma unroll
      for (int q = 0; q < 4; ++q) { const int r = rb + q; float a = 0.f;
#pragma unroll
        for (int jj = 0; jj < 4; ++jj) a += v[q][jj][0] * v[q][jj][0] + v[q][jj][1] * v[q][jj][1] + v[q][jj][2] * v[q][jj][2] + v[q][jj][3] * v[q][jj][3];
#pragma unroll
        for (int o = 1; o < 64; o <<= 1) a += __shfl_xor(a, o);
        if (lane == 0) rss[r] = a;
        const size_t mo = (size_t)modrow(r) * MODW;
#pragma unroll
        for (int jj = 0; jj < 4; ++jj) { const int c = lane * 4 + 256 * jj;
          const f32x4 gg = *(const f32x4*)(g + c), sc = *(const f32x4*)(msc + mo + c);
          const f32x4 h = v[q][jj] * gg * (sc + 1.f);
          *(u32x2*)(yout + (size_t)r * D + c) = (u32x2){pk2(h[0], h[1]), pk2(h[2], h[3])}; } } }
  }
}

struct HgBufs { const bf16_t *q, *k, *v, *g; const float* lf; float* o32; bf16_t* on; };

constexpr int SPAN = 256, NSPAN = SEQ / SPAN, CH = 32, NCH = SPAN / CH;
constexpr int L_CUM = 0, L_QT = 16896, L_KT = 25600, L_KE = 34304, L_VT = 44544, L_PS = 54784, L_DEC = 55808, L_HALF = 57344;
constexpr int CUS = 132, QS = 136, KES = 40;
DI bf16x8 pack8(const f32x16& x, const int s) {
  return __builtin_bit_cast(bf16x8, (u32x4){pk2(x[8 * s], x[8 * s + 1]), pk2(x[8 * s + 2], x[8 * s + 3]), pk2(x[8 * s + 4], x[8 * s + 5]), pk2(x[8 * s + 6], x[8 * s + 7])});
}
template <int MODE>
DI void scan_prompt(KP p, const int l, const HgBufs& B, unsigned char* shm) {
  const int tid = tid_get(), lane = tid & 63, wave = tid >> 6, hb = wave >> 2, th = tid & 255, vb = wave & 3, h5 = lane >> 5, l31 = lane & 31;
  unsigned char* base = shm + hb * L_HALF;
  float* cumb = (float*)(base + L_CUM); bf16_t* Qt = (bf16_t*)(base + L_QT); bf16_t* Kt = (bf16_t*)(base + L_KT);
  bf16_t* KeT = (bf16_t*)(base + L_KE); bf16_t* Vt = (bf16_t*)(base + L_VT); float* psum = (float*)(base + L_PS); float* dec = (float*)(base + L_DEC);
  float* dS = B.o32; float* Lsum = B.o32 + (size_t)512 * 16384;
#pragma unroll 1
  for (int it0 = blockIdx.x * 2; it0 < 32 * NSPAN; it0 += gridDim.x * 2) {
    const int item = it0 + hb, bh = item / NSPAN, span = item % NSPAN, b = bh >> 3, h = bh & 7;
    f32x16 S[4];
#pragma unroll
    for (int db = 0; db < 4; ++db)
#pragma unroll
      for (int r = 0; r < 16; ++r) S[db][r] = 0.f;
    if (MODE == 1) {
      const unsigned ob = (unsigned)item * 16384u + (unsigned)(vb * 32 + l31) + (unsigned)(4 * h5) * 128u;
#pragma unroll
      for (int db = 0; db < 4; ++db) {
#pragma unroll
        for (int r = 0; r < 16; ++r) S[db][r] = dS[ob + (unsigned)((32 * db + (r & 3) + 8 * (r >> 2)) * 128)];
        __builtin_amdgcn_sched_barrier(0); }
    }
    float Ltot = 0.f;
#define LBAR() do { asm volatile("s_waitcnt lgkmcnt(0)" ::: "memory"); __builtin_amdgcn_s_barrier(); asm volatile("" ::: "memory"); } while (0)
    const int d1 = th & 127, part = th >> 7, t2 = th >> 3, dg = th & 7;
    const size_t tokS = (size_t)b * SEQ + (size_t)span * SPAN;
    float lfr[16]; unsigned kr[16], vr[16]; u32x4 q0, q1, k0, k1, g0, g1;
#define SCAN_LOAD(chx) do { const size_t o0_ = (tokS + (size_t)(chx) * CH + part * 16) * D + h * 128 + d1; \
      _Pragma("unroll") for (int i = 0; i < 16; ++i) { lfr[i] = B.lf[o0_ + (size_t)i * D]; kr[i] = B.k[o0_ + (size_t)i * D]; vr[i] = B.v[o0_ + (size_t)i * D]; } \
      } while (0)
    __builtin_amdgcn_sched_barrier(0);
    SCAN_LOAD(0);
    __builtin_amdgcn_sched_barrier(0);
#pragma unroll 1
    for (int ch = 0; ch < NCH; ++ch) {
      const size_t tok0 = tokS + (size_t)ch * CH;
      if (MODE == 1) { const size_t o_ = (tok0 + t2) * D + h * 128 + dg * 16;
        q0 = *(const u32x4*)(B.q + o_); q1 = *(const u32x4*)(B.q + o_ + 8); k0 = *(const u32x4*)(B.k + o_); k1 = *(const u32x4*)(B.k + o_ + 8);
        g0 = *(const u32x4*)(B.g + o_); g1 = *(const u32x4*)(B.g + o_ + 8); }
      { const int d = d1;
        float c[16]; float run = 0.f;
#pragma unroll
        for (int i = 0; i < 16; ++i) { run += lfr[i]; c[i] = run; }
        psum[part * 128 + d] = run;
        LBAR();
        const float t0 = psum[d], t1 = psum[128 + d]; const float off = part ? t0 : 0.f; const float Lc = t0 + t1;
        float ke[16];
#pragma unroll
        for (int i = 0; i < 16; ++i) { const float cu = off + c[i]; if (MODE == 1) cumb[(part * 16 + i) * CUS + d] = cu; ke[i] = bf2f(kr[i]) * __expf(Lc - cu); }
        *(u32x4*)(KeT + d * KES + part * 16) = (u32x4){pk2(ke[0], ke[1]), pk2(ke[2], ke[3]), pk2(ke[4], ke[5]), pk2(ke[6], ke[7])};
        *(u32x4*)(KeT + d * KES + part * 16 + 8) = (u32x4){pk2(ke[8], ke[9]), pk2(ke[10], ke[11]), pk2(ke[12], ke[13]), pk2(ke[14], ke[15])};
        *(u32x4*)(Vt + d * KES + part * 16) = (u32x4){vr[0] | (vr[1] << 16), vr[2] | (vr[3] << 16), vr[4] | (vr[5] << 16), vr[6] | (vr[7] << 16)};
        *(u32x4*)(Vt + d * KES + part * 16 + 8) = (u32x4){vr[8] | (vr[9] << 16), vr[10] | (vr[11] << 16), vr[12] | (vr[13] << 16), vr[14] | (vr[15] << 16)};
        if (part == 0) { dec[d] = __expf(Lc); Ltot += Lc; }
      }
      LBAR();
      if (MODE == 1) {
        const int t = t2;
        unsigned qo[8], ko[8];
#pragma unroll
        for (int g4 = 0; g4 < 4; ++g4) { const f32x4 cv = *(const f32x4*)(cumb + t * CUS + dg * 16 + 4 * g4);
#pragma unroll
          for (int e2 = 0; e2 < 2; ++e2) { const int w = g4 * 2 + e2; const unsigned qw = (w < 4) ? q0[w & 3] : q1[w & 3], kw = (w < 4) ? k0[w & 3] : k1[w & 3];
            const float ca = cv[2 * e2], cb = cv[2 * e2 + 1];
            qo[w] = pk2(bf2f(qw & 0xffffu) * __expf(ca), bf2f(qw >> 16) * __expf(cb));
            ko[w] = pk2(bf2f(kw & 0xffffu) * __expf(fminf(-ca, 80.f)), bf2f(kw >> 16) * __expf(fminf(-cb, 80.f))); } }
        *(u32x4*)(Qt + t * QS + dg * 16) = (u32x4){qo[0], qo[1], qo[2], qo[3]}; *(u32x4*)(Qt + t * QS + dg * 16 + 8) = (u32x4){qo[4], qo[5], qo[6], qo[7]};
        *(u32x4*)(Kt + t * QS + dg * 16) = (u32x4){ko[0], ko[1], ko[2], ko[3]}; *(u32x4*)(Kt + t * QS + dg * 16 + 8) = (u32x4){ko[4], ko[5], ko[6], ko[7]};
        LBAR();
      }
      { const int chn = (ch + 1 < NCH) ? ch + 1 : ch; SCAN_LOAD(chn); }
      f32x16 O;
      if (MODE == 1) {
        f32x16 X;
#pragma unroll
        for (int r = 0; r < 16; ++r) { X[r] = 0.f; O[r] = 0.f; }
#pragma unroll
        for (int ks = 0; ks < 8; ++ks) { const bf16x8 a = *(const bf16x8*)(Kt + l31 * QS + 16 * ks + 8 * h5), bq = *(const bf16x8*)(Qt + l31 * QS + 16 * ks + 8 * h5);
          X = __builtin_amdgcn_mfma_f32_32x32x16_bf16(a, bq, X, 0, 0, 0); }
#pragma unroll
        for (int r = 0; r < 16; ++r) if (crow(r, h5) > l31) X[r] = 0.f;
#pragma unroll
        for (int st = 0; st < 2; ++st) { const bf16_t* vp = Vt + (vb * 32 + l31) * KES + 16 * st + 4 * h5; const u32x2 lo = *(const u32x2*)vp, hi = *(const u32x2*)(vp + 8);
          O = __builtin_amdgcn_mfma_f32_32x32x16_bf16(pack8(X, st), __builtin_bit_cast(bf16x8, (u32x4){lo[0], lo[1], hi[0], hi[1]}), O, 0, 0, 0); }
#pragma unroll
        for (int db = 0; db < 4; ++db)
#pragma unroll
          for (int st = 0; st < 2; ++st) { const bf16_t* qp = Qt + l31 * QS + 32 * db + 16 * st + 4 * h5; const u32x2 lo = *(const u32x2*)qp, hi = *(const u32x2*)(qp + 8);
            O = __builtin_amdgcn_mfma_f32_32x32x16_bf16(__builtin_bit_cast(bf16x8, (u32x4){lo[0], lo[1], hi[0], hi[1]}), pack8(S[db], st), O, 0, 0, 0); }
      }
#pragma unroll
      for (int db = 0; db < 4; ++db) {
#pragma unroll
        for (int r4 = 0; r4 < 4; ++r4) { const f32x4 dv = *(const f32x4*)(dec + 32 * db + 8 * r4 + 4 * h5);
#pragma unroll
          for (int e = 0; e < 4; ++e) S[db][4 * r4 + e] *= dv[e]; }
#pragma unroll
        for (int st = 0; st < 2; ++st) { const bf16x8 a = *(const bf16x8*)(KeT + (32 * db + l31) * KES + 16 * st + 8 * h5), bv = *(const bf16x8*)(Vt + (vb * 32 + l31) * KES + 16 * st + 8 * h5);
          S[db] = __builtin_amdgcn_mfma_f32_32x32x16_bf16(a, bv, S[db], 0, 0, 0); } }
      if (MODE == 1) {
#pragma unroll
        for (int r = 0; r < 16; ++r) cumb[crow(r, h5) * CUS + vb * 32 + l31] = O[r];
        LBAR();
        const int t = t2, vg = dg; const size_t o = (tok0 + t) * D + h * 128 + vg * 16;
        f32x4 ov[4]; float ss = 0.f;
#pragma unroll
        for (int g4 = 0; g4 < 4; ++g4) { ov[g4] = *(const f32x4*)(cumb + t * CUS + vg * 16 + 4 * g4); ss += ov[g4][0] * ov[g4][0] + ov[g4][1] * ov[g4][1] + ov[g4][2] * ov[g4][2] + ov[g4][3] * ov[g4][3]; }
        ss += __shfl_xor(ss, 1); ss += __shfl_xor(ss, 2); ss += __shfl_xor(ss, 4);
        const float rstd = rsqrtf(ss * (1.f / 128.f) + EPS);
        unsigned w[8];
#pragma unroll
        for (int g4 = 0; g4 < 4; ++g4) { const f32x4 gn = *(const f32x4*)(p->hg_gn_g + l * 128 + vg * 16 + 4 * g4);
#pragma unroll
          for (int e2 = 0; e2 < 2; ++e2) { const int wi = g4 * 2 + e2; const unsigned gw = (wi < 4) ? g0[wi & 3] : g1[wi & 3];
            w[wi] = pk2(ov[g4][2 * e2] * rstd * gn[2 * e2] * bf2f(gw & 0xffffu), ov[g4][2 * e2 + 1] * rstd * gn[2 * e2 + 1] * bf2f(gw >> 16)); } }
        *(u32x4*)(B.on + o) = (u32x4){w[0], w[1], w[2], w[3]}; *(u32x4*)(B.on + o + 8) = (u32x4){w[4], w[5], w[6], w[7]};
      } else {
        LBAR();
      }
    }
    if (MODE == 0) {
      float* dSo = dS + (size_t)item * 16384 + vb * 32 + l31;
#pragma unroll
      for (int db = 0; db < 4; ++db)
#pragma unroll
        for (int r = 0; r < 16; ++r) dSo[(size_t)(32 * db + crow(r, h5)) * 128] = S[db][r];
      if (th < 128) Lsum[(size_t)item * 128 + th] = Ltot;
    } else if (span == NSPAN - 1) {
      float* so = p->out + O_HGP + ((size_t)((l * 4 + b) * 8 + h)) * 16384 + vb * 32 + l31;
#pragma unroll
      for (int db = 0; db < 4; ++db)
#pragma unroll
        for (int r = 0; r < 16; ++r) so[(size_t)(32 * db + crow(r, h5)) * 128] = S[db][r];
    }
    __syncthreads();
  }
}

DI void scan_passB(const HgBufs& B) {
  const int tid = tid_get();
  float* dS = B.o32; const float* Lsum = B.o32 + (size_t)512 * 16384;
  const int gt = blockIdx.x * NTHREADS + tid, NGT = gridDim.x * NTHREADS;
#pragma unroll 1
  for (int e = gt; e < 32 * 4096; e += NGT) { const int bh = e >> 12, q4 = e & 4095, d = q4 >> 5;
    float* base = dS + (size_t)bh * NSPAN * 16384 + (size_t)q4 * 4; const float* Lb = Lsum + (size_t)bh * NSPAN * 128 + d;
    f32x4 v[NSPAN]; float lv[NSPAN];
#pragma unroll
    for (int sp = 0; sp < NSPAN; ++sp) { v[sp] = *(const f32x4*)(base + (size_t)sp * 16384); lv[sp] = Lb[sp * 128]; }
    f32x4 run = (f32x4){0.f, 0.f, 0.f, 0.f};
#pragma unroll
    for (int sp = 0; sp < NSPAN; ++sp) { *(f32x4*)(base + (size_t)sp * 16384) = run; run = run * __expf(lv[sp]) + v[sp]; }
  }
}

DI void scan_phase(KP p, const int l, const HgBufs& B, unsigned char* shm) {
  scan_prompt<0>(p, l, B, shm);
  const int tid = tid_get(), lane = tid & 63, wave = tid >> 6;
  {
    float* ps = (float*)shm;
    const int v4 = (tid & 31) * 4, dq = tid >> 5;
    f32x4 sv[8], svn[8]; float lfv[8], lfn[8]; unsigned kq[8], kqn[8]; u32x2 vw, vwn;
#define SMP_LOAD(IT, SV, LF, KQ, VW) do { const int bs_ = (IT) >> 3, h_ = (IT) & 7; const size_t r_ = TP + bs_; \
      const float* s0_ = p->state_hgrn + ((size_t)((l * 128 + bs_) * 8 + h_)) * 16384; \
      VW = *(const u32x2*)(B.v + r_ * D + h_ * 128 + v4); \
      _Pragma("unroll") for (int i = 0; i < 8; ++i) { const int d_ = dq * 8 + i; const size_t o_ = r_ * D + h_ * 128 + d_; \
        LF[i] = B.lf[o_]; KQ[i] = (unsigned)B.k[o_] | ((unsigned)B.q[o_] << 16); SV[i] = __builtin_nontemporal_load((const f32x4*)(s0_ + d_ * 128 + v4)); } } while (0)
    int item = blockIdx.x, par = 0;
    if (item < 1024) SMP_LOAD(item, sv, lfv, kq, vw);
#pragma unroll 1
    for (; item < 1024; item += gridDim.x, par ^= 1) {
      const int bs = item >> 3, h = item & 7; const size_t r = TP + bs;
      const int nitem = item + gridDim.x;
      if (nitem < 1024) SMP_LOAD(nitem, svn, lfn, kqn, vwn);
      float* s1 = p->out + O_HGS + ((size_t)((l * 128 + bs) * 8 + h)) * 16384;
      const f32x4 vv = (f32x4){bf2f(vw[0] & 0xffffu), bf2f(vw[0] >> 16), bf2f(vw[1] & 0xffffu), bf2f(vw[1] >> 16)};
      f32x4 op = (f32x4){0.f, 0.f, 0.f, 0.f};
#pragma unroll
      for (int i = 0; i < 8; ++i) { const int d = dq * 8 + i;
        const float f = __expf(lfv[i]), kk = bf2f(kq[i] & 0xffffu), qq = bf2f(kq[i] >> 16);
        const f32x4 sn = sv[i] * f + vv * kk;
        __builtin_nontemporal_store(sn, (f32x4*)(s1 + d * 128 + v4)); op += sn * qq; }
#pragma unroll
      for (int jx = 0; jx < 4; ++jx) op[jx] += __shfl_xor(op[jx], 32);
      float* psb = ps + par * 1024;
      if (lane < 32) *(f32x4*)(psb + wave * 128 + v4) = op;
      __syncthreads();
      if (tid < 64) { float o0 = 0.f, o1 = 0.f;
#pragma unroll
        for (int w = 0; w < 8; ++w) { const f32x2 x = *(const f32x2*)(psb + w * 128 + tid * 2); o0 += x[0]; o1 += x[1]; }
        float ss = o0 * o0 + o1 * o1;
#pragma unroll
        for (int o = 1; o < 64; o <<= 1) ss += __shfl_xor(ss, o);
        const float rstd = rsqrtf(ss * (1.f / 128.f) + EPS);
        const int vv2 = tid * 2; const size_t o = r * D + h * 128 + vv2;
        const float g0 = p->hg_gn_g[l * 128 + vv2], g1 = p->hg_gn_g[l * 128 + vv2 + 1];
        *(unsigned*)(B.on + o) = pk2(o0 * rstd * g0 * bf2f(B.g[o]), o1 * rstd * g1 * bf2f(B.g[o + 1])); }
#pragma unroll
      for (int i = 0; i < 8; ++i) { sv[i] = svn[i]; lfv[i] = lfn[i]; kq[i] = kqn[i]; }
      vw = vwn;
    }
    __syncthreads();
  }
}

DI void onorm_phase(KP p, const int l, const HgBufs& B) {
  const int tid = tid_get(); const int lane = tid & 63, wave = tid >> 6;
  const int gw = blockIdx.x * NWAVES + wave, NGW = gridDim.x * NWAVES;
  for (int r = gw; r < TP; r += NGW) {
#pragma unroll
    for (int j = 0; j < 4; ++j) { const int c = lane * 4 + 256 * j; const size_t o = (size_t)r * D + c;
      const f32x4 v = *(const f32x4*)(B.o32 + o); float s = v[0] * v[0] + v[1] * v[1] + v[2] * v[2] + v[3] * v[3];
#pragma unroll
      for (int x = 1; x < 32; x <<= 1) s += __shfl_xor(s, x);
      const float rstd = rsqrtf(s * (1.f / 128.f) + EPS);
      const f32x4 gg = *(const f32x4*)(p->hg_gn_g + l * 128 + (c & 127));
      const u32x2 gt = *(const u32x2*)(B.g + o);
      const float g0 = bf2f(gt[0] & 0xffffu), g1 = bf2f(gt[0] >> 16), g2 = bf2f(gt[1] & 0xffffu), g3 = bf2f(gt[1] >> 16);
      *(u32x2*)(B.on + o) = (u32x2){pk2(v[0] * rstd * gg[0] * g0, v[1] * rstd * gg[1] * g1), pk2(v[2] * rstd * gg[2] * g2, v[3] * rstd * gg[3] * g3)}; }
  }
}

constexpr int KN_STRIDE = 72, VT_STRIDE = 264;
constexpr int KN_BYTES = 256 * KN_STRIDE * 2;
struct AtBufs { const bf16_t* qraw; const float* kvraw; bf16_t* on; const float* tab; };

DI void attn_phase(KP p, const int l, const AtBufs& B, unsigned char* shm) {
  const int tid = tid_get(), lane = tid & 63, wave = tid >> 6;
  const int j = l - 2;
  const float* qg = p->q_norm_g + j * 64; const float* sinkp = p->sinks + j * 16;
  const bool write_cache = (l == 2);
  const int nitems = 512 + 512;
#pragma unroll 1
  for (int item = blockIdx.x; item < 512; item += gridDim.x) {
    {
      const int b = item >> 7, qb = (item >> 2) & 31, kvh = item & 3;
      bf16_t* Kn = (bf16_t*)shm; bf16_t* Vt = (bf16_t*)(shm + KN_BYTES);
      const int band0 = (qb - 1) * 128;
      {
        const int key = tid >> 1, part = tid & 1; const int pos = band0 + key; const bool valid = pos >= 0;
        float x1[16], x2[16];
        if (valid) { const float* kp = B.kvraw + ((size_t)b * SEQ + pos) * 512 + kvh * 64 + part * 16;
#pragma unroll
          for (int i = 0; i < 4; ++i) { const f32x4 a = *(const f32x4*)(kp + 4 * i), c = *(const f32x4*)(kp + 32 + 4 * i);
#pragma unroll
            for (int e = 0; e < 4; ++e) { x1[4 * i + e] = a[e]; x2[4 * i + e] = c[e]; } }
        } else {
#pragma unroll
          for (int i = 0; i < 16; ++i) { x1[i] = 0.f; x2[i] = 0.f; } }
        float ss = 0.f;
#pragma unroll
        for (int i = 0; i < 16; ++i) ss += x1[i] * x1[i] + x2[i] * x2[i];
        ss += __shfl_xor(ss, 1);
        const float rstd = rsqrtf(ss * (1.f / 64.f) + EPS);
        const float* tb = B.tab + (size_t)(valid ? pos : 0) * 64 + part * 16;
        float o1[16], o2[16];
#pragma unroll
        for (int i = 0; i < 16; ++i) { const float a = x1[i] * rstd * p->k_norm_g[part * 16 + i], c = x2[i] * rstd * p->k_norm_g[32 + part * 16 + i];
          const float cs = tb[i], sn = tb[32 + i]; o1[i] = a * cs - c * sn; o2[i] = c * cs + a * sn; }
        u32x4 w;
        w = (u32x4){pk2(o1[0], o1[1]), pk2(o1[2], o1[3]), pk2(o1[4], o1[5]), pk2(o1[6], o1[7])}; *(u32x4*)(Kn + key * KN_STRIDE + part * 16) = w;
        w = (u32x4){pk2(o1[8], o1[9]), pk2(o1[10], o1[11]), pk2(o1[12], o1[13]), pk2(o1[14], o1[15])}; *(u32x4*)(Kn + key * KN_STRIDE + part * 16 + 8) = w;
        w = (u32x4){pk2(o2[0], o2[1]), pk2(o2[2], o2[3]), pk2(o2[4], o2[5]), pk2(o2[6], o2[7])}; *(u32x4*)(Kn + key * KN_STRIDE + 32 + part * 16) = w;
        w = (u32x4){pk2(o2[8], o2[9]), pk2(o2[10], o2[11]), pk2(o2[12], o2[13]), pk2(o2[14], o2[15])}; *(u32x4*)(Kn + key * KN_STRIDE + 32 + part * 16 + 8) = w;
        if (write_cache && qb == 31 && key >= 128) { float* ko = p->out + O_KP + ((size_t)(b * 128 + key - 128) * 4 + kvh) * 64 + part * 16;
#pragma unroll
          for (int i = 0; i < 4; ++i) { *(f32x4*)(ko + 4 * i) = (f32x4){o1[4 * i], o1[4 * i + 1], o1[4 * i + 2], o1[4 * i + 3]};
            *(f32x4*)(ko + 32 + 4 * i) = (f32x4){o2[4 * i], o2[4 * i + 1], o2[4 * i + 2], o2[4 * i + 3]}; } }
      }
      {
        const int key = tid & 255, dh = tid >> 8; const int pos = band0 + key; const bool valid = pos >= 0;
        const float* vp = B.kvraw + ((size_t)b * SEQ + (valid ? pos : 0)) * 512 + 256 + kvh * 64 + dh * 32;
#pragma unroll
        for (int i = 0; i < 8; ++i) { f32x4 a = *(const f32x4*)(vp + 4 * i); if (!valid) a = (f32x4){0.f, 0.f, 0.f, 0.f};
#pragma unroll
          for (int e = 0; e < 4; ++e) Vt[(dh * 32 + 4 * i + e) * VT_STRIDE + key] = (bf16_t)f2bf(a[e]);
          if (write_cache && qb == 31 && key >= 128) *(f32x4*)(p->out + O_VP + ((size_t)(b * 128 + key - 128) * 4 + kvh) * 64 + dh * 32 + 4 * i) = a; }
      }
      __syncthreads();
      const int g = wave & 3, qhalf = wave >> 2, hq = kvh * 4 + g, h = lane >> 5, l31 = lane & 31;
      const float sink = sinkp[hq];
#pragma unroll 1
      for (int sub = 0; sub < 2; ++sub) {
        const int Q0 = 128 + qhalf * 64 + sub * 32, qi = Q0 + l31, pos = band0 + qi;
        const size_t tok = (size_t)b * SEQ + pos;
        float x[4][8];
        { const bf16_t* qp = B.qraw + tok * D + hq * 64 + 8 * h;
#pragma unroll
          for (int s = 0; s < 4; ++s) { const u32x4 w = *(const u32x4*)(qp + 16 * s);
#pragma unroll
            for (int e = 0; e < 4; ++e) { x[s][2 * e] = bf2f(w[e] & 0xffffu); x[s][2 * e + 1] = bf2f(w[e] >> 16); } } }
        float ss = 0.f;
#pragma unroll
        for (int s = 0; s < 4; ++s)
#pragma unroll
          for (int e = 0; e < 8; ++e) ss += x[s][e] * x[s][e];
        ss += __shfl_xor(ss, 32);
        const float rstd = rsqrtf(ss * (1.f / 64.f) + EPS) ;
#pragma unroll
        for (int s = 0; s < 4; ++s)
#pragma unroll
          for (int e = 0; e < 8; ++e) x[s][e] *= rstd * qg[16 * s + 8 * h + e];
        const float* tb = B.tab + (size_t)pos * 64;
        bf16x8 qf[4];
#pragma unroll
        for (int s = 0; s < 2; ++s) { unsigned lo[4], hi[4]; float r1[8], r2[8];
#pragma unroll
          for (int e = 0; e < 8; ++e) { const int i = 16 * s + 8 * h + e; const float cs = tb[i], sn = tb[32 + i]; const float a = x[s][e], c = x[s + 2][e];
            r1[e] = (a * cs - c * sn) * 0.125f; r2[e] = (c * cs + a * sn) * 0.125f; }
#pragma unroll
          for (int e = 0; e < 4; ++e) { lo[e] = pk2(r1[2 * e], r1[2 * e + 1]); hi[e] = pk2(r2[2 * e], r2[2 * e + 1]); }
          qf[s] = __builtin_bit_cast(bf16x8, (u32x4){lo[0], lo[1], lo[2], lo[3]}); qf[s + 2] = __builtin_bit_cast(bf16x8, (u32x4){hi[0], hi[1], hi[2], hi[3]}); }
        const int kb0 = (Q0 - 128) >> 5;
        f32x16 sacc[5]; float mx = sink;
#pragma unroll
        for (int i = 0; i < 5; ++i) { const int kb = kb0 + i; f32x16 a16;
#pragma unroll
          for (int r = 0; r < 16; ++r) a16[r] = 0.f;
          bf16x8 ka[4];
#pragma unroll
          for (int s = 0; s < 4; ++s) ka[s] = *(const bf16x8*)(Kn + (kb * 32 + l31) * KN_STRIDE + 16 * s + 8 * h);
#pragma unroll
          for (int s = 0; s < 4; ++s) a16 = __builtin_amdgcn_mfma_f32_32x32x16_bf16(ka[s], qf[s], a16, 0, 0, 0);
#pragma unroll
          for (int r = 0; r < 16; ++r) { const int key = kb * 32 + crow(r, h); const int rel = qi - key; const bool ok = (rel >= 0) && (rel < 128) && (qb > 0 || key >= 128);
            const float sv = ok ? a16[r] : -1e30f; a16[r] = sv; mx = fmaxf(mx, sv); }
          sacc[i] = a16; }
        mx = fmaxf(mx, __shfl_xor(mx, 32));
        float sum = 0.f; bf16x8 pf[5][2];
#pragma unroll
        for (int i = 0; i < 5; ++i) { float e[16];
#pragma unroll
          for (int r = 0; r < 16; ++r) { e[r] = __expf(sacc[i][r] - mx); sum += e[r]; }
#pragma unroll
          for (int st = 0; st < 2; ++st) pf[i][st] = __builtin_bit_cast(bf16x8, (u32x4){pk2(e[8 * st], e[8 * st + 1]), pk2(e[8 * st + 2], e[8 * st + 3]), pk2(e[8 * st + 4], e[8 * st + 5]), pk2(e[8 * st + 6], e[8 * st + 7])}); }
        sum += __shfl_xor(sum, 32);
        const float inv = 1.f / (sum + __expf(sink - mx));
#pragma unroll
        for (int db = 0; db < 2; ++db) { f32x16 o16;
#pragma unroll
          for (int r = 0; r < 16; ++r) o16[r] = 0.f;
          bf16x8 va[10];
#pragma unroll
          for (int i = 0; i < 5; ++i)
#pragma unroll
            for (int st = 0; st < 2; ++st) { const bf16_t* vp = Vt + (db * 32 + l31) * VT_STRIDE + (kb0 + i) * 32 + 16 * st + 4 * h;
              const u32x2 lo = *(const u32x2*)vp, hi = *(const u32x2*)(vp + 8);
              va[i * 2 + st] = __builtin_bit_cast(bf16x8, (u32x4){lo[0], lo[1], hi[0], hi[1]}); }
          f32x16 o16b;
#pragma unroll
          for (int r = 0; r < 16; ++r) o16b[r] = 0.f;
#pragma unroll
          for (int i = 0; i < 5; ++i) { o16 = __builtin_amdgcn_mfma_f32_32x32x16_bf16(va[i * 2], pf[i][0], o16, 0, 0, 0); o16b = __builtin_amdgcn_mfma_f32_32x32x16_bf16(va[i * 2 + 1], pf[i][1], o16b, 0, 0, 0); }
#pragma unroll
          for (int r = 0; r < 16; ++r) o16[r] += o16b[r];
          bf16_t* op = B.on + tok * D + hq * 64 + db * 32 + 4 * h;
#pragma unroll
          for (int r4 = 0; r4 < 4; ++r4) *(u32x2*)(op + 8 * r4) = (u32x2){pk2(o16[4 * r4] * inv, o16[4 * r4 + 1] * inv), pk2(o16[4 * r4 + 2] * inv, o16[4 * r4 + 3] * inv)}; }
      }
      __syncthreads();
    }
  }
  {
    const int tid = tid_get(), lane = tid & 63, wave = tid >> 6;
#pragma unroll 1
    for (int item = 512 + blockIdx.x; item < nitems; item += gridDim.x) {
      const int sidx = item - 512, bs = sidx >> 2, kvh = sidx & 3; const size_t r = TP + bs;
      float* Ks = (float*)shm; float* Vs = Ks + 128 * 68; float* q_s = Vs + 128 * 64; float* p_s = q_s + 256; float* redm = p_s + 512; float* reds = redm + 8; float* po = reds + 8;
      const float* tb = B.tab + (size_t)4096 * 64;
      f32x4 kreg[4], vreg[4];
#pragma unroll
      for (int i = 0; i < 4; ++i) { const int e = tid + 512 * i, jr = e >> 4, c4 = (e & 15) * 4;
        if (jr < 127) { const size_t o = (((size_t)bs * 128 + jr + 1) * 4 + kvh) * 64 + c4; kreg[i] = __builtin_nontemporal_load((const f32x4*)(p->cache_k + o)); vreg[i] = __builtin_nontemporal_load((const f32x4*)(p->cache_v + o)); } }
      if (tid < 128) { const int g = tid >> 5, i = tid & 31, hq = kvh * 4 + g;
        float a = bf2f(B.qraw[r * D + hq * 64 + i]), c = bf2f(B.qraw[r * D + hq * 64 + 32 + i]);
        float ss = a * a + c * c;
#pragma unroll
        for (int o = 1; o < 32; o <<= 1) ss += __shfl_xor(ss, o);
        const float rstd = rsqrtf(ss * (1.f / 64.f) + EPS); a *= rstd * qg[i]; c *= rstd * qg[32 + i];
        const float cs = tb[i], sn = tb[32 + i];
        q_s[g * 64 + i] = (a * cs - c * sn) * 0.125f; q_s[g * 64 + 32 + i] = (c * cs + a * sn) * 0.125f;
      } else if (tid < 160) { const int i = tid & 31;
        float a = B.kvraw[r * 512 + kvh * 64 + i], c = B.kvraw[r * 512 + kvh * 64 + 32 + i];
        float ss = a * a + c * c;
#pragma unroll
        for (int o = 1; o < 32; o <<= 1) ss += __shfl_xor(ss, o);
        const float rstd = rsqrtf(ss * (1.f / 64.f) + EPS); a *= rstd * p->k_norm_g[i]; c *= rstd * p->k_norm_g[32 + i];
        const float cs = tb[i], sn = tb[32 + i];
        const float k1 = a * cs - c * sn, k2 = c * cs + a * sn, v1 = B.kvraw[r * 512 + 256 + kvh * 64 + i], v2 = B.kvraw[r * 512 + 256 + kvh * 64 + 32 + i];
        Ks[127 * 68 + i] = k1; Ks[127 * 68 + 32 + i] = k2; Vs[127 * 64 + i] = v1; Vs[127 * 64 + 32 + i] = v2;
        if (write_cache) { float* ok = p->out + O_KS + (((size_t)bs * 128 + 127) * 4 + kvh) * 64; float* ov = p->out + O_VS + (((size_t)bs * 128 + 127) * 4 + kvh) * 64;
          ok[i] = k1; ok[32 + i] = k2; ov[i] = v1; ov[32 + i] = v2; } }
#pragma unroll
      for (int i = 0; i < 4; ++i) { const int e = tid + 512 * i, jr = e >> 4, c4 = (e & 15) * 4;
        if (jr < 127) { *(f32x4*)(Ks + jr * 68 + c4) = kreg[i]; *(f32x4*)(Vs + jr * 64 + c4) = vreg[i];
          if (write_cache) { const size_t o = (((size_t)bs * 128 + jr) * 4 + kvh) * 64 + c4; __builtin_nontemporal_store(kreg[i], (f32x4*)(p->out + O_KS + o)); __builtin_nontemporal_store(vreg[i], (f32x4*)(p->out + O_VS + o)); } } }
      __syncthreads();
      const int g = tid >> 7, jk = tid & 127, hq = kvh * 4 + g; const float sink = sinkp[hq];
      float sc = 0.f;
#pragma unroll
      for (int d4 = 0; d4 < 16; ++d4) { const f32x4 kv = *(const f32x4*)(Ks + jk * 68 + 4 * d4), qv = *(const f32x4*)(q_s + g * 64 + 4 * d4); sc += kv[0] * qv[0] + kv[1] * qv[1] + kv[2] * qv[2] + kv[3] * qv[3]; }
      float mx = sc;
#pragma unroll
      for (int o = 1; o < 64; o <<= 1) mx = fmaxf(mx, __shfl_xor(mx, o));
      if (lane == 0) redm[wave] = mx;
      __syncthreads();
      mx = fmaxf(fmaxf(redm[2 * g], redm[2 * g + 1]), sink);
      const float ev = __expf(sc - mx); float sum = ev;
#pragma unroll
      for (int o = 1; o < 64; o <<= 1) sum += __shfl_xor(sum, o);
      if (lane == 0) reds[wave] = sum;
      p_s[g * 128 + jk] = ev;
      __syncthreads();
      const float inv = 1.f / (reds[2 * g] + reds[2 * g + 1] + __expf(sink - mx));
      { const int d = jk & 63, jh = jk >> 6; float o = 0.f;
#pragma unroll 8
        for (int jx = 0; jx < 64; ++jx) o += p_s[g * 128 + jh * 64 + jx] * Vs[(jh * 64 + jx) * 64 + d];
        po[tid] = o;
        __syncthreads();
        if (jh == 0) { const float tot = (o + po[tid + 64]) * inv; B.on[r * D + hq * 64 + d] = (bf16_t)f2bf(tot); } }
      __syncthreads();
    }
  }
}

#define XB_TMO      128
#define XB_XCNT(j)  (256  + 64 * (j))
#define XB_XSUB(j)  (1280 + 64 * (j))
#define XB_XGEN(j)  (2304 + 64 * (j))
#define XB_TOP      3328
#define XB_TOPGEN   3392
#define XCD_BAR_WORDS 3456
#define XB_SPIN_CAP (1u << 18)

__device__ __forceinline__ unsigned xb_ld(unsigned* p)              { return __hip_atomic_load(p, __ATOMIC_RELAXED, __HIP_MEMORY_SCOPE_AGENT); }
__device__ __forceinline__ unsigned xb_add(unsigned* p, unsigned v) { return __hip_atomic_fetch_add(p, v, __ATOMIC_RELAXED, __HIP_MEMORY_SCOPE_AGENT); }
__device__ __forceinline__ unsigned xb_xcc_id() { return (unsigned)__builtin_amdgcn_s_getreg((3 << 11) | 20) & 0xFu; }
#define XB_SPIN(cond, bar) do { unsigned _sp = 0; while (cond) { __builtin_amdgcn_s_sleep(1); \
    if ((++_sp & 255u) == 0u) { if (xb_ld(&(bar)[XB_TMO])) break; if (_sp > XB_SPIN_CAP) { atomicAdd(&(bar)[XB_TMO], 1u); break; } } } } while (0)

struct XcdBarrier {
    unsigned* bar; unsigned x;
    volatile LAS unsigned* st;
};

__device__ __forceinline__ XcdBarrier xcd_barrier_post(unsigned* bar, volatile LAS unsigned* st) {
    XcdBarrier b; b.bar = bar; b.x = xb_xcc_id(); b.st = st;
    if (threadIdx.x == 0) (void)xb_add(&bar[XB_XCNT(b.x)], 1u);
    return b;
}
__device__ __forceinline__ void xcd_barrier_complete(unsigned* bar, unsigned x, unsigned& nloc, unsigned& nx) {
    const unsigned G = gridDim.x * gridDim.y * gridDim.z;
    unsigned sum, cnt, mine, sp = 0u;
    for (;;) {
        sum = 0u; cnt = 0u; mine = 0u;
#pragma unroll
        for (unsigned j = 0; j < 16; ++j) { const unsigned c = xb_ld(&bar[XB_XCNT(j)]); sum += c; cnt += (c > 0u) ? 1u : 0u; mine = (j == x) ? c : mine; }
        if (sum == G) break;
        __builtin_amdgcn_s_sleep(1);
        if ((++sp & 255u) == 0u) { if (xb_ld(&bar[XB_TMO])) break; if (sp > XB_SPIN_CAP) { atomicAdd(&bar[XB_TMO], 1u); break; } }
    }
    nloc = mine > 0u ? mine : 1u; nx = cnt > 0u ? cnt : 1u;
}

__device__ __forceinline__ void xcd_barrier(const XcdBarrier& b) {
    asm volatile("s_waitcnt vmcnt(0)" ::: "memory");
    __syncthreads();
    if (threadIdx.x == 0) {
        unsigned* bar = b.bar;
        __builtin_amdgcn_s_waitcnt(0);
        unsigned nloc = b.st[0], nx = b.st[1];
        if (nloc == 0u) { xcd_barrier_complete(bar, b.x, nloc, nx); b.st[0] = nloc; b.st[1] = nx; }
        const unsigned old = xb_add(&bar[XB_XSUB(b.x)], 1u);
        const unsigned gen = old / nloc;
        if (old + 1u == (gen + 1u) * nloc) {
            __builtin_amdgcn_fence(__ATOMIC_RELEASE, "agent");
            asm volatile("s_waitcnt vmcnt(0)" ::: "memory");
            const unsigned og = xb_add(&bar[XB_TOP], 1u);
            const unsigned tg = og / nx;
            if (og + 1u == (tg + 1u) * nx) xb_add(&bar[XB_TOPGEN], 1u);
            else XB_SPIN(xb_ld(&bar[XB_TOPGEN]) == tg, bar);
            __builtin_amdgcn_fence(__ATOMIC_ACQUIRE, "agent");
            xb_add(&bar[XB_XGEN(b.x)], 1u);
            asm volatile("s_waitcnt vmcnt(0)" ::: "memory");
        } else {
            XB_SPIN(xb_ld(&bar[XB_XGEN(b.x)]) == gen, bar);
            __builtin_amdgcn_fence(__ATOMIC_ACQUIRE, "agent");
            asm volatile("s_waitcnt vmcnt(0)" ::: "memory");
        }
    }
    __syncthreads();
}


__global__ void __launch_bounds__(NTHREADS, 2) yoco_fwd(P parg) {
  extern __shared__ __attribute__((aligned(16))) unsigned char shm[];
  cg::grid_group grid = cg::this_grid();
  volatile LAS unsigned* xst = (volatile LAS unsigned*)((LAS unsigned char*)shm + 131072);
  if (threadIdx.x < 4) xst[threadIdx.x] = 0u;
  __syncthreads();
  { KP p0 = kp_get(); (void)xcd_barrier_post((unsigned*)(p0->ws + OFF_BAR), xst); }
  const int nMt = TP / BM;
#pragma unroll 1
  for (int step = -2; step < 32; ++step) {
    const int l = (step < 0) ? 0 : (step >> 3), sub = (step < 0) ? (8 + step + 2) : (step & 7); const bool hg = (l < 2);
    if (sub == 3 && !hg) continue;
    if (sub == 5 || (sub == 0 && l > 0)) continue;
    KP p = kp_get(); unsigned char* ws = p->ws;
#ifndef PROBE_REPS
#define PROBE_REPS 1
#endif
#ifndef PROBE_GREPS
#define PROBE_GREPS 1
#endif
    const bool is_gemm = (sub == 0 || sub == 1 || sub == 4 || sub == 6 || sub == 7 || sub == 9);
#ifndef PROBE_MASK
#define PROBE_MASK 0
#endif
    const int pcode = (sub == 2 && !hg) ? 10 : sub;
    const int reps = (((PROBE_MASK >> pcode) & 1) && !(sub == 4 || sub == 7)) ? 2 : 1;
#pragma unroll 1
    for (int rep = 0; rep < reps; ++rep) {
    if (sub == 8) {
      prep_phase(p, shm);
    } else if (sub == 0 || sub == 1 || sub == 4 || sub == 6 || sub == 7 || sub == 9) {
      float* mods = (float*)(ws + OFF_MODS);
      bf16_t* hbuf = (bf16_t*)(ws + OFF_H); bf16_t* onbuf = (bf16_t*)(ws + OFF_ON); bf16_t* ubuf = (bf16_t*)(ws + OFF_U);
      GemmJob j0, j1; EpiArgs E{}; int nj = 1; E.layer = l; E.first = 0;
      float* rssb = (float*)(ws + OFF_RSS); const float* biasb = (const float*)(ws + OFF_BIAS);
      j1.A = (const bf16_t*)(ws + OFF_X); j1.Bt = (const bf16_t*)(ws + OFF_WKV); j1.nM = nMt; j1.nN = 2; j1.K = D; j1.epi = EPI_KVRAW;
      j0.nM = nMt; j0.K = D;
      if (sub == 0) { j0.A = (const bf16_t*)(ws + OFF_ASH); j0.Bt = (const bf16_t*)ws; j0.nM = 1; j0.nN = 106; j0.epi = EPI_BIAS; j1.A = (const bf16_t*)(ws + OFF_BIAS); }
      else if (sub == 9) { j0.A = (const bf16_t*)(ws + OFF_X + (size_t)MODW * D * 2); j0.Bt = (const bf16_t*)(ws + OFF_X); j0.nM = 1; j0.nN = MODW / BM; j0.epi = EPI_ADA; E.f0 = mods; E.ash = (bf16_t*)(ws + OFF_ASH); }
      else if (sub == 1 && hg) { E.rss = rssb + (size_t)(2 * l) * T; E.bias = biasb + (size_t)132 * site_prefN(l); E.bN = 4096; j0.A = hbuf; j0.Bt = (const bf16_t*)(ws + OFF_WIN) + (size_t)l * 4096 * D; j0.nN = 16; j0.epi = EPI_HGIN;
        E.f0 = (float*)(ws + OFF_X); E.b0 = (bf16_t*)(ws + OFF_U); E.b1 = (bf16_t*)(ws + OFF_U + SZ_ACT); E.b2 = (bf16_t*)(ws + OFF_U + 2 * SZ_ACT); E.b3 = (bf16_t*)(ws + OFF_U + 3 * SZ_ACT); }
      else if (sub == 1) { E.rss = rssb + (size_t)(2 * l) * T; E.bias = biasb + (size_t)132 * site_prefN(l); E.bN = 1024; E.bias1 = biasb + (size_t)132 * site_prefN(4); E.bN1 = 512; j0.A = hbuf; j0.Bt = (const bf16_t*)(ws + OFF_WQ) + (size_t)(l - 2) * D * D; j0.nN = 4; j0.epi = EPI_QRAW;
        E.b1 = (bf16_t*)(ws + OFF_X + SZ_ACT); E.f2 = (float*)(ws + OFF_X + 2 * SZ_ACT); nj = (l == 2) ? 2 : 1; }
      else if (sub == 4) { E.rss_out = rssb + (size_t)(1 + 2 * l) * T; E.ng = p->norm2_g + l * D; E.nsc = mods + l * 6144 + 4096; E.yout = hbuf; j0.A = onbuf; j0.Bt = hg ? (const bf16_t*)(ws + OFF_WOUT) + (size_t)l * D * D : (const bf16_t*)(ws + OFF_WO) + (size_t)(l - 2) * D * D; j0.nN = 4; j0.epi = EPI_RESID;
        E.f0 = p->out + O_Y; E.f1 = mods + l * 6144 + 2048; E.first = (l == 0); }
      else if (sub == 6) { E.rss = rssb + (size_t)(1 + 2 * l) * T; E.bias = biasb + (size_t)132 * site_prefN(5 + l); E.bN = 4096; j0.A = hbuf; j0.Bt = (const bf16_t*)(ws + OFF_WUP) + (size_t)l * D * FF; j0.nN = 16; j0.epi = EPI_UP; E.b0 = ubuf; }
      else { if (l < 3) { E.rss_out = rssb + (size_t)(2 * (l + 1)) * T; E.ng = p->norm1_g + (l + 1) * D; E.nsc = mods + (l + 1) * 6144 + 1024; E.yout = hbuf;
          if (l == 1) { E.ngkv = p->kv_norm_g; E.nsckv = mods + 24576 + 1024; E.ykv = (bf16_t*)(ws + OFF_X); } }
        j0.A = ubuf; j0.Bt = (const bf16_t*)(ws + OFF_WDN) + (size_t)l * D * FF; j0.nN = 4; j0.K = FF; j0.epi = EPI_RESID; E.f0 = p->out + O_Y; E.f1 = mods + l * 6144 + 5120; }
      gemm_phase(p, (LAS unsigned char*)shm, shm, j0, j1, nj, E, sub != 9 && sub != 0);
      if (sub == 0) init_rows(p, (unsigned*)(ws + OFF_BAR) + XCD_BAR_WORDS + 100);
    } else if (sub == 2 && hg) {
      HgBufs HB; HB.q = (bf16_t*)(ws + OFF_U); HB.k = (bf16_t*)(ws + OFF_U + SZ_ACT); HB.v = (bf16_t*)(ws + OFF_U + 2 * SZ_ACT); HB.g = (bf16_t*)(ws + OFF_U + 3 * SZ_ACT);
      HB.lf = (float*)(ws + OFF_X); HB.o32 = (float*)(ws + OFF_X + 2 * SZ_ACT); HB.on = (bf16_t*)(ws + OFF_ON);
      scan_phase(p, l, HB, shm);
    } else if (sub == 2) {
      AtBufs AB; AB.qraw = (bf16_t*)(ws + OFF_X + SZ_ACT); AB.kvraw = (float*)(ws + OFF_X + 2 * SZ_ACT); AB.on = (bf16_t*)(ws + OFF_ON); AB.tab = (const float*)(ws + OFF_TAB);
      attn_phase(p, l, AB, shm);
    } else {
      HgBufs HB; HB.q = (bf16_t*)(ws + OFF_U); HB.k = (bf16_t*)(ws + OFF_U + SZ_ACT); HB.v = (bf16_t*)(ws + OFF_U + 2 * SZ_ACT); HB.g = (bf16_t*)(ws + OFF_U + 3 * SZ_ACT);
      HB.lf = (float*)(ws + OFF_X); HB.o32 = (float*)(ws + OFF_X + 2 * SZ_ACT); HB.on = (bf16_t*)(ws + OFF_ON);
      scan_passB(HB);
      { KP pb = kp_get(); XcdBarrier xb; xb.bar = (unsigned*)(pb->ws + OFF_BAR); xb.x = xb_xcc_id(); xb.st = xst; xcd_barrier(xb); }
      scan_prompt<1>(p, l, HB, shm);
    }
    }
    if (step == 31) break;
    if (step == -2) grid.sync();
    else { KP pb = kp_get(); XcdBarrier xb; xb.bar = (unsigned*)(pb->ws + OFF_BAR); xb.x = xb_xcc_id(); xb.st = xst; xcd_barrier(xb); }
  }
}

extern "C" void kernel_launch(void* const* d_in, const int* in_sizes, int n_in, void* d_out, int out_size, void* d_ws, size_t ws_size, hipStream_t stream) {
  static int grid_blocks = 0;
  if (!grid_blocks) {
    int dev = 0, cus = 0, per_cu = 0;
    hipGetDevice(&dev);
    hipDeviceGetAttribute(&cus, hipDeviceAttributeMultiprocessorCount, dev);
    if (hipFuncSetAttribute((const void*)yoco_fwd, hipFuncAttributeMaxDynamicSharedMemorySize, LDS_BYTES) != hipSuccess) fprintf(stderr, "hipFuncSetAttribute failed\n");
    if (hipOccupancyMaxActiveBlocksPerMultiprocessor(&per_cu, (const void*)yoco_fwd, NTHREADS, LDS_BYTES) != hipSuccess || per_cu < 1) { fprintf(stderr, "occupancy query failed\n"); per_cu = 1; }
    grid_blocks = cus * per_cu;
    if (ws_size < WS_NEED) fprintf(stderr, "workspace too small: %zu < %zu\n", ws_size, (size_t)WS_NEED);
  }
  P p{};
  const float** pp = (const float**)&p;
  for (int i = 0; i < 26; ++i) pp[i] = (const float*)d_in[i];
  p.out = (float*)d_out; p.ws = (unsigned char*)d_ws;
  (void)hipMemsetAsync((unsigned char*)d_ws + OFF_BAR, 0, ZERO_BYTES, stream);
  void* args[] = {&p};
  hipError_t e = hipLaunchCooperativeKernel((const void*)yoco_fwd, dim3(grid_blocks), dim3(NTHREADS), args, LDS_BYTES, stream);
  if (e != hipSuccess) fprintf(stderr, "cooperative launch failed: %s (grid %d)\n", hipGetErrorString(e), grid_blocks);
}
```

```cpp
#include <hip/hip_runtime.h>
#include <hip/hip_cooperative_groups.h>
#include <cstdio>
#include <cstdint>
namespace cg = cooperative_groups;

#define DI __device__ __forceinline__
typedef unsigned short bf16_t;
typedef short bf16x8 __attribute__((ext_vector_type(8)));
typedef float f32x4 __attribute__((ext_vector_type(4)));
typedef float f32x2 __attribute__((ext_vector_type(2)));
typedef float f32x16 __attribute__((ext_vector_type(16)));
typedef unsigned u32x4 __attribute__((ext_vector_type(4)));
typedef unsigned u32x2 __attribute__((ext_vector_type(2)));
#define LAS __attribute__((address_space(3)))

constexpr int D = 1024, FF = 4096, TP = 16384, TS = 128, T = TP + TS, TPAD = 16640, SEQ = 4096;
constexpr int NMOD = 132, MODW = 4 * 6144 + 2048;
constexpr float EPS = 1e-6f;
constexpr int NTHREADS = 512, NWAVES = 8;
constexpr int LDS_BYTES = 131072 + 16;

constexpr size_t O_Y = 0;
constexpr size_t O_HGP = (size_t)T * D;
constexpr size_t O_KP = O_HGP + (size_t)2 * 4 * 8 * 128 * 128;
constexpr size_t O_VP = O_KP + (size_t)4 * 128 * 4 * 64;
constexpr size_t O_HGS = O_VP + (size_t)4 * 128 * 4 * 64;
constexpr size_t O_KS = O_HGS + (size_t)2 * 128 * 8 * 128 * 128;
constexpr size_t O_VS = O_KS + (size_t)128 * 128 * 4 * 64;

constexpr size_t SZ_ACT = (size_t)TPAD * D * 2;
constexpr size_t OFF_WIN = 0;
constexpr size_t OFF_WOUT = OFF_WIN + (size_t)2 * 4096 * 1024 * 2;
constexpr size_t OFF_WKV = OFF_WOUT + (size_t)2 * 1024 * 1024 * 2;
constexpr size_t OFF_WQ = OFF_WKV + (size_t)512 * 1024 * 2;
constexpr size_t OFF_WO = OFF_WQ + (size_t)2 * 1024 * 1024 * 2;
constexpr size_t OFF_WUP = OFF_WO + (size_t)2 * 1024 * 1024 * 2;
constexpr size_t OFF_WDN = OFF_WUP + (size_t)4 * 4096 * 1024 * 2;
constexpr size_t OFF_MODS = OFF_WDN + (size_t)4 * 4096 * 1024 * 2;
constexpr size_t OFF_TAB = OFF_MODS + (((size_t)NMOD * MODW * 4 + 4095) & ~(size_t)4095);
constexpr size_t OFF_H = OFF_TAB + (((size_t)4097 * 64 * 4 + 4095) & ~(size_t)4095);
constexpr size_t OFF_ON = OFF_H + SZ_ACT;
constexpr size_t OFF_U = OFF_ON + SZ_ACT;
constexpr size_t OFF_X = OFF_U + 4 * SZ_ACT;
constexpr size_t OFF_BAR = OFF_X + 4 * SZ_ACT;
constexpr size_t BAR_BYTES = 16384;
constexpr size_t OFF_RSS = OFF_BAR + BAR_BYTES;
constexpr size_t ZERO_BYTES = BAR_BYTES + (size_t)9 * T * 4;
constexpr size_t OFF_ASH = OFF_BAR + ((ZERO_BYTES + 4095) & ~(size_t)4095);
constexpr size_t OFF_BIAS = OFF_ASH + (size_t)9 * 256 * 1024 * 2;
constexpr size_t WS_NEED = OFF_BIAS + (size_t)132 * 27136 * 4;

struct P {
  const float *x_prompt, *x_sample, *c_prompt, *c_sample, *state_hgrn, *cache_k, *cache_v;
  const float *w_ada, *b_ada, *norm1_g, *norm2_g, *hg_w_in, *hg_w_out, *hg_lbp, *hg_gn_g;
  const float *kv_w_ada, *kv_b_ada, *kv_norm_g, *w_kv, *k_norm_g, *w_q, *q_norm_g, *sinks, *w_o, *w_up, *w_down;
  float* out; unsigned char* ws;
};

typedef const P __attribute__((address_space(4)))* KP;
DI KP kp_get() { KP q = (KP)__builtin_amdgcn_kernarg_segment_ptr(); asm volatile("" : "+s"(q)); return q; }
DI int tid_get() { int t = threadIdx.x; asm volatile("" : "+v"(t)); return t; }
DI unsigned f2bf(float f) { unsigned u = __float_as_uint(f); return (u + 0x7fffu + ((u >> 16) & 1u)) >> 16; }
typedef __bf16 bf16x2_n __attribute__((ext_vector_type(2)));
DI unsigned pk2(float lo, float hi) { return __builtin_bit_cast(unsigned, __builtin_convertvector((f32x2){lo, hi}, bf16x2_n)); }
DI float bf2f(unsigned b) { return __uint_as_float(b << 16); }
DI float silu_f(float x) { return x * __builtin_amdgcn_rcpf(1.f + __expf(-x)); }
DI int modrow(int r) { return r < TP ? (r >> 12) : (4 + r - TP); }
DI int crow(int reg, int h) { return (reg & 3) + 8 * (reg >> 2) + 4 * h; }

constexpr int BM = 256, BK = 64, HALF = 128, HTB = HALF * BK * 2;
DI int lds_byte(int r, int c) { const int st = (r >> 4) * 2 + (c >> 5), rr = r & 15, cc = c & 31, ob = rr * 64 + cc * 2; return st * 1024 + (ob ^ (((ob >> 9) & 1) << 5)); }
DI void stage_rc(int b, int& R, int& C) { const int st = b / 1024, sb = b % 1024, swz = sb ^ (((sb >> 9) & 1) << 5); R = (st >> 1) * 16 + swz / 64; C = (st & 1) * 32 + (swz % 64) / 2; }

enum { EPI_ADA = 0, EPI_HGIN = 1, EPI_RESID = 2, EPI_UP = 3, EPI_QRAW = 4, EPI_KVRAW = 5, EPI_NOP = 6, EPI_BIAS = 7 };
struct GemmJob { const bf16_t* A; const bf16_t* Bt; int nM, nN, K, epi; };
struct EpiArgs {
  float* f0; const float* f1; float* f2; bf16_t* b0; bf16_t* b1; bf16_t* b2; bf16_t* b3; int layer; int first;
  const float* rss; const float* bias; const float* bias1; int bN, bN1;
  float* rss_out; const float* ng; const float* nsc; bf16_t* yout; const float* ngkv; const float* nsckv; bf16_t* ykv;
  bf16_t* ash;
};
DI int site_N(const int s) { return (s == 2 || s == 3) ? 1024 : (s == 4 ? 512 : 4096); }
DI int site_prefN(const int s) { return s == 0 ? 0 : s == 1 ? 4096 : s == 2 ? 8192 : s == 3 ? 9216 : s == 4 ? 10240 : 10752 + (s - 5) * 4096; }

DI void tile_of(int L, int nM, int nN, int& pm, int& pn) {
  const int nwg = nM * nN; int wgid = L;
  { const int q = nwg / 8, r = nwg % 8, xcd = wgid % 8, off = wgid / 8; wgid = (xcd < r ? xcd * (q + 1) : r * (q + 1) + (xcd - r) * q) + off; }
  const int nig = 8 * nN, gid = wgid / nig, fm = gid * 8, gsz = (nM - fm) < 8 ? (nM - fm) : 8;
  pm = fm + ((wgid % nig) % gsz); pn = (wgid % nig) / gsz;
}

DI void epi_frag(KP p, const int epi, const EpiArgs& E, const int r, const int c, const f32x4 vin) {
  if (epi == EPI_NOP) return;
  f32x4 v = vin;
  if (epi == EPI_HGIN || epi == EPI_UP || epi == EPI_QRAW || epi == EPI_KVRAW) {
    const float rstd = rsqrtf(E.rss[r] * (1.f / D) + EPS);
    const float* bp = ((epi == EPI_KVRAW) ? E.bias1 + (size_t)modrow(r) * E.bN1 : E.bias + (size_t)modrow(r) * E.bN) + c;
    v = v * rstd + *(const f32x4*)bp; }
  if (epi == EPI_HGIN) {
    const int sec = c >> 10, cc = c & 1023; const size_t o = (size_t)r * D + cc;
    if (sec == 1) { f32x4 lb = (f32x4){0.f, 0.f, 0.f, 0.f};
      if (E.layer == 1) { const f32x4 l0 = *(const f32x4*)(p->hg_lbp + cc), l1 = *(const f32x4*)(p->hg_lbp + D + cc);
#pragma unroll
        for (int j = 0; j < 4; ++j) lb[j] = __builtin_amdgcn_rcpf(1.f + __expf(l0[j] - l1[j])); }
      f32x4 lf; float kk[4];
#pragma unroll
      for (int j = 0; j < 4; ++j) { const float sg = __builtin_amdgcn_rcpf(1.f + __expf(-v[j])); const float fg = lb[j] + (1.f - lb[j]) * sg; lf[j] = __logf(fg); kk[j] = (1.f - lb[j]) * (1.f - sg); }
      *(f32x4*)(E.f0 + o) = lf; *(u32x2*)(E.b1 + o) = (u32x2){pk2(kk[0], kk[1]), pk2(kk[2], kk[3])};
    } else if (sec == 2) { *(u32x2*)(E.b2 + o) = (u32x2){pk2(v[0], v[1]), pk2(v[2], v[3])};
    } else { bf16_t* dst = (sec == 0) ? E.b0 : E.b3; *(u32x2*)(dst + o) = (u32x2){pk2(silu_f(v[0]), silu_f(v[1])), pk2(silu_f(v[2]), silu_f(v[3]))}; }
  } else if (epi == EPI_RESID) {
    const float* xin = E.first ? (r < TP ? p->x_prompt + (size_t)r * D : p->x_sample + (size_t)(r - TP) * D) : (E.f0 + (size_t)r * D);
    const size_t mo = (size_t)modrow(r) * MODW;
    const f32x4 xv = *(const f32x4*)(xin + c), gv = *(const f32x4*)(E.f1 + mo + c);
    const f32x4 yn = xv + gv * v;
    *(f32x4*)(E.f0 + (size_t)r * D + c) = yn;
    if (E.yout) {
      const f32x4 g = *(const f32x4*)(E.ng + c), sc = *(const f32x4*)(E.nsc + mo + c); const f32x4 y = yn * g * (sc + 1.f);
      *(u32x2*)(E.yout + (size_t)r * D + c) = (u32x2){pk2(y[0], y[1]), pk2(y[2], y[3])};
      if (E.ykv) { const f32x4 g2 = *(const f32x4*)(E.ngkv + c), sc2 = *(const f32x4*)(E.nsckv + mo + c); const f32x4 y2 = yn * g2 * (sc2 + 1.f);
        *(u32x2*)(E.ykv + (size_t)r * D + c) = (u32x2){pk2(y2[0], y2[1]), pk2(y2[2], y2[3])}; }
      float ss = yn[0] * yn[0] + yn[1] * yn[1] + yn[2] * yn[2] + yn[3] * yn[3];
      ss += __shfl_xor(ss, 1); ss += __shfl_xor(ss, 2);
      if ((tid_get() & 3) == 0) atomicAdd(E.rss_out + r, ss); }
  } else if (epi == EPI_UP) {
    f32x4 u;
#pragma unroll
    for (int j = 0; j < 4; ++j) { const float t = fmaxf(v[j], 0.f); u[j] = t * t; }
    *(u32x2*)(E.b0 + (size_t)r * FF + c) = (u32x2){pk2(u[0], u[1]), pk2(u[2], u[3])};
  } else if (epi == EPI_QRAW) { *(u32x2*)(E.b1 + (size_t)r * D + c) = (u32x2){pk2(v[0], v[1]), pk2(v[2], v[3])};
  } else if (epi == EPI_KVRAW) { *(f32x4*)(E.f2 + (size_t)r * 512 + c) = v; }
}

DI void epi_frag8(KP p, const int epi, const EpiArgs& E, const int r, const int c, const f32x4 v0, const f32x4 v1, const f32x4 lbA = (f32x4){0.f, 0.f, 0.f, 0.f}, const f32x4 lbB = (f32x4){0.f, 0.f, 0.f, 0.f}) {
  if (epi == EPI_NOP) return;
  if (epi == EPI_ADA) { if (r < NMOD) { const float* bp = (c < 24576) ? (p->b_ada + c) : (p->kv_b_ada + (c - 24576)); float* o = E.f0 + (size_t)r * MODW + c;
      const f32x4 m0 = v0 + *(const f32x4*)bp, m1 = v1 + *(const f32x4*)(bp + 4);
      *(f32x4*)o = m0; *(f32x4*)(o + 4) = m1;
      int site = -1;
      if (c < 24576) { const int l = c / 6144, part = (c - l * 6144) >> 10; site = (part == 0) ? l : (part == 3 ? 5 + l : -1); } else if (c < 25600) site = 4;
      if (site >= 0) *(u32x4*)(E.ash + ((size_t)site * 256 + r) * 1024 + (c & 1023)) = (u32x4){pk2(m0[0], m0[1]), pk2(m0[2], m0[3]), pk2(m1[0], m1[1]), pk2(m1[2], m1[3])}; }
  } else if (epi == EPI_HGIN) {
    const int sec = c >> 10, cc = c & 1023; const size_t o = (size_t)r * D + cc;
    if (sec == 1) { float lb[8];
#pragma unroll
      for (int j = 0; j < 4; ++j) { lb[j] = lbA[j]; lb[4 + j] = lbB[j]; }
      float lf[8], kk[8];
#pragma unroll
      for (int j = 0; j < 8; ++j) { const float x = (j < 4) ? v0[j & 3] : v1[j & 3]; const float sg = __builtin_amdgcn_rcpf(1.f + __expf(-x)); const float fg = lb[j] + (1.f - lb[j]) * sg;
        lf[j] = __logf(fg); kk[j] = (1.f - lb[j]) * (1.f - sg); }
      *(f32x4*)(E.f0 + o) = (f32x4){lf[0], lf[1], lf[2], lf[3]}; *(f32x4*)(E.f0 + o + 4) = (f32x4){lf[4], lf[5], lf[6], lf[7]};
      *(u32x4*)(E.b1 + o) = (u32x4){pk2(kk[0], kk[1]), pk2(kk[2], kk[3]), pk2(kk[4], kk[5]), pk2(kk[6], kk[7])};
    } else if (sec == 2) { *(u32x4*)(E.b2 + o) = (u32x4){pk2(v0[0], v0[1]), pk2(v0[2], v0[3]), pk2(v1[0], v1[1]), pk2(v1[2], v1[3])};
    } else { bf16_t* dst = (sec == 0) ? E.b0 : E.b3;
      *(u32x4*)(dst + o) = (u32x4){pk2(silu_f(v0[0]), silu_f(v0[1])), pk2(silu_f(v0[2]), silu_f(v0[3])), pk2(silu_f(v1[0]), silu_f(v1[1])), pk2(silu_f(v1[2]), silu_f(v1[3]))}; }
  } else if (epi == EPI_RESID) {
    const float* xin = E.first ? (r < TP ? p->x_prompt + (size_t)r * D : p->x_sample + (size_t)(r - TP) * D) : (E.f0 + (size_t)r * D);
    const size_t mo = (size_t)modrow(r) * MODW;
    const float* gm = E.f1 + mo + c; float* o = E.f0 + (size_t)r * D + c;
    const f32x4 xa = *(const f32x4*)(xin + c), xb = *(const f32x4*)(xin + c + 4), ga = *(const f32x4*)gm, gb = *(const f32x4*)(gm + 4);
    const f32x4 ya = xa + ga * v0, yb = xb + gb * v1;
    *(f32x4*)o = ya; *(f32x4*)(o + 4) = yb;
    if (E.yout) {
      const f32x4 g0 = *(const f32x4*)(E.ng + c), g1 = *(const f32x4*)(E.ng + c + 4), s0 = *(const f32x4*)(E.nsc + mo + c), s1 = *(const f32x4*)(E.nsc + mo + c + 4);
      const f32x4 y0 = ya * g0 * (s0 + 1.f), y1 = yb * g1 * (s1 + 1.f);
      *(u32x4*)(E.yout + (size_t)r * D + c) = (u32x4){pk2(y0[0], y0[1]), pk2(y0[2], y0[3]), pk2(y1[0], y1[1]), pk2(y1[2], y1[3])};
      if (E.ykv) { const f32x4 h0 = *(const f32x4*)(E.ngkv + c), h1 = *(const f32x4*)(E.ngkv + c + 4), t0 = *(const f32x4*)(E.nsckv + mo + c), t1 = *(const f32x4*)(E.nsckv + mo + c + 4);
        const f32x4 z0 = ya * h0 * (t0 + 1.f), z1 = yb * h1 * (t1 + 1.f);
        *(u32x4*)(E.ykv + (size_t)r * D + c) = (u32x4){pk2(z0[0], z0[1]), pk2(z0[2], z0[3]), pk2(z1[0], z1[1]), pk2(z1[2], z1[3])}; }
      float ss = ya[0] * ya[0] + ya[1] * ya[1] + ya[2] * ya[2] + ya[3] * ya[3] + yb[0] * yb[0] + yb[1] * yb[1] + yb[2] * yb[2] + yb[3] * yb[3];
      ss += __shfl_xor(ss, 16); ss += __shfl_xor(ss, 32);
      if ((tid_get() & 63) < 16) atomicAdd(E.rss_out + r, ss); }
  } else if (epi == EPI_UP) {
    float u[8];
#pragma unroll
    for (int j = 0; j < 8; ++j) { const float t = fmaxf((j < 4) ? v0[j & 3] : v1[j & 3], 0.f); u[j] = t * t; }
    *(u32x4*)(E.b0 + (size_t)r * FF + c) = (u32x4){pk2(u[0], u[1]), pk2(u[2], u[3]), pk2(u[4], u[5]), pk2(u[6], u[7])};
  } else if (epi == EPI_QRAW) { *(u32x4*)(E.b1 + (size_t)r * D + c) = (u32x4){pk2(v0[0], v0[1]), pk2(v0[2], v0[3]), pk2(v1[0], v1[1]), pk2(v1[2], v1[3])};
  } else { float* o = E.f2 + (size_t)r * 512 + c; *(f32x4*)o = v0; *(f32x4*)(o + 4) = v1; }
}

DI void skinny_unit(KP p, unsigned char* shm, const bf16_t* A, const bf16_t* Bt, const int K, const int n0, const int epi, const EpiArgs& E) {
  const int tid = tid_get(), lane = tid & 63, wave = tid >> 6, fr = lane & 15, fq = lane >> 4;
  const int ks = K >> 3;
  const bf16_t* ap = A + (size_t)(TP + fr) * K + wave * ks + fq * 8;
  const bf16_t* bp = Bt + (size_t)(n0 + fr) * K + wave * ks + fq * 8;
  f32x4 acc[8];
#pragma unroll
  for (int mb = 0; mb < 8; ++mb) acc[mb] = (f32x4){0.f, 0.f, 0.f, 0.f};
#pragma unroll 2
  for (int k = 0; k < ks; k += 32) { const bf16x8 b = *(const bf16x8*)(bp + k);
#pragma unroll
    for (int mb = 0; mb < 8; ++mb) { const bf16x8 a = *(const bf16x8*)(ap + (size_t)mb * 16 * K + k); acc[mb] = __builtin_amdgcn_mfma_f32_16x16x32_bf16(b, a, acc[mb], 0, 0, 0); } }
  float* red = (float*)shm;
#pragma unroll
  for (int mb = 0; mb < 8; ++mb) *(f32x4*)(red + wave * 2048 + (mb * 16 + fr) * 16 + fq * 4) = acc[mb];
  __syncthreads();
  { const int row = tid >> 2, c4 = (tid & 3) * 4; f32x4 sum = (f32x4){0.f, 0.f, 0.f, 0.f};
#pragma unroll
    for (int w = 0; w < 8; ++w) sum += *(const f32x4*)(red + w * 2048 + row * 16 + c4);
    epi_frag(p, epi, E, TP + row, n0 + c4, sum); }
  __syncthreads();
}

DI int perm32(int rho) { const int n = rho >> 4, i = rho & 15; return 8 * (i >> 2) + 4 * n + (i & 3); }
struct UnitD { const char* A; const char* B; int pm, pn, epi; float* ob; int on; };
DI void unit_of(const int L, const GemmJob& j0, const GemmJob& j1, const int n0, const size_t tstep, UnitD& u) {
  if (j0.epi == EPI_BIAS) {
    const int st = L < 16 ? 0 : L < 32 ? 1 : L < 36 ? 2 : L < 40 ? 3 : L < 42 ? 4 : 5 + (L - 42) / 16;
    const int lb = st == 0 ? 0 : st == 1 ? 16 : st == 2 ? 32 : st == 3 ? 36 : st == 4 ? 40 : 42 + (st - 5) * 16;
    const unsigned char* wsb = (const unsigned char*)j0.Bt;
    const bf16_t* Bt = (st < 2) ? (const bf16_t*)(wsb + OFF_WIN) + (size_t)st * 4096 * D : (st < 4) ? (const bf16_t*)(wsb + OFF_WQ) + (size_t)(st - 2) * D * D
                     : (st == 4) ? (const bf16_t*)(wsb + OFF_WKV) : (const bf16_t*)(wsb + OFF_WUP) + (size_t)(st - 5) * D * FF;
    u.pm = 0; u.pn = L - lb; u.epi = EPI_BIAS; u.A = (const char*)(j0.A + (size_t)st * 256 * 1024); u.B = (const char*)Bt + (size_t)u.pn * tstep;
    u.ob = (float*)j1.A + (size_t)132 * site_prefN(st); u.on = site_N(st); return; }
  const bool second = (L >= n0); int pm, pn; tile_of(second ? L - n0 : L, second ? j1.nM : j0.nM, second ? j1.nN : j0.nN, pm, pn);
  u.pm = pm; u.pn = pn; u.epi = second ? j1.epi : j0.epi;
  u.A = (const char*)(second ? j1.A : j0.A) + (size_t)pm * tstep; u.B = (const char*)(second ? j1.Bt : j0.Bt) + (size_t)pn * tstep;
}
DI void gemm_phase(KP p, LAS unsigned char* lds, unsigned char* shm, const GemmJob& j0, const GemmJob& j1, const int njobs, const EpiArgs& E, const int skinny) {
  const int tid = tid_get(), wid = __builtin_amdgcn_readfirstlane(tid >> 6), lane = tid & 63, wr = wid >> 2, wc = wid & 3, fr = lane & 15, fq = lane >> 4;
  const int K = j0.K, nt = K / BK;
  const int n0 = j0.nM * j0.nN, n1 = (njobs > 1) ? j1.nM * j1.nN : 0, ntl = n0 + n1;
  if ((int)blockIdx.x < ntl) {
    unsigned voffA[2], voffB[2];
#pragma unroll
    for (int i = 0; i < 2; ++i) { int R, C; stage_rc(tid * 16 + i * 8192, R, C); const int Rb = (R & ~31) + perm32(R & 31);
      voffA[i] = (unsigned)(R * K + C) * 2u; voffB[i] = (unsigned)(Rb * K + C) * 2u; }
    const size_t kstep = (size_t)(BK * 2), hstep = (size_t)HALF * K * 2, tstep = 2 * hstep;
    const unsigned ldsw = (unsigned)wid * 1024u;
    const int aoff = lds_byte(wr * 64 + fr, fq * 8), boff = lds_byte(wc * 32 + fr, fq * 8);
#define G_SA(b, h) (((b) * 2 + (h)) * HTB)
#define G_SB(b, h) ((4 + (b) * 2 + (h)) * HTB)
#define G_STAGE(bufoff, gbase, voff) do { _Pragma("unroll") for (int _i = 0; _i < 2; ++_i) \
      __builtin_amdgcn_global_load_lds((const unsigned*)((const char*)(gbase) + (voff)[_i]), (LAS unsigned*)(lds + (bufoff) + ldsw + _i * 8192), 16, 0, 0); } while (0)
#define G_LDA(dst, b, h) do { _Pragma("unroll") for (int m = 0; m < 4; ++m) _Pragma("unroll") for (int k = 0; k < 2; ++k) dst[m][k] = *(const LAS bf16x8*)(lds + G_SA(b, h) + aoff + m * 2048 + k * 1024); } while (0)
#define G_LDB(dst, b, h) do { _Pragma("unroll") for (int n = 0; n < 2; ++n) _Pragma("unroll") for (int k = 0; k < 2; ++k) dst[n][k] = *(const LAS bf16x8*)(lds + G_SB(b, h) + boff + n * 2048 + k * 1024); } while (0)
#define G_MMA(ai, bj, At, Bt) do { __builtin_amdgcn_s_setprio(1); _Pragma("unroll") for (int m = 0; m < 4; ++m) _Pragma("unroll") for (int n = 0; n < 2; ++n) _Pragma("unroll") for (int k = 0; k < 2; ++k) \
      acc[ai][bj][m][n] = __builtin_amdgcn_mfma_f32_16x16x32_bf16(Bt[n][k], At[m][k], acc[ai][bj][m][n], 0, 0, 0); __builtin_amdgcn_s_setprio(0); } while (0)
#define G_WAIT_V(n) asm volatile("s_waitcnt vmcnt(" #n ")" ::: "memory")
#define G_WAIT_L(n) asm volatile("s_waitcnt lgkmcnt(" #n ")" ::: "memory")
#define G_BAR __builtin_amdgcn_s_barrier()
#define G_SCHED __builtin_amdgcn_sched_barrier(0)
    int L = blockIdx.x;
    UnitD cur, nxt; unit_of(L, j0, j1, n0, tstep, cur);
    f32x4 acc[2][2][4][2];
#pragma unroll
    for (int a = 0; a < 2; ++a)
#pragma unroll
      for (int b = 0; b < 2; ++b)
#pragma unroll
        for (int m = 0; m < 4; ++m)
#pragma unroll
          for (int n = 0; n < 2; ++n) acc[a][b][m][n] = (f32x4){0.f, 0.f, 0.f, 0.f};
    bf16x8 At[4][2], B0[2][2], B1[2][2];
    const char* cA = cur.A; const char* cB = cur.B;
    G_STAGE(G_SB(0, 0), cB, voffB); G_STAGE(G_SB(0, 1), cB + hstep, voffB); G_STAGE(G_SA(0, 0), cA, voffA); G_STAGE(G_SA(0, 1), cA + hstep, voffA);
    if (wr == 1) G_BAR;
    G_WAIT_V(2); G_BAR;
    G_STAGE(G_SB(1, 0), cB + kstep, voffB); G_STAGE(G_SA(1, 0), cA + kstep, voffA); G_STAGE(G_SB(1, 1), cB + hstep + kstep, voffB);
    G_WAIT_V(6); G_BAR;
#pragma unroll 1
    for (;;) {
      const int Ln = L + (int)gridDim.x; const bool has_next = (Ln < ntl);
      if (has_next) unit_of(Ln, j0, j1, n0, tstep, nxt);
      const char* nA = has_next ? nxt.A : cA; const char* nB = has_next ? nxt.B : cB;
#pragma unroll 1
      for (int t = 0; t < nt; t += 2) {
        const bool last = (t == nt - 2);
        const char* a1 = cA + (size_t)(t + 1) * kstep;
        const char* a2 = last ? nA : cA + (size_t)(t + 2) * kstep; const char* b2 = last ? nB : cB + (size_t)(t + 2) * kstep;
        const char* a3 = a2 + kstep; const char* b3 = b2 + kstep;
        G_LDB(B0, 0, 0); G_LDB(B1, 0, 1); G_SCHED; G_LDA(At, 0, 0); G_STAGE(G_SA(1, 1), a1 + hstep, voffA);
        G_WAIT_V(8); G_WAIT_L(0); G_BAR; G_MMA(0, 0, At, B0); G_MMA(0, 1, At, B1); G_BAR; G_SCHED;
        G_LDA(At, 0, 1); G_STAGE(G_SB(0, 0), b2, voffB); G_STAGE(G_SB(0, 1), b2 + hstep, voffB); G_STAGE(G_SA(0, 0), a2, voffA);
        G_WAIT_V(8); G_WAIT_L(0); G_BAR; G_MMA(1, 0, At, B0); G_MMA(1, 1, At, B1); G_BAR; G_SCHED;
        G_LDB(B0, 1, 0); G_LDB(B1, 1, 1); G_SCHED; G_LDA(At, 1, 0); G_STAGE(G_SA(0, 1), a2 + hstep, voffA);
        G_WAIT_V(8); G_WAIT_L(0); G_BAR; G_MMA(0, 0, At, B0); G_MMA(0, 1, At, B1); G_BAR; G_SCHED;
        G_LDA(At, 1, 1); G_STAGE(G_SB(1, 0), b3, voffB); G_STAGE(G_SB(1, 1), b3 + hstep, voffB); G_STAGE(G_SA(1, 0), a3, voffA);
        G_WAIT_V(8); G_WAIT_L(0); G_BAR; G_MMA(1, 0, At, B0); G_MMA(1, 1, At, B1); G_BAR; G_SCHED;
      }
      if (wr == 0) G_BAR;
      { const int r0 = cur.pm * BM + wr * 64 + fr, c0 = cur.pn * BM + wc * 32 + fq * 8; const int epi = cur.epi;
#define EPI_LOOP(MODE) { _Pragma("unroll") for (int ai = 0; ai < 2; ++ai) _Pragma("unroll") for (int m = 0; m < 4; ++m) _Pragma("unroll") for (int bj = 0; bj < 2; ++bj) \
          epi_frag8(p, MODE, E, r0 + ai * 128 + m * 16, c0 + bj * 128, acc[ai][bj][m][0], acc[ai][bj][m][1]); }
        if (epi == EPI_ADA) EPI_LOOP(EPI_ADA)
        else if (epi == EPI_BIAS) {
#pragma unroll
          for (int ai = 0; ai < 2; ++ai)
#pragma unroll
            for (int m = 0; m < 4; ++m) { const int r = r0 + ai * 128 + m * 16; if (r < NMOD) {
#pragma unroll
              for (int bj = 0; bj < 2; ++bj) { float* o = cur.ob + (size_t)r * cur.on + (c0 + bj * 128); *(f32x4*)o = acc[ai][bj][m][0]; *(f32x4*)(o + 4) = acc[ai][bj][m][1]; } } }
        } else if (epi == EPI_RESID) {
          const size_t mo = (size_t)modrow(r0) * MODW;
#pragma unroll
          for (int bj = 0; bj < 2; ++bj) { const int c = c0 + bj * 128;
            const f32x4 ga = *(const f32x4*)(E.f1 + mo + c), gb = *(const f32x4*)(E.f1 + mo + c + 4);
            f32x4 m0 = (f32x4){0.f, 0.f, 0.f, 0.f}, m1 = m0, k0 = m0, k1 = m0;
            if (E.yout) { const f32x4 g0 = *(const f32x4*)(E.ng + c), g1 = *(const f32x4*)(E.ng + c + 4), s0 = *(const f32x4*)(E.nsc + mo + c), s1 = *(const f32x4*)(E.nsc + mo + c + 4);
              m0 = g0 * (s0 + 1.f); m1 = g1 * (s1 + 1.f);
              if (E.ykv) { const f32x4 h0 = *(const f32x4*)(E.ngkv + c), h1 = *(const f32x4*)(E.ngkv + c + 4), t0 = *(const f32x4*)(E.nsckv + mo + c), t1 = *(const f32x4*)(E.nsckv + mo + c + 4);
                k0 = h0 * (t0 + 1.f); k1 = h1 * (t1 + 1.f); } }
#pragma unroll
            for (int ah = 0; ah < 2; ++ah) { const int ai = ah, mb = 0;
              f32x4 ya[4], yb[4];
              const float* xbase = E.first ? p->x_prompt : E.f0;
#pragma unroll
              for (int m = mb; m < mb + 4; ++m) { const unsigned off = (unsigned)(r0 + ai * 128 + m * 16) * (unsigned)D + (unsigned)c;
                ya[m] = *(const f32x4*)(xbase + off); yb[m] = *(const f32x4*)(xbase + off + 4); }
#pragma unroll
              for (int m = mb; m < mb + 4; ++m) { const int r = r0 + ai * 128 + m * 16; const unsigned off = (unsigned)r * (unsigned)D + (unsigned)c;
                const f32x4 xa = ya[m] + ga * acc[ai][bj][m][0], xb = yb[m] + gb * acc[ai][bj][m][1];
                *(f32x4*)(E.f0 + off) = xa; *(f32x4*)(E.f0 + off + 4) = xb;
                if (E.yout) { const f32x4 y0 = xa * m0, y1 = xb * m1;
                  *(u32x4*)(E.yout + off) = (u32x4){pk2(y0[0], y0[1]), pk2(y0[2], y0[3]), pk2(y1[0], y1[1]), pk2(y1[2], y1[3])};
                  if (E.ykv) { const f32x4 z0 = xa * k0, z1 = xb * k1;
                    *(u32x4*)(E.ykv + off) = (u32x4){pk2(z0[0], z0[1]), pk2(z0[2], z0[3]), pk2(z1[0], z1[1]), pk2(z1[2], z1[3])}; }
                  float ss = xa[0] * xa[0] + xa[1] * xa[1] + xa[2] * xa[2] + xa[3] * xa[3] + xb[0] * xb[0] + xb[1] * xb[1] + xb[2] * xb[2] + xb[3] * xb[3];
                  ss += __shfl_xor(ss, 16); ss += __shfl_xor(ss, 32);
                  if (fq == 0) atomicAdd(E.rss_out + (unsigned)r, ss); } } } }
        } else if (epi != EPI_NOP) {
          float rstd8[8];
#pragma unroll
          for (int q = 0; q < 8; ++q) rstd8[q] = rsqrtf(E.rss[r0 + (q >> 2) * 128 + (q & 3) * 16] * (1.f / D) + EPS);
          const float* bb = (epi == EPI_KVRAW) ? E.bias1 + (size_t)modrow(r0) * E.bN1 : E.bias + (size_t)modrow(r0) * E.bN;
          f32x4 bv[2][2], lbv[2][2];
#pragma unroll
          for (int bj = 0; bj < 2; ++bj) { const int c = c0 + bj * 128; bv[bj][0] = *(const f32x4*)(bb + c); bv[bj][1] = *(const f32x4*)(bb + c + 4);
            lbv[bj][0] = (f32x4){0.f, 0.f, 0.f, 0.f}; lbv[bj][1] = (f32x4){0.f, 0.f, 0.f, 0.f};
            if (epi == EPI_HGIN && (c >> 10) == 1 && E.layer == 1) { const int cc = c & 1023;
              const f32x4 l0 = *(const f32x4*)(p->hg_lbp + cc), l1 = *(const f32x4*)(p->hg_lbp + D + cc), l2 = *(const f32x4*)(p->hg_lbp + cc + 4), l3 = *(const f32x4*)(p->hg_lbp + D + cc + 4);
#pragma unroll
              for (int jj = 0; jj < 4; ++jj) { lbv[bj][0][jj] = __builtin_amdgcn_rcpf(1.f + __expf(l0[jj] - l1[jj])); lbv[bj][1][jj] = __builtin_amdgcn_rcpf(1.f + __expf(l2[jj] - l3[jj])); } } }
#define CONS_LOOP(MODE) { _Pragma("unroll") for (int ai = 0; ai < 2; ++ai) _Pragma("unroll") for (int m = 0; m < 4; ++m) _Pragma("unroll") for (int bj = 0; bj < 2; ++bj) \
            epi_frag8(p, MODE, E, r0 + ai * 128 + m * 16, c0 + bj * 128, acc[ai][bj][m][0] * rstd8[ai * 4 + m] + bv[bj][0], acc[ai][bj][m][1] * rstd8[ai * 4 + m] + bv[bj][1], lbv[bj][0], lbv[bj][1]); }
          if (epi == EPI_HGIN) CONS_LOOP(EPI_HGIN) else if (epi == EPI_UP) CONS_LOOP(EPI_UP) else if (epi == EPI_QRAW) CONS_LOOP(EPI_QRAW) else CONS_LOOP(EPI_KVRAW)
        }
      }
      if (!has_next) break;
#pragma unroll
      for (int a = 0; a < 2; ++a)
#pragma unroll
        for (int b = 0; b < 2; ++b)
#pragma unroll
          for (int m = 0; m < 4; ++m)
#pragma unroll
            for (int n = 0; n < 2; ++n) acc[a][b][m][n] = (f32x4){0.f, 0.f, 0.f, 0.f};
      cur = nxt; cA = nA; cB = nB; L = Ln;
      if (wr == 1) G_BAR;
    }
    G_WAIT_V(0);
    G_BAR;
  }
  if (skinny) {
    __syncthreads();
    const int u0 = j0.nN * 16, u1 = (njobs > 1) ? j1.nN * 16 : 0;
#pragma unroll 1
    for (int u = (int)gridDim.x - 1 - (int)blockIdx.x; u < u0 + u1; u += gridDim.x) {
      const bool second = (u >= u0);
      skinny_unit(p, shm, second ? j1.A : j0.A, second ? j1.Bt : j0.Bt, second ? j1.K : j0.K, (second ? u - u0 : u) * 16, second ? j1.epi : j0.epi, E);
    }
  }
}

__device__ const float INVF[32] = {1.000000000e+00f, 7.498942614e-01f, 5.623413324e-01f, 4.216965139e-01f, 3.162277639e-01f, 2.371373773e-01f, 1.778279394e-01f, 1.333521307e-01f, 1.000000015e-01f, 7.498941571e-02f, 5.623413250e-02f, 4.216965288e-02f, 3.162277490e-02f, 2.371373773e-02f, 1.778279431e-02f, 1.333521493e-02f, 9.999999776e-03f, 7.498941850e-03f, 5.623413250e-03f, 4.216964822e-03f, 3.162277630e-03f, 2.371373586e-03f, 1.778279431e-03f, 1.333521446e-03f, 1.000000047e-03f, 7.498942432e-04f, 5.623413017e-04f, 4.216965172e-04f, 3.162277571e-04f, 2.371373703e-04f, 1.778279402e-04f, 1.333521504e-04f};
DI void transpose_item(const float* W, int K, int N, bf16_t* WT, int row_off, float* scr, int item, int lane) {
  const int nblk = N / 32, kb = item / nblk, nb = item % nblk, k0 = 64 * kb, n0 = 32 * nb;
#pragma unroll 8
  for (int i = 0; i < 32; ++i) { const int kk = 2 * i + (lane >> 5); scr[kk * 33 + (lane & 31)] = W[(size_t)(k0 + kk) * N + n0 + (lane & 31)]; }
  asm volatile("s_waitcnt lgkmcnt(0)" ::: "memory");
  const int c = lane & 7;
#pragma unroll
  for (int j = 0; j < 4; ++j) { const int n = (lane >> 3) + 8 * j; const float* s = scr + (8 * c) * 33 + n;
    u32x4 o; o.x = pk2(s[0 * 33], s[1 * 33]); o.y = pk2(s[2 * 33], s[3 * 33]); o.z = pk2(s[4 * 33], s[5 * 33]); o.w = pk2(s[6 * 33], s[7 * 33]);
    *(u32x4*)(WT + (size_t)(row_off + n0 + n) * K + k0 + 8 * c) = o; }
  asm volatile("s_waitcnt lgkmcnt(0)" ::: "memory");
}

DI void prep_phase(KP p, unsigned char* shm) {
  const int tid = tid_get(), lane = tid & 63, wave = tid >> 6;
  const int gw = blockIdx.x * NWAVES + wave, NGW = gridDim.x * NWAVES;
  float* scr = (float*)(shm + wave * 16384);
  unsigned char* ws = p->ws;
  int base = 0;
  for (int mi = 0; mi < 22; ++mi) {
    const float* W; int K, N, row_off; bf16_t* WT;
    if (mi < 2) { W = p->hg_w_in + (size_t)mi * D * 4096; K = D; N = 4096; WT = (bf16_t*)(ws + OFF_WIN) + (size_t)mi * 4096 * D; row_off = 0; }
    else if (mi < 4) { W = p->hg_w_out + (size_t)(mi - 2) * D * D; K = D; N = D; WT = (bf16_t*)(ws + OFF_WOUT) + (size_t)(mi - 2) * D * D; row_off = 0; }
    else if (mi < 5) { W = p->w_kv; K = D; N = 512; WT = (bf16_t*)(ws + OFF_WKV); row_off = 0; }
    else if (mi < 7) { W = p->w_q + (size_t)(mi - 5) * D * D; K = D; N = D; WT = (bf16_t*)(ws + OFF_WQ) + (size_t)(mi - 5) * D * D; row_off = 0; }
    else if (mi < 9) { W = p->w_o + (size_t)(mi - 7) * D * D; K = D; N = D; WT = (bf16_t*)(ws + OFF_WO) + (size_t)(mi - 7) * D * D; row_off = 0; }
    else if (mi < 13) { W = p->w_up + (size_t)(mi - 9) * D * FF; K = D; N = FF; WT = (bf16_t*)(ws + OFF_WUP) + (size_t)(mi - 9) * D * FF; row_off = 0; }
    else if (mi < 17) { W = p->w_down + (size_t)(mi - 13) * D * FF; K = FF; N = D; WT = (bf16_t*)(ws + OFF_WDN) + (size_t)(mi - 13) * D * FF; row_off = 0; }
    else if (mi < 21) { W = p->w_ada + (size_t)(mi - 17) * D * 6144; K = D; N = 6144; WT = (bf16_t*)(ws + OFF_X); row_off = (mi - 17) * 6144; }
    else { W = p->kv_w_ada; K = D; N = 2048; WT = (bf16_t*)(ws + OFF_X); row_off = 24576; }
    const int nitems = (K / 64) * (N / 32);
    int first = (gw - (base % NGW) + NGW) % NGW;
    for (int it = first; it < nitems; it += NGW) transpose_item(W, K, N, WT, row_off, scr, it, lane);
    base += nitems;
  }
  bf16_t* Ac = (bf16_t*)(ws + OFF_X + (size_t)MODW * D * 2);
  const int gt = blockIdx.x * NTHREADS + tid, NGT = gridDim.x * NTHREADS;
  for (int e = gt; e < 256 * D / 2; e += NGT) { const int r = e / (D / 2), c = (e % (D / 2)) * 2; float a = 0.f, b = 0.f;
    if (r < NMOD) { const float* cp = (r < 4) ? p->c_prompt + (size_t)r * D : p->c_sample + (size_t)(r - 4) * D; a = silu_f(cp[c]); b = silu_f(cp[c + 1]); }
    *(unsigned*)(Ac + (size_t)r * D + c) = pk2(a, b); }
  float* tab = (float*)(ws + OFF_TAB);
  for (int e = gt; e < 4097 * 32; e += NGT) { const int pi = e >> 5, i = e & 31; const float pos = (pi < 4096) ? (float)pi : 8192.f;
    const float ang = pos * INVF[i]; float sn, cs; sincosf(ang, &sn, &cs);
    tab[pi * 64 + i] = cs; tab[pi * 64 + 32 + i] = sn; }
}

DI void init_rows(KP p, unsigned* ctr) {
  const int tid = tid_get(); const int lane = tid & 63;
  unsigned char* ws = p->ws; const float* mods = (const float*)(ws + OFF_MODS); bf16_t* yout = (bf16_t*)(ws + OFF_H); float* rss = (float*)(ws + OFF_RSS);
  const float* g = p->norm1_g; const float* msc = mods + 1024;
#pragma unroll 1
  for (;;) {
    unsigned cidx = 0; if (lane == 0) cidx = __hip_atomic_fetch_add(ctr, 1u, __ATOMIC_RELAXED, __HIP_MEMORY_SCOPE_AGENT);
    cidx = __builtin_amdgcn_readfirstlane(cidx);
    if (cidx >= (unsigned)(T / 8)) break;
#pragma unroll 1
    for (int hh = 0; hh < 2; ++hh) { const int rb = (int)cidx * 8 + hh * 4;
      f32x4 v[4][4];
#pragma unroll
      for (int q = 0; q < 4; ++q) { const int r = rb + q; const float* xr = (r < TP) ? p->x_prompt + (size_t)r * D : p->x_sample + (size_t)(r - TP) * D;
#pragma unroll
        for (int jj = 0; jj < 4; ++jj) v[q][jj] = *(const f32x4*)(xr + lane * 4 + 256 * jj); }
#pragma unroll
      for (int q = 0; q < 4; ++q) { const int r = rb + q; float a = 0.f;
#pragma unroll
        for (int jj = 0; jj < 4; ++jj) a += v[q][jj][0] * v[q][jj][0] + v[q][jj][1] * v[q][jj][1] + v[q][jj][2] * v[q][jj][2] + v[q][jj][3] * v[q][jj][3];
#pragma unroll
        for (int o = 1; o < 64; o <<= 1) a += __shfl_xor(a, o);
        if (lane == 0) rss[r] = a;
        const size_t mo = (size_t)modrow(r) * MODW;
#pragma unroll
        for (int jj = 0; jj < 4; ++jj) { const int c = lane * 4 + 256 * jj;
          const f32x4 gg = *(const f32x4*)(g + c), sc = *(const f32x4*)(msc + mo + c);
          const f32x4 h = v[q][jj] * gg * (sc + 1.f);
          *(u32x2*)(yout + (size_t)r * D + c) = (u32x2){pk2(h[0], h[1]), pk2(h[2], h[3])}; } } }
  }
}

struct HgBufs { const bf16_t *q, *k, *v, *g; const float* lf; float* o32; bf16_t* on; };

constexpr int SPAN = 256, NSPAN = SEQ / SPAN, CH = 32, NCH = SPAN / CH;
constexpr int L_CUM = 0, L_QT = 16896, L_KT = 25600, L_KE = 34304, L_VT = 44544, L_PS = 54784, L_DEC = 55808, L_HALF = 57344;
constexpr int CUS = 132, QS = 136, KES = 40;
DI bf16x8 pack8(const f32x16& x, const int s) {
  return __builtin_bit_cast(bf16x8, (u32x4){pk2(x[8 * s], x[8 * s + 1]), pk2(x[8 * s + 2], x[8 * s + 3]), pk2(x[8 * s + 4], x[8 * s + 5]), pk2(x[8 * s + 6], x[8 * s + 7])});
}
template <int MODE>
DI void scan_prompt(KP p, const int l, const HgBufs& B, unsigned char* shm) {
  const int tid = tid_get(), lane = tid & 63, wave = tid >> 6, hb = wave >> 2, th = tid & 255, vb = wave & 3, h5 = lane >> 5, l31 = lane & 31;
  unsigned char* base = shm + hb * L_HALF;
  float* cumb = (float*)(base + L_CUM); bf16_t* Qt = (bf16_t*)(base + L_QT); bf16_t* Kt = (bf16_t*)(base + L_KT);
  bf16_t* KeT = (bf16_t*)(base + L_KE); bf16_t* Vt = (bf16_t*)(base + L_VT); float* psum = (float*)(base + L_PS); float* dec = (float*)(base + L_DEC);
  float* dS = B.o32; float* Lsum = B.o32 + (size_t)512 * 16384;
#pragma unroll 1
  for (int it0 = blockIdx.x * 2; it0 < 32 * NSPAN; it0 += gridDim.x * 2) {
    const int item = it0 + hb, bh = item / NSPAN, span = item % NSPAN, b = bh >> 3, h = bh & 7;
    f32x16 S[4];
#pragma unroll
    for (int db = 0; db < 4; ++db)
#pragma unroll
      for (int r = 0; r < 16; ++r) S[db][r] = 0.f;
    if (MODE == 1) {
      const unsigned ob = (unsigned)item * 16384u + (unsigned)(vb * 32 + l31) + (unsigned)(4 * h5) * 128u;
#pragma unroll
      for (int db = 0; db < 4; ++db) {
#pragma unroll
        for (int r = 0; r < 16; ++r) S[db][r] = dS[ob + (unsigned)((32 * db + (r & 3) + 8 * (r >> 2)) * 128)];
        __builtin_amdgcn_sched_barrier(0); }
    }
    float Ltot = 0.f;
#define LBAR() do { asm volatile("s_waitcnt lgkmcnt(0)" ::: "memory"); __builtin_amdgcn_s_barrier(); asm volatile("" ::: "memory"); } while (0)
    const int d1 = th & 127, part = th >> 7, t2 = th >> 3, dg = th & 7;
    const size_t tokS = (size_t)b * SEQ + (size_t)span * SPAN;
    float lfr[16]; unsigned kr[16], vr[16]; u32x4 q0, q1, k0, k1, g0, g1;
#define SCAN_LOAD(chx) do { const size_t o0_ = (tokS + (size_t)(chx) * CH + part * 16) * D + h * 128 + d1; \
      _Pragma("unroll") for (int i = 0; i < 16; ++i) { lfr[i] = B.lf[o0_ + (size_t)i * D]; kr[i] = B.k[o0_ + (size_t)i * D]; vr[i] = B.v[o0_ + (size_t)i * D]; } \
      } while (0)
    __builtin_amdgcn_sched_barrier(0);
    SCAN_LOAD(0);
    __builtin_amdgcn_sched_barrier(0);
#pragma unroll 1
    for (int ch = 0; ch < NCH; ++ch) {
      const size_t tok0 = tokS + (size_t)ch * CH;
      if (MODE == 1) { const size_t o_ = (tok0 + t2) * D + h * 128 + dg * 16;
        q0 = *(const u32x4*)(B.q + o_); q1 = *(const u32x4*)(B.q + o_ + 8); k0 = *(const u32x4*)(B.k + o_); k1 = *(const u32x4*)(B.k + o_ + 8);
        g0 = *(const u32x4*)(B.g + o_); g1 = *(const u32x4*)(B.g + o_ + 8); }
      { const int d = d1;
        float c[16]; float run = 0.f;
#pragma unroll
        for (int i = 0; i < 16; ++i) { run += lfr[i]; c[i] = run; }
        psum[part * 128 + d] = run;
        LBAR();
        const float t0 = psum[d], t1 = psum[128 + d]; const float off = part ? t0 : 0.f; const float Lc = t0 + t1;
        float ke[16];
#pragma unroll
        for (int i = 0; i < 16; ++i) { const float cu = off + c[i]; if (MODE == 1) cumb[(part * 16 + i) * CUS + d] = cu; ke[i] = bf2f(kr[i]) * __expf(Lc - cu); }
        *(u32x4*)(KeT + d * KES + part * 16) = (u32x4){pk2(ke[0], ke[1]), pk2(ke[2], ke[3]), pk2(ke[4], ke[5]), pk2(ke[6], ke[7])};
        *(u32x4*)(KeT + d * KES + part * 16 + 8) = (u32x4){pk2(ke[8], ke[9]), pk2(ke[10], ke[11]), pk2(ke[12], ke[13]), pk2(ke[14], ke[15])};
        *(u32x4*)(Vt + d * KES + part * 16) = (u32x4){vr[0] | (vr[1] << 16), vr[2] | (vr[3] << 16), vr[4] | (vr[5] << 16), vr[6] | (vr[7] << 16)};
        *(u32x4*)(Vt + d * KES + part * 16 + 8) = (u32x4){vr[8] | (vr[9] << 16), vr[10] | (vr[11] << 16), vr[12] | (vr[13] << 16), vr[14] | (vr[15] << 16)};
        if (part == 0) { dec[d] = __expf(Lc); Ltot += Lc; }
      }
      LBAR();
      if (MODE == 1) {
        const int t = t2;
        unsigned qo[8], ko[8];
#pragma unroll
        for (int g4 = 0; g4 < 4; ++g4) { const f32x4 cv = *(const f32x4*)(cumb + t * CUS + dg * 16 + 4 * g4);
#pragma unroll
          for (int e2 = 0; e2 < 2; ++e2) { const int w = g4 * 2 + e2; const unsigned qw = (w < 4) ? q0[w & 3] : q1[w & 3], kw = (w < 4) ? k0[w & 3] : k1[w & 3];
            const float ca = cv[2 * e2], cb = cv[2 * e2 + 1];
            qo[w] = pk2(bf2f(qw & 0xffffu) * __expf(ca), bf2f(qw >> 16) * __expf(cb));
            ko[w] = pk2(bf2f(kw & 0xffffu) * __expf(fminf(-ca, 80.f)), bf2f(kw >> 16) * __expf(fminf(-cb, 80.f))); } }
        *(u32x4*)(Qt + t * QS + dg * 16) = (u32x4){qo[0], qo[1], qo[2], qo[3]}; *(u32x4*)(Qt + t * QS + dg * 16 + 8) = (u32x4){qo[4], qo[5], qo[6], qo[7]};
        *(u32x4*)(Kt + t * QS + dg * 16) = (u32x4){ko[0], ko[1], ko[2], ko[3]}; *(u32x4*)(Kt + t * QS + dg * 16 + 8) = (u32x4){ko[4], ko[5], ko[6], ko[7]};
        LBAR();
      }
      { const int chn = (ch + 1 < NCH) ? ch + 1 : ch; SCAN_LOAD(chn); }
      f32x16 O;
      if (MODE == 1) {
        f32x16 X;
#pragma unroll
        for (int r = 0; r < 16; ++r) { X[r] = 0.f; O[r] = 0.f; }
#pragma unroll
        for (int ks = 0; ks < 8; ++ks) { const bf16x8 a = *(const bf16x8*)(Kt + l31 * QS + 16 * ks + 8 * h5), bq = *(const bf16x8*)(Qt + l31 * QS + 16 * ks + 8 * h5);
          X = __builtin_amdgcn_mfma_f32_32x32x16_bf16(a, bq, X, 0, 0, 0); }
#pragma unroll
        for (int r = 0; r < 16; ++r) if (crow(r, h5) > l31) X[r] = 0.f;
#pragma unroll
        for (int st = 0; st < 2; ++st) { const bf16_t* vp = Vt + (vb * 32 + l31) * KES + 16 * st + 4 * h5; const u32x2 lo = *(const u32x2*)vp, hi = *(const u32x2*)(vp + 8);
          O = __builtin_amdgcn_mfma_f32_32x32x16_bf16(pack8(X, st), __builtin_bit_cast(bf16x8, (u32x4){lo[0], lo[1], hi[0], hi[1]}), O, 0, 0, 0); }
#pragma unroll
        for (int db = 0; db < 4; ++db)
#pragma unroll
          for (int st = 0; st < 2; ++st) { const bf16_t* qp = Qt + l31 * QS + 32 * db + 16 * st + 4 * h5; const u32x2 lo = *(const u32x2*)qp, hi = *(const u32x2*)(qp + 8);
            O = __builtin_amdgcn_mfma_f32_32x32x16_bf16(__builtin_bit_cast(bf16x8, (u32x4){lo[0], lo[1], hi[0], hi[1]}), pack8(S[db], st), O, 0, 0, 0); }
      }
#pragma unroll
      for (int db = 0; db < 4; ++db) {
#pragma unroll
        for (int r4 = 0; r4 < 4; ++r4) { const f32x4 dv = *(const f32x4*)(dec + 32 * db + 8 * r4 + 4 * h5);
#pragma unroll
          for (int e = 0; e < 4; ++e) S[db][4 * r4 + e] *= dv[e]; }
#pragma unroll
        for (int st = 0; st < 2; ++st) { const bf16x8 a = *(const bf16x8*)(KeT + (32 * db + l31) * KES + 16 * st + 8 * h5), bv = *(const bf16x8*)(Vt + (vb * 32 + l31) * KES + 16 * st + 8 * h5);
          S[db] = __builtin_amdgcn_mfma_f32_32x32x16_bf16(a, bv, S[db], 0, 0, 0); } }
      if (MODE == 1) {
#pragma unroll
        for (int r = 0; r < 16; ++r) cumb[crow(r, h5) * CUS + vb * 32 + l31] = O[r];
        LBAR();
        const int t = t2, vg = dg; const size_t o = (tok0 + t) * D + h * 128 + vg * 16;
        f32x4 ov[4]; float ss = 0.f;
#pragma unroll
        for (int g4 = 0; g4 < 4; ++g4) { ov[g4] = *(const f32x4*)(cumb + t * CUS + vg * 16 + 4 * g4); ss += ov[g4][0] * ov[g4][0] + ov[g4][1] * ov[g4][1] + ov[g4][2] * ov[g4][2] + ov[g4][3] * ov[g4][3]; }
        ss += __shfl_xor(ss, 1); ss += __shfl_xor(ss, 2); ss += __shfl_xor(ss, 4);
        const float rstd = rsqrtf(ss * (1.f / 128.f) + EPS);
        unsigned w[8];
#pragma unroll
        for (int g4 = 0; g4 < 4; ++g4) { const f32x4 gn = *(const f32x4*)(p->hg_gn_g + l * 128 + vg * 16 + 4 * g4);
#pragma unroll
          for (int e2 = 0; e2 < 2; ++e2) { const int wi = g4 * 2 + e2; const unsigned gw = (wi < 4) ? g0[wi & 3] : g1[wi & 3];
            w[wi] = pk2(ov[g4][2 * e2] * rstd * gn[2 * e2] * bf2f(gw & 0xffffu), ov[g4][2 * e2 + 1] * rstd * gn[2 * e2 + 1] * bf2f(gw >> 16)); } }
        *(u32x4*)(B.on + o) = (u32x4){w[0], w[1], w[2], w[3]}; *(u32x4*)(B.on + o + 8) = (u32x4){w[4], w[5], w[6], w[7]};
      } else {
        LBAR();
      }
    }
    if (MODE == 0) {
      float* dSo = dS + (size_t)item * 16384 + vb * 32 + l31;
#pragma unroll
      for (int db = 0; db < 4; ++db)
#pragma unroll
        for (int r = 0; r < 16; ++r) dSo[(size_t)(32 * db + crow(r, h5)) * 128] = S[db][r];
      if (th < 128) Lsum[(size_t)item * 128 + th] = Ltot;
    } else if (span == NSPAN - 1) {
      float* so = p->out + O_HGP + ((size_t)((l * 4 + b) * 8 + h)) * 16384 + vb * 32 + l31;
#pragma unroll
      for (int db = 0; db < 4; ++db)
#pragma unroll
        for (int r = 0; r < 16; ++r) so[(size_t)(32 * db + crow(r, h5)) * 128] = S[db][r];
    }
    __syncthreads();
  }
}

DI void scan_passB(const HgBufs& B) {
  const int tid = tid_get();
  float* dS = B.o32; const float* Lsum = B.o32 + (size_t)512 * 16384;
  const int gt = blockIdx.x * NTHREADS + tid, NGT = gridDim.x * NTHREADS;
#pragma unroll 1
  for (int e = gt; e < 32 * 4096; e += NGT) { const int bh = e >> 12, q4 = e & 4095, d = q4 >> 5;
    float* base = dS + (size_t)bh * NSPAN * 16384 + (size_t)q4 * 4; const float* Lb = Lsum + (size_t)bh * NSPAN * 128 + d;
    f32x4 v[NSPAN]; float lv[NSPAN];
#pragma unroll
    for (int sp = 0; sp < NSPAN; ++sp) { v[sp] = *(const f32x4*)(base + (size_t)sp * 16384); lv[sp] = Lb[sp * 128]; }
    f32x4 run = (f32x4){0.f, 0.f, 0.f, 0.f};
#pragma unroll
    for (int sp = 0; sp < NSPAN; ++sp) { *(f32x4*)(base + (size_t)sp * 16384) = run; run = run * __expf(lv[sp]) + v[sp]; }
  }
}

DI void scan_phase(KP p, const int l, const HgBufs& B, unsigned char* shm) {
  scan_prompt<0>(p, l, B, shm);
  const int tid = tid_get(), lane = tid & 63, wave = tid >> 6;
  {
    float* ps = (float*)shm;
    const int v4 = (tid & 31) * 4, dq = tid >> 5;
    f32x4 sv[8], svn[8]; float lfv[8], lfn[8]; unsigned kq[8], kqn[8]; u32x2 vw, vwn;
#define SMP_LOAD(IT, SV, LF, KQ, VW) do { const int bs_ = (IT) >> 3, h_ = (IT) & 7; const size_t r_ = TP + bs_; \
      const float* s0_ = p->state_hgrn + ((size_t)((l * 128 + bs_) * 8 + h_)) * 16384; \
      VW = *(const u32x2*)(B.v + r_ * D + h_ * 128 + v4); \
      _Pragma("unroll") for (int i = 0; i < 8; ++i) { const int d_ = dq * 8 + i; const size_t o_ = r_ * D + h_ * 128 + d_; \
        LF[i] = B.lf[o_]; KQ[i] = (unsigned)B.k[o_] | ((unsigned)B.q[o_] << 16); SV[i] = __builtin_nontemporal_load((const f32x4*)(s0_ + d_ * 128 + v4)); } } while (0)
    int item = blockIdx.x, par = 0;
    if (item < 1024) SMP_LOAD(item, sv, lfv, kq, vw);
#pragma unroll 1
    for (; item < 1024; item += gridDim.x, par ^= 1) {
      const int bs = item >> 3, h = item & 7; const size_t r = TP + bs;
      const int nitem = item + gridDim.x;
      if (nitem < 1024) SMP_LOAD(nitem, svn, lfn, kqn, vwn);
      float* s1 = p->out + O_HGS + ((size_t)((l * 128 + bs) * 8 + h)) * 16384;
      const f32x4 vv = (f32x4){bf2f(vw[0] & 0xffffu), bf2f(vw[0] >> 16), bf2f(vw[1] & 0xffffu), bf2f(vw[1] >> 16)};
      f32x4 op = (f32x4){0.f, 0.f, 0.f, 0.f};
#pragma unroll
      for (int i = 0; i < 8; ++i) { const int d = dq * 8 + i;
        const float f = __expf(lfv[i]), kk = bf2f(kq[i] & 0xffffu), qq = bf2f(kq[i] >> 16);
        const f32x4 sn = sv[i] * f + vv * kk;
        __builtin_nontemporal_store(sn, (f32x4*)(s1 + d * 128 + v4)); op += sn * qq; }
#pragma unroll
      for (int jx = 0; jx < 4; ++jx) op[jx] += __shfl_xor(op[jx], 32);
      float* psb = ps + par * 1024;
      if (lane < 32) *(f32x4*)(psb + wave * 128 + v4) = op;
      __syncthreads();
      if (tid < 64) { float o0 = 0.f, o1 = 0.f;
#pragma unroll
        for (int w = 0; w < 8; ++w) { const f32x2 x = *(const f32x2*)(psb + w * 128 + tid * 2); o0 += x[0]; o1 += x[1]; }
        float ss = o0 * o0 + o1 * o1;
#pragma unroll
        for (int o = 1; o < 64; o <<= 1) ss += __shfl_xor(ss, o);
        const float rstd = rsqrtf(ss * (1.f / 128.f) + EPS);
        const int vv2 = tid * 2; const size_t o = r * D + h * 128 + vv2;
        const float g0 = p->hg_gn_g[l * 128 + vv2], g1 = p->hg_gn_g[l * 128 + vv2 + 1];
        *(unsigned*)(B.on + o) = pk2(o0 * rstd * g0 * bf2f(B.g[o]), o1 * rstd * g1 * bf2f(B.g[o + 1])); }
#pragma unroll
      for (int i = 0; i < 8; ++i) { sv[i] = svn[i]; lfv[i] = lfn[i]; kq[i] = kqn[i]; }
      vw = vwn;
    }
    __syncthreads();
  }
}

constexpr int KN_STRIDE = 72, VT_STRIDE = 264;
constexpr int KN_BYTES = 256 * KN_STRIDE * 2;
struct AtBufs { const bf16_t* qraw; const float* kvraw; bf16_t* on; const float* tab; };

DI void attn_phase(KP p, const int l, const AtBufs& B, unsigned char* shm) {
  const int tid = tid_get(), lane = tid & 63, wave = tid >> 6;
  const int j = l - 2;
  const float* qg = p->q_norm_g + j * 64; const float* sinkp = p->sinks + j * 16;
  const bool write_cache = (l == 2);
  const int nitems = 512 + 512;
#pragma unroll 1
  for (int item = blockIdx.x; item < 512; item += gridDim.x) {
    {
      const int b = item >> 7, qb = (item >> 2) & 31, kvh = item & 3;
      bf16_t* Kn = (bf16_t*)shm; bf16_t* Vt = (bf16_t*)(shm + KN_BYTES);
      const int band0 = (qb - 1) * 128;
      {
        const int key = tid >> 1, part = tid & 1; const int pos = band0 + key; const bool valid = pos >= 0;
        float x1[16], x2[16];
        if (valid) { const float* kp = B.kvraw + ((size_t)b * SEQ + pos) * 512 + kvh * 64 + part * 16;
#pragma unroll
          for (int i = 0; i < 4; ++i) { const f32x4 a = *(const f32x4*)(kp + 4 * i), c = *(const f32x4*)(kp + 32 + 4 * i);
#pragma unroll
            for (int e = 0; e < 4; ++e) { x1[4 * i + e] = a[e]; x2[4 * i + e] = c[e]; } }
        } else {
#pragma unroll
          for (int i = 0; i < 16; ++i) { x1[i] = 0.f; x2[i] = 0.f; } }
        float ss = 0.f;
#pragma unroll
        for (int i = 0; i < 16; ++i) ss += x1[i] * x1[i] + x2[i] * x2[i];
        ss += __shfl_xor(ss, 1);
        const float rstd = rsqrtf(ss * (1.f / 64.f) + EPS);
        const float* tb = B.tab + (size_t)(valid ? pos : 0) * 64 + part * 16;
        float o1[16], o2[16];
#pragma unroll
        for (int i = 0; i < 16; ++i) { const float a = x1[i] * rstd * p->k_norm_g[part * 16 + i], c = x2[i] * rstd * p->k_norm_g[32 + part * 16 + i];
          const float cs = tb[i], sn = tb[32 + i]; o1[i] = a * cs - c * sn; o2[i] = c * cs + a * sn; }
        u32x4 w;
        w = (u32x4){pk2(o1[0], o1[1]), pk2(o1[2], o1[3]), pk2(o1[4], o1[5]), pk2(o1[6], o1[7])}; *(u32x4*)(Kn + key * KN_STRIDE + part * 16) = w;
        w = (u32x4){pk2(o1[8], o1[9]), pk2(o1[10], o1[11]), pk2(o1[12], o1[13]), pk2(o1[14], o1[15])}; *(u32x4*)(Kn + key * KN_STRIDE + part * 16 + 8) = w;
        w = (u32x4){pk2(o2[0], o2[1]), pk2(o2[2], o2[3]), pk2(o2[4], o2[5]), pk2(o2[6], o2[7])}; *(u32x4*)(Kn + key * KN_STRIDE + 32 + part * 16) = w;
        w = (u32x4){pk2(o2[8], o2[9]), pk2(o2[10], o2[11]), pk2(o2[12], o2[13]), pk2(o2[14], o2[15])}; *(u32x4*)(Kn + key * KN_STRIDE + 32 + part * 16 + 8) = w;
        if (write_cache && qb == 31 && key >= 128) { float* ko = p->out + O_KP + ((size_t)(b * 128 + key - 128) * 4 + kvh) * 64 + part * 16;
#pragma unroll
          for (int i = 0; i < 4; ++i) { *(f32x4*)(ko + 4 * i) = (f32x4){o1[4 * i], o1[4 * i + 1], o1[4 * i + 2], o1[4 * i + 3]};
            *(f32x4*)(ko + 32 + 4 * i) = (f32x4){o2[4 * i], o2[4 * i + 1], o2[4 * i + 2], o2[4 * i + 3]}; } }
      }
      {
        const int key = tid & 255, dh = tid >> 8; const int pos = band0 + key; const bool valid = pos >= 0;
        const float* vp = B.kvraw + ((size_t)b * SEQ + (valid ? pos : 0)) * 512 + 256 + kvh * 64 + dh * 32;
#pragma unroll
        for (int i = 0; i < 8; ++i) { f32x4 a = *(const f32x4*)(vp + 4 * i); if (!valid) a = (f32x4){0.f, 0.f, 0.f, 0.f};
#pragma unroll
          for (int e = 0; e < 4; ++e) Vt[(dh * 32 + 4 * i + e) * VT_STRIDE + key] = (bf16_t)f2bf(a[e]);
          if (write_cache && qb == 31 && key >= 128) *(f32x4*)(p->out + O_VP + ((size_t)(b * 128 + key - 128) * 4 + kvh) * 64 + dh * 32 + 4 * i) = a; }
      }
      __syncthreads();
      const int g = wave & 3, qhalf = wave >> 2, hq = kvh * 4 + g, h = lane >> 5, l31 = lane & 31;
      const float sink = sinkp[hq];
#pragma unroll 1
      for (int sub = 0; sub < 2; ++sub) {
        const int Q0 = 128 + qhalf * 64 + sub * 32, qi = Q0 + l31, pos = band0 + qi;
        const size_t tok = (size_t)b * SEQ + pos;
        float x[4][8];
        { const bf16_t* qp = B.qraw + tok * D + hq * 64 + 8 * h;
#pragma unroll
          for (int s = 0; s < 4; ++s) { const u32x4 w = *(const u32x4*)(qp + 16 * s);
#pragma unroll
            for (int e = 0; e < 4; ++e) { x[s][2 * e] = bf2f(w[e] & 0xffffu); x[s][2 * e + 1] = bf2f(w[e] >> 16); } } }
        float ss = 0.f;
#pragma unroll
        for (int s = 0; s < 4; ++s)
#pragma unroll
          for (int e = 0; e < 8; ++e) ss += x[s][e] * x[s][e];
        ss += __shfl_xor(ss, 32);
        const float rstd = rsqrtf(ss * (1.f / 64.f) + EPS) ;
#pragma unroll
        for (int s = 0; s < 4; ++s)
#pragma unroll
          for (int e = 0; e < 8; ++e) x[s][e] *= rstd * qg[16 * s + 8 * h + e];
        const float* tb = B.tab + (size_t)pos * 64;
        bf16x8 qf[4];
#pragma unroll
        for (int s = 0; s < 2; ++s) { unsigned lo[4], hi[4]; float r1[8], r2[8];
#pragma unroll
          for (int e = 0; e < 8; ++e) { const int i = 16 * s + 8 * h + e; const float cs = tb[i], sn = tb[32 + i]; const float a = x[s][e], c = x[s + 2][e];
            r1[e] = (a * cs - c * sn) * 0.125f; r2[e] = (c * cs + a * sn) * 0.125f; }
#pragma unroll
          for (int e = 0; e < 4; ++e) { lo[e] = pk2(r1[2 * e], r1[2 * e + 1]); hi[e] = pk2(r2[2 * e], r2[2 * e + 1]); }
          qf[s] = __builtin_bit_cast(bf16x8, (u32x4){lo[0], lo[1], lo[2], lo[3]}); qf[s + 2] = __builtin_bit_cast(bf16x8, (u32x4){hi[0], hi[1], hi[2], hi[3]}); }
        const int kb0 = (Q0 - 128) >> 5;
        f32x16 sacc[5]; float mx = sink;
#pragma unroll
        for (int i = 0; i < 5; ++i) { const int kb = kb0 + i; f32x16 a16;
#pragma unroll
          for (int r = 0; r < 16; ++r) a16[r] = 0.f;
          bf16x8 ka[4];
#pragma unroll
          for (int s = 0; s < 4; ++s) ka[s] = *(const bf16x8*)(Kn + (kb * 32 + l31) * KN_STRIDE + 16 * s + 8 * h);
#pragma unroll
          for (int s = 0; s < 4; ++s) a16 = __builtin_amdgcn_mfma_f32_32x32x16_bf16(ka[s], qf[s], a16, 0, 0, 0);
#pragma unroll
          for (int r = 0; r < 16; ++r) { const int key = kb * 32 + crow(r, h); const int rel = qi - key; const bool ok = (rel >= 0) && (rel < 128) && (qb > 0 || key >= 128);
            const float sv = ok ? a16[r] : -1e30f; a16[r] = sv; mx = fmaxf(mx, sv); }
          sacc[i] = a16; }
        mx = fmaxf(mx, __shfl_xor(mx, 32));
        float sum = 0.f; bf16x8 pf[5][2];
#pragma unroll
        for (int i = 0; i < 5; ++i) { float e[16];
#pragma unroll
          for (int r = 0; r < 16; ++r) { e[r] = __expf(sacc[i][r] - mx); sum += e[r]; }
#pragma unroll
          for (int st = 0; st < 2; ++st) pf[i][st] = __builtin_bit_cast(bf16x8, (u32x4){pk2(e[8 * st], e[8 * st + 1]), pk2(e[8 * st + 2], e[8 * st + 3]), pk2(e[8 * st + 4], e[8 * st + 5]), pk2(e[8 * st + 6], e[8 * st + 7])}); }
        sum += __shfl_xor(sum, 32);
        const float inv = 1.f / (sum + __expf(sink - mx));
#pragma unroll
        for (int db = 0; db < 2; ++db) { f32x16 o16;
#pragma unroll
          for (int r = 0; r < 16; ++r) o16[r] = 0.f;
          bf16x8 va[10];
#pragma unroll
          for (int i = 0; i < 5; ++i)
#pragma unroll
            for (int st = 0; st < 2; ++st) { const bf16_t* vp = Vt + (db * 32 + l31) * VT_STRIDE + (kb0 + i) * 32 + 16 * st + 4 * h;
              const u32x2 lo = *(const u32x2*)vp, hi = *(const u32x2*)(vp + 8);
              va[i * 2 + st] = __builtin_bit_cast(bf16x8, (u32x4){lo[0], lo[1], hi[0], hi[1]}); }
          f32x16 o16b;
#pragma unroll
          for (int r = 0; r < 16; ++r) o16b[r] = 0.f;
#pragma unroll
          for (int i = 0; i < 5; ++i) { o16 = __builtin_amdgcn_mfma_f32_32x32x16_bf16(va[i * 2], pf[i][0], o16, 0, 0, 0); o16b = __builtin_amdgcn_mfma_f32_32x32x16_bf16(va[i * 2 + 1], pf[i][1], o16b, 0, 0, 0); }
#pragma unroll
          for (int r = 0; r < 16; ++r) o16[r] += o16b[r];
          bf16_t* op = B.on + tok * D + hq * 64 + db * 32 + 4 * h;
#pragma unroll
          for (int r4 = 0; r4 < 4; ++r4) *(u32x2*)(op + 8 * r4) = (u32x2){pk2(o16[4 * r4] * inv, o16[4 * r4 + 1] * inv), pk2(o16[4 * r4 + 2] * inv, o16[4 * r4 + 3] * inv)}; }
      }
      __syncthreads();
    }
  }
  {
    const int tid = tid_get(), lane = tid & 63, wave = tid >> 6;
#pragma unroll 1
    for (int item = 512 + blockIdx.x; item < nitems; item += gridDim.x) {
      const int sidx = item - 512, bs = sidx >> 2, kvh = sidx & 3; const size_t r = TP + bs;
      float* Ks = (float*)shm; float* Vs = Ks + 128 * 68; float* q_s = Vs + 128 * 64; float* p_s = q_s + 256; float* redm = p_s + 512; float* reds = redm + 8; float* po = reds + 8;
      const float* tb = B.tab + (size_t)4096 * 64;
      f32x4 kreg[4], vreg[4];
#pragma unroll
      for (int i = 0; i < 4; ++i) { const int e = tid + 512 * i, jr = e >> 4, c4 = (e & 15) * 4;
        if (jr < 127) { const size_t o = (((size_t)bs * 128 + jr + 1) * 4 + kvh) * 64 + c4; kreg[i] = __builtin_nontemporal_load((const f32x4*)(p->cache_k + o)); vreg[i] = __builtin_nontemporal_load((const f32x4*)(p->cache_v + o)); } }
      if (tid < 128) { const int g = tid >> 5, i = tid & 31, hq = kvh * 4 + g;
        float a = bf2f(B.qraw[r * D + hq * 64 + i]), c = bf2f(B.qraw[r * D + hq * 64 + 32 + i]);
        float ss = a * a + c * c;
#pragma unroll
        for (int o = 1; o < 32; o <<= 1) ss += __shfl_xor(ss, o);
        const float rstd = rsqrtf(ss * (1.f / 64.f) + EPS); a *= rstd * qg[i]; c *= rstd * qg[32 + i];
        const float cs = tb[i], sn = tb[32 + i];
        q_s[g * 64 + i] = (a * cs - c * sn) * 0.125f; q_s[g * 64 + 32 + i] = (c * cs + a * sn) * 0.125f;
      } else if (tid < 160) { const int i = tid & 31;
        float a = B.kvraw[r * 512 + kvh * 64 + i], c = B.kvraw[r * 512 + kvh * 64 + 32 + i];
        float ss = a * a + c * c;
#pragma unroll
        for (int o = 1; o < 32; o <<= 1) ss += __shfl_xor(ss, o);
        const float rstd = rsqrtf(ss * (1.f / 64.f) + EPS); a *= rstd * p->k_norm_g[i]; c *= rstd * p->k_norm_g[32 + i];
        const float cs = tb[i], sn = tb[32 + i];
        const float k1 = a * cs - c * sn, k2 = c * cs + a * sn, v1 = B.kvraw[r * 512 + 256 + kvh * 64 + i], v2 = B.kvraw[r * 512 + 256 + kvh * 64 + 32 + i];
        Ks[127 * 68 + i] = k1; Ks[127 * 68 + 32 + i] = k2; Vs[127 * 64 + i] = v1; Vs[127 * 64 + 32 + i] = v2;
        if (write_cache) { float* ok = p->out + O_KS + (((size_t)bs * 128 + 127) * 4 + kvh) * 64; float* ov = p->out + O_VS + (((size_t)bs * 128 + 127) * 4 + kvh) * 64;
          ok[i] = k1; ok[32 + i] = k2; ov[i] = v1; ov[32 + i] = v2; } }
#pragma unroll
      for (int i = 0; i < 4; ++i) { const int e = tid + 512 * i, jr = e >> 4, c4 = (e & 15) * 4;
        if (jr < 127) { *(f32x4*)(Ks + jr * 68 + c4) = kreg[i]; *(f32x4*)(Vs + jr * 64 + c4) = vreg[i];
          if (write_cache) { const size_t o = (((size_t)bs * 128 + jr) * 4 + kvh) * 64 + c4; __builtin_nontemporal_store(kreg[i], (f32x4*)(p->out + O_KS + o)); __builtin_nontemporal_store(vreg[i], (f32x4*)(p->out + O_VS + o)); } } }
      __syncthreads();
      const int g = tid >> 7, jk = tid & 127, hq = kvh * 4 + g; const float sink = sinkp[hq];
      float sc = 0.f;
#pragma unroll
      for (int d4 = 0; d4 < 16; ++d4) { const f32x4 kv = *(const f32x4*)(Ks + jk * 68 + 4 * d4), qv = *(const f32x4*)(q_s + g * 64 + 4 * d4); sc += kv[0] * qv[0] + kv[1] * qv[1] + kv[2] * qv[2] + kv[3] * qv[3]; }
      float mx = sc;
#pragma unroll
      for (int o = 1; o < 64; o <<= 1) mx = fmaxf(mx, __shfl_xor(mx, o));
      if (lane == 0) redm[wave] = mx;
      __syncthreads();
      mx = fmaxf(fmaxf(redm[2 * g], redm[2 * g + 1]), sink);
      const float ev = __expf(sc - mx); float sum = ev;
#pragma unroll
      for (int o = 1; o < 64; o <<= 1) sum += __shfl_xor(sum, o);
      if (lane == 0) reds[wave] = sum;
      p_s[g * 128 + jk] = ev;
      __syncthreads();
      const float inv = 1.f / (reds[2 * g] + reds[2 * g + 1] + __expf(sink - mx));
      { const int d = jk & 63, jh = jk >> 6; float o = 0.f;
#pragma unroll 8
        for (int jx = 0; jx < 64; ++jx) o += p_s[g * 128 + jh * 64 + jx] * Vs[(jh * 64 + jx) * 64 + d];
        po[tid] = o;
        __syncthreads();
        if (jh == 0) { const float tot = (o + po[tid + 64]) * inv; B.on[r * D + hq * 64 + d] = (bf16_t)f2bf(tot); } }
      __syncthreads();
    }
  }
}

#define XB_TMO      128
#define XB_XCNT(j)  (256  + 64 * (j))
#define XB_XSUB(j)  (1280 + 64 * (j))
#define XB_XGEN(j)  (2304 + 64 * (j))
#define XB_TOP      3328
#define XB_TOPGEN   3392
#define XCD_BAR_WORDS 3456
#define XB_SPIN_CAP (1u << 18)

__device__ __forceinline__ unsigned xb_ld(unsigned* p)              { return __hip_atomic_load(p, __ATOMIC_RELAXED, __HIP_MEMORY_SCOPE_AGENT); }
__device__ __forceinline__ unsigned xb_add(unsigned* p, unsigned v) { return __hip_atomic_fetch_add(p, v, __ATOMIC_RELAXED, __HIP_MEMORY_SCOPE_AGENT); }
__device__ __forceinline__ unsigned xb_xcc_id() { return (unsigned)__builtin_amdgcn_s_getreg((3 << 11) | 20) & 0xFu; }
#define XB_SPIN(cond, bar) do { unsigned _sp = 0; while (cond) { __builtin_amdgcn_s_sleep(1); \
    if ((++_sp & 255u) == 0u) { if (xb_ld(&(bar)[XB_TMO])) break; if (_sp > XB_SPIN_CAP) { atomicAdd(&(bar)[XB_TMO], 1u); break; } } } } while (0)

struct XcdBarrier {
    unsigned* bar; unsigned x;
    volatile LAS unsigned* st;
};

__device__ __forceinline__ XcdBarrier xcd_barrier_post(unsigned* bar, volatile LAS unsigned* st) {
    XcdBarrier b; b.bar = bar; b.x = xb_xcc_id(); b.st = st;
    if (threadIdx.x == 0) (void)xb_add(&bar[XB_XCNT(b.x)], 1u);
    return b;
}
__device__ __forceinline__ void xcd_barrier_complete(unsigned* bar, unsigned x, unsigned& nloc, unsigned& nx) {
    const unsigned G = gridDim.x * gridDim.y * gridDim.z;
    unsigned sum, cnt, mine, sp = 0u;
    for (;;) {
        sum = 0u; cnt = 0u; mine = 0u;
#pragma unroll
        for (unsigned j = 0; j < 16; ++j) { const unsigned c = xb_ld(&bar[XB_XCNT(j)]); sum += c; cnt += (c > 0u) ? 1u : 0u; mine = (j == x) ? c : mine; }
        if (sum == G) break;
        __builtin_amdgcn_s_sleep(1);
        if ((++sp & 255u) == 0u) { if (xb_ld(&bar[XB_TMO])) break; if (sp > XB_SPIN_CAP) { atomicAdd(&bar[XB_TMO], 1u); break; } }
    }
    nloc = mine > 0u ? mine : 1u; nx = cnt > 0u ? cnt : 1u;
}

__device__ __forceinline__ void xcd_barrier(const XcdBarrier& b) {
    asm volatile("s_waitcnt vmcnt(0)" ::: "memory");
    __syncthreads();
    if (threadIdx.x == 0) {
        unsigned* bar = b.bar;
        __builtin_amdgcn_s_waitcnt(0);
        unsigned nloc = b.st[0], nx = b.st[1];
        if (nloc == 0u) { xcd_barrier_complete(bar, b.x, nloc, nx); b.st[0] = nloc; b.st[1] = nx; }
        const unsigned old = xb_add(&bar[XB_XSUB(b.x)], 1u);
        const unsigned gen = old / nloc;
        if (old + 1u == (gen + 1u) * nloc) {
            __builtin_amdgcn_fence(__ATOMIC_RELEASE, "agent");
            asm volatile("s_waitcnt vmcnt(0)" ::: "memory");
            const unsigned og = xb_add(&bar[XB_TOP], 1u);
            const unsigned tg = og / nx;
            if (og + 1u == (tg + 1u) * nx) xb_add(&bar[XB_TOPGEN], 1u);
            else XB_SPIN(xb_ld(&bar[XB_TOPGEN]) == tg, bar);
            __builtin_amdgcn_fence(__ATOMIC_ACQUIRE, "agent");
            xb_add(&bar[XB_XGEN(b.x)], 1u);
            asm volatile("s_waitcnt vmcnt(0)" ::: "memory");
        } else {
            XB_SPIN(xb_ld(&bar[XB_XGEN(b.x)]) == gen, bar);
            __builtin_amdgcn_fence(__ATOMIC_ACQUIRE, "agent");
            asm volatile("s_waitcnt vmcnt(0)" ::: "memory");
        }
    }
    __syncthreads();
}


__global__ void __launch_bounds__(NTHREADS, 2) yoco_fwd(P parg) {
  extern __shared__ __attribute__((aligned(16))) unsigned char shm[];
  cg::grid_group grid = cg::this_grid();
  volatile LAS unsigned* xst = (volatile LAS unsigned*)((LAS unsigned char*)shm + 131072);
  if (threadIdx.x < 4) xst[threadIdx.x] = 0u;
  __syncthreads();
  { KP p0 = kp_get(); (void)xcd_barrier_post((unsigned*)(p0->ws + OFF_BAR), xst); }
  const int nMt = TP / BM;
#pragma unroll 1
  for (int step = -2; step < 32; ++step) {
    const int l = (step < 0) ? 0 : (step >> 3), sub = (step < 0) ? (8 + step + 2) : (step & 7); const bool hg = (l < 2);
    if (sub == 3 && !hg) continue;
    if (sub == 5 || (sub == 0 && l > 0)) continue;
    KP p = kp_get(); unsigned char* ws = p->ws;
#ifndef PROBE_REPS
#define PROBE_REPS 1
#endif
#ifndef PROBE_GREPS
#define PROBE_GREPS 1
#endif
    const bool is_gemm = (sub == 0 || sub == 1 || sub == 4 || sub == 6 || sub == 7 || sub == 9);
#ifndef PROBE_MASK
#define PROBE_MASK 0
#endif
    const int pcode = (sub == 2 && !hg) ? 10 : sub;
    const int reps = (((PROBE_MASK >> pcode) & 1) && !(sub == 4 || sub == 7)) ? 2 : 1;
#pragma unroll 1
    for (int rep = 0; rep < reps; ++rep) {
    if (sub == 8) {
      prep_phase(p, shm);
    } else if (sub == 0 || sub == 1 || sub == 4 || sub == 6 || sub == 7 || sub == 9) {
      float* mods = (float*)(ws + OFF_MODS);
      bf16_t* hbuf = (bf16_t*)(ws + OFF_H); bf16_t* onbuf = (bf16_t*)(ws + OFF_ON); bf16_t* ubuf = (bf16_t*)(ws + OFF_U);
      GemmJob j0, j1; EpiArgs E{}; int nj = 1; E.layer = l; E.first = 0;
      float* rssb = (float*)(ws + OFF_RSS); const float* biasb = (const float*)(ws + OFF_BIAS);
      j1.A = (const bf16_t*)(ws + OFF_X); j1.Bt = (const bf16_t*)(ws + OFF_WKV); j1.nM = nMt; j1.nN = 2; j1.K = D; j1.epi = EPI_KVRAW;
      j0.nM = nMt; j0.K = D;
      if (sub == 0) { j0.A = (const bf16_t*)(ws + OFF_ASH); j0.Bt = (const bf16_t*)ws; j0.nM = 1; j0.nN = 106; j0.epi = EPI_BIAS; j1.A = (const bf16_t*)(ws + OFF_BIAS); }
      else if (sub == 9) { j0.A = (const bf16_t*)(ws + OFF_X + (size_t)MODW * D * 2); j0.Bt = (const bf16_t*)(ws + OFF_X); j0.nM = 1; j0.nN = MODW / BM; j0.epi = EPI_ADA; E.f0 = mods; E.ash = (bf16_t*)(ws + OFF_ASH); }
      else if (sub == 1 && hg) { E.rss = rssb + (size_t)(2 * l) * T; E.bias = biasb + (size_t)132 * site_prefN(l); E.bN = 4096; j0.A = hbuf; j0.Bt = (const bf16_t*)(ws + OFF_WIN) + (size_t)l * 4096 * D; j0.nN = 16; j0.epi = EPI_HGIN;
        E.f0 = (float*)(ws + OFF_X); E.b0 = (bf16_t*)(ws + OFF_U); E.b1 = (bf16_t*)(ws + OFF_U + SZ_ACT); E.b2 = (bf16_t*)(ws + OFF_U + 2 * SZ_ACT); E.b3 = (bf16_t*)(ws + OFF_U + 3 * SZ_ACT); }
      else if (sub == 1) { E.rss = rssb + (size_t)(2 * l) * T; E.bias = biasb + (size_t)132 * site_prefN(l); E.bN = 1024; E.bias1 = biasb + (size_t)132 * site_prefN(4); E.bN1 = 512; j0.A = hbuf; j0.Bt = (const bf16_t*)(ws + OFF_WQ) + (size_t)(l - 2) * D * D; j0.nN = 4; j0.epi = EPI_QRAW;
        E.b1 = (bf16_t*)(ws + OFF_X + SZ_ACT); E.f2 = (float*)(ws + OFF_X + 2 * SZ_ACT); nj = (l == 2) ? 2 : 1; }
      else if (sub == 4) { E.rss_out = rssb + (size_t)(1 + 2 * l) * T; E.ng = p->norm2_g + l * D; E.nsc = mods + l * 6144 + 4096; E.yout = hbuf; j0.A = onbuf; j0.Bt = hg ? (const bf16_t*)(ws + OFF_WOUT) + (size_t)l * D * D : (const bf16_t*)(ws + OFF_WO) + (size_t)(l - 2) * D * D; j0.nN = 4; j0.epi = EPI_RESID;
        E.f0 = p->out + O_Y; E.f1 = mods + l * 6144 + 2048; E.first = (l == 0); }
      else if (sub == 6) { E.rss = rssb + (size_t)(1 + 2 * l) * T; E.bias = biasb + (size_t)132 * site_prefN(5 + l); E.bN = 4096; j0.A = hbuf; j0.Bt = (const bf16_t*)(ws + OFF_WUP) + (size_t)l * D * FF; j0.nN = 16; j0.epi = EPI_UP; E.b0 = ubuf; }
      else { if (l < 3) { E.rss_out = rssb + (size_t)(2 * (l + 1)) * T; E.ng = p->norm1_g + (l + 1) * D; E.nsc = mods + (l + 1) * 6144 + 1024; E.yout = hbuf;
          if (l == 1) { E.ngkv = p->kv_norm_g; E.nsckv = mods + 24576 + 1024; E.ykv = (bf16_t*)(ws + OFF_X); } }
        j0.A = ubuf; j0.Bt = (const bf16_t*)(ws + OFF_WDN) + (size_t)l * D * FF; j0.nN = 4; j0.K = FF; j0.epi = EPI_RESID; E.f0 = p->out + O_Y; E.f1 = mods + l * 6144 + 5120; }
      gemm_phase(p, (LAS unsigned char*)shm, shm, j0, j1, nj, E, sub != 9 && sub != 0);
      if (sub == 0) init_rows(p, (unsigned*)(ws + OFF_BAR) + XCD_BAR_WORDS + 100);
    } else if (sub == 2 && hg) {
      HgBufs HB; HB.q = (bf16_t*)(ws + OFF_U); HB.k = (bf16_t*)(ws + OFF_U + SZ_ACT); HB.v = (bf16_t*)(ws + OFF_U + 2 * SZ_ACT); HB.g = (bf16_t*)(ws + OFF_U + 3 * SZ_ACT);
      HB.lf = (float*)(ws + OFF_X); HB.o32 = (float*)(ws + OFF_X + 2 * SZ_ACT); HB.on = (bf16_t*)(ws + OFF_ON);
      scan_phase(p, l, HB, shm);
    } else if (sub == 2) {
      AtBufs AB; AB.qraw = (bf16_t*)(ws + OFF_X + SZ_ACT); AB.kvraw = (float*)(ws + OFF_X + 2 * SZ_ACT); AB.on = (bf16_t*)(ws + OFF_ON); AB.tab = (const float*)(ws + OFF_TAB);
      attn_phase(p, l, AB, shm);
    } else {
      HgBufs HB; HB.q = (bf16_t*)(ws + OFF_U); HB.k = (bf16_t*)(ws + OFF_U + SZ_ACT); HB.v = (bf16_t*)(ws + OFF_U + 2 * SZ_ACT); HB.g = (bf16_t*)(ws + OFF_U + 3 * SZ_ACT);
      HB.lf = (float*)(ws + OFF_X); HB.o32 = (float*)(ws + OFF_X + 2 * SZ_ACT); HB.on = (bf16_t*)(ws + OFF_ON);
      scan_passB(HB);
      { KP pb = kp_get(); XcdBarrier xb; xb.bar = (unsigned*)(pb->ws + OFF_BAR); xb.x = xb_xcc_id(); xb.st = xst; xcd_barrier(xb); }
      scan_prompt<1>(p, l, HB, shm);
    }
    }
    if (step == 31) break;
    if (step == -2) grid.sync();
    else { KP pb = kp_get(); XcdBarrier xb; xb.bar = (unsigned*)(pb->ws + OFF_BAR); xb.x = xb_xcc_id(); xb.st = xst; xcd_barrier(xb); }
  }
}

extern "C" void kernel_launch(void* const* d_in, const int* in_sizes, int n_in, void* d_out, int out_size, void* d_ws, size_t ws_size, hipStream_t stream) {
  static int grid_blocks = 0;
  if (!grid_blocks) {
    int dev = 0, cus = 0, per_cu = 0;
    hipGetDevice(&dev);
    hipDeviceGetAttribute(&cus, hipDeviceAttributeMultiprocessorCount, dev);
    if (hipFuncSetAttribute((const void*)yoco_fwd, hipFuncAttributeMaxDynamicSharedMemorySize, LDS_BYTES) != hipSuccess) fprintf(stderr, "hipFuncSetAttribute failed\n");
    if (hipOccupancyMaxActiveBlocksPerMultiprocessor(&per_cu, (const void*)yoco_fwd, NTHREADS, LDS_BYTES) != hipSuccess || per_cu < 1) { fprintf(stderr, "occupancy query failed\n"); per_cu = 1; }
    grid_blocks = cus * per_cu;
    if (ws_size < WS_NEED) fprintf(stderr, "workspace too small: %zu < %zu\n", ws_size, (size_t)WS_NEED);
  }
  P p{};
  const float** pp = (const float**)&p;
  for (int i = 0; i < 26; ++i) pp[i] = (const float*)d_in[i];
  p.out = (float*)d_out; p.ws = (unsigned char*)d_ws;
  (void)hipMemsetAsync((unsigned char*)d_ws + OFF_BAR, 0, ZERO_BYTES, stream);
  void* args[] = {&p};
  hipError_t e = hipLaunchCooperativeKernel((const void*)yoco_fwd, dim3(grid_blocks), dim3(NTHREADS), args, LDS_BYTES, stream);
  if (e != hipSuccess) fprintf(stderr, "cooperative launch failed: %s (grid %d)\n", hipGetErrorString(e), grid_blocks);
}
```

```cpp
#include <hip/hip_runtime.h>
#include <hip/hip_cooperative_groups.h>
#include <cstdio>
#include <cstdint>
namespace cg = cooperative_groups;

#define DI __device__ __forceinline__
typedef unsigned short bf16_t;
typedef short bf16x8 __attribute__((ext_vector_type(8)));
typedef float f32x4 __attribute__((ext_vector_type(4)));
typedef float f32x2 __attribute__((ext_vector_type(2)));
typedef float f32x16 __attribute__((ext_vector_type(16)));
typedef unsigned u32x4 __attribute__((ext_vector_type(4)));
typedef unsigned u32x2 __attribute__((ext_vector_type(2)));
#define LAS __attribute__((address_space(3)))

constexpr int D = 1024, FF = 4096, TP = 16384, TS = 128, T = TP + TS, TPAD = 16640, SEQ = 4096;
constexpr int NMOD = 132, MODW = 4 * 6144 + 2048;
constexpr float EPS = 1e-6f;
constexpr int NTHREADS = 512, NWAVES = 8;
constexpr int LDS_BYTES = 131072 + 16;

constexpr size_t O_Y = 0;
constexpr size_t O_HGP = (size_t)T * D;
constexpr size_t O_KP = O_HGP + (size_t)2 * 4 * 8 * 128 * 128;
constexpr size_t O_VP = O_KP + (size_t)4 * 128 * 4 * 64;
constexpr size_t O_HGS = O_VP + (size_t)4 * 128 * 4 * 64;
constexpr size_t O_KS = O_HGS + (size_t)2 * 128 * 8 * 128 * 128;
constexpr size_t O_VS = O_KS + (size_t)128 * 128 * 4 * 64;

constexpr size_t SZ_ACT = (size_t)TPAD * D * 2;
constexpr size_t OFF_WIN = 0;
constexpr size_t OFF_WOUT = OFF_WIN + (size_t)2 * 4096 * 1024 * 2;
constexpr size_t OFF_WKV = OFF_WOUT + (size_t)2 * 1024 * 1024 * 2;
constexpr size_t OFF_WQ = OFF_WKV + (size_t)512 * 1024 * 2;
constexpr size_t OFF_WO = OFF_WQ + (size_t)2 * 1024 * 1024 * 2;
constexpr size_t OFF_WUP = OFF_WO + (size_t)2 * 1024 * 1024 * 2;
constexpr size_t OFF_WDN = OFF_WUP + (size_t)4 * 4096 * 1024 * 2;
constexpr size_t OFF_MODS = OFF_WDN + (size_t)4 * 4096 * 1024 * 2;
constexpr size_t OFF_TAB = OFF_MODS + (((size_t)NMOD * MODW * 4 + 4095) & ~(size_t)4095);
constexpr size_t OFF_H = OFF_TAB + (((size_t)4097 * 64 * 4 + 4095) & ~(size_t)4095);
constexpr size_t OFF_ON = OFF_H + SZ_ACT;
constexpr size_t OFF_U = OFF_ON + SZ_ACT;
constexpr size_t OFF_X = OFF_U + 4 * SZ_ACT;
constexpr size_t OFF_BAR = OFF_X + 4 * SZ_ACT;
constexpr size_t BAR_BYTES = 16384;
constexpr size_t OFF_RSS = OFF_BAR + BAR_BYTES;
constexpr size_t ZERO_BYTES = BAR_BYTES + (size_t)9 * T * 4;
constexpr size_t OFF_ASH = OFF_BAR + ((ZERO_BYTES + 4095) & ~(size_t)4095);
constexpr size_t OFF_BIAS = OFF_ASH + (size_t)9 * 256 * 1024 * 2;
constexpr size_t WS_NEED = OFF_BIAS + (size_t)132 * 27136 * 4;

struct P {
  const float *x_prompt, *x_sample, *c_prompt, *c_sample, *state_hgrn, *cache_k, *cache_v;
  const float *w_ada, *b_ada, *norm1_g, *norm2_g, *hg_w_in, *hg_w_out, *hg_lbp, *hg_gn_g;
  const float *kv_w_ada, *kv_b_ada, *kv_norm_g, *w_kv, *k_norm_g, *w_q, *q_norm_g, *sinks, *w_o, *w_up, *w_down;
  float* out; unsigned char* ws;
};

typedef const P __attribute__((address_space(4)))* KP;
DI KP kp_get() { KP q = (KP)__builtin_amdgcn_kernarg_segment_ptr(); asm volatile("" : "+s"(q)); return q; }
DI int tid_get() { int t = threadIdx.x; asm volatile("" : "+v"(t)); return t; }
DI unsigned f2bf(float f) { unsigned u = __float_as_uint(f); return (u + 0x7fffu + ((u >> 16) & 1u)) >> 16; }
typedef __bf16 bf16x2_n __attribute__((ext_vector_type(2)));
DI unsigned pk2(float lo, float hi) { return __builtin_bit_cast(unsigned, __builtin_convertvector((f32x2){lo, hi}, bf16x2_n)); }
DI float bf2f(unsigned b) { return __uint_as_float(b << 16); }
DI float silu_f(float x) { return x * __builtin_amdgcn_rcpf(1.f + __expf(-x)); }
DI int modrow(int r) { return r < TP ? (r >> 12) : (4 + r - TP); }
DI int crow(int reg, int h) { return (reg & 3) + 8 * (reg >> 2) + 4 * h; }

constexpr int BM = 256, BK = 64, HALF = 128, HTB = HALF * BK * 2;
DI int lds_byte(int r, int c) { const int st = (r >> 4) * 2 + (c >> 5), rr = r & 15, cc = c & 31, ob = rr * 64 + cc * 2; return st * 1024 + (ob ^ (((ob >> 9) & 1) << 5)); }
DI void stage_rc(int b, int& R, int& C) { const int st = b / 1024, sb = b % 1024, swz = sb ^ (((sb >> 9) & 1) << 5); R = (st >> 1) * 16 + swz / 64; C = (st & 1) * 32 + (swz % 64) / 2; }

enum { EPI_ADA = 0, EPI_HGIN = 1, EPI_RESID = 2, EPI_UP = 3, EPI_QRAW = 4, EPI_KVRAW = 5, EPI_NOP = 6, EPI_BIAS = 7 };
struct GemmJob { const bf16_t* A; const bf16_t* Bt; int nM, nN, K, epi; };
struct EpiArgs {
  float* f0; const float* f1; float* f2; bf16_t* b0; bf16_t* b1; bf16_t* b2; bf16_t* b3; int layer; int first;
  const float* rss; const float* bias; const float* bias1; int bN, bN1;
  float* rss_out; const float* ng; const float* nsc; bf16_t* yout; const float* ngkv; const float* nsckv; bf16_t* ykv;
  bf16_t* ash;
};
DI int site_N(const int s) { return (s == 2 || s == 3) ? 1024 : (s == 4 ? 512 : 4096); }
DI int site_prefN(const int s) { return s == 0 ? 0 : s == 1 ? 4096 : s == 2 ? 8192 : s == 3 ? 9216 : s == 4 ? 10240 : 10752 + (s - 5) * 4096; }

DI void tile_of(int L, int nM, int nN, int& pm, int& pn) {
  const int nwg = nM * nN; int wgid = L;
  { const int q = nwg / 8, r = nwg % 8, xcd = wgid % 8, off = wgid / 8; wgid = (xcd < r ? xcd * (q + 1) : r * (q + 1) + (xcd - r) * q) + off; }
  const int nig = 8 * nN, gid = wgid / nig, fm = gid * 8, gsz = (nM - fm) < 8 ? (nM - fm) : 8;
  pm = fm + ((wgid % nig) % gsz); pn = (wgid % nig) / gsz;
}

DI void epi_frag(KP p, const int epi, const EpiArgs& E, const int r, const int c, const f32x4 vin) {
  if (epi == EPI_NOP) return;
  f32x4 v = vin;
  if (epi == EPI_HGIN || epi == EPI_UP || epi == EPI_QRAW || epi == EPI_KVRAW) {
    const float rstd = rsqrtf(E.rss[r] * (1.f / D) + EPS);
    const float* bp = ((epi == EPI_KVRAW) ? E.bias1 + (size_t)modrow(r) * E.bN1 : E.bias + (size_t)modrow(r) * E.bN) + c;
    v = v * rstd + *(const f32x4*)bp; }
  if (epi == EPI_HGIN) {
    const int sec = c >> 10, cc = c & 1023; const size_t o = (size_t)r * D + cc;
    if (sec == 1) { f32x4 lb = (f32x4){0.f, 0.f, 0.f, 0.f};
      if (E.layer == 1) { const f32x4 l0 = *(const f32x4*)(p->hg_lbp + cc), l1 = *(const f32x4*)(p->hg_lbp + D + cc);
#pragma unroll
        for (int j = 0; j < 4; ++j) lb[j] = __builtin_amdgcn_rcpf(1.f + __expf(l0[j] - l1[j])); }
      f32x4 lf; float kk[4];
#pragma unroll
      for (int j = 0; j < 4; ++j) { const float sg = __builtin_amdgcn_rcpf(1.f + __expf(-v[j])); const float fg = lb[j] + (1.f - lb[j]) * sg; lf[j] = __logf(fg); kk[j] = (1.f - lb[j]) * (1.f - sg); }
      *(f32x4*)(E.f0 + o) = lf; *(u32x2*)(E.b1 + o) = (u32x2){pk2(kk[0], kk[1]), pk2(kk[2], kk[3])};
    } else if (sec == 2) { *(u32x2*)(E.b2 + o) = (u32x2){pk2(v[0], v[1]), pk2(v[2], v[3])};
    } else { bf16_t* dst = (sec == 0) ? E.b0 : E.b3; *(u32x2*)(dst + o) = (u32x2){pk2(silu_f(v[0]), silu_f(v[1])), pk2(silu_f(v[2]), silu_f(v[3]))}; }
  } else if (epi == EPI_RESID) {
    const float* xin = E.first ? (r < TP ? p->x_prompt + (size_t)r * D : p->x_sample + (size_t)(r - TP) * D) : (E.f0 + (size_t)r * D);
    const size_t mo = (size_t)modrow(r) * MODW;
    const f32x4 xv = *(const f32x4*)(xin + c), gv = *(const f32x4*)(E.f1 + mo + c);
    const f32x4 yn = xv + gv * v;
    *(f32x4*)(E.f0 + (size_t)r * D + c) = yn;
    if (E.yout) {
      const f32x4 g = *(const f32x4*)(E.ng + c), sc = *(const f32x4*)(E.nsc + mo + c); const f32x4 y = yn * g * (sc + 1.f);
      *(u32x2*)(E.yout + (size_t)r * D + c) = (u32x2){pk2(y[0], y[1]), pk2(y[2], y[3])};
      if (E.ykv) { const f32x4 g2 = *(const f32x4*)(E.ngkv + c), sc2 = *(const f32x4*)(E.nsckv + mo + c); const f32x4 y2 = yn * g2 * (sc2 + 1.f);
        *(u32x2*)(E.ykv + (size_t)r * D + c) = (u32x2){pk2(y2[0], y2[1]), pk2(y2[2], y2[3])}; }
      float ss = yn[0] * yn[0] + yn[1] * yn[1] + yn[2] * yn[2] + yn[3] * yn[3];
      ss += __shfl_xor(ss, 1); ss += __shfl_xor(ss, 2);
      if ((tid_get() & 3) == 0) atomicAdd(E.rss_out + r, ss); }
  } else if (epi == EPI_UP) {
    f32x4 u;
#pragma unroll
    for (int j = 0; j < 4; ++j) { const float t = fmaxf(v[j], 0.f); u[j] = t * t; }
    *(u32x2*)(E.b0 + (size_t)r * FF + c) = (u32x2){pk2(u[0], u[1]), pk2(u[2], u[3])};
  } else if (epi == EPI_QRAW) { *(u32x2*)(E.b1 + (size_t)r * D + c) = (u32x2){pk2(v[0], v[1]), pk2(v[2], v[3])};
  } else if (epi == EPI_KVRAW) { *(f32x4*)(E.f2 + (size_t)r * 512 + c) = v; }
}

DI void epi_frag8(KP p, const int epi, const EpiArgs& E, const int r, const int c, const f32x4 v0, const f32x4 v1, const f32x4 lbA = (f32x4){0.f, 0.f, 0.f, 0.f}, const f32x4 lbB = (f32x4){0.f, 0.f, 0.f, 0.f}) {
  if (epi == EPI_NOP) return;
  if (epi == EPI_ADA) { if (r < NMOD) { const float* bp = (c < 24576) ? (p->b_ada + c) : (p->kv_b_ada + (c - 24576)); float* o = E.f0 + (size_t)r * MODW + c;
      const f32x4 m0 = v0 + *(const f32x4*)bp, m1 = v1 + *(const f32x4*)(bp + 4);
      *(f32x4*)o = m0; *(f32x4*)(o + 4) = m1;
      int site = -1;
      if (c < 24576) { const int l = c / 6144, part = (c - l * 6144) >> 10; site = (part == 0) ? l : (part == 3 ? 5 + l : -1); } else if (c < 25600) site = 4;
      if (site >= 0) *(u32x4*)(E.ash + ((size_t)site * 256 + r) * 1024 + (c & 1023)) = (u32x4){pk2(m0[0], m0[1]), pk2(m0[2], m0[3]), pk2(m1[0], m1[1]), pk2(m1[2], m1[3])}; }
  } else if (epi == EPI_HGIN) {
    const int sec = c >> 10, cc = c & 1023; const size_t o = (size_t)r * D + cc;
    if (sec == 1) { float lb[8];
#pragma unroll
      for (int j = 0; j < 4; ++j) { lb[j] = lbA[j]; lb[4 + j] = lbB[j]; }
      float lf[8], kk[8];
#pragma unroll
      for (int j = 0; j < 8; ++j) { const float x = (j < 4) ? v0[j & 3] : v1[j & 3]; const float sg = __builtin_amdgcn_rcpf(1.f + __expf(-x)); const float fg = lb[j] + (1.f - lb[j]) * sg;
        lf[j] = __logf(fg); kk[j] = (1.f - lb[j]) * (1.f - sg); }
      *(f32x4*)(E.f0 + o) = (f32x4){lf[0], lf[1], lf[2], lf[3]}; *(f32x4*)(E.f0 + o + 4) = (f32x4){lf[4], lf[5], lf[6], lf[7]};
      *(u32x4*)(E.b1 + o) = (u32x4){pk2(kk[0], kk[1]), pk2(kk[2], kk[3]), pk2(kk[4], kk[5]), pk2(kk[6], kk[7])};
    } else if (sec == 2) { *(u32x4*)(E.b2 + o) = (u32x4){pk2(v0[0], v0[1]), pk2(v0[2], v0[3]), pk2(v1[0], v1[1]), pk2(v1[2], v1[3])};
    } else { bf16_t* dst = (sec == 0) ? E.b0 : E.b3;
      *(u32x4*)(dst + o) = (u32x4){pk2(silu_f(v0[0]), silu_f(v0[1])), pk2(silu_f(v0[2]), silu_f(v0[3])), pk2(silu_f(v1[0]), silu_f(v1[1])), pk2(silu_f(v1[2]), silu_f(v1[3]))}; }
  } else if (epi == EPI_RESID) {
    const float* xin = E.first ? (r < TP ? p->x_prompt + (size_t)r * D : p->x_sample + (size_t)(r - TP) * D) : (E.f0 + (size_t)r * D);
    const size_t mo = (size_t)modrow(r) * MODW;
    const float* gm = E.f1 + mo + c; float* o = E.f0 + (size_t)r * D + c;
    const f32x4 xa = *(const f32x4*)(xin + c), xb = *(const f32x4*)(xin + c + 4), ga = *(const f32x4*)gm, gb = *(const f32x4*)(gm + 4);
    const f32x4 ya = xa + ga * v0, yb = xb + gb * v1;
    *(f32x4*)o = ya; *(f32x4*)(o + 4) = yb;
    if (E.yout) {
      const f32x4 g0 = *(const f32x4*)(E.ng + c), g1 = *(const f32x4*)(E.ng + c + 4), s0 = *(const f32x4*)(E.nsc + mo + c), s1 = *(const f32x4*)(E.nsc + mo + c + 4);
      const f32x4 y0 = ya * g0 * (s0 + 1.f), y1 = yb * g1 * (s1 + 1.f);
      *(u32x4*)(E.yout + (size_t)r * D + c) = (u32x4){pk2(y0[0], y0[1]), pk2(y0[2], y0[3]), pk2(y1[0], y1[1]), pk2(y1[2], y1[3])};
      if (E.ykv) { const f32x4 h0 = *(const f32x4*)(E.ngkv + c), h1 = *(const f32x4*)(E.ngkv + c + 4), t0 = *(const f32x4*)(E.nsckv + mo + c), t1 = *(const f32x4*)(E.nsckv + mo + c + 4);
        const f32x4 z0 = ya * h0 * (t0 + 1.f), z1 = yb * h1 * (t1 + 1.f);
        *(u32x4*)(E.ykv + (size_t)r * D + c) = (u32x4){pk2(z0[0], z0[1]), pk2(z0[2], z0[3]), pk2(z1[0], z1[1]), pk2(z1[2], z1[3])}; }
      float ss = ya[0] * ya[0] + ya[1] * ya[1] + ya[2] * ya[2] + ya[3] * ya[3] + yb[0] * yb[0] + yb[1] * yb[1] + yb[2] * yb[2] + yb[3] * yb[3];
      ss += __shfl_xor(ss, 16); ss += __shfl_xor(ss, 32);
      if ((tid_get() & 63) < 16) atomicAdd(E.rss_out + r, ss); }
  } else if (epi == EPI_UP) {
    float u[8];
#pragma unroll
    for (int j = 0; j < 8; ++j) { const float t = fmaxf((j < 4) ? v0[j & 3] : v1[j & 3], 0.f); u[j] = t * t; }
    *(u32x4*)(E.b0 + (size_t)r * FF + c) = (u32x4){pk2(u[0], u[1]), pk2(u[2], u[3]), pk2(u[4], u[5]), pk2(u[6], u[7])};
  } else if (epi == EPI_QRAW) { *(u32x4*)(E.b1 + (size_t)r * D + c) = (u32x4){pk2(v0[0], v0[1]), pk2(v0[2], v0[3]), pk2(v1[0], v1[1]), pk2(v1[2], v1[3])};
  } else { float* o = E.f2 + (size_t)r * 512 + c; *(f32x4*)o = v0; *(f32x4*)(o + 4) = v1; }
}

template <int NMB>
DI void skinny_unit(KP p, unsigned char* shm, const bf16_t* A, const bf16_t* Bt, const int K, const int mrow0, const int n0, const int epi, const EpiArgs& E) {
  const int tid = tid_get(), lane = tid & 63, wave = tid >> 6, fr = lane & 15, fq = lane >> 4;
  const int ks = K >> 3;
  const bf16_t* ap = A + (size_t)(TP + mrow0 + fr) * K + wave * ks + fq * 8;
  const bf16_t* bp = Bt + (size_t)(n0 + fr) * K + wave * ks + fq * 8;
  f32x4 acc[NMB];
#pragma unroll
  for (int mb = 0; mb < NMB; ++mb) acc[mb] = (f32x4){0.f, 0.f, 0.f, 0.f};
#pragma unroll 2
  for (int k = 0; k < ks; k += 32) { const bf16x8 b = *(const bf16x8*)(bp + k);
#pragma unroll
    for (int mb = 0; mb < NMB; ++mb) { const bf16x8 a = *(const bf16x8*)(ap + (size_t)mb * 16 * K + k); acc[mb] = __builtin_amdgcn_mfma_f32_16x16x32_bf16(b, a, acc[mb], 0, 0, 0); } }
  float* red = (float*)shm;
#pragma unroll
  for (int mb = 0; mb < NMB; ++mb) *(f32x4*)(red + wave * (NMB * 256) + (mb * 16 + fr) * 16 + fq * 4) = acc[mb];
  __syncthreads();
  if (tid < NMB * 64) { const int row = tid >> 2, c4 = (tid & 3) * 4; f32x4 sum = (f32x4){0.f, 0.f, 0.f, 0.f};
#pragma unroll
    for (int w = 0; w < 8; ++w) sum += *(const f32x4*)(red + w * (NMB * 256) + row * 16 + c4);
    epi_frag(p, epi, E, TP + mrow0 + row, n0 + c4, sum); }
  __syncthreads();
}

DI int perm32(int rho) { const int n = rho >> 4, i = rho & 15; return 8 * (i >> 2) + 4 * n + (i & 3); }
struct UnitD { const char* A; const char* B; int pm, pn, epi; float* ob; int on; };
DI void unit_of(const int L, const GemmJob& j0, const GemmJob& j1, const int n0, const size_t tstep, UnitD& u) {
  if (j0.epi == EPI_BIAS) {
    const int st = L < 16 ? 0 : L < 32 ? 1 : L < 36 ? 2 : L < 40 ? 3 : L < 42 ? 4 : 5 + (L - 42) / 16;
    const int lb = st == 0 ? 0 : st == 1 ? 16 : st == 2 ? 32 : st == 3 ? 36 : st == 4 ? 40 : 42 + (st - 5) * 16;
    const unsigned char* wsb = (const unsigned char*)j0.Bt;
    const bf16_t* Bt = (st < 2) ? (const bf16_t*)(wsb + OFF_WIN) + (size_t)st * 4096 * D : (st < 4) ? (const bf16_t*)(wsb + OFF_WQ) + (size_t)(st - 2) * D * D
                     : (st == 4) ? (const bf16_t*)(wsb + OFF_WKV) : (const bf16_t*)(wsb + OFF_WUP) + (size_t)(st - 5) * D * FF;
    u.pm = 0; u.pn = L - lb; u.epi = EPI_BIAS; u.A = (const char*)(j0.A + (size_t)st * 256 * 1024); u.B = (const char*)Bt + (size_t)u.pn * tstep;
    u.ob = (float*)j1.A + (size_t)132 * site_prefN(st); u.on = site_N(st); return; }
  const bool second = (L >= n0); int pm, pn; tile_of(second ? L - n0 : L, second ? j1.nM : j0.nM, second ? j1.nN : j0.nN, pm, pn);
  u.pm = pm; u.pn = pn; u.epi = second ? j1.epi : j0.epi;
  u.A = (const char*)(second ? j1.A : j0.A) + (size_t)pm * tstep; u.B = (const char*)(second ? j1.Bt : j0.Bt) + (size_t)pn * tstep;
}
DI void gemm_phase(KP p, LAS unsigned char* lds, unsigned char* shm, const GemmJob& j0, const GemmJob& j1, const int njobs, const EpiArgs& E, const int skinny) {
  const int tid = tid_get(), wid = __builtin_amdgcn_readfirstlane(tid >> 6), lane = tid & 63, wr = wid >> 2, wc = wid & 3, fr = lane & 15, fq = lane >> 4;
  const int K = j0.K, nt = K / BK;
  const int n0 = j0.nM * j0.nN, n1 = (njobs > 1) ? j1.nM * j1.nN : 0, ntl = n0 + n1;
  if ((int)blockIdx.x < ntl) {
    unsigned voffA[2], voffB[2];
#pragma unroll
    for (int i = 0; i < 2; ++i) { int R, C; stage_rc(tid * 16 + i * 8192, R, C); const int Rb = (R & ~31) + perm32(R & 31);
      voffA[i] = (unsigned)(R * K + C) * 2u; voffB[i] = (unsigned)(Rb * K + C) * 2u; }
    const size_t kstep = (size_t)(BK * 2), hstep = (size_t)HALF * K * 2, tstep = 2 * hstep;
    const unsigned ldsw = (unsigned)wid * 1024u;
    const int aoff = lds_byte(wr * 64 + fr, fq * 8), boff = lds_byte(wc * 32 + fr, fq * 8);
#define G_SA(b, h) (((b) * 2 + (h)) * HTB)
#define G_SB(b, h) ((4 + (b) * 2 + (h)) * HTB)
#define G_STAGE(bufoff, gbase, voff) do { _Pragma("unroll") for (int _i = 0; _i < 2; ++_i) \
      __builtin_amdgcn_global_load_lds((const unsigned*)((const char*)(gbase) + (voff)[_i]), (LAS unsigned*)(lds + (bufoff) + ldsw + _i * 8192), 16, 0, 0); } while (0)
#define G_LDA(dst, b, h) do { _Pragma("unroll") for (int m = 0; m < 4; ++m) _Pragma("unroll") for (int k = 0; k < 2; ++k) dst[m][k] = *(const LAS bf16x8*)(lds + G_SA(b, h) + aoff + m * 2048 + k * 1024); } while (0)
#define G_LDB(dst, b, h) do { _Pragma("unroll") for (int n = 0; n < 2; ++n) _Pragma("unroll") for (int k = 0; k < 2; ++k) dst[n][k] = *(const LAS bf16x8*)(lds + G_SB(b, h) + boff + n * 2048 + k * 1024); } while (0)
#define G_MMA(ai, bj, At, Bt) do { __builtin_amdgcn_s_setprio(1); _Pragma("unroll") for (int m = 0; m < 4; ++m) _Pragma("unroll") for (int n = 0; n < 2; ++n) _Pragma("unroll") for (int k = 0; k < 2; ++k) \
      acc[ai][bj][m][n] = __builtin_amdgcn_mfma_f32_16x16x32_bf16(Bt[n][k], At[m][k], acc[ai][bj][m][n], 0, 0, 0); __builtin_amdgcn_s_setprio(0); } while (0)
#define G_WAIT_V(n) asm volatile("s_waitcnt vmcnt(" #n ")" ::: "memory")
#define G_WAIT_L(n) asm volatile("s_waitcnt lgkmcnt(" #n ")" ::: "memory")
#define G_BAR __builtin_amdgcn_s_barrier()
#define G_SCHED __builtin_amdgcn_sched_barrier(0)
    int L = blockIdx.x;
    UnitD cur, nxt; unit_of(L, j0, j1, n0, tstep, cur);
    f32x4 acc[2][2][4][2];
#pragma unroll
    for (int a = 0; a < 2; ++a)
#pragma unroll
      for (int b = 0; b < 2; ++b)
#pragma unroll
        for (int m = 0; m < 4; ++m)
#pragma unroll
          for (int n = 0; n < 2; ++n) acc[a][b][m][n] = (f32x4){0.f, 0.f, 0.f, 0.f};
    bf16x8 At[4][2], B0[2][2], B1[2][2];
    const char* cA = cur.A; const char* cB = cur.B;
    G_STAGE(G_SB(0, 0), cB, voffB); G_STAGE(G_SB(0, 1), cB + hstep, voffB); G_STAGE(G_SA(0, 0), cA, voffA); G_STAGE(G_SA(0, 1), cA + hstep, voffA);
    if (wr == 1) G_BAR;
    G_WAIT_V(2); G_BAR;
    G_STAGE(G_SB(1, 0), cB + kstep, voffB); G_STAGE(G_SA(1, 0), cA + kstep, voffA); G_STAGE(G_SB(1, 1), cB + hstep + kstep, voffB);
    G_WAIT_V(6); G_BAR;
#pragma unroll 1
    for (;;) {
      const int Ln = L + (int)gridDim.x; const bool has_next = (Ln < ntl);
      if (has_next) unit_of(Ln, j0, j1, n0, tstep, nxt);
      const char* nA = has_next ? nxt.A : cA; const char* nB = has_next ? nxt.B : cB;
#pragma unroll 1
      for (int t = 0; t < nt; t += 2) {
        const bool last = (t == nt - 2);
        const char* a1 = cA + (size_t)(t + 1) * kstep;
        const char* a2 = last ? nA : cA + (size_t)(t + 2) * kstep; const char* b2 = last ? nB : cB + (size_t)(t + 2) * kstep;
        const char* a3 = a2 + kstep; const char* b3 = b2 + kstep;
        G_LDB(B0, 0, 0); G_LDB(B1, 0, 1); G_SCHED; G_LDA(At, 0, 0); G_STAGE(G_SA(1, 1), a1 + hstep, voffA);
        G_WAIT_V(8); G_WAIT_L(0); G_BAR; G_MMA(0, 0, At, B0); G_MMA(0, 1, At, B1); G_BAR; G_SCHED;
        G_LDA(At, 0, 1); G_STAGE(G_SB(0, 0), b2, voffB); G_STAGE(G_SB(0, 1), b2 + hstep, voffB); G_STAGE(G_SA(0, 0), a2, voffA);
        G_WAIT_V(8); G_WAIT_L(0); G_BAR; G_MMA(1, 0, At, B0); G_MMA(1, 1, At, B1); G_BAR; G_SCHED;
        G_LDB(B0, 1, 0); G_LDB(B1, 1, 1); G_SCHED; G_LDA(At, 1, 0); G_STAGE(G_SA(0, 1), a2 + hstep, voffA);
        G_WAIT_V(8); G_WAIT_L(0); G_BAR; G_MMA(0, 0, At, B0); G_MMA(0, 1, At, B1); G_BAR; G_SCHED;
        G_LDA(At, 1, 1); G_STAGE(G_SB(1, 0), b3, voffB); G_STAGE(G_SB(1, 1), b3 + hstep, voffB); G_STAGE(G_SA(1, 0), a3, voffA);
        G_WAIT_V(8); G_WAIT_L(0); G_BAR; G_MMA(1, 0, At, B0); G_MMA(1, 1, At, B1); G_BAR; G_SCHED;
      }
      if (wr == 0) G_BAR;
      { const int r0 = cur.pm * BM + wr * 64 + fr, c0 = cur.pn * BM + wc * 32 + fq * 8; const int epi = cur.epi;
#define EPI_LOOP(MODE) { _Pragma("unroll") for (int ai = 0; ai < 2; ++ai) _Pragma("unroll") for (int m = 0; m < 4; ++m) _Pragma("unroll") for (int bj = 0; bj < 2; ++bj) \
          epi_frag8(p, MODE, E, r0 + ai * 128 + m * 16, c0 + bj * 128, acc[ai][bj][m][0], acc[ai][bj][m][1]); }
        if (epi == EPI_ADA) EPI_LOOP(EPI_ADA)
        else if (epi == EPI_BIAS) {
#pragma unroll
          for (int ai = 0; ai < 2; ++ai)
#pragma unroll
            for (int m = 0; m < 4; ++m) { const int r = r0 + ai * 128 + m * 16; if (r < NMOD) {
#pragma unroll
              for (int bj = 0; bj < 2; ++bj) { float* o = cur.ob + (size_t)r * cur.on + (c0 + bj * 128); *(f32x4*)o = acc[ai][bj][m][0]; *(f32x4*)(o + 4) = acc[ai][bj][m][1]; } } }
        } else if (epi == EPI_RESID) {
          const size_t mo = (size_t)modrow(r0) * MODW;
#pragma unroll
          for (int bj = 0; bj < 2; ++bj) { const int c = c0 + bj * 128;
            const f32x4 ga = *(const f32x4*)(E.f1 + mo + c), gb = *(const f32x4*)(E.f1 + mo + c + 4);
            f32x4 m0 = (f32x4){0.f, 0.f, 0.f, 0.f}, m1 = m0, k0 = m0, k1 = m0;
            if (E.yout) { const f32x4 g0 = *(const f32x4*)(E.ng + c), g1 = *(const f32x4*)(E.ng + c + 4), s0 = *(const f32x4*)(E.nsc + mo + c), s1 = *(const f32x4*)(E.nsc + mo + c + 4);
              m0 = g0 * (s0 + 1.f); m1 = g1 * (s1 + 1.f);
              if (E.ykv) { const f32x4 h0 = *(const f32x4*)(E.ngkv + c), h1 = *(const f32x4*)(E.ngkv + c + 4), t0 = *(const f32x4*)(E.nsckv + mo + c), t1 = *(const f32x4*)(E.nsckv + mo + c + 4);
                k0 = h0 * (t0 + 1.f); k1 = h1 * (t1 + 1.f); } }
#pragma unroll
            for (int ah = 0; ah < 2; ++ah) { const int ai = ah, mb = 0;
              f32x4 ya[4], yb[4];
              const float* xbase = E.first ? p->x_prompt : E.f0;
#pragma unroll
              for (int m = mb; m < mb + 4; ++m) { const unsigned off = (unsigned)(r0 + ai * 128 + m * 16) * (unsigned)D + (unsigned)c;
                ya[m] = *(const f32x4*)(xbase + off); yb[m] = *(const f32x4*)(xbase + off + 4); }
#pragma unroll
              for (int m = mb; m < mb + 4; ++m) { const int r = r0 + ai * 128 + m * 16; const unsigned off = (unsigned)r * (unsigned)D + (unsigned)c;
                const f32x4 xa = ya[m] + ga * acc[ai][bj][m][0], xb = yb[m] + gb * acc[ai][bj][m][1];
                *(f32x4*)(E.f0 + off) = xa; *(f32x4*)(E.f0 + off + 4) = xb;
                if (E.yout) { const f32x4 y0 = xa * m0, y1 = xb * m1;
                  *(u32x4*)(E.yout + off) = (u32x4){pk2(y0[0], y0[1]), pk2(y0[2], y0[3]), pk2(y1[0], y1[1]), pk2(y1[2], y1[3])};
                  if (E.ykv) { const f32x4 z0 = xa * k0, z1 = xb * k1;
                    *(u32x4*)(E.ykv + off) = (u32x4){pk2(z0[0], z0[1]), pk2(z0[2], z0[3]), pk2(z1[0], z1[1]), pk2(z1[2], z1[3])}; }
                  float ss = xa[0] * xa[0] + xa[1] * xa[1] + xa[2] * xa[2] + xa[3] * xa[3] + xb[0] * xb[0] + xb[1] * xb[1] + xb[2] * xb[2] + xb[3] * xb[3];
                  ss += __shfl_xor(ss, 16); ss += __shfl_xor(ss, 32);
                  if (fq == 0) atomicAdd(E.rss_out + (unsigned)r, ss); } } } }
        } else if (epi != EPI_NOP) {
          float rstd8[8];
#pragma unroll
          for (int q = 0; q < 8; ++q) rstd8[q] = rsqrtf(E.rss[r0 + (q >> 2) * 128 + (q & 3) * 16] * (1.f / D) + EPS);
          const float* bb = (epi == EPI_KVRAW) ? E.bias1 + (size_t)modrow(r0) * E.bN1 : E.bias + (size_t)modrow(r0) * E.bN;
          f32x4 bv[2][2], lbv[2][2];
#pragma unroll
          for (int bj = 0; bj < 2; ++bj) { const int c = c0 + bj * 128; bv[bj][0] = *(const f32x4*)(bb + c); bv[bj][1] = *(const f32x4*)(bb + c + 4);
            lbv[bj][0] = (f32x4){0.f, 0.f, 0.f, 0.f}; lbv[bj][1] = (f32x4){0.f, 0.f, 0.f, 0.f};
            if (epi == EPI_HGIN && (c >> 10) == 1 && E.layer == 1) { const int cc = c & 1023;
              const f32x4 l0 = *(const f32x4*)(p->hg_lbp + cc), l1 = *(const f32x4*)(p->hg_lbp + D + cc), l2 = *(const f32x4*)(p->hg_lbp + cc + 4), l3 = *(const f32x4*)(p->hg_lbp + D + cc + 4);
#pragma unroll
              for (int jj = 0; jj < 4; ++jj) { lbv[bj][0][jj] = __builtin_amdgcn_rcpf(1.f + __expf(l0[jj] - l1[jj])); lbv[bj][1][jj] = __builtin_amdgcn_rcpf(1.f + __expf(l2[jj] - l3[jj])); } } }
#define CONS_LOOP(MODE) { _Pragma("unroll") for (int ai = 0; ai < 2; ++ai) _Pragma("unroll") for (int m = 0; m < 4; ++m) _Pragma("unroll") for (int bj = 0; bj < 2; ++bj) \
            epi_frag8(p, MODE, E, r0 + ai * 128 + m * 16, c0 + bj * 128, acc[ai][bj][m][0] * rstd8[ai * 4 + m] + bv[bj][0], acc[ai][bj][m][1] * rstd8[ai * 4 + m] + bv[bj][1], lbv[bj][0], lbv[bj][1]); }
          if (epi == EPI_HGIN) CONS_LOOP(EPI_HGIN) else if (epi == EPI_UP) CONS_LOOP(EPI_UP) else if (epi == EPI_QRAW) CONS_LOOP(EPI_QRAW) else CONS_LOOP(EPI_KVRAW)
        }
      }
      if (!has_next) break;
#pragma unroll
      for (int a = 0; a < 2; ++a)
#pragma unroll
        for (int b = 0; b < 2; ++b)
#pragma unroll
          for (int m = 0; m < 4; ++m)
#pragma unroll
            for (int n = 0; n < 2; ++n) acc[a][b][m][n] = (f32x4){0.f, 0.f, 0.f, 0.f};
      cur = nxt; cA = nA; cB = nB; L = Ln;
      if (wr == 1) G_BAR;
    }
    G_WAIT_V(0);
    G_BAR;
  }
  if (skinny) {
    __syncthreads();
    const int u0 = j0.nN * 16, u1 = (njobs > 1) ? j1.nN * 16 : 0;
    const int rs = ((u0 + u1) * 4 <= (int)gridDim.x) ? 4 : (((u0 + u1) * 2 <= (int)gridDim.x) ? 2 : 1);
#pragma unroll 1
    for (int uu = (int)gridDim.x - 1 - (int)blockIdx.x; uu < (u0 + u1) * rs; uu += gridDim.x) {
      const int u = uu / rs, rg = uu - u * rs;
      const bool second = (u >= u0);
      const bf16_t* sa = second ? j1.A : j0.A; const bf16_t* sb = second ? j1.Bt : j0.Bt; const int sk = second ? j1.K : j0.K, sn = (second ? u - u0 : u) * 16, se = second ? j1.epi : j0.epi;
      if (rs == 4) skinny_unit<2>(p, shm, sa, sb, sk, rg * 32, sn, se, E);
      else if (rs == 2) skinny_unit<4>(p, shm, sa, sb, sk, rg * 64, sn, se, E);
      else skinny_unit<8>(p, shm, sa, sb, sk, 0, sn, se, E);
    }
  }
}

__device__ const float INVF[32] = {1.000000000e+00f, 7.498942614e-01f, 5.623413324e-01f, 4.216965139e-01f, 3.162277639e-01f, 2.371373773e-01f, 1.778279394e-01f, 1.333521307e-01f, 1.000000015e-01f, 7.498941571e-02f, 5.623413250e-02f, 4.216965288e-02f, 3.162277490e-02f, 2.371373773e-02f, 1.778279431e-02f, 1.333521493e-02f, 9.999999776e-03f, 7.498941850e-03f, 5.623413250e-03f, 4.216964822e-03f, 3.162277630e-03f, 2.371373586e-03f, 1.778279431e-03f, 1.333521446e-03f, 1.000000047e-03f, 7.498942432e-04f, 5.623413017e-04f, 4.216965172e-04f, 3.162277571e-04f, 2.371373703e-04f, 1.778279402e-04f, 1.333521504e-04f};
DI void transpose_item(const float* W, int K, int N, bf16_t* WT, int row_off, float* scr, int item, int lane) {
  const int nblk = N / 32, kb = item / nblk, nb = item % nblk, k0 = 64 * kb, n0 = 32 * nb;
#pragma unroll 8
  for (int i = 0; i < 32; ++i) { const int kk = 2 * i + (lane >> 5); scr[kk * 33 + (lane & 31)] = W[(size_t)(k0 + kk) * N + n0 + (lane & 31)]; }
  asm volatile("s_waitcnt lgkmcnt(0)" ::: "memory");
  const int c = lane & 7;
#pragma unroll
  for (int j = 0; j < 4; ++j) { const int n = (lane >> 3) + 8 * j; const float* s = scr + (8 * c) * 33 + n;
    u32x4 o; o.x = pk2(s[0 * 33], s[1 * 33]); o.y = pk2(s[2 * 33], s[3 * 33]); o.z = pk2(s[4 * 33], s[5 * 33]); o.w = pk2(s[6 * 33], s[7 * 33]);
    *(u32x4*)(WT + (size_t)(row_off + n0 + n) * K + k0 + 8 * c) = o; }
  asm volatile("s_waitcnt lgkmcnt(0)" ::: "memory");
}

DI void prep_phase(KP p, unsigned char* shm) {
  const int tid = tid_get(), lane = tid & 63, wave = tid >> 6;
  const int gw = blockIdx.x * NWAVES + wave, NGW = gridDim.x * NWAVES;
  float* scr = (float*)(shm + wave * 16384);
  unsigned char* ws = p->ws;
  int base = 0;
  for (int mi = 0; mi < 22; ++mi) {
    const float* W; int K, N, row_off; bf16_t* WT;
    if (mi < 2) { W = p->hg_w_in + (size_t)mi * D * 4096; K = D; N = 4096; WT = (bf16_t*)(ws + OFF_WIN) + (size_t)mi * 4096 * D; row_off = 0; }
    else if (mi < 4) { W = p->hg_w_out + (size_t)(mi - 2) * D * D; K = D; N = D; WT = (bf16_t*)(ws + OFF_WOUT) + (size_t)(mi - 2) * D * D; row_off = 0; }
    else if (mi < 5) { W = p->w_kv; K = D; N = 512; WT = (bf16_t*)(ws + OFF_WKV); row_off = 0; }
    else if (mi < 7) { W = p->w_q + (size_t)(mi - 5) * D * D; K = D; N = D; WT = (bf16_t*)(ws + OFF_WQ) + (size_t)(mi - 5) * D * D; row_off = 0; }
    else if (mi < 9) { W = p->w_o + (size_t)(mi - 7) * D * D; K = D; N = D; WT = (bf16_t*)(ws + OFF_WO) + (size_t)(mi - 7) * D * D; row_off = 0; }
    else if (mi < 13) { W = p->w_up + (size_t)(mi - 9) * D * FF; K = D; N = FF; WT = (bf16_t*)(ws + OFF_WUP) + (size_t)(mi - 9) * D * FF; row_off = 0; }
    else if (mi < 17) { W = p->w_down + (size_t)(mi - 13) * D * FF; K = FF; N = D; WT = (bf16_t*)(ws + OFF_WDN) + (size_t)(mi - 13) * D * FF; row_off = 0; }
    else if (mi < 21) { W = p->w_ada + (size_t)(mi - 17) * D * 6144; K = D; N = 6144; WT = (bf16_t*)(ws + OFF_X); row_off = (mi - 17) * 6144; }
    else { W = p->kv_w_ada; K = D; N = 2048; WT = (bf16_t*)(ws + OFF_X); row_off = 24576; }
    const int nitems = (K / 64) * (N / 32);
    int first = (gw - (base % NGW) + NGW) % NGW;
    for (int it = first; it < nitems; it += NGW) transpose_item(W, K, N, WT, row_off, scr, it, lane);
    base += nitems;
  }
  bf16_t* Ac = (bf16_t*)(ws + OFF_X + (size_t)MODW * D * 2);
  const int gt = blockIdx.x * NTHREADS + tid, NGT = gridDim.x * NTHREADS;
  for (int e = gt; e < 256 * D / 2; e += NGT) { const int r = e / (D / 2), c = (e % (D / 2)) * 2; float a = 0.f, b = 0.f;
    if (r < NMOD) { const float* cp = (r < 4) ? p->c_prompt + (size_t)r * D : p->c_sample + (size_t)(r - 4) * D; a = silu_f(cp[c]); b = silu_f(cp[c + 1]); }
    *(unsigned*)(Ac + (size_t)r * D + c) = pk2(a, b); }
  float* tab = (float*)(ws + OFF_TAB);
  for (int e = gt; e < 4097 * 32; e += NGT) { const int pi = e >> 5, i = e & 31; const float pos = (pi < 4096) ? (float)pi : 8192.f;
    const float ang = pos * INVF[i]; float sn, cs; sincosf(ang, &sn, &cs);
    tab[pi * 64 + i] = cs; tab[pi * 64 + 32 + i] = sn; }
}

DI void init_rows(KP p, unsigned* ctr) {
  const int tid = tid_get(); const int lane = tid & 63;
  unsigned char* ws = p->ws; const float* mods = (const float*)(ws + OFF_MODS); bf16_t* yout = (bf16_t*)(ws + OFF_H); float* rss = (float*)(ws + OFF_RSS);
  const float* g = p->norm1_g; const float* msc = mods + 1024;
#pragma unroll 1
  for (;;) {
    unsigned cidx = 0; if (lane == 0) cidx = __hip_atomic_fetch_add(ctr, 1u, __ATOMIC_RELAXED, __HIP_MEMORY_SCOPE_AGENT);
    cidx = __builtin_amdgcn_readfirstlane(cidx);
    if (cidx >= (unsigned)(T / 8)) break;
#pragma unroll 1
    for (int hh = 0; hh < 2; ++hh) { const int rb = (int)cidx * 8 + hh * 4;
      f32x4 v[4][4];
#pragma unroll
      for (int q = 0; q < 4; ++q) { const int r = rb + q; const float* xr = (r < TP) ? p->x_prompt + (size_t)r * D : p->x_sample + (size_t)(r - TP) * D;
#pragma unroll
        for (int jj = 0; jj < 4; ++jj) v[q][jj] = *(const f32x4*)(xr + lane * 4 + 256 * jj); }
#pragma unroll
      for (int q = 0; q < 4; ++q) { const int r = rb + q; float a = 0.f;
#pragma unroll
        for (int jj = 0; jj < 4; ++jj) a += v[q][jj][0] * v[q][jj][0] + v[q][jj][1] * v[q][jj][1] + v[q][jj][2] * v[q][jj][2] + v[q][jj][3] * v[q][jj][3];
#pragma unroll
        for (int o = 1; o < 64; o <<= 1) a += __shfl_xor(a, o);
        if (lane == 0) rss[r] = a;
        const size_t mo = (size_t)modrow(r) * MODW;
#pragma unroll
        for (int jj = 0; jj < 4; ++jj) { const int c = lane * 4 + 256 * jj;
          const f32x4 gg = *(const f32x4*)(g + c), sc = *(const f32x4*)(msc + mo + c);
          const f32x4 h = v[q][jj] * gg * (sc + 1.f);
          *(u32x2*)(yout + (size_t)r * D + c) = (u32x2){pk2(h[0], h[1]), pk2(h[2], h[3])}; } } }
  }
}

struct HgBufs { const bf16_t *q, *k, *v, *g; const float* lf; float* o32; bf16_t* on; };

constexpr int SPAN = 256, NSPAN = SEQ / SPAN, CH = 32, NCH = SPAN / CH;
constexpr int L_CUM = 0, L_QT = 16896, L_KT = 25600, L_KE = 34304, L_VT = 44544, L_PS = 54784, L_DEC = 55808, L_HALF = 57344;
constexpr int CUS = 132, QS = 136, KES = 40;
DI bf16x8 pack8(const f32x16& x, const int s) {
  return __builtin_bit_cast(bf16x8, (u32x4){pk2(x[8 * s], x[8 * s + 1]), pk2(x[8 * s + 2], x[8 * s + 3]), pk2(x[8 * s + 4], x[8 * s + 5]), pk2(x[8 * s + 6], x[8 * s + 7])});
}
template <int MODE>
DI void scan_prompt(KP p, const int l, const HgBufs& B, unsigned char* shm) {
  const int tid = tid_get(), lane = tid & 63, wave = tid >> 6, hb = wave >> 2, th = tid & 255, vb = wave & 3, h5 = lane >> 5, l31 = lane & 31;
  unsigned char* base = shm + hb * L_HALF;
  float* cumb = (float*)(base + L_CUM); bf16_t* Qt = (bf16_t*)(base + L_QT); bf16_t* Kt = (bf16_t*)(base + L_KT);
  bf16_t* KeT = (bf16_t*)(base + L_KE); bf16_t* Vt = (bf16_t*)(base + L_VT); float* psum = (float*)(base + L_PS); float* dec = (float*)(base + L_DEC);
  float* dS = B.o32; float* Lsum = B.o32 + (size_t)512 * 16384;
#pragma unroll 1
  for (int it0 = blockIdx.x * 2; it0 < 32 * NSPAN; it0 += gridDim.x * 2) {
    const int item = it0 + hb, bh = item / NSPAN, span = item % NSPAN, b = bh >> 3, h = bh & 7;
    f32x16 S[4];
#pragma unroll
    for (int db = 0; db < 4; ++db)
#pragma unroll
      for (int r = 0; r < 16; ++r) S[db][r] = 0.f;
    if (MODE == 1) {
      const unsigned ob = (unsigned)item * 16384u + (unsigned)(vb * 32 + l31) + (unsigned)(4 * h5) * 128u;
#pragma unroll
      for (int db = 0; db < 4; ++db) {
#pragma unroll
        for (int r = 0; r < 16; ++r) S[db][r] = dS[ob + (unsigned)((32 * db + (r & 3) + 8 * (r >> 2)) * 128)];
        __builtin_amdgcn_sched_barrier(0); }
    }
    float Ltot = 0.f;
#define LBAR() do { asm volatile("s_waitcnt lgkmcnt(0)" ::: "memory"); __builtin_amdgcn_s_barrier(); asm volatile("" ::: "memory"); } while (0)
    const int d1 = th & 127, part = th >> 7, t2 = th >> 3, dg = th & 7;
    const size_t tokS = (size_t)b * SEQ + (size_t)span * SPAN;
    float lfr[16]; unsigned kr[16], vr[16]; u32x4 q0, q1, k0, k1, g0, g1;
#define SCAN_LOAD(chx) do { const size_t o0_ = (tokS + (size_t)(chx) * CH + part * 16) * D + h * 128 + d1; \
      _Pragma("unroll") for (int i = 0; i < 16; ++i) { lfr[i] = B.lf[o0_ + (size_t)i * D]; kr[i] = B.k[o0_ + (size_t)i * D]; vr[i] = B.v[o0_ + (size_t)i * D]; } \
      } while (0)
    __builtin_amdgcn_sched_barrier(0);
    SCAN_LOAD(0);
    __builtin_amdgcn_sched_barrier(0);
#pragma unroll 1
    for (int ch = 0; ch < NCH; ++ch) {
      const size_t tok0 = tokS + (size_t)ch * CH;
      if (MODE == 1) { const size_t o_ = (tok0 + t2) * D + h * 128 + dg * 16;
        q0 = *(const u32x4*)(B.q + o_); q1 = *(const u32x4*)(B.q + o_ + 8); k0 = *(const u32x4*)(B.k + o_); k1 = *(const u32x4*)(B.k + o_ + 8);
        g0 = *(const u32x4*)(B.g + o_); g1 = *(const u32x4*)(B.g + o_ + 8); }
      { const int d = d1;
        float c[16]; float run = 0.f;
#pragma unroll
        for (int i = 0; i < 16; ++i) { run += lfr[i]; c[i] = run; }
        psum[part * 128 + d] = run;
        LBAR();
        const float t0 = psum[d], t1 = psum[128 + d]; const float off = part ? t0 : 0.f; const float Lc = t0 + t1;
        float ke[16];
#pragma unroll
        for (int i = 0; i < 16; ++i) { const float cu = off + c[i]; if (MODE == 1) cumb[(part * 16 + i) * CUS + d] = cu; ke[i] = bf2f(kr[i]) * __expf(Lc - cu); }
        *(u32x4*)(KeT + d * KES + part * 16) = (u32x4){pk2(ke[0], ke[1]), pk2(ke[2], ke[3]), pk2(ke[4], ke[5]), pk2(ke[6], ke[7])};
        *(u32x4*)(KeT + d * KES + part * 16 + 8) = (u32x4){pk2(ke[8], ke[9]), pk2(ke[10], ke[11]), pk2(ke[12], ke[13]), pk2(ke[14], ke[15])};
        *(u32x4*)(Vt + d * KES + part * 16) = (u32x4){vr[0] | (vr[1] << 16), vr[2] | (vr[3] << 16), vr[4] | (vr[5] << 16), vr[6] | (vr[7] << 16)};
        *(u32x4*)(Vt + d * KES + part * 16 + 8) = (u32x4){vr[8] | (vr[9] << 16), vr[10] | (vr[11] << 16), vr[12] | (vr[13] << 16), vr[14] | (vr[15] << 16)};
        if (part == 0) { dec[d] = __expf(Lc); Ltot += Lc; }
      }
      LBAR();
      if (MODE == 1) {
        const int t = t2;
        unsigned qo[8], ko[8];
#pragma unroll
        for (int g4 = 0; g4 < 4; ++g4) { const f32x4 cv = *(const f32x4*)(cumb + t * CUS + dg * 16 + 4 * g4);
#pragma unroll
          for (int e2 = 0; e2 < 2; ++e2) { const int w = g4 * 2 + e2; const unsigned qw = (w < 4) ? q0[w & 3] : q1[w & 3], kw = (w < 4) ? k0[w & 3] : k1[w & 3];
            const float ca = cv[2 * e2], cb = cv[2 * e2 + 1];
            qo[w] = pk2(bf2f(qw & 0xffffu) * __expf(ca), bf2f(qw >> 16) * __expf(cb));
            ko[w] = pk2(bf2f(kw & 0xffffu) * __expf(fminf(-ca, 80.f)), bf2f(kw >> 16) * __expf(fminf(-cb, 80.f))); } }
        *(u32x4*)(Qt + t * QS + dg * 16) = (u32x4){qo[0], qo[1], qo[2], qo[3]}; *(u32x4*)(Qt + t * QS + dg * 16 + 8) = (u32x4){qo[4], qo[5], qo[6], qo[7]};
        *(u32x4*)(Kt + t * QS + dg * 16) = (u32x4){ko[0], ko[1], ko[2], ko[3]}; *(u32x4*)(Kt + t * QS + dg * 16 + 8) = (u32x4){ko[4], ko[5], ko[6], ko[7]};
        LBAR();
      }
      { const int chn = (ch + 1 < NCH) ? ch + 1 : ch; SCAN_LOAD(chn); }
      f32x16 O;
      if (MODE == 1) {
        f32x16 X;
#pragma unroll
        for (int r = 0; r < 16; ++r) { X[r] = 0.f; O[r] = 0.f; }
#pragma unroll
        for (int ks = 0; ks < 8; ++ks) { const bf16x8 a = *(const bf16x8*)(Kt + l31 * QS + 16 * ks + 8 * h5), bq = *(const bf16x8*)(Qt + l31 * QS + 16 * ks + 8 * h5);
          X = __builtin_amdgcn_mfma_f32_32x32x16_bf16(a, bq, X, 0, 0, 0); }
#pragma unroll
        for (int r = 0; r < 16; ++r) if (crow(r, h5) > l31) X[r] = 0.f;
#pragma unroll
        for (int st = 0; st < 2; ++st) { const bf16_t* vp = Vt + (vb * 32 + l31) * KES + 16 * st + 4 * h5; const u32x2 lo = *(const u32x2*)vp, hi = *(const u32x2*)(vp + 8);
          O = __builtin_amdgcn_mfma_f32_32x32x16_bf16(pack8(X, st), __builtin_bit_cast(bf16x8, (u32x4){lo[0], lo[1], hi[0], hi[1]}), O, 0, 0, 0); }
#pragma unroll
        for (int db = 0; db < 4; ++db)
#pragma unroll
          for (int st = 0; st < 2; ++st) { const bf16_t* qp = Qt + l31 * QS + 32 * db + 16 * st + 4 * h5; const u32x2 lo = *(const u32x2*)qp, hi = *(const u32x2*)(qp + 8);
            O = __builtin_amdgcn_mfma_f32_32x32x16_bf16(__builtin_bit_cast(bf16x8, (u32x4){lo[0], lo[1], hi[0], hi[1]}), pack8(S[db], st), O, 0, 0, 0); }
      }
#pragma unroll
      for (int db = 0; db < 4; ++db) {
#pragma unroll
        for (int r4 = 0; r4 < 4; ++r4) { const f32x4 dv = *(const f32x4*)(dec + 32 * db + 8 * r4 + 4 * h5);
#pragma unroll
          for (int e = 0; e < 4; ++e) S[db][4 * r4 + e] *= dv[e]; }
#pragma unroll
        for (int st = 0; st < 2; ++st) { const bf16x8 a = *(const bf16x8*)(KeT + (32 * db + l31) * KES + 16 * st + 8 * h5), bv = *(const bf16x8*)(Vt + (vb * 32 + l31) * KES + 16 * st + 8 * h5);
          S[db] = __builtin_amdgcn_mfma_f32_32x32x16_bf16(a, bv, S[db], 0, 0, 0); } }
      if (MODE == 1) {
#pragma unroll
        for (int r = 0; r < 16; ++r) cumb[crow(r, h5) * CUS + vb * 32 + l31] = O[r];
        LBAR();
        const int t = t2, vg = dg; const size_t o = (tok0 + t) * D + h * 128 + vg * 16;
        f32x4 ov[4]; float ss = 0.f;
#pragma unroll
        for (int g4 = 0; g4 < 4; ++g4) { ov[g4] = *(const f32x4*)(cumb + t * CUS + vg * 16 + 4 * g4); ss += ov[g4][0] * ov[g4][0] + ov[g4][1] * ov[g4][1] + ov[g4][2] * ov[g4][2] + ov[g4][3] * ov[g4][3]; }
        ss += __shfl_xor(ss, 1); ss += __shfl_xor(ss, 2); ss += __shfl_xor(ss, 4);
        const float rstd = rsqrtf(ss * (1.f / 128.f) + EPS);
        unsigned w[8];
#pragma unroll
        for (int g4 = 0; g4 < 4; ++g4) { const f32x4 gn = *(const f32x4*)(p->hg_gn_g + l * 128 + vg * 16 + 4 * g4);
#pragma unroll
          for (int e2 = 0; e2 < 2; ++e2) { const int wi = g4 * 2 + e2; const unsigned gw = (wi < 4) ? g0[wi & 3] : g1[wi & 3];
            w[wi] = pk2(ov[g4][2 * e2] * rstd * gn[2 * e2] * bf2f(gw & 0xffffu), ov[g4][2 * e2 + 1] * rstd * gn[2 * e2 + 1] * bf2f(gw >> 16)); } }
        *(u32x4*)(B.on + o) = (u32x4){w[0], w[1], w[2], w[3]}; *(u32x4*)(B.on + o + 8) = (u32x4){w[4], w[5], w[6], w[7]};
      } else {
        LBAR();
      }
    }
    if (MODE == 0) {
      float* dSo = dS + (size_t)item * 16384 + vb * 32 + l31;
#pragma unroll
      for (int db = 0; db < 4; ++db)
#pragma unroll
        for (int r = 0; r < 16; ++r) dSo[(size_t)(32 * db + crow(r, h5)) * 128] = S[db][r];
      if (th < 128) Lsum[(size_t)item * 128 + th] = Ltot;
    } else if (span == NSPAN - 1) {
      float* so = p->out + O_HGP + ((size_t)((l * 4 + b) * 8 + h)) * 16384 + vb * 32 + l31;
#pragma unroll
      for (int db = 0; db < 4; ++db)
#pragma unroll
        for (int r = 0; r < 16; ++r) so[(size_t)(32 * db + crow(r, h5)) * 128] = S[db][r];
    }
    __syncthreads();
  }
}

DI void scan_passB(const HgBufs& B) {
  const int tid = tid_get();
  float* dS = B.o32; const float* Lsum = B.o32 + (size_t)512 * 16384;
  const int gt = blockIdx.x * NTHREADS + tid, NGT = gridDim.x * NTHREADS;
#pragma unroll 1
  for (int e = gt; e < 32 * 4096; e += NGT) { const int bh = e >> 12, q4 = e & 4095, d = q4 >> 5;
    float* base = dS + (size_t)bh * NSPAN * 16384 + (size_t)q4 * 4; const float* Lb = Lsum + (size_t)bh * NSPAN * 128 + d;
    f32x4 v[NSPAN]; float lv[NSPAN];
#pragma unroll
    for (int sp = 0; sp < NSPAN; ++sp) { v[sp] = *(const f32x4*)(base + (size_t)sp * 16384); lv[sp] = Lb[sp * 128]; }
    f32x4 run = (f32x4){0.f, 0.f, 0.f, 0.f};
#pragma unroll
    for (int sp = 0; sp < NSPAN; ++sp) { *(f32x4*)(base + (size_t)sp * 16384) = run; run = run * __expf(lv[sp]) + v[sp]; }
  }
}

DI void scan_phase(KP p, const int l, const HgBufs& B, unsigned char* shm) {
  scan_prompt<0>(p, l, B, shm);
  const int tid = tid_get(), lane = tid & 63, wave = tid >> 6;
  {
    float* ps = (float*)shm;
    const int v4 = (tid & 31) * 4, dq = tid >> 5;
    f32x4 sv[8], svn[8]; float lfv[8], lfn[8]; unsigned kq[8], kqn[8]; u32x2 vw, vwn;
#define SMP_LOAD(IT, SV, LF, KQ, VW) do { const int bs_ = (IT) >> 3, h_ = (IT) & 7; const size_t r_ = TP + bs_; \
      const float* s0_ = p->state_hgrn + ((size_t)((l * 128 + bs_) * 8 + h_)) * 16384; \
      VW = *(const u32x2*)(B.v + r_ * D + h_ * 128 + v4); \
      _Pragma("unroll") for (int i = 0; i < 8; ++i) { const int d_ = dq * 8 + i; const size_t o_ = r_ * D + h_ * 128 + d_; \
        LF[i] = B.lf[o_]; KQ[i] = (unsigned)B.k[o_] | ((unsigned)B.q[o_] << 16); SV[i] = __builtin_nontemporal_load((const f32x4*)(s0_ + d_ * 128 + v4)); } } while (0)
    int item = blockIdx.x, par = 0;
    if (item < 1024) SMP_LOAD(item, sv, lfv, kq, vw);
#pragma unroll 1
    for (; item < 1024; item += gridDim.x, par ^= 1) {
      const int bs = item >> 3, h = item & 7; const size_t r = TP + bs;
      const int nitem = item + gridDim.x;
      if (nitem < 1024) SMP_LOAD(nitem, svn, lfn, kqn, vwn);
      float* s1 = p->out + O_HGS + ((size_t)((l * 128 + bs) * 8 + h)) * 16384;
      const f32x4 vv = (f32x4){bf2f(vw[0] & 0xffffu), bf2f(vw[0] >> 16), bf2f(vw[1] & 0xffffu), bf2f(vw[1] >> 16)};
      f32x4 op = (f32x4){0.f, 0.f, 0.f, 0.f};
#pragma unroll
      for (int i = 0; i < 8; ++i) { const int d = dq * 8 + i;
        const float f = __expf(lfv[i]), kk = bf2f(kq[i] & 0xffffu), qq = bf2f(kq[i] >> 16);
        const f32x4 sn = sv[i] * f + vv * kk;
        __builtin_nontemporal_store(sn, (f32x4*)(s1 + d * 128 + v4)); op += sn * qq; }
#pragma unroll
      for (int jx = 0; jx < 4; ++jx) op[jx] += __shfl_xor(op[jx], 32);
      float* psb = ps + par * 1024;
      if (lane < 32) *(f32x4*)(psb + wave * 128 + v4) = op;
      __syncthreads();
      if (tid < 64) { float o0 = 0.f, o1 = 0.f;
#pragma unroll
        for (int w = 0; w < 8; ++w) { const f32x2 x = *(const f32x2*)(psb + w * 128 + tid * 2); o0 += x[0]; o1 += x[1]; }
        float ss = o0 * o0 + o1 * o1;
#pragma unroll
        for (int o = 1; o < 64; o <<= 1) ss += __shfl_xor(ss, o);
        const float rstd = rsqrtf(ss * (1.f / 128.f) + EPS);
        const int vv2 = tid * 2; const size_t o = r * D + h * 128 + vv2;
        const float g0 = p->hg_gn_g[l * 128 + vv2], g1 = p->hg_gn_g[l * 128 + vv2 + 1];
        *(unsigned*)(B.on + o) = pk2(o0 * rstd * g0 * bf2f(B.g[o]), o1 * rstd * g1 * bf2f(B.g[o + 1])); }
#pragma unroll
      for (int i = 0; i < 8; ++i) { sv[i] = svn[i]; lfv[i] = lfn[i]; kq[i] = kqn[i]; }
      vw = vwn;
    }
    __syncthreads();
  }
}

constexpr int KN_STRIDE = 72, VT_STRIDE = 264;
constexpr int KN_BYTES = 256 * KN_STRIDE * 2;
struct AtBufs { const bf16_t* qraw; const float* kvraw; bf16_t* on; const float* tab; };

DI void attn_phase(KP p, const int l, const AtBufs& B, unsigned char* shm) {
  const int tid = tid_get(), lane = tid & 63, wave = tid >> 6;
  const int j = l - 2;
  const float* qg = p->q_norm_g + j * 64; const float* sinkp = p->sinks + j * 16;
  const bool write_cache = (l == 2);
  const int nitems = 512 + 512;
#pragma unroll 1
  for (int item = blockIdx.x; item < 512; item += gridDim.x) {
    {
      const int b = item >> 7, qb = (item >> 2) & 31, kvh = item & 3;
      bf16_t* Kn = (bf16_t*)shm; bf16_t* Vt = (bf16_t*)(shm + KN_BYTES);
      const int band0 = (qb - 1) * 128;
      {
        const int key = tid >> 1, part = tid & 1; const int pos = band0 + key; const bool valid = pos >= 0;
        float x1[16], x2[16];
        if (valid) { const float* kp = B.kvraw + ((size_t)b * SEQ + pos) * 512 + kvh * 64 + part * 16;
#pragma unroll
          for (int i = 0; i < 4; ++i) { const f32x4 a = *(const f32x4*)(kp + 4 * i), c = *(const f32x4*)(kp + 32 + 4 * i);
#pragma unroll
            for (int e = 0; e < 4; ++e) { x1[4 * i + e] = a[e]; x2[4 * i + e] = c[e]; } }
        } else {
#pragma unroll
          for (int i = 0; i < 16; ++i) { x1[i] = 0.f; x2[i] = 0.f; } }
        float ss = 0.f;
#pragma unroll
        for (int i = 0; i < 16; ++i) ss += x1[i] * x1[i] + x2[i] * x2[i];
        ss += __shfl_xor(ss, 1);
        const float rstd = rsqrtf(ss * (1.f / 64.f) + EPS);
        const float* tb = B.tab + (size_t)(valid ? pos : 0) * 64 + part * 16;
        float o1[16], o2[16];
#pragma unroll
        for (int i = 0; i < 16; ++i) { const float a = x1[i] * rstd * p->k_norm_g[part * 16 + i], c = x2[i] * rstd * p->k_norm_g[32 + part * 16 + i];
          const float cs = tb[i], sn = tb[32 + i]; o1[i] = a * cs - c * sn; o2[i] = c * cs + a * sn; }
        u32x4 w;
        w = (u32x4){pk2(o1[0], o1[1]), pk2(o1[2], o1[3]), pk2(o1[4], o1[5]), pk2(o1[6], o1[7])}; *(u32x4*)(Kn + key * KN_STRIDE + part * 16) = w;
        w = (u32x4){pk2(o1[8], o1[9]), pk2(o1[10], o1[11]), pk2(o1[12], o1[13]), pk2(o1[14], o1[15])}; *(u32x4*)(Kn + key * KN_STRIDE + part * 16 + 8) = w;
        w = (u32x4){pk2(o2[0], o2[1]), pk2(o2[2], o2[3]), pk2(o2[4], o2[5]), pk2(o2[6], o2[7])}; *(u32x4*)(Kn + key * KN_STRIDE + 32 + part * 16) = w;
        w = (u32x4){pk2(o2[8], o2[9]), pk2(o2[10], o2[11]), pk2(o2[12], o2[13]), pk2(o2[14], o2[15])}; *(u32x4*)(Kn + key * KN_STRIDE + 32 + part * 16 + 8) = w;
        if (write_cache && qb == 31 && key >= 128) { float* ko = p->out + O_KP + ((size_t)(b * 128 + key - 128) * 4 + kvh) * 64 + part * 16;
#pragma unroll
          for (int i = 0; i < 4; ++i) { *(f32x4*)(ko + 4 * i) = (f32x4){o1[4 * i], o1[4 * i + 1], o1[4 * i + 2], o1[4 * i + 3]};
            *(f32x4*)(ko + 32 + 4 * i) = (f32x4){o2[4 * i], o2[4 * i + 1], o2[4 * i + 2], o2[4 * i + 3]}; } }
      }
      {
        const int key = tid & 255, dh = tid >> 8; const int pos = band0 + key; const bool valid = pos >= 0;
        const float* vp = B.kvraw + ((size_t)b * SEQ + (valid ? pos : 0)) * 512 + 256 + kvh * 64 + dh * 32;
#pragma unroll
        for (int i = 0; i < 8; ++i) { f32x4 a = *(const f32x4*)(vp + 4 * i); if (!valid) a = (f32x4){0.f, 0.f, 0.f, 0.f};
#pragma unroll
          for (int e = 0; e < 4; ++e) Vt[(dh * 32 + 4 * i + e) * VT_STRIDE + key] = (bf16_t)f2bf(a[e]);
          if (write_cache && qb == 31 && key >= 128) *(f32x4*)(p->out + O_VP + ((size_t)(b * 128 + key - 128) * 4 + kvh) * 64 + dh * 32 + 4 * i) = a; }
      }
      __syncthreads();
      const int g = wave & 3, qhalf = wave >> 2, hq = kvh * 4 + g, h = lane >> 5, l31 = lane & 31;
      const float sink = sinkp[hq];
#pragma unroll 1
      for (int sub = 0; sub < 2; ++sub) {
        const int Q0 = 128 + qhalf * 64 + sub * 32, qi = Q0 + l31, pos = band0 + qi;
        const size_t tok = (size_t)b * SEQ + pos;
        float x[4][8];
        { const bf16_t* qp = B.qraw + tok * D + hq * 64 + 8 * h;
#pragma unroll
          for (int s = 0; s < 4; ++s) { const u32x4 w = *(const u32x4*)(qp + 16 * s);
#pragma unroll
            for (int e = 0; e < 4; ++e) { x[s][2 * e] = bf2f(w[e] & 0xffffu); x[s][2 * e + 1] = bf2f(w[e] >> 16); } } }
        float ss = 0.f;
#pragma unroll
        for (int s = 0; s < 4; ++s)
#pragma unroll
          for (int e = 0; e < 8; ++e) ss += x[s][e] * x[s][e];
        ss += __shfl_xor(ss, 32);
        const float rstd = rsqrtf(ss * (1.f / 64.f) + EPS) ;
#pragma unroll
        for (int s = 0; s < 4; ++s)
#pragma unroll
          for (int e = 0; e < 8; ++e) x[s][e] *= rstd * qg[16 * s + 8 * h + e];
        const float* tb = B.tab + (size_t)pos * 64;
        bf16x8 qf[4];
#pragma unroll
        for (int s = 0; s < 2; ++s) { unsigned lo[4], hi[4]; float r1[8], r2[8];
#pragma unroll
          for (int e = 0; e < 8; ++e) { const int i = 16 * s + 8 * h + e; const float cs = tb[i], sn = tb[32 + i]; const float a = x[s][e], c = x[s + 2][e];
            r1[e] = (a * cs - c * sn) * 0.125f; r2[e] = (c * cs + a * sn) * 0.125f; }
#pragma unroll
          for (int e = 0; e < 4; ++e) { lo[e] = pk2(r1[2 * e], r1[2 * e + 1]); hi[e] = pk2(r2[2 * e], r2[2 * e + 1]); }
          qf[s] = __builtin_bit_cast(bf16x8, (u32x4){lo[0], lo[1], lo[2], lo[3]}); qf[s + 2] = __builtin_bit_cast(bf16x8, (u32x4){hi[0], hi[1], hi[2], hi[3]}); }
        const int kb0 = (Q0 - 128) >> 5;
        f32x16 sacc[5]; float mx = sink;
#pragma unroll
        for (int i = 0; i < 5; ++i) { const int kb = kb0 + i; f32x16 a16;
#pragma unroll
          for (int r = 0; r < 16; ++r) a16[r] = 0.f;
          bf16x8 ka[4];
#pragma unroll
          for (int s = 0; s < 4; ++s) ka[s] = *(const bf16x8*)(Kn + (kb * 32 + l31) * KN_STRIDE + 16 * s + 8 * h);
#pragma unroll
          for (int s = 0; s < 4; ++s) a16 = __builtin_amdgcn_mfma_f32_32x32x16_bf16(ka[s], qf[s], a16, 0, 0, 0);
#pragma unroll
          for (int r = 0; r < 16; ++r) { const int key = kb * 32 + crow(r, h); const int rel = qi - key; const bool ok = (rel >= 0) && (rel < 128) && (qb > 0 || key >= 128);
            const float sv = ok ? a16[r] : -1e30f; a16[r] = sv; mx = fmaxf(mx, sv); }
          sacc[i] = a16; }
        mx = fmaxf(mx, __shfl_xor(mx, 32));
        float sum = 0.f; bf16x8 pf[5][2];
#pragma unroll
        for (int i = 0; i < 5; ++i) { float e[16];
#pragma unroll
          for (int r = 0; r < 16; ++r) { e[r] = __expf(sacc[i][r] - mx); sum += e[r]; }
#pragma unroll
          for (int st = 0; st < 2; ++st) pf[i][st] = __builtin_bit_cast(bf16x8, (u32x4){pk2(e[8 * st], e[8 * st + 1]), pk2(e[8 * st + 2], e[8 * st + 3]), pk2(e[8 * st + 4], e[8 * st + 5]), pk2(e[8 * st + 6], e[8 * st + 7])}); }
        sum += __shfl_xor(sum, 32);
        const float inv = 1.f / (sum + __expf(sink - mx));
#pragma unroll
        for (int db = 0; db < 2; ++db) { f32x16 o16;
#pragma unroll
          for (int r = 0; r < 16; ++r) o16[r] = 0.f;
          bf16x8 va[10];
#pragma unroll
          for (int i = 0; i < 5; ++i)
#pragma unroll
            for (int st = 0; st < 2; ++st) { const bf16_t* vp = Vt + (db * 32 + l31) * VT_STRIDE + (kb0 + i) * 32 + 16 * st + 4 * h;
              const u32x2 lo = *(const u32x2*)vp, hi = *(const u32x2*)(vp + 8);
              va[i * 2 + st] = __builtin_bit_cast(bf16x8, (u32x4){lo[0], lo[1], hi[0], hi[1]}); }
          f32x16 o16b;
#pragma unroll
          for (int r = 0; r < 16; ++r) o16b[r] = 0.f;
#pragma unroll
          for (int i = 0; i < 5; ++i) { o16 = __builtin_amdgcn_mfma_f32_32x32x16_bf16(va[i * 2], pf[i][0], o16, 0, 0, 0); o16b = __builtin_amdgcn_mfma_f32_32x32x16_bf16(va[i * 2 + 1], pf[i][1], o16b, 0, 0, 0); }
#pragma unroll
          for (int r = 0; r < 16; ++r) o16[r] += o16b[r];
          bf16_t* op = B.on + tok * D + hq * 64 + db * 32 + 4 * h;
#pragma unroll
          for (int r4 = 0; r4 < 4; ++r4) *(u32x2*)(op + 8 * r4) = (u32x2){pk2(o16[4 * r4] * inv, o16[4 * r4 + 1] * inv), pk2(o16[4 * r4 + 2] * inv, o16[4 * r4 + 3] * inv)}; }
      }
      __syncthreads();
    }
  }
  {
    const int tid = tid_get(), lane = tid & 63, wave = tid >> 6;
#pragma unroll 1
    for (int item = 512 + blockIdx.x; item < nitems; item += gridDim.x) {
      const int sidx = item - 512, bs = sidx >> 2, kvh = sidx & 3; const size_t r = TP + bs;
      float* Ks = (float*)shm; float* Vs = Ks + 128 * 68; float* q_s = Vs + 128 * 64; float* p_s = q_s + 256; float* redm = p_s + 512; float* reds = redm + 8; float* po = reds + 8;
      const float* tb = B.tab + (size_t)4096 * 64;
      f32x4 kreg[4], vreg[4];
#pragma unroll
      for (int i = 0; i < 4; ++i) { const int e = tid + 512 * i, jr = e >> 4, c4 = (e & 15) * 4;
        if (jr < 127) { const size_t o = (((size_t)bs * 128 + jr + 1) * 4 + kvh) * 64 + c4; kreg[i] = __builtin_nontemporal_load((const f32x4*)(p->cache_k + o)); vreg[i] = __builtin_nontemporal_load((const f32x4*)(p->cache_v + o)); } }
      if (tid < 128) { const int g = tid >> 5, i = tid & 31, hq = kvh * 4 + g;
        float a = bf2f(B.qraw[r * D + hq * 64 + i]), c = bf2f(B.qraw[r * D + hq * 64 + 32 + i]);
        float ss = a * a + c * c;
#pragma unroll
        for (int o = 1; o < 32; o <<= 1) ss += __shfl_xor(ss, o);
        const float rstd = rsqrtf(ss * (1.f / 64.f) + EPS); a *= rstd * qg[i]; c *= rstd * qg[32 + i];
        const float cs = tb[i], sn = tb[32 + i];
        q_s[g * 64 + i] = (a * cs - c * sn) * 0.125f; q_s[g * 64 + 32 + i] = (c * cs + a * sn) * 0.125f;
      } else if (tid < 160) { const int i = tid & 31;
        float a = B.kvraw[r * 512 + kvh * 64 + i], c = B.kvraw[r * 512 + kvh * 64 + 32 + i];
        float ss = a * a + c * c;
#pragma unroll
        for (int o = 1; o < 32; o <<= 1) ss += __shfl_xor(ss, o);
        const float rstd = rsqrtf(ss * (1.f / 64.f) + EPS); a *= rstd * p->k_norm_g[i]; c *= rstd * p->k_norm_g[32 + i];
        const float cs = tb[i], sn = tb[32 + i];
        const float k1 = a * cs - c * sn, k2 = c * cs + a * sn, v1 = B.kvraw[r * 512 + 256 + kvh * 64 + i], v2 = B.kvraw[r * 512 + 256 + kvh * 64 + 32 + i];
        Ks[127 * 68 + i] = k1; Ks[127 * 68 + 32 + i] = k2; Vs[127 * 64 + i] = v1; Vs[127 * 64 + 32 + i] = v2;
        if (write_cache) { float* ok = p->out + O_KS + (((size_t)bs * 128 + 127) * 4 + kvh) * 64; float* ov = p->out + O_VS + (((size_t)bs * 128 + 127) * 4 + kvh) * 64;
          ok[i] = k1; ok[32 + i] = k2; ov[i] = v1; ov[32 + i] = v2; } }
#pragma unroll
      for (int i = 0; i < 4; ++i) { const int e = tid + 512 * i, jr = e >> 4, c4 = (e & 15) * 4;
        if (jr < 127) { *(f32x4*)(Ks + jr * 68 + c4) = kreg[i]; *(f32x4*)(Vs + jr * 64 + c4) = vreg[i];
          if (write_cache) { const size_t o = (((size_t)bs * 128 + jr) * 4 + kvh) * 64 + c4; __builtin_nontemporal_store(kreg[i], (f32x4*)(p->out + O_KS + o)); __builtin_nontemporal_store(vreg[i], (f32x4*)(p->out + O_VS + o)); } } }
      __syncthreads();
      const int g = tid >> 7, jk = tid & 127, hq = kvh * 4 + g; const float sink = sinkp[hq];
      float sc = 0.f;
#pragma unroll
      for (int d4 = 0; d4 < 16; ++d4) { const f32x4 kv = *(const f32x4*)(Ks + jk * 68 + 4 * d4), qv = *(const f32x4*)(q_s + g * 64 + 4 * d4); sc += kv[0] * qv[0] + kv[1] * qv[1] + kv[2] * qv[2] + kv[3] * qv[3]; }
      float mx = sc;
#pragma unroll
      for (int o = 1; o < 64; o <<= 1) mx = fmaxf(mx, __shfl_xor(mx, o));
      if (lane == 0) redm[wave] = mx;
      __syncthreads();
      mx = fmaxf(fmaxf(redm[2 * g], redm[2 * g + 1]), sink);
      const float ev = __expf(sc - mx); float sum = ev;
#pragma unroll
      for (int o = 1; o < 64; o <<= 1) sum += __shfl_xor(sum, o);
      if (lane == 0) reds[wave] = sum;
      p_s[g * 128 + jk] = ev;
      __syncthreads();
      const float inv = 1.f / (reds[2 * g] + reds[2 * g + 1] + __expf(sink - mx));
      { const int d = jk & 63, jh = jk >> 6; float o = 0.f;
#pragma unroll 8
        for (int jx = 0; jx < 64; ++jx) o += p_s[g * 128 + jh * 64 + jx] * Vs[(jh * 64 + jx) * 64 + d];
        po[tid] = o;
        __syncthreads();
        if (jh == 0) { const float tot = (o + po[tid + 64]) * inv; B.on[r * D + hq * 64 + d] = (bf16_t)f2bf(tot); } }
      __syncthreads();
    }
  }
}

#define XB_TMO      128
#define XB_XCNT(j)  (256  + 64 * (j))
#define XB_XSUB(j)  (1280 + 64 * (j))
#define XB_XGEN(j)  (2304 + 64 * (j))
#define XB_TOP      3328
#define XB_TOPGEN   3392
#define XCD_BAR_WORDS 3456
#define XB_SPIN_CAP (1u << 18)

__device__ __forceinline__ unsigned xb_ld(unsigned* p)              { return __hip_atomic_load(p, __ATOMIC_RELAXED, __HIP_MEMORY_SCOPE_AGENT); }
__device__ __forceinline__ unsigned xb_add(unsigned* p, unsigned v) { return __hip_atomic_fetch_add(p, v, __ATOMIC_RELAXED, __HIP_MEMORY_SCOPE_AGENT); }
__device__ __forceinline__ unsigned xb_xcc_id() { return (unsigned)__builtin_amdgcn_s_getreg((3 << 11) | 20) & 0xFu; }
#define XB_SPIN(cond, bar) do { unsigned _sp = 0; while (cond) { __builtin_amdgcn_s_sleep(1); \
    if ((++_sp & 255u) == 0u) { if (xb_ld(&(bar)[XB_TMO])) break; if (_sp > XB_SPIN_CAP) { atomicAdd(&(bar)[XB_TMO], 1u); break; } } } } while (0)

struct XcdBarrier {
    unsigned* bar; unsigned x;
    volatile LAS unsigned* st;
};

__device__ __forceinline__ XcdBarrier xcd_barrier_post(unsigned* bar, volatile LAS unsigned* st) {
    XcdBarrier b; b.bar = bar; b.x = xb_xcc_id(); b.st = st;
    if (threadIdx.x == 0) (void)xb_add(&bar[XB_XCNT(b.x)], 1u);
    return b;
}
__device__ __forceinline__ void xcd_barrier_complete(unsigned* bar, unsigned x, unsigned& nloc, unsigned& nx) {
    const unsigned G = gridDim.x * gridDim.y * gridDim.z;
    unsigned sum, cnt, mine, sp = 0u;
    for (;;) {
        sum = 0u; cnt = 0u; mine = 0u;
#pragma unroll
        for (unsigned j = 0; j < 16; ++j) { const unsigned c = xb_ld(&bar[XB_XCNT(j)]); sum += c; cnt += (c > 0u) ? 1u : 0u; mine = (j == x) ? c : mine; }
        if (sum == G) break;
        __builtin_amdgcn_s_sleep(1);
        if ((++sp & 255u) == 0u) { if (xb_ld(&bar[XB_TMO])) break; if (sp > XB_SPIN_CAP) { atomicAdd(&bar[XB_TMO], 1u); break; } }
    }
    nloc = mine > 0u ? mine : 1u; nx = cnt > 0u ? cnt : 1u;
}

__device__ __forceinline__ void xcd_barrier(const XcdBarrier& b) {
    asm volatile("s_waitcnt vmcnt(0)" ::: "memory");
    __syncthreads();
    if (threadIdx.x == 0) {
        unsigned* bar = b.bar;
        __builtin_amdgcn_s_waitcnt(0);
        unsigned nloc = b.st[0], nx = b.st[1];
        if (nloc == 0u) { xcd_barrier_complete(bar, b.x, nloc, nx); b.st[0] = nloc; b.st[1] = nx; }
        const unsigned old = xb_add(&bar[XB_XSUB(b.x)], 1u);
        const unsigned gen = old / nloc;
        if (old + 1u == (gen + 1u) * nloc) {
            __builtin_amdgcn_fence(__ATOMIC_RELEASE, "agent");
            asm volatile("s_waitcnt vmcnt(0)" ::: "memory");
            const unsigned og = xb_add(&bar[XB_TOP], 1u);
            const unsigned tg = og / nx;
            if (og + 1u == (tg + 1u) * nx) xb_add(&bar[XB_TOPGEN], 1u);
            else XB_SPIN(xb_ld(&bar[XB_TOPGEN]) == tg, bar);
            __builtin_amdgcn_fence(__ATOMIC_ACQUIRE, "agent");
            xb_add(&bar[XB_XGEN(b.x)], 1u);
            asm volatile("s_waitcnt vmcnt(0)" ::: "memory");
        } else {
            XB_SPIN(xb_ld(&bar[XB_XGEN(b.x)]) == gen, bar);
            __builtin_amdgcn_fence(__ATOMIC_ACQUIRE, "agent");
            asm volatile("s_waitcnt vmcnt(0)" ::: "memory");
        }
    }
    __syncthreads();
}


__global__ void __launch_bounds__(NTHREADS, 2) yoco_fwd(P parg) {
  extern __shared__ __attribute__((aligned(16))) unsigned char shm[];
  cg::grid_group grid = cg::this_grid();
  volatile LAS unsigned* xst = (volatile LAS unsigned*)((LAS unsigned char*)shm + 131072);
  if (threadIdx.x < 4) xst[threadIdx.x] = 0u;
  __syncthreads();
  { KP p0 = kp_get(); (void)xcd_barrier_post((unsigned*)(p0->ws + OFF_BAR), xst); }
  const int nMt = TP / BM;
#pragma unroll 1
  for (int step = -2; step < 32; ++step) {
    const int l = (step < 0) ? 0 : (step >> 3), sub = (step < 0) ? (8 + step + 2) : (step & 7); const bool hg = (l < 2);
    if (sub == 3 && !hg) continue;
    if (sub == 5 || (sub == 0 && l > 0)) continue;
    KP p = kp_get(); unsigned char* ws = p->ws;
#ifndef PROBE_REPS
#define PROBE_REPS 1
#endif
#ifndef PROBE_GREPS
#define PROBE_GREPS 1
#endif
    const bool is_gemm = (sub == 0 || sub == 1 || sub == 4 || sub == 6 || sub == 7 || sub == 9);
#ifndef PROBE_MASK
#define PROBE_MASK 0
#endif
    const int pcode = (sub == 2 && !hg) ? 10 : sub;
    const int reps = (((PROBE_MASK >> pcode) & 1) && !(sub == 4 || sub == 7)) ? 2 : 1;
#pragma unroll 1
    for (int rep = 0; rep < reps; ++rep) {
    if (sub == 8) {
      prep_phase(p, shm);
    } else if (sub == 0 || sub == 1 || sub == 4 || sub == 6 || sub == 7 || sub == 9) {
      float* mods = (float*)(ws + OFF_MODS);
      bf16_t* hbuf = (bf16_t*)(ws + OFF_H); bf16_t* onbuf = (bf16_t*)(ws + OFF_ON); bf16_t* ubuf = (bf16_t*)(ws + OFF_U);
      GemmJob j0, j1; EpiArgs E{}; int nj = 1; E.layer = l; E.first = 0;
      float* rssb = (float*)(ws + OFF_RSS); const float* biasb = (const float*)(ws + OFF_BIAS);
      j1.A = (const bf16_t*)(ws + OFF_X); j1.Bt = (const bf16_t*)(ws + OFF_WKV); j1.nM = nMt; j1.nN = 2; j1.K = D; j1.epi = EPI_KVRAW;
      j0.nM = nMt; j0.K = D;
      if (sub == 0) { j0.A = (const bf16_t*)(ws + OFF_ASH); j0.Bt = (const bf16_t*)ws; j0.nM = 1; j0.nN = 106; j0.epi = EPI_BIAS; j1.A = (const bf16_t*)(ws + OFF_BIAS); }
      else if (sub == 9) { j0.A = (const bf16_t*)(ws + OFF_X + (size_t)MODW * D * 2); j0.Bt = (const bf16_t*)(ws + OFF_X); j0.nM = 1; j0.nN = MODW / BM; j0.epi = EPI_ADA; E.f0 = mods; E.ash = (bf16_t*)(ws + OFF_ASH); }
      else if (sub == 1 && hg) { E.rss = rssb + (size_t)(2 * l) * T; E.bias = biasb + (size_t)132 * site_prefN(l); E.bN = 4096; j0.A = hbuf; j0.Bt = (const bf16_t*)(ws + OFF_WIN) + (size_t)l * 4096 * D; j0.nN = 16; j0.epi = EPI_HGIN;
        E.f0 = (float*)(ws + OFF_X); E.b0 = (bf16_t*)(ws + OFF_U); E.b1 = (bf16_t*)(ws + OFF_U + SZ_ACT); E.b2 = (bf16_t*)(ws + OFF_U + 2 * SZ_ACT); E.b3 = (bf16_t*)(ws + OFF_U + 3 * SZ_ACT); }
      else if (sub == 1) { E.rss = rssb + (size_t)(2 * l) * T; E.bias = biasb + (size_t)132 * site_prefN(l); E.bN = 1024; E.bias1 = biasb + (size_t)132 * site_prefN(4); E.bN1 = 512; j0.A = hbuf; j0.Bt = (const bf16_t*)(ws + OFF_WQ) + (size_t)(l - 2) * D * D; j0.nN = 4; j0.epi = EPI_QRAW;
        E.b1 = (bf16_t*)(ws + OFF_X + SZ_ACT); E.f2 = (float*)(ws + OFF_X + 2 * SZ_ACT); nj = (l == 2) ? 2 : 1; }
      else if (sub == 4) { E.rss_out = rssb + (size_t)(1 + 2 * l) * T; E.ng = p->norm2_g + l * D; E.nsc = mods + l * 6144 + 4096; E.yout = hbuf; j0.A = onbuf; j0.Bt = hg ? (const bf16_t*)(ws + OFF_WOUT) + (size_t)l * D * D : (const bf16_t*)(ws + OFF_WO) + (size_t)(l - 2) * D * D; j0.nN = 4; j0.epi = EPI_RESID;
        E.f0 = p->out + O_Y; E.f1 = mods + l * 6144 + 2048; E.first = (l == 0); }
      else if (sub == 6) { E.rss = rssb + (size_t)(1 + 2 * l) * T; E.bias = biasb + (size_t)132 * site_prefN(5 + l); E.bN = 4096; j0.A = hbuf; j0.Bt = (const bf16_t*)(ws + OFF_WUP) + (size_t)l * D * FF; j0.nN = 16; j0.epi = EPI_UP; E.b0 = ubuf; }
      else { if (l < 3) { E.rss_out = rssb + (size_t)(2 * (l + 1)) * T; E.ng = p->norm1_g + (l + 1) * D; E.nsc = mods + (l + 1) * 6144 + 1024; E.yout = hbuf;
          if (l == 1) { E.ngkv = p->kv_norm_g; E.nsckv = mods + 24576 + 1024; E.ykv = (bf16_t*)(ws + OFF_X); } }
        j0.A = ubuf; j0.Bt = (const bf16_t*)(ws + OFF_WDN) + (size_t)l * D * FF; j0.nN = 4; j0.K = FF; j0.epi = EPI_RESID; E.f0 = p->out + O_Y; E.f1 = mods + l * 6144 + 5120; }
      gemm_phase(p, (LAS unsigned char*)shm, shm, j0, j1, nj, E, sub != 9 && sub != 0);
      if (sub == 0) init_rows(p, (unsigned*)(ws + OFF_BAR) + XCD_BAR_WORDS + 100);
    } else if (sub == 2 && hg) {
      HgBufs HB; HB.q = (bf16_t*)(ws + OFF_U); HB.k = (bf16_t*)(ws + OFF_U + SZ_ACT); HB.v = (bf16_t*)(ws + OFF_U + 2 * SZ_ACT); HB.g = (bf16_t*)(ws + OFF_U + 3 * SZ_ACT);
      HB.lf = (float*)(ws + OFF_X); HB.o32 = (float*)(ws + OFF_X + 2 * SZ_ACT); HB.on = (bf16_t*)(ws + OFF_ON);
      scan_phase(p, l, HB, shm);
    } else if (sub == 2) {
      AtBufs AB; AB.qraw = (bf16_t*)(ws + OFF_X + SZ_ACT); AB.kvraw = (float*)(ws + OFF_X + 2 * SZ_ACT); AB.on = (bf16_t*)(ws + OFF_ON); AB.tab = (const float*)(ws + OFF_TAB);
      attn_phase(p, l, AB, shm);
    } else {
      HgBufs HB; HB.q = (bf16_t*)(ws + OFF_U); HB.k = (bf16_t*)(ws + OFF_U + SZ_ACT); HB.v = (bf16_t*)(ws + OFF_U + 2 * SZ_ACT); HB.g = (bf16_t*)(ws + OFF_U + 3 * SZ_ACT);
      HB.lf = (float*)(ws + OFF_X); HB.o32 = (float*)(ws + OFF_X + 2 * SZ_ACT); HB.on = (bf16_t*)(ws + OFF_ON);
      scan_passB(HB);
      { KP pb = kp_get(); XcdBarrier xb; xb.bar = (unsigned*)(pb->ws + OFF_BAR); xb.x = xb_xcc_id(); xb.st = xst; xcd_barrier(xb); }
      scan_prompt<1>(p, l, HB, shm);
    }
    }
    if (step == 31) break;
    if (step == -2) grid.sync();
    else { KP pb = kp_get(); XcdBarrier xb; xb.bar = (unsigned*)(pb->ws + OFF_BAR); xb.x = xb_xcc_id(); xb.st = xst; xcd_barrier(xb); }
  }
}

extern "C" void kernel_launch(void* const* d_in, const int* in_sizes, int n_in, void* d_out, int out_size, void* d_ws, size_t ws_size, hipStream_t stream) {
  static int grid_blocks = 0;
  if (!grid_blocks) {
    int dev = 0, cus = 0, per_cu = 0;
    hipGetDevice(&dev);
    hipDeviceGetAttribute(&cus, hipDeviceAttributeMultiprocessorCount, dev);
    if (hipFuncSetAttribute((const void*)yoco_fwd, hipFuncAttributeMaxDynamicSharedMemorySize, LDS_BYTES) != hipSuccess) fprintf(stderr, "hipFuncSetAttribute failed\n");
    if (hipOccupancyMaxActiveBlocksPerMultiprocessor(&per_cu, (const void*)yoco_fwd, NTHREADS, LDS_BYTES) != hipSuccess || per_cu < 1) { fprintf(stderr, "occupancy query failed\n"); per_cu = 1; }
    grid_blocks = cus * per_cu;
    if (ws_size < WS_NEED) fprintf(stderr, "workspace too small: %zu < %zu\n", ws_size, (size_t)WS_NEED);
  }
  P p{};
  const float** pp = (const float**)&p;
  for (int i = 0; i < 26; ++i) pp[i] = (const float*)d_in[i];
  p.out = (float*)d_out; p.ws = (unsigned char*)d_ws;
  (void)hipMemsetAsync((unsigned char*)d_ws + OFF_BAR, 0, ZERO_BYTES, stream);
  void* args[] = {&p};
  hipError_t e = hipLaunchCooperativeKernel((const void*)yoco_fwd, dim3(grid_blocks), dim3(NTHREADS), args, LDS_BYTES, stream);
  if (e != hipSuccess) fprintf(stderr, "cooperative launch failed: %s (grid %d)\n", hipGetErrorString(e), grid_blocks);
}
```

```cpp
#include <hip/hip_runtime.h>
#include <hip/hip_cooperative_groups.h>
#include <cstdio>
#include <cstdint>
namespace cg = cooperative_groups;

#define DI __device__ __forceinline__
typedef unsigned short bf16_t;
typedef short bf16x8 __attribute__((ext_vector_type(8)));
typedef float f32x4 __attribute__((ext_vector_type(4)));
typedef float f32x2 __attribute__((ext_vector_type(2)));
typedef float f32x16 __attribute__((ext_vector_type(16)));
typedef unsigned u32x4 __attribute__((ext_vector_type(4)));
typedef unsigned u32x2 __attribute__((ext_vector_type(2)));
#define LAS __attribute__((address_space(3)))

constexpr int D = 1024, FF = 4096, TP = 16384, TS = 128, T = TP + TS, TPAD = 16640, SEQ = 4096;
constexpr int NMOD = 132, MODW = 4 * 6144 + 2048;
constexpr float EPS = 1e-6f;
constexpr int NTHREADS = 512, NWAVES = 8;
constexpr int LDS_BYTES = 131072 + 16;

constexpr size_t O_Y = 0;
constexpr size_t O_HGP = (size_t)T * D;
constexpr size_t O_KP = O_HGP + (size_t)2 * 4 * 8 * 128 * 128;
constexpr size_t O_VP = O_KP + (size_t)4 * 128 * 4 * 64;
constexpr size_t O_HGS = O_VP + (size_t)4 * 128 * 4 * 64;
constexpr size_t O_KS = O_HGS + (size_t)2 * 128 * 8 * 128 * 128;
constexpr size_t O_VS = O_KS + (size_t)128 * 128 * 4 * 64;

constexpr size_t SZ_ACT = (size_t)TPAD * D * 2;
constexpr size_t OFF_WIN = 0;
constexpr size_t OFF_WOUT = OFF_WIN + (size_t)2 * 4096 * 1024 * 2;
constexpr size_t OFF_WKV = OFF_WOUT + (size_t)2 * 1024 * 1024 * 2;
constexpr size_t OFF_WQ = OFF_WKV + (size_t)512 * 1024 * 2;
constexpr size_t OFF_WO = OFF_WQ + (size_t)2 * 1024 * 1024 * 2;
constexpr size_t OFF_WUP = OFF_WO + (size_t)2 * 1024 * 1024 * 2;
constexpr size_t OFF_WDN = OFF_WUP + (size_t)4 * 4096 * 1024 * 2;
constexpr size_t OFF_MODS = OFF_WDN + (size_t)4 * 4096 * 1024 * 2;
constexpr size_t OFF_TAB = OFF_MODS + (((size_t)NMOD * MODW * 4 + 4095) & ~(size_t)4095);
constexpr size_t OFF_H = OFF_TAB + (((size_t)4097 * 64 * 4 + 4095) & ~(size_t)4095);
constexpr size_t OFF_ON = OFF_H + SZ_ACT;
constexpr size_t OFF_U = OFF_ON + SZ_ACT;
constexpr size_t OFF_X = OFF_U + 4 * SZ_ACT;
constexpr size_t OFF_BAR = OFF_X + 4 * SZ_ACT;
constexpr size_t BAR_BYTES = 16384;
constexpr size_t OFF_RSS = OFF_BAR + BAR_BYTES;
constexpr size_t ZERO_BYTES = BAR_BYTES + (size_t)9 * T * 4;
constexpr size_t OFF_ASH = OFF_BAR + ((ZERO_BYTES + 4095) & ~(size_t)4095);
constexpr size_t OFF_BIAS = OFF_ASH + (size_t)9 * 256 * 1024 * 2;
constexpr size_t WS_NEED = OFF_BIAS + (size_t)132 * 27136 * 4;

struct P {
  const float *x_prompt, *x_sample, *c_prompt, *c_sample, *state_hgrn, *cache_k, *cache_v;
  const float *w_ada, *b_ada, *norm1_g, *norm2_g, *hg_w_in, *hg_w_out, *hg_lbp, *hg_gn_g;
  const float *kv_w_ada, *kv_b_ada, *kv_norm_g, *w_kv, *k_norm_g, *w_q, *q_norm_g, *sinks, *w_o, *w_up, *w_down;
  float* out; unsigned char* ws;
};

typedef const P __attribute__((address_space(4)))* KP;
DI KP kp_get() { KP q = (KP)__builtin_amdgcn_kernarg_segment_ptr(); asm volatile("" : "+s"(q)); return q; }
DI int tid_get() { int t = threadIdx.x; asm volatile("" : "+v"(t)); return t; }
DI unsigned f2bf(float f) { unsigned u = __float_as_uint(f); return (u + 0x7fffu + ((u >> 16) & 1u)) >> 16; }
typedef __bf16 bf16x2_n __attribute__((ext_vector_type(2)));
DI unsigned pk2(float lo, float hi) { return __builtin_bit_cast(unsigned, __builtin_convertvector((f32x2){lo, hi}, bf16x2_n)); }
DI float bf2f(unsigned b) { return __uint_as_float(b << 16); }
DI float silu_f(float x) { return x * __builtin_amdgcn_rcpf(1.f + __expf(-x)); }
DI int modrow(int r) { return r < TP ? (r >> 12) : (4 + r - TP); }
DI int crow(int reg, int h) { return (reg & 3) + 8 * (reg >> 2) + 4 * h; }

constexpr int BM = 256, BK = 64, HALF = 128, HTB = HALF * BK * 2;
DI int lds_byte(int r, int c) { const int st = (r >> 4) * 2 + (c >> 5), rr = r & 15, cc = c & 31, ob = rr * 64 + cc * 2; return st * 1024 + (ob ^ (((ob >> 9) & 1) << 5)); }
DI void stage_rc(int b, int& R, int& C) { const int st = b / 1024, sb = b % 1024, swz = sb ^ (((sb >> 9) & 1) << 5); R = (st >> 1) * 16 + swz / 64; C = (st & 1) * 32 + (swz % 64) / 2; }

enum { EPI_ADA = 0, EPI_HGIN = 1, EPI_RESID = 2, EPI_UP = 3, EPI_QRAW = 4, EPI_KVRAW = 5, EPI_NOP = 6, EPI_BIAS = 7 };
struct GemmJob { const bf16_t* A; const bf16_t* Bt; int nM, nN, K, epi; };
struct EpiArgs {
  float* f0; const float* f1; float* f2; bf16_t* b0; bf16_t* b1; bf16_t* b2; bf16_t* b3; int layer; int first;
  const float* rss; const float* bias; const float* bias1; int bN, bN1;
  float* rss_out; const float* ng; const float* nsc; bf16_t* yout; const float* ngkv; const float* nsckv; bf16_t* ykv;
  bf16_t* ash;
};
DI int site_N(const int s) { return (s == 2 || s == 3) ? 1024 : (s == 4 ? 512 : 4096); }
DI int site_prefN(const int s) { return s == 0 ? 0 : s == 1 ? 4096 : s == 2 ? 8192 : s == 3 ? 9216 : s == 4 ? 10240 : 10752 + (s - 5) * 4096; }

DI void tile_of(int L, int nM, int nN, int& pm, int& pn) {
  const int nwg = nM * nN; int wgid = L;
  { const int q = nwg / 8, r = nwg % 8, xcd = wgid % 8, off = wgid / 8; wgid = (xcd < r ? xcd * (q + 1) : r * (q + 1) + (xcd - r) * q) + off; }
  const int nig = 8 * nN, gid = wgid / nig, fm = gid * 8, gsz = (nM - fm) < 8 ? (nM - fm) : 8;
  pm = fm + ((wgid % nig) % gsz); pn = (wgid % nig) / gsz;
}

DI void epi_frag(KP p, const int epi, const EpiArgs& E, const int r, const int c, const f32x4 vin) {
  if (epi == EPI_NOP) return;
  f32x4 v = vin;
  if (epi == EPI_HGIN || epi == EPI_UP || epi == EPI_QRAW || epi == EPI_KVRAW) {
    const float rstd = rsqrtf(E.rss[r] * (1.f / D) + EPS);
    const float* bp = ((epi == EPI_KVRAW) ? E.bias1 + (size_t)modrow(r) * E.bN1 : E.bias + (size_t)modrow(r) * E.bN) + c;
    v = v * rstd + *(const f32x4*)bp; }
  if (epi == EPI_HGIN) {
    const int sec = c >> 10, cc = c & 1023; const size_t o = (size_t)r * D + cc;
    if (sec == 1) { f32x4 lb = (f32x4){0.f, 0.f, 0.f, 0.f};
      if (E.layer == 1) { const f32x4 l0 = *(const f32x4*)(p->hg_lbp + cc), l1 = *(const f32x4*)(p->hg_lbp + D + cc);
#pragma unroll
        for (int j = 0; j < 4; ++j) lb[j] = __builtin_amdgcn_rcpf(1.f + __expf(l0[j] - l1[j])); }
      f32x4 lf; float kk[4];
#pragma unroll
      for (int j = 0; j < 4; ++j) { const float sg = __builtin_amdgcn_rcpf(1.f + __expf(-v[j])); const float fg = lb[j] + (1.f - lb[j]) * sg; lf[j] = __logf(fg); kk[j] = (1.f - lb[j]) * (1.f - sg); }
      *(f32x4*)(E.f0 + o) = lf; *(u32x2*)(E.b1 + o) = (u32x2){pk2(kk[0], kk[1]), pk2(kk[2], kk[3])};
    } else if (sec == 2) { *(u32x2*)(E.b2 + o) = (u32x2){pk2(v[0], v[1]), pk2(v[2], v[3])};
    } else { bf16_t* dst = (sec == 0) ? E.b0 : E.b3; *(u32x2*)(dst + o) = (u32x2){pk2(silu_f(v[0]), silu_f(v[1])), pk2(silu_f(v[2]), silu_f(v[3]))}; }
  } else if (epi == EPI_RESID) {
    const float* xin = E.first ? (r < TP ? p->x_prompt + (size_t)r * D : p->x_sample + (size_t)(r - TP) * D) : (E.f0 + (size_t)r * D);
    const size_t mo = (size_t)modrow(r) * MODW;
    const f32x4 xv = *(const f32x4*)(xin + c), gv = *(const f32x4*)(E.f1 + mo + c);
    const f32x4 yn = xv + gv * v;
    *(f32x4*)(E.f0 + (size_t)r * D + c) = yn;
    if (E.yout) {
      const f32x4 g = *(const f32x4*)(E.ng + c), sc = *(const f32x4*)(E.nsc + mo + c); const f32x4 y = yn * g * (sc + 1.f);
      *(u32x2*)(E.yout + (size_t)r * D + c) = (u32x2){pk2(y[0], y[1]), pk2(y[2], y[3])};
      if (E.ykv) { const f32x4 g2 = *(const f32x4*)(E.ngkv + c), sc2 = *(const f32x4*)(E.nsckv + mo + c); const f32x4 y2 = yn * g2 * (sc2 + 1.f);
        *(u32x2*)(E.ykv + (size_t)r * D + c) = (u32x2){pk2(y2[0], y2[1]), pk2(y2[2], y2[3])}; }
      float ss = yn[0] * yn[0] + yn[1] * yn[1] + yn[2] * yn[2] + yn[3] * yn[3];
      ss += __shfl_xor(ss, 1); ss += __shfl_xor(ss, 2);
      if ((tid_get() & 3) == 0) atomicAdd(E.rss_out + r, ss); }
  } else if (epi == EPI_UP) {
    f32x4 u;
#pragma unroll
    for (int j = 0; j < 4; ++j) { const float t = fmaxf(v[j], 0.f); u[j] = t * t; }
    *(u32x2*)(E.b0 + (size_t)r * FF + c) = (u32x2){pk2(u[0], u[1]), pk2(u[2], u[3])};
  } else if (epi == EPI_QRAW) { *(u32x2*)(E.b1 + (size_t)r * D + c) = (u32x2){pk2(v[0], v[1]), pk2(v[2], v[3])};
  } else if (epi == EPI_KVRAW) { *(f32x4*)(E.f2 + (size_t)r * 512 + c) = v; }
}

DI void epi_frag8(KP p, const int epi, const EpiArgs& E, const int r, const int c, const f32x4 v0, const f32x4 v1, const f32x4 lbA = (f32x4){0.f, 0.f, 0.f, 0.f}, const f32x4 lbB = (f32x4){0.f, 0.f, 0.f, 0.f}) {
  if (epi == EPI_NOP) return;
  if (epi == EPI_ADA) { if (r < NMOD) { const float* bp = (c < 24576) ? (p->b_ada + c) : (p->kv_b_ada + (c - 24576)); float* o = E.f0 + (size_t)r * MODW + c;
      const f32x4 m0 = v0 + *(const f32x4*)bp, m1 = v1 + *(const f32x4*)(bp + 4);
      *(f32x4*)o = m0; *(f32x4*)(o + 4) = m1;
      int site = -1;
      if (c < 24576) { const int l = c / 6144, part = (c - l * 6144) >> 10; site = (part == 0) ? l : (part == 3 ? 5 + l : -1); } else if (c < 25600) site = 4;
      if (site >= 0) *(u32x4*)(E.ash + ((size_t)site * 256 + r) * 1024 + (c & 1023)) = (u32x4){pk2(m0[0], m0[1]), pk2(m0[2], m0[3]), pk2(m1[0], m1[1]), pk2(m1[2], m1[3])}; }
  } else if (epi == EPI_HGIN) {
    const int sec = c >> 10, cc = c & 1023; const size_t o = (size_t)r * D + cc;
    if (sec == 1) { float lb[8];
#pragma unroll
      for (int j = 0; j < 4; ++j) { lb[j] = lbA[j]; lb[4 + j] = lbB[j]; }
      float lf[8], kk[8];
#pragma unroll
      for (int j = 0; j < 8; ++j) { const float x = (j < 4) ? v0[j & 3] : v1[j & 3]; const float sg = __builtin_amdgcn_rcpf(1.f + __expf(-x)); const float fg = lb[j] + (1.f - lb[j]) * sg;
        lf[j] = __logf(fg); kk[j] = (1.f - lb[j]) * (1.f - sg); }
      *(f32x4*)(E.f0 + o) = (f32x4){lf[0], lf[1], lf[2], lf[3]}; *(f32x4*)(E.f0 + o + 4) = (f32x4){lf[4], lf[5], lf[6], lf[7]};
      *(u32x4*)(E.b1 + o) = (u32x4){pk2(kk[0], kk[1]), pk2(kk[2], kk[3]), pk2(kk[4], kk[5]), pk2(kk[6], kk[7])};
    } else if (sec == 2) { *(u32x4*)(E.b2 + o) = (u32x4){pk2(v0[0], v0[1]), pk2(v0[2], v0[3]), pk2(v1[0], v1[1]), pk2(v1[2], v1[3])};
    } else { bf16_t* dst = (sec == 0) ? E.b0 : E.b3;
      *(u32x4*)(dst + o) = (u32x4){pk2(silu_f(v0[0]), silu_f(v0[1])), pk2(silu_f(v0[2]), silu_f(v0[3])), pk2(silu_f(v1[0]), silu_f(v1[1])), pk2(silu_f(v1[2]), silu_f(v1[3]))}; }
  } else if (epi == EPI_RESID) {
    const float* xin = E.first ? (r < TP ? p->x_prompt + (size_t)r * D : p->x_sample + (size_t)(r - TP) * D) : (E.f0 + (size_t)r * D);
    const size_t mo = (size_t)modrow(r) * MODW;
    const float* gm = E.f1 + mo + c; float* o = E.f0 + (size_t)r * D + c;
    const f32x4 xa = *(const f32x4*)(xin + c), xb = *(const f32x4*)(xin + c + 4), ga = *(const f32x4*)gm, gb = *(const f32x4*)(gm + 4);
    const f32x4 ya = xa + ga * v0, yb = xb + gb * v1;
    *(f32x4*)o = ya; *(f32x4*)(o + 4) = yb;
    if (E.yout) {
      const f32x4 g0 = *(const f32x4*)(E.ng + c), g1 = *(const f32x4*)(E.ng + c + 4), s0 = *(const f32x4*)(E.nsc + mo + c), s1 = *(const f32x4*)(E.nsc + mo + c + 4);
      const f32x4 y0 = ya * g0 * (s0 + 1.f), y1 = yb * g1 * (s1 + 1.f);
      *(u32x4*)(E.yout + (size_t)r * D + c) = (u32x4){pk2(y0[0], y0[1]), pk2(y0[2], y0[3]), pk2(y1[0], y1[1]), pk2(y1[2], y1[3])};
      if (E.ykv) { const f32x4 h0 = *(const f32x4*)(E.ngkv + c), h1 = *(const f32x4*)(E.ngkv + c + 4), t0 = *(const f32x4*)(E.nsckv + mo + c), t1 = *(const f32x4*)(E.nsckv + mo + c + 4);
        const f32x4 z0 = ya * h0 * (t0 + 1.f), z1 = yb * h1 * (t1 + 1.f);
        *(u32x4*)(E.ykv + (size_t)r * D + c) = (u32x4){pk2(z0[0], z0[1]), pk2(z0[2], z0[3]), pk2(z1[0], z1[1]), pk2(z1[2], z1[3])}; }
      float ss = ya[0] * ya[0] + ya[1] * ya[1] + ya[2] * ya[2] + ya[3] * ya[3] + yb[0] * yb[0] + yb[1] * yb[1] + yb[2] * yb[2] + yb[3] * yb[3];
      ss += __shfl_xor(ss, 16); ss += __shfl_xor(ss, 32);
      if ((tid_get() & 63) < 16) atomicAdd(E.rss_out + r, ss); }
  } else if (epi == EPI_UP) {
    float u[8];
#pragma unroll
    for (int j = 0; j < 8; ++j) { const float t = fmaxf((j < 4) ? v0[j & 3] : v1[j & 3], 0.f); u[j] = t * t; }
    *(u32x4*)(E.b0 + (size_t)r * FF + c) = (u32x4){pk2(u[0], u[1]), pk2(u[2], u[3]), pk2(u[4], u[5]), pk2(u[6], u[7])};
  } else if (epi == EPI_QRAW) { *(u32x4*)(E.b1 + (size_t)r * D + c) = (u32x4){pk2(v0[0], v0[1]), pk2(v0[2], v0[3]), pk2(v1[0], v1[1]), pk2(v1[2], v1[3])};
  } else { float* o = E.f2 + (size_t)r * 512 + c; *(f32x4*)o = v0; *(f32x4*)(o + 4) = v1; }
}

template <int NMB>
DI void skinny_unit(KP p, unsigned char* shm, const bf16_t* A, const bf16_t* Bt, const int K, const int mrow0, const int n0, const int epi, const EpiArgs& E) {
  const int tid = tid_get(), lane = tid & 63, wave = tid >> 6, fr = lane & 15, fq = lane >> 4;
  const int ks = K >> 3;
  const bf16_t* ap = A + (size_t)(TP + mrow0 + fr) * K + wave * ks + fq * 8;
  const bf16_t* bp = Bt + (size_t)(n0 + fr) * K + wave * ks + fq * 8;
  f32x4 acc[NMB];
#pragma unroll
  for (int mb = 0; mb < NMB; ++mb) acc[mb] = (f32x4){0.f, 0.f, 0.f, 0.f};
#pragma unroll 2
  for (int k = 0; k < ks; k += 32) { const bf16x8 b = *(const bf16x8*)(bp + k);
#pragma unroll
    for (int mb = 0; mb < NMB; ++mb) { const bf16x8 a = *(const bf16x8*)(ap + (size_t)mb * 16 * K + k); acc[mb] = __builtin_amdgcn_mfma_f32_16x16x32_bf16(b, a, acc[mb], 0, 0, 0); } }
  float* red = (float*)shm;
#pragma unroll
  for (int mb = 0; mb < NMB; ++mb) *(f32x4*)(red + wave * (NMB * 256) + (mb * 16 + fr) * 16 + fq * 4) = acc[mb];
  __syncthreads();
  if (tid < NMB * 64) { const int row = tid >> 2, c4 = (tid & 3) * 4; f32x4 sum = (f32x4){0.f, 0.f, 0.f, 0.f};
#pragma unroll
    for (int w = 0; w < 8; ++w) sum += *(const f32x4*)(red + w * (NMB * 256) + row * 16 + c4);
    epi_frag(p, epi, E, TP + mrow0 + row, n0 + c4, sum); }
  __syncthreads();
}

DI int perm32(int rho) { const int n = rho >> 4, i = rho & 15; return 8 * (i >> 2) + 4 * n + (i & 3); }
struct UnitD { const char* A; const char* B; int pm, pn, epi; float* ob; int on; };
DI void unit_of(const int L, const GemmJob& j0, const GemmJob& j1, const int n0, const size_t tstep, UnitD& u) {
  if (j0.epi == EPI_BIAS) {
    const int st = L < 16 ? 0 : L < 32 ? 1 : L < 36 ? 2 : L < 40 ? 3 : L < 42 ? 4 : 5 + (L - 42) / 16;
    const int lb = st == 0 ? 0 : st == 1 ? 16 : st == 2 ? 32 : st == 3 ? 36 : st == 4 ? 40 : 42 + (st - 5) * 16;
    const unsigned char* wsb = (const unsigned char*)j0.Bt;
    const bf16_t* Bt = (st < 2) ? (const bf16_t*)(wsb + OFF_WIN) + (size_t)st * 4096 * D : (st < 4) ? (const bf16_t*)(wsb + OFF_WQ) + (size_t)(st - 2) * D * D
                     : (st == 4) ? (const bf16_t*)(wsb + OFF_WKV) : (const bf16_t*)(wsb + OFF_WUP) + (size_t)(st - 5) * D * FF;
    u.pm = 0; u.pn = L - lb; u.epi = EPI_BIAS; u.A = (const char*)(j0.A + (size_t)st * 256 * 1024); u.B = (const char*)Bt + (size_t)u.pn * tstep;
    u.ob = (float*)j1.A + (size_t)132 * site_prefN(st); u.on = site_N(st); return; }
  const bool second = (L >= n0); int pm, pn; tile_of(second ? L - n0 : L, second ? j1.nM : j0.nM, second ? j1.nN : j0.nN, pm, pn);
  u.pm = pm; u.pn = pn; u.epi = second ? j1.epi : j0.epi;
  u.A = (const char*)(second ? j1.A : j0.A) + (size_t)pm * tstep; u.B = (const char*)(second ? j1.Bt : j0.Bt) + (size_t)pn * tstep;
}
DI void gemm_phase(KP p, LAS unsigned char* lds, unsigned char* shm, const GemmJob& j0, const GemmJob& j1, const int njobs, const EpiArgs& E, const int skinny) {
  const int tid = tid_get(), wid = __builtin_amdgcn_readfirstlane(tid >> 6), lane = tid & 63, wr = wid >> 2, wc = wid & 3, fr = lane & 15, fq = lane >> 4;
  const int K = j0.K, nt = K / BK;
  const int n0 = j0.nM * j0.nN, n1 = (njobs > 1) ? j1.nM * j1.nN : 0, ntl = n0 + n1;
  if ((int)blockIdx.x < ntl) {
    unsigned voffA[2], voffB[2];
#pragma unroll
    for (int i = 0; i < 2; ++i) { int R, C; stage_rc(tid * 16 + i * 8192, R, C); const int Rb = (R & ~31) + perm32(R & 31);
      voffA[i] = (unsigned)(R * K + C) * 2u; voffB[i] = (unsigned)(Rb * K + C) * 2u; }
    const size_t kstep = (size_t)(BK * 2), hstep = (size_t)HALF * K * 2, tstep = 2 * hstep;
    const unsigned ldsw = (unsigned)wid * 1024u;
    const int aoff = lds_byte(wr * 64 + fr, fq * 8), boff = lds_byte(wc * 32 + fr, fq * 8);
#define G_SA(b, h) (((b) * 2 + (h)) * HTB)
#define G_SB(b, h) ((4 + (b) * 2 + (h)) * HTB)
#define G_STAGE(bufoff, gbase, voff) do { _Pragma("unroll") for (int _i = 0; _i < 2; ++_i) \
      __builtin_amdgcn_global_load_lds((const unsigned*)((const char*)(gbase) + (voff)[_i]), (LAS unsigned*)(lds + (bufoff) + ldsw + _i * 8192), 16, 0, 0); } while (0)
#define G_LDA(dst, b, h) do { _Pragma("unroll") for (int m = 0; m < 4; ++m) _Pragma("unroll") for (int k = 0; k < 2; ++k) dst[m][k] = *(const LAS bf16x8*)(lds + G_SA(b, h) + aoff + m * 2048 + k * 1024); } while (0)
#define G_LDB(dst, b, h) do { _Pragma("unroll") for (int n = 0; n < 2; ++n) _Pragma("unroll") for (int k = 0; k < 2; ++k) dst[n][k] = *(const LAS bf16x8*)(lds + G_SB(b, h) + boff + n * 2048 + k * 1024); } while (0)
#define G_MMA(ai, bj, At, Bt) do { __builtin_amdgcn_s_setprio(1); _Pragma("unroll") for (int m = 0; m < 4; ++m) _Pragma("unroll") for (int n = 0; n < 2; ++n) _Pragma("unroll") for (int k = 0; k < 2; ++k) \
      acc[ai][bj][m][n] = __builtin_amdgcn_mfma_f32_16x16x32_bf16(Bt[n][k], At[m][k], acc[ai][bj][m][n], 0, 0, 0); __builtin_amdgcn_s_setprio(0); } while (0)
#define G_WAIT_V(n) asm volatile("s_waitcnt vmcnt(" #n ")" ::: "memory")
#define G_WAIT_L(n) asm volatile("s_waitcnt lgkmcnt(" #n ")" ::: "memory")
#define G_BAR __builtin_amdgcn_s_barrier()
#define G_SCHED __builtin_amdgcn_sched_barrier(0)
    int L = blockIdx.x;
    UnitD cur, nxt; unit_of(L, j0, j1, n0, tstep, cur);
    f32x4 acc[2][2][4][2];
#pragma unroll
    for (int a = 0; a < 2; ++a)
#pragma unroll
      for (int b = 0; b < 2; ++b)
#pragma unroll
        for (int m = 0; m < 4; ++m)
#pragma unroll
          for (int n = 0; n < 2; ++n) acc[a][b][m][n] = (f32x4){0.f, 0.f, 0.f, 0.f};
    bf16x8 At[4][2], B0[2][2], B1[2][2];
    const char* cA = cur.A; const char* cB = cur.B;
    G_STAGE(G_SB(0, 0), cB, voffB); G_STAGE(G_SB(0, 1), cB + hstep, voffB); G_STAGE(G_SA(0, 0), cA, voffA); G_STAGE(G_SA(0, 1), cA + hstep, voffA);
    if (wr == 1) G_BAR;
    G_WAIT_V(2); G_BAR;
    G_STAGE(G_SB(1, 0), cB + kstep, voffB); G_STAGE(G_SA(1, 0), cA + kstep, voffA); G_STAGE(G_SB(1, 1), cB + hstep + kstep, voffB);
    G_WAIT_V(6); G_BAR;
#pragma unroll 1
    for (;;) {
      const int Ln = L + (int)gridDim.x; const bool has_next = (Ln < ntl);
      if (has_next) unit_of(Ln, j0, j1, n0, tstep, nxt);
      const char* nA = has_next ? nxt.A : cA; const char* nB = has_next ? nxt.B : cB;
#pragma unroll 1
      for (int t = 0; t < nt; t += 2) {
        const bool last = (t == nt - 2);
        const char* a1 = cA + (size_t)(t + 1) * kstep;
        const char* a2 = last ? nA : cA + (size_t)(t + 2) * kstep; const char* b2 = last ? nB : cB + (size_t)(t + 2) * kstep;
        const char* a3 = a2 + kstep; const char* b3 = b2 + kstep;
        G_LDB(B0, 0, 0); G_LDB(B1, 0, 1); G_SCHED; G_LDA(At, 0, 0); G_STAGE(G_SA(1, 1), a1 + hstep, voffA);
        G_WAIT_V(8); G_WAIT_L(0); G_BAR; G_MMA(0, 0, At, B0); G_MMA(0, 1, At, B1); G_BAR; G_SCHED;
        G_LDA(At, 0, 1); G_STAGE(G_SB(0, 0), b2, voffB); G_STAGE(G_SB(0, 1), b2 + hstep, voffB); G_STAGE(G_SA(0, 0), a2, voffA);
        G_WAIT_V(8); G_WAIT_L(0); G_BAR; G_MMA(1, 0, At, B0); G_MMA(1, 1, At, B1); G_BAR; G_SCHED;
        G_LDB(B0, 1, 0); G_LDB(B1, 1, 1); G_SCHED; G_LDA(At, 1, 0); G_STAGE(G_SA(0, 1), a2 + hstep, voffA);
        G_WAIT_V(8); G_WAIT_L(0); G_BAR; G_MMA(0, 0, At, B0); G_MMA(0, 1, At, B1); G_BAR; G_SCHED;
        G_LDA(At, 1, 1); G_STAGE(G_SB(1, 0), b3, voffB); G_STAGE(G_SB(1, 1), b3 + hstep, voffB); G_STAGE(G_SA(1, 0), a3, voffA);
        G_WAIT_V(8); G_WAIT_L(0); G_BAR; G_MMA(1, 0, At, B0); G_MMA(1, 1, At, B1); G_BAR; G_SCHED;
      }
      if (wr == 0) G_BAR;
      { const int r0 = cur.pm * BM + wr * 64 + fr, c0 = cur.pn * BM + wc * 32 + fq * 8; const int epi = cur.epi;
#define EPI_LOOP(MODE) { _Pragma("unroll") for (int ai = 0; ai < 2; ++ai) _Pragma("unroll") for (int m = 0; m < 4; ++m) _Pragma("unroll") for (int bj = 0; bj < 2; ++bj) \
          epi_frag8(p, MODE, E, r0 + ai * 128 + m * 16, c0 + bj * 128, acc[ai][bj][m][0], acc[ai][bj][m][1]); }
        if (epi == EPI_ADA) EPI_LOOP(EPI_ADA)
        else if (epi == EPI_BIAS) {
#pragma unroll
          for (int ai = 0; ai < 2; ++ai)
#pragma unroll
            for (int m = 0; m < 4; ++m) { const int r = r0 + ai * 128 + m * 16; if (r < NMOD) {
#pragma unroll
              for (int bj = 0; bj < 2; ++bj) { float* o = cur.ob + (size_t)r * cur.on + (c0 + bj * 128); *(f32x4*)o = acc[ai][bj][m][0]; *(f32x4*)(o + 4) = acc[ai][bj][m][1]; } } }
        } else if (epi == EPI_RESID) {
          const size_t mo = (size_t)modrow(r0) * MODW;
#pragma unroll
          for (int bj = 0; bj < 2; ++bj) { const int c = c0 + bj * 128;
            const f32x4 ga = *(const f32x4*)(E.f1 + mo + c), gb = *(const f32x4*)(E.f1 + mo + c + 4);
            f32x4 m0 = (f32x4){0.f, 0.f, 0.f, 0.f}, m1 = m0, k0 = m0, k1 = m0;
            if (E.yout) { const f32x4 g0 = *(const f32x4*)(E.ng + c), g1 = *(const f32x4*)(E.ng + c + 4), s0 = *(const f32x4*)(E.nsc + mo + c), s1 = *(const f32x4*)(E.nsc + mo + c + 4);
              m0 = g0 * (s0 + 1.f); m1 = g1 * (s1 + 1.f);
              if (E.ykv) { const f32x4 h0 = *(const f32x4*)(E.ngkv + c), h1 = *(const f32x4*)(E.ngkv + c + 4), t0 = *(const f32x4*)(E.nsckv + mo + c), t1 = *(const f32x4*)(E.nsckv + mo + c + 4);
                k0 = h0 * (t0 + 1.f); k1 = h1 * (t1 + 1.f); } }
#pragma unroll
            for (int ah = 0; ah < 2; ++ah) { const int ai = ah, mb = 0;
              f32x4 ya[4], yb[4];
              const float* xbase = E.first ? p->x_prompt : E.f0;
#pragma unroll
              for (int m = mb; m < mb + 4; ++m) { const unsigned off = (unsigned)(r0 + ai * 128 + m * 16) * (unsigned)D + (unsigned)c;
                ya[m] = __builtin_nontemporal_load((const f32x4*)(xbase + off)); yb[m] = __builtin_nontemporal_load((const f32x4*)(xbase + off + 4)); }
#pragma unroll
              for (int m = mb; m < mb + 4; ++m) { const int r = r0 + ai * 128 + m * 16; const unsigned off = (unsigned)r * (unsigned)D + (unsigned)c;
                const f32x4 xa = ya[m] + ga * acc[ai][bj][m][0], xb = yb[m] + gb * acc[ai][bj][m][1];
                __builtin_nontemporal_store(xa, (f32x4*)(E.f0 + off)); __builtin_nontemporal_store(xb, (f32x4*)(E.f0 + off + 4));
                if (E.yout) { const f32x4 y0 = xa * m0, y1 = xb * m1;
                  *(u32x4*)(E.yout + off) = (u32x4){pk2(y0[0], y0[1]), pk2(y0[2], y0[3]), pk2(y1[0], y1[1]), pk2(y1[2], y1[3])};
                  if (E.ykv) { const f32x4 z0 = xa * k0, z1 = xb * k1;
                    *(u32x4*)(E.ykv + off) = (u32x4){pk2(z0[0], z0[1]), pk2(z0[2], z0[3]), pk2(z1[0], z1[1]), pk2(z1[2], z1[3])}; }
                  float ss = xa[0] * xa[0] + xa[1] * xa[1] + xa[2] * xa[2] + xa[3] * xa[3] + xb[0] * xb[0] + xb[1] * xb[1] + xb[2] * xb[2] + xb[3] * xb[3];
                  ss += __shfl_xor(ss, 16); ss += __shfl_xor(ss, 32);
                  if (fq == 0) atomicAdd(E.rss_out + (unsigned)r, ss); } } } }
        } else if (epi != EPI_NOP) {
          float rstd8[8];
#pragma unroll
          for (int q = 0; q < 8; ++q) rstd8[q] = rsqrtf(E.rss[r0 + (q >> 2) * 128 + (q & 3) * 16] * (1.f / D) + EPS);
          const float* bb = (epi == EPI_KVRAW) ? E.bias1 + (size_t)modrow(r0) * E.bN1 : E.bias + (size_t)modrow(r0) * E.bN;
          f32x4 bv[2][2], lbv[2][2];
#pragma unroll
          for (int bj = 0; bj < 2; ++bj) { const int c = c0 + bj * 128; bv[bj][0] = *(const f32x4*)(bb + c); bv[bj][1] = *(const f32x4*)(bb + c + 4);
            lbv[bj][0] = (f32x4){0.f, 0.f, 0.f, 0.f}; lbv[bj][1] = (f32x4){0.f, 0.f, 0.f, 0.f};
            if (epi == EPI_HGIN && (c >> 10) == 1 && E.layer == 1) { const int cc = c & 1023;
              const f32x4 l0 = *(const f32x4*)(p->hg_lbp + cc), l1 = *(const f32x4*)(p->hg_lbp + D + cc), l2 = *(const f32x4*)(p->hg_lbp + cc + 4), l3 = *(const f32x4*)(p->hg_lbp + D + cc + 4);
#pragma unroll
              for (int jj = 0; jj < 4; ++jj) { lbv[bj][0][jj] = __builtin_amdgcn_rcpf(1.f + __expf(l0[jj] - l1[jj])); lbv[bj][1][jj] = __builtin_amdgcn_rcpf(1.f + __expf(l2[jj] - l3[jj])); } } }
#define CONS_LOOP(MODE) { _Pragma("unroll") for (int ai = 0; ai < 2; ++ai) _Pragma("unroll") for (int m = 0; m < 4; ++m) _Pragma("unroll") for (int bj = 0; bj < 2; ++bj) \
            epi_frag8(p, MODE, E, r0 + ai * 128 + m * 16, c0 + bj * 128, acc[ai][bj][m][0] * rstd8[ai * 4 + m] + bv[bj][0], acc[ai][bj][m][1] * rstd8[ai * 4 + m] + bv[bj][1], lbv[bj][0], lbv[bj][1]); }
          if (epi == EPI_HGIN) CONS_LOOP(EPI_HGIN) else if (epi == EPI_UP) CONS_LOOP(EPI_UP) else if (epi == EPI_QRAW) CONS_LOOP(EPI_QRAW) else CONS_LOOP(EPI_KVRAW)
        }
      }
      if (!has_next) break;
#pragma unroll
      for (int a = 0; a < 2; ++a)
#pragma unroll
        for (int b = 0; b < 2; ++b)
#pragma unroll
          for (int m = 0; m < 4; ++m)
#pragma unroll
            for (int n = 0; n < 2; ++n) acc[a][b][m][n] = (f32x4){0.f, 0.f, 0.f, 0.f};
      cur = nxt; cA = nA; cB = nB; L = Ln;
      if (wr == 1) G_BAR;
    }
    G_WAIT_V(0);
    G_BAR;
  }
  if (skinny) {
    __syncthreads();
    const int u0 = j0.nN * 16, u1 = (njobs > 1) ? j1.nN * 16 : 0;
    const int rs = ((u0 + u1) * 4 <= (int)gridDim.x) ? 4 : (((u0 + u1) * 2 <= (int)gridDim.x) ? 2 : 1);
#pragma unroll 1
    for (int uu = (int)gridDim.x - 1 - (int)blockIdx.x; uu < (u0 + u1) * rs; uu += gridDim.x) {
      const int u = uu / rs, rg = uu - u * rs;
      const bool second = (u >= u0);
      const bf16_t* sa = second ? j1.A : j0.A; const bf16_t* sb = second ? j1.Bt : j0.Bt; const int sk = second ? j1.K : j0.K, sn = (second ? u - u0 : u) * 16, se = second ? j1.epi : j0.epi;
      if (rs == 4) skinny_unit<2>(p, shm, sa, sb, sk, rg * 32, sn, se, E);
      else if (rs == 2) skinny_unit<4>(p, shm, sa, sb, sk, rg * 64, sn, se, E);
      else skinny_unit<8>(p, shm, sa, sb, sk, 0, sn, se, E);
    }
  }
}

__device__ const float INVF[32] = {1.000000000e+00f, 7.498942614e-01f, 5.623413324e-01f, 4.216965139e-01f, 3.162277639e-01f, 2.371373773e-01f, 1.778279394e-01f, 1.333521307e-01f, 1.000000015e-01f, 7.498941571e-02f, 5.623413250e-02f, 4.216965288e-02f, 3.162277490e-02f, 2.371373773e-02f, 1.778279431e-02f, 1.333521493e-02f, 9.999999776e-03f, 7.498941850e-03f, 5.623413250e-03f, 4.216964822e-03f, 3.162277630e-03f, 2.371373586e-03f, 1.778279431e-03f, 1.333521446e-03f, 1.000000047e-03f, 7.498942432e-04f, 5.623413017e-04f, 4.216965172e-04f, 3.162277571e-04f, 2.371373703e-04f, 1.778279402e-04f, 1.333521504e-04f};
DI void transpose_item(const float* W, int K, int N, bf16_t* WT, int row_off, float* scr, int item, int lane) {
  const int nblk = N / 32, kb = item / nblk, nb = item % nblk, k0 = 64 * kb, n0 = 32 * nb;
#pragma unroll 8
  for (int i = 0; i < 32; ++i) { const int kk = 2 * i + (lane >> 5); scr[kk * 33 + (lane & 31)] = __builtin_nontemporal_load(W + (size_t)(k0 + kk) * N + n0 + (lane & 31)); }
  asm volatile("s_waitcnt lgkmcnt(0)" ::: "memory");
  const int c = lane & 7;
#pragma unroll
  for (int j = 0; j < 4; ++j) { const int n = (lane >> 3) + 8 * j; const float* s = scr + (8 * c) * 33 + n;
    u32x4 o; o.x = pk2(s[0 * 33], s[1 * 33]); o.y = pk2(s[2 * 33], s[3 * 33]); o.z = pk2(s[4 * 33], s[5 * 33]); o.w = pk2(s[6 * 33], s[7 * 33]);
    *(u32x4*)(WT + (size_t)(row_off + n0 + n) * K + k0 + 8 * c) = o; }
  asm volatile("s_waitcnt lgkmcnt(0)" ::: "memory");
}

DI void prep_phase(KP p, unsigned char* shm) {
  const int tid = tid_get(), lane = tid & 63, wave = tid >> 6;
  const int gw = blockIdx.x * NWAVES + wave, NGW = gridDim.x * NWAVES;
  float* scr = (float*)(shm + wave * 16384);
  unsigned char* ws = p->ws;
  int base = 0;
  for (int mi = 0; mi < 22; ++mi) {
    const float* W; int K, N, row_off; bf16_t* WT;
    if (mi < 2) { W = p->hg_w_in + (size_t)mi * D * 4096; K = D; N = 4096; WT = (bf16_t*)(ws + OFF_WIN) + (size_t)mi * 4096 * D; row_off = 0; }
    else if (mi < 4) { W = p->hg_w_out + (size_t)(mi - 2) * D * D; K = D; N = D; WT = (bf16_t*)(ws + OFF_WOUT) + (size_t)(mi - 2) * D * D; row_off = 0; }
    else if (mi < 5) { W = p->w_kv; K = D; N = 512; WT = (bf16_t*)(ws + OFF_WKV); row_off = 0; }
    else if (mi < 7) { W = p->w_q + (size_t)(mi - 5) * D * D; K = D; N = D; WT = (bf16_t*)(ws + OFF_WQ) + (size_t)(mi - 5) * D * D; row_off = 0; }
    else if (mi < 9) { W = p->w_o + (size_t)(mi - 7) * D * D; K = D; N = D; WT = (bf16_t*)(ws + OFF_WO) + (size_t)(mi - 7) * D * D; row_off = 0; }
    else if (mi < 13) { W = p->w_up + (size_t)(mi - 9) * D * FF; K = D; N = FF; WT = (bf16_t*)(ws + OFF_WUP) + (size_t)(mi - 9) * D * FF; row_off = 0; }
    else if (mi < 17) { W = p->w_down + (size_t)(mi - 13) * D * FF; K = FF; N = D; WT = (bf16_t*)(ws + OFF_WDN) + (size_t)(mi - 13) * D * FF; row_off = 0; }
    else if (mi < 21) { W = p->w_ada + (size_t)(mi - 17) * D * 6144; K = D; N = 6144; WT = (bf16_t*)(ws + OFF_X); row_off = (mi - 17) * 6144; }
    else { W = p->kv_w_ada; K = D; N = 2048; WT = (bf16_t*)(ws + OFF_X); row_off = 24576; }
    const int nitems = (K / 64) * (N / 32);
    int first = (gw - (base % NGW) + NGW) % NGW;
    for (int it = first; it < nitems; it += NGW) transpose_item(W, K, N, WT, row_off, scr, it, lane);
    base += nitems;
  }
  bf16_t* Ac = (bf16_t*)(ws + OFF_X + (size_t)MODW * D * 2);
  const int gt = blockIdx.x * NTHREADS + tid, NGT = gridDim.x * NTHREADS;
  for (int e = gt; e < 256 * D / 2; e += NGT) { const int r = e / (D / 2), c = (e % (D / 2)) * 2; float a = 0.f, b = 0.f;
    if (r < NMOD) { const float* cp = (r < 4) ? p->c_prompt + (size_t)r * D : p->c_sample + (size_t)(r - 4) * D; a = silu_f(cp[c]); b = silu_f(cp[c + 1]); }
    *(unsigned*)(Ac + (size_t)r * D + c) = pk2(a, b); }
  float* tab = (float*)(ws + OFF_TAB);
  for (int e = gt; e < 4097 * 32; e += NGT) { const int pi = e >> 5, i = e & 31; const float pos = (pi < 4096) ? (float)pi : 8192.f;
    const float ang = pos * INVF[i]; float sn, cs; sincosf(ang, &sn, &cs);
    tab[pi * 64 + i] = cs; tab[pi * 64 + 32 + i] = sn; }
}

DI void init_rows(KP p, unsigned* ctr) {
  const int tid = tid_get(); const int lane = tid & 63;
  unsigned char* ws = p->ws; const float* mods = (const float*)(ws + OFF_MODS); bf16_t* yout = (bf16_t*)(ws + OFF_H); float* rss = (float*)(ws + OFF_RSS);
  const float* g = p->norm1_g; const float* msc = mods + 1024;
#pragma unroll 1
  for (;;) {
    unsigned cidx = 0; if (lane == 0) cidx = __hip_atomic_fetch_add(ctr, 1u, __ATOMIC_RELAXED, __HIP_MEMORY_SCOPE_AGENT);
    cidx = __builtin_amdgcn_readfirstlane(cidx);
    if (cidx >= (unsigned)(T / 8)) break;
#pragma unroll 1
    for (int hh = 0; hh < 2; ++hh) { const int rb = (int)cidx * 8 + hh * 4;
      f32x4 v[4][4];
#pragma unroll
      for (int q = 0; q < 4; ++q) { const int r = rb + q; const float* xr = (r < TP) ? p->x_prompt + (size_t)r * D : p->x_sample + (size_t)(r - TP) * D;
#pragma unroll
        for (int jj = 0; jj < 4; ++jj) v[q][jj] = *(const f32x4*)(xr + lane * 4 + 256 * jj); }
#pragma unroll
      for (int q = 0; q < 4; ++q) { const int r = rb + q; float a = 0.f;
#pragma unroll
        for (int jj = 0; jj < 4; ++jj) a += v[q][jj][0] * v[q][jj][0] + v[q][jj][1] * v[q][jj][1] + v[q][jj][2] * v[q][jj][2] + v[q][jj][3] * v[q][jj][3];
#pragma unroll
        for (int o = 1; o < 64; o <<= 1) a += __shfl_xor(a, o);
        if (lane == 0) rss[r] = a;
        const size_t mo = (size_t)modrow(r) * MODW;
#pragma unroll
        for (int jj = 0; jj < 4; ++jj) { const int c = lane * 4 + 256 * jj;
          const f32x4 gg = *(const f32x4*)(g + c), sc = *(const f32x4*)(msc + mo + c);
          const f32x4 h = v[q][jj] * gg * (sc + 1.f);
          *(u32x2*)(yout + (size_t)r * D + c) = (u32x2){pk2(h[0], h[1]), pk2(h[2], h[3])}; } } }
  }
}

struct HgBufs { const bf16_t *q, *k, *v, *g; const float* lf; float* o32; bf16_t* on; };

constexpr int SPAN = 256, NSPAN = SEQ / SPAN, CH = 32, NCH = SPAN / CH;
constexpr int L_CUM = 0, L_QT = 16896, L_KT = 25600, L_KE = 34304, L_VT = 44544, L_PS = 54784, L_DEC = 55808, L_HALF = 57344;
constexpr int CUS = 132, QS = 136, KES = 40;
DI bf16x8 pack8(const f32x16& x, const int s) {
  return __builtin_bit_cast(bf16x8, (u32x4){pk2(x[8 * s], x[8 * s + 1]), pk2(x[8 * s + 2], x[8 * s + 3]), pk2(x[8 * s + 4], x[8 * s + 5]), pk2(x[8 * s + 6], x[8 * s + 7])});
}
template <int MODE>
DI void scan_prompt(KP p, const int l, const HgBufs& B, unsigned char* shm) {
  const int tid = tid_get(), lane = tid & 63, wave = tid >> 6, hb = wave >> 2, th = tid & 255, vb = wave & 3, h5 = lane >> 5, l31 = lane & 31;
  unsigned char* base = shm + hb * L_HALF;
  float* cumb = (float*)(base + L_CUM); bf16_t* Qt = (bf16_t*)(base + L_QT); bf16_t* Kt = (bf16_t*)(base + L_KT);
  bf16_t* KeT = (bf16_t*)(base + L_KE); bf16_t* Vt = (bf16_t*)(base + L_VT); float* psum = (float*)(base + L_PS); float* dec = (float*)(base + L_DEC);
  float* dS = B.o32; float* Lsum = B.o32 + (size_t)512 * 16384;
#pragma unroll 1
  for (int it0 = blockIdx.x * 2; it0 < 32 * NSPAN; it0 += gridDim.x * 2) {
    const int item = it0 + hb, bh = item / NSPAN, span = item % NSPAN, b = bh >> 3, h = bh & 7;
    f32x16 S[4];
#pragma unroll
    for (int db = 0; db < 4; ++db)
#pragma unroll
      for (int r = 0; r < 16; ++r) S[db][r] = 0.f;
    if (MODE == 1) {
      const unsigned ob = (unsigned)item * 16384u + (unsigned)(vb * 32 + l31) + (unsigned)(4 * h5) * 128u;
#pragma unroll
      for (int db = 0; db < 4; ++db) {
#pragma unroll
        for (int r = 0; r < 16; ++r) S[db][r] = dS[ob + (unsigned)((32 * db + (r & 3) + 8 * (r >> 2)) * 128)];
        __builtin_amdgcn_sched_barrier(0); }
    }
    float Ltot = 0.f;
#define LBAR() do { asm volatile("s_waitcnt lgkmcnt(0)" ::: "memory"); __builtin_amdgcn_s_barrier(); asm volatile("" ::: "memory"); } while (0)
    const int d1 = th & 127, part = th >> 7, t2 = th >> 3, dg = th & 7;
    const size_t tokS = (size_t)b * SEQ + (size_t)span * SPAN;
    float lfr[16]; unsigned kr[16], vr[16]; u32x4 q0, q1, k0, k1, g0, g1;
#define SCAN_LOAD(chx) do { const size_t o0_ = (tokS + (size_t)(chx) * CH + part * 16) * D + h * 128 + d1; \
      _Pragma("unroll") for (int i = 0; i < 16; ++i) { lfr[i] = B.lf[o0_ + (size_t)i * D]; kr[i] = B.k[o0_ + (size_t)i * D]; vr[i] = B.v[o0_ + (size_t)i * D]; } \
      } while (0)
    __builtin_amdgcn_sched_barrier(0);
    SCAN_LOAD(0);
    __builtin_amdgcn_sched_barrier(0);
#pragma unroll 1
    for (int ch = 0; ch < NCH; ++ch) {
      const size_t tok0 = tokS + (size_t)ch * CH;
      if (MODE == 1) { const size_t o_ = (tok0 + t2) * D + h * 128 + dg * 16;
        q0 = *(const u32x4*)(B.q + o_); q1 = *(const u32x4*)(B.q + o_ + 8); k0 = *(const u32x4*)(B.k + o_); k1 = *(const u32x4*)(B.k + o_ + 8);
        g0 = *(const u32x4*)(B.g + o_); g1 = *(const u32x4*)(B.g + o_ + 8); }
      { const int d = d1;
        float c[16]; float run = 0.f;
#pragma unroll
        for (int i = 0; i < 16; ++i) { run += lfr[i]; c[i] = run; }
        psum[part * 128 + d] = run;
        LBAR();
        const float t0 = psum[d], t1 = psum[128 + d]; const float off = part ? t0 : 0.f; const float Lc = t0 + t1;
        float ke[16];
#pragma unroll
        for (int i = 0; i < 16; ++i) { const float cu = off + c[i]; if (MODE == 1) cumb[(part * 16 + i) * CUS + d] = cu; ke[i] = bf2f(kr[i]) * __expf(Lc - cu); }
        *(u32x4*)(KeT + d * KES + part * 16) = (u32x4){pk2(ke[0], ke[1]), pk2(ke[2], ke[3]), pk2(ke[4], ke[5]), pk2(ke[6], ke[7])};
        *(u32x4*)(KeT + d * KES + part * 16 + 8) = (u32x4){pk2(ke[8], ke[9]), pk2(ke[10], ke[11]), pk2(ke[12], ke[13]), pk2(ke[14], ke[15])};
        *(u32x4*)(Vt + d * KES + part * 16) = (u32x4){vr[0] | (vr[1] << 16), vr[2] | (vr[3] << 16), vr[4] | (vr[5] << 16), vr[6] | (vr[7] << 16)};
        *(u32x4*)(Vt + d * KES + part * 16 + 8) = (u32x4){vr[8] | (vr[9] << 16), vr[10] | (vr[11] << 16), vr[12] | (vr[13] << 16), vr[14] | (vr[15] << 16)};
        if (part == 0) { dec[d] = __expf(Lc); Ltot += Lc; }
      }
      LBAR();
      if (MODE == 1) {
        const int t = t2;
        unsigned qo[8], ko[8];
#pragma unroll
        for (int g4 = 0; g4 < 4; ++g4) { const f32x4 cv = *(const f32x4*)(cumb + t * CUS + dg * 16 + 4 * g4);
#pragma unroll
          for (int e2 = 0; e2 < 2; ++e2) { const int w = g4 * 2 + e2; const unsigned qw = (w < 4) ? q0[w & 3] : q1[w & 3], kw = (w < 4) ? k0[w & 3] : k1[w & 3];
            const float ca = cv[2 * e2], cb = cv[2 * e2 + 1];
            qo[w] = pk2(bf2f(qw & 0xffffu) * __expf(ca), bf2f(qw >> 16) * __expf(cb));
            ko[w] = pk2(bf2f(kw & 0xffffu) * __expf(fminf(-ca, 80.f)), bf2f(kw >> 16) * __expf(fminf(-cb, 80.f))); } }
        *(u32x4*)(Qt + t * QS + dg * 16) = (u32x4){qo[0], qo[1], qo[2], qo[3]}; *(u32x4*)(Qt + t * QS + dg * 16 + 8) = (u32x4){qo[4], qo[5], qo[6], qo[7]};
        *(u32x4*)(Kt + t * QS + dg * 16) = (u32x4){ko[0], ko[1], ko[2], ko[3]}; *(u32x4*)(Kt + t * QS + dg * 16 + 8) = (u32x4){ko[4], ko[5], ko[6], ko[7]};
        LBAR();
      }
      { const int chn = (ch + 1 < NCH) ? ch + 1 : ch; SCAN_LOAD(chn); }
      f32x16 O;
      if (MODE == 1) {
        f32x16 X;
#pragma unroll
        for (int r = 0; r < 16; ++r) { X[r] = 0.f; O[r] = 0.f; }
#pragma unroll
        for (int ks = 0; ks < 8; ++ks) { const bf16x8 a = *(const bf16x8*)(Kt + l31 * QS + 16 * ks + 8 * h5), bq = *(const bf16x8*)(Qt + l31 * QS + 16 * ks + 8 * h5);
          X = __builtin_amdgcn_mfma_f32_32x32x16_bf16(a, bq, X, 0, 0, 0); }
#pragma unroll
        for (int r = 0; r < 16; ++r) if (crow(r, h5) > l31) X[r] = 0.f;
#pragma unroll
        for (int st = 0; st < 2; ++st) { const bf16_t* vp = Vt + (vb * 32 + l31) * KES + 16 * st + 4 * h5; const u32x2 lo = *(const u32x2*)vp, hi = *(const u32x2*)(vp + 8);
          O = __builtin_amdgcn_mfma_f32_32x32x16_bf16(pack8(X, st), __builtin_bit_cast(bf16x8, (u32x4){lo[0], lo[1], hi[0], hi[1]}), O, 0, 0, 0); }
#pragma unroll
        for (int db = 0; db < 4; ++db)
#pragma unroll
          for (int st = 0; st < 2; ++st) { const bf16_t* qp = Qt + l31 * QS + 32 * db + 16 * st + 4 * h5; const u32x2 lo = *(const u32x2*)qp, hi = *(const u32x2*)(qp + 8);
            O = __builtin_amdgcn_mfma_f32_32x32x16_bf16(__builtin_bit_cast(bf16x8, (u32x4){lo[0], lo[1], hi[0], hi[1]}), pack8(S[db], st), O, 0, 0, 0); }
      }
#pragma unroll
      for (int db = 0; db < 4; ++db) {
#pragma unroll
        for (int r4 = 0; r4 < 4; ++r4) { const f32x4 dv = *(const f32x4*)(dec + 32 * db + 8 * r4 + 4 * h5);
#pragma unroll
          for (int e = 0; e < 4; ++e) S[db][4 * r4 + e] *= dv[e]; }
#pragma unroll
        for (int st = 0; st < 2; ++st) { const bf16x8 a = *(const bf16x8*)(KeT + (32 * db + l31) * KES + 16 * st + 8 * h5), bv = *(const bf16x8*)(Vt + (vb * 32 + l31) * KES + 16 * st + 8 * h5);
          S[db] = __builtin_amdgcn_mfma_f32_32x32x16_bf16(a, bv, S[db], 0, 0, 0); } }
      if (MODE == 1) {
#pragma unroll
        for (int r = 0; r < 16; ++r) cumb[crow(r, h5) * CUS + vb * 32 + l31] = O[r];
        LBAR();
        const int t = t2, vg = dg; const size_t o = (tok0 + t) * D + h * 128 + vg * 16;
        f32x4 ov[4]; float ss = 0.f;
#pragma unroll
        for (int g4 = 0; g4 < 4; ++g4) { ov[g4] = *(const f32x4*)(cumb + t * CUS + vg * 16 + 4 * g4); ss += ov[g4][0] * ov[g4][0] + ov[g4][1] * ov[g4][1] + ov[g4][2] * ov[g4][2] + ov[g4][3] * ov[g4][3]; }
        ss += __shfl_xor(ss, 1); ss += __shfl_xor(ss, 2); ss += __shfl_xor(ss, 4);
        const float rstd = rsqrtf(ss * (1.f / 128.f) + EPS);
        unsigned w[8];
#pragma unroll
        for (int g4 = 0; g4 < 4; ++g4) { const f32x4 gn = *(const f32x4*)(p->hg_gn_g + l * 128 + vg * 16 + 4 * g4);
#pragma unroll
          for (int e2 = 0; e2 < 2; ++e2) { const int wi = g4 * 2 + e2; const unsigned gw = (wi < 4) ? g0[wi & 3] : g1[wi & 3];
            w[wi] = pk2(ov[g4][2 * e2] * rstd * gn[2 * e2] * bf2f(gw & 0xffffu), ov[g4][2 * e2 + 1] * rstd * gn[2 * e2 + 1] * bf2f(gw >> 16)); } }
        *(u32x4*)(B.on + o) = (u32x4){w[0], w[1], w[2], w[3]}; *(u32x4*)(B.on + o + 8) = (u32x4){w[4], w[5], w[6], w[7]};
      } else {
        LBAR();
      }
    }
    if (MODE == 0) {
      float* dSo = dS + (size_t)item * 16384 + vb * 32 + l31;
#pragma unroll
      for (int db = 0; db < 4; ++db)
#pragma unroll
        for (int r = 0; r < 16; ++r) dSo[(size_t)(32 * db + crow(r, h5)) * 128] = S[db][r];
      if (th < 128) Lsum[(size_t)item * 128 + th] = Ltot;
    } else if (span == NSPAN - 1) {
      float* so = p->out + O_HGP + ((size_t)((l * 4 + b) * 8 + h)) * 16384 + vb * 32 + l31;
#pragma unroll
      for (int db = 0; db < 4; ++db)
#pragma unroll
        for (int r = 0; r < 16; ++r) so[(size_t)(32 * db + crow(r, h5)) * 128] = S[db][r];
    }
    __syncthreads();
  }
}

DI void scan_passB(const HgBufs& B) {
  const int tid = tid_get();
  float* dS = B.o32; const float* Lsum = B.o32 + (size_t)512 * 16384;
  const int gt = blockIdx.x * NTHREADS + tid, NGT = gridDim.x * NTHREADS;
#pragma unroll 1
  for (int e = gt; e < 32 * 4096; e += NGT) { const int bh = e >> 12, q4 = e & 4095, d = q4 >> 5;
    float* base = dS + (size_t)bh * NSPAN * 16384 + (size_t)q4 * 4; const float* Lb = Lsum + (size_t)bh * NSPAN * 128 + d;
    f32x4 v[NSPAN]; float lv[NSPAN];
#pragma unroll
    for (int sp = 0; sp < NSPAN; ++sp) { v[sp] = *(const f32x4*)(base + (size_t)sp * 16384); lv[sp] = Lb[sp * 128]; }
    f32x4 run = (f32x4){0.f, 0.f, 0.f, 0.f};
#pragma unroll
    for (int sp = 0; sp < NSPAN; ++sp) { *(f32x4*)(base + (size_t)sp * 16384) = run; run = run * __expf(lv[sp]) + v[sp]; }
  }
}

DI void scan_phase(KP p, const int l, const HgBufs& B, unsigned char* shm) {
  scan_prompt<0>(p, l, B, shm);
  const int tid = tid_get(), lane = tid & 63, wave = tid >> 6;
  {
    float* ps = (float*)shm;
    const int v4 = (tid & 31) * 4, dq = tid >> 5;
    f32x4 sv[8], svn[8]; float lfv[8], lfn[8]; unsigned kq[8], kqn[8]; u32x2 vw, vwn;
#define SMP_LOAD(IT, SV, LF, KQ, VW) do { const int bs_ = (IT) >> 3, h_ = (IT) & 7; const size_t r_ = TP + bs_; \
      const float* s0_ = p->state_hgrn + ((size_t)((l * 128 + bs_) * 8 + h_)) * 16384; \
      VW = *(const u32x2*)(B.v + r_ * D + h_ * 128 + v4); \
      _Pragma("unroll") for (int i = 0; i < 8; ++i) { const int d_ = dq * 8 + i; const size_t o_ = r_ * D + h_ * 128 + d_; \
        LF[i] = B.lf[o_]; KQ[i] = (unsigned)B.k[o_] | ((unsigned)B.q[o_] << 16); SV[i] = __builtin_nontemporal_load((const f32x4*)(s0_ + d_ * 128 + v4)); } } while (0)
    int item = blockIdx.x, par = 0;
    if (item < 1024) SMP_LOAD(item, sv, lfv, kq, vw);
#pragma unroll 1
    for (; item < 1024; item += gridDim.x, par ^= 1) {
      const int bs = item >> 3, h = item & 7; const size_t r = TP + bs;
      const int nitem = item + gridDim.x;
      if (nitem < 1024) SMP_LOAD(nitem, svn, lfn, kqn, vwn);
      float* s1 = p->out + O_HGS + ((size_t)((l * 128 + bs) * 8 + h)) * 16384;
      const f32x4 vv = (f32x4){bf2f(vw[0] & 0xffffu), bf2f(vw[0] >> 16), bf2f(vw[1] & 0xffffu), bf2f(vw[1] >> 16)};
      f32x4 op = (f32x4){0.f, 0.f, 0.f, 0.f};
#pragma unroll
      for (int i = 0; i < 8; ++i) { const int d = dq * 8 + i;
        const float f = __expf(lfv[i]), kk = bf2f(kq[i] & 0xffffu), qq = bf2f(kq[i] >> 16);
        const f32x4 sn = sv[i] * f + vv * kk;
        __builtin_nontemporal_store(sn, (f32x4*)(s1 + d * 128 + v4)); op += sn * qq; }
#pragma unroll
      for (int jx = 0; jx < 4; ++jx) op[jx] += __shfl_xor(op[jx], 32);
      float* psb = ps + par * 1024;
      if (lane < 32) *(f32x4*)(psb + wave * 128 + v4) = op;
      __syncthreads();
      if (tid < 64) { float o0 = 0.f, o1 = 0.f;
#pragma unroll
        for (int w = 0; w < 8; ++w) { const f32x2 x = *(const f32x2*)(psb + w * 128 + tid * 2); o0 += x[0]; o1 += x[1]; }
        float ss = o0 * o0 + o1 * o1;
#pragma unroll
        for (int o = 1; o < 64; o <<= 1) ss += __shfl_xor(ss, o);
        const float rstd = rsqrtf(ss * (1.f / 128.f) + EPS);
        const int vv2 = tid * 2; const size_t o = r * D + h * 128 + vv2;
        const float g0 = p->hg_gn_g[l * 128 + vv2], g1 = p->hg_gn_g[l * 128 + vv2 + 1];
        *(unsigned*)(B.on + o) = pk2(o0 * rstd * g0 * bf2f(B.g[o]), o1 * rstd * g1 * bf2f(B.g[o + 1])); }
#pragma unroll
      for (int i = 0; i < 8; ++i) { sv[i] = svn[i]; lfv[i] = lfn[i]; kq[i] = kqn[i]; }
      vw = vwn;
    }
    __syncthreads();
  }
}

constexpr int KN_STRIDE = 72, VT_STRIDE = 264;
constexpr int KN_BYTES = 256 * KN_STRIDE * 2;
struct AtBufs { const bf16_t* qraw; const float* kvraw; bf16_t* on; const float* tab; };

DI void attn_phase(KP p, const int l, const AtBufs& B, unsigned char* shm) {
  const int tid = tid_get(), lane = tid & 63, wave = tid >> 6;
  const int j = l - 2;
  const float* qg = p->q_norm_g + j * 64; const float* sinkp = p->sinks + j * 16;
  const bool write_cache = (l == 2);
  const int nitems = 512 + 512;
#pragma unroll 1
  for (int item = blockIdx.x; item < 512; item += gridDim.x) {
    {
      const int b = item >> 7, qb = (item >> 2) & 31, kvh = item & 3;
      bf16_t* Kn = (bf16_t*)shm; bf16_t* Vt = (bf16_t*)(shm + KN_BYTES);
      const int band0 = (qb - 1) * 128;
      {
        const int key = tid >> 1, part = tid & 1; const int pos = band0 + key; const bool valid = pos >= 0;
        float x1[16], x2[16];
        if (valid) { const float* kp = B.kvraw + ((size_t)b * SEQ + pos) * 512 + kvh * 64 + part * 16;
#pragma unroll
          for (int i = 0; i < 4; ++i) { const f32x4 a = *(const f32x4*)(kp + 4 * i), c = *(const f32x4*)(kp + 32 + 4 * i);
#pragma unroll
            for (int e = 0; e < 4; ++e) { x1[4 * i + e] = a[e]; x2[4 * i + e] = c[e]; } }
        } else {
#pragma unroll
          for (int i = 0; i < 16; ++i) { x1[i] = 0.f; x2[i] = 0.f; } }
        float ss = 0.f;
#pragma unroll
        for (int i = 0; i < 16; ++i) ss += x1[i] * x1[i] + x2[i] * x2[i];
        ss += __shfl_xor(ss, 1);
        const float rstd = rsqrtf(ss * (1.f / 64.f) + EPS);
        const float* tb = B.tab + (size_t)(valid ? pos : 0) * 64 + part * 16;
        float o1[16], o2[16];
#pragma unroll
        for (int i = 0; i < 16; ++i) { const float a = x1[i] * rstd * p->k_norm_g[part * 16 + i], c = x2[i] * rstd * p->k_norm_g[32 + part * 16 + i];
          const float cs = tb[i], sn = tb[32 + i]; o1[i] = a * cs - c * sn; o2[i] = c * cs + a * sn; }
        u32x4 w;
        w = (u32x4){pk2(o1[0], o1[1]), pk2(o1[2], o1[3]), pk2(o1[4], o1[5]), pk2(o1[6], o1[7])}; *(u32x4*)(Kn + key * KN_STRIDE + part * 16) = w;
        w = (u32x4){pk2(o1[8], o1[9]), pk2(o1[10], o1[11]), pk2(o1[12], o1[13]), pk2(o1[14], o1[15])}; *(u32x4*)(Kn + key * KN_STRIDE + part * 16 + 8) = w;
        w = (u32x4){pk2(o2[0], o2[1]), pk2(o2[2], o2[3]), pk2(o2[4], o2[5]), pk2(o2[6], o2[7])}; *(u32x4*)(Kn + key * KN_STRIDE + 32 + part * 16) = w;
        w = (u32x4){pk2(o2[8], o2[9]), pk2(o2[10], o2[11]), pk2(o2[12], o2[13]), pk2(o2[14], o2[15])}; *(u32x4*)(Kn + key * KN_STRIDE + 32 + part * 16 + 8) = w;
        if (write_cache && qb == 31 && key >= 128) { float* ko = p->out + O_KP + ((size_t)(b * 128 + key - 128) * 4 + kvh) * 64 + part * 16;
#pragma unroll
          for (int i = 0; i < 4; ++i) { *(f32x4*)(ko + 4 * i) = (f32x4){o1[4 * i], o1[4 * i + 1], o1[4 * i + 2], o1[4 * i + 3]};
            *(f32x4*)(ko + 32 + 4 * i) = (f32x4){o2[4 * i], o2[4 * i + 1], o2[4 * i + 2], o2[4 * i + 3]}; } }
      }
      {
        const int key = tid & 255, dh = tid >> 8; const int pos = band0 + key; const bool valid = pos >= 0;
        const float* vp = B.kvraw + ((size_t)b * SEQ + (valid ? pos : 0)) * 512 + 256 + kvh * 64 + dh * 32;
#pragma unroll
        for (int i = 0; i < 8; ++i) { f32x4 a = *(const f32x4*)(vp + 4 * i); if (!valid) a = (f32x4){0.f, 0.f, 0.f, 0.f};
#pragma unroll
          for (int e = 0; e < 4; ++e) Vt[(dh * 32 + 4 * i + e) * VT_STRIDE + key] = (bf16_t)f2bf(a[e]);
          if (write_cache && qb == 31 && key >= 128) *(f32x4*)(p->out + O_VP + ((size_t)(b * 128 + key - 128) * 4 + kvh) * 64 + dh * 32 + 4 * i) = a; }
      }
      __syncthreads();
      const int g = wave & 3, qhalf = wave >> 2, hq = kvh * 4 + g, h = lane >> 5, l31 = lane & 31;
      const float sink = sinkp[hq];
#pragma unroll 1
      for (int sub = 0; sub < 2; ++sub) {
        const int Q0 = 128 + qhalf * 64 + sub * 32, qi = Q0 + l31, pos = band0 + qi;
        const size_t tok = (size_t)b * SEQ + pos;
        float x[4][8];
        { const bf16_t* qp = B.qraw + tok * D + hq * 64 + 8 * h;
#pragma unroll
          for (int s = 0; s < 4; ++s) { const u32x4 w = *(const u32x4*)(qp + 16 * s);
#pragma unroll
            for (int e = 0; e < 4; ++e) { x[s][2 * e] = bf2f(w[e] & 0xffffu); x[s][2 * e + 1] = bf2f(w[e] >> 16); } } }
        float ss = 0.f;
#pragma unroll
        for (int s = 0; s < 4; ++s)
#pragma unroll
          for (int e = 0; e < 8; ++e) ss += x[s][e] * x[s][e];
        ss += __shfl_xor(ss, 32);
        const float rstd = rsqrtf(ss * (1.f / 64.f) + EPS) ;
#pragma unroll
        for (int s = 0; s < 4; ++s)
#pragma unroll
          for (int e = 0; e < 8; ++e) x[s][e] *= rstd * qg[16 * s + 8 * h + e];
        const float* tb = B.tab + (size_t)pos * 64;
        bf16x8 qf[4];
#pragma unroll
        for (int s = 0; s < 2; ++s) { unsigned lo[4], hi[4]; float r1[8], r2[8];
#pragma unroll
          for (int e = 0; e < 8; ++e) { const int i = 16 * s + 8 * h + e; const float cs = tb[i], sn = tb[32 + i]; const float a = x[s][e], c = x[s + 2][e];
            r1[e] = (a * cs - c * sn) * 0.125f; r2[e] = (c * cs + a * sn) * 0.125f; }
#pragma unroll
          for (int e = 0; e < 4; ++e) { lo[e] = pk2(r1[2 * e], r1[2 * e + 1]); hi[e] = pk2(r2[2 * e], r2[2 * e + 1]); }
          qf[s] = __builtin_bit_cast(bf16x8, (u32x4){lo[0], lo[1], lo[2], lo[3]}); qf[s + 2] = __builtin_bit_cast(bf16x8, (u32x4){hi[0], hi[1], hi[2], hi[3]}); }
        const int kb0 = (Q0 - 128) >> 5;
        f32x16 sacc[5]; float mx = sink;
#pragma unroll
        for (int i = 0; i < 5; ++i) { const int kb = kb0 + i; f32x16 a16;
#pragma unroll
          for (int r = 0; r < 16; ++r) a16[r] = 0.f;
          bf16x8 ka[4];
#pragma unroll
          for (int s = 0; s < 4; ++s) ka[s] = *(const bf16x8*)(Kn + (kb * 32 + l31) * KN_STRIDE + 16 * s + 8 * h);
#pragma unroll
          for (int s = 0; s < 4; ++s) a16 = __builtin_amdgcn_mfma_f32_32x32x16_bf16(ka[s], qf[s], a16, 0, 0, 0);
#pragma unroll
          for (int r = 0; r < 16; ++r) { const int key = kb * 32 + crow(r, h); const int rel = qi - key; const bool ok = (rel >= 0) && (rel < 128) && (qb > 0 || key >= 128);
            const float sv = ok ? a16[r] : -1e30f; a16[r] = sv; mx = fmaxf(mx, sv); }
          sacc[i] = a16; }
        mx = fmaxf(mx, __shfl_xor(mx, 32));
        float sum = 0.f; bf16x8 pf[5][2];
#pragma unroll
        for (int i = 0; i < 5; ++i) { float e[16];
#pragma unroll
          for (int r = 0; r < 16; ++r) { e[r] = __expf(sacc[i][r] - mx); sum += e[r]; }
#pragma unroll
          for (int st = 0; st < 2; ++st) pf[i][st] = __builtin_bit_cast(bf16x8, (u32x4){pk2(e[8 * st], e[8 * st + 1]), pk2(e[8 * st + 2], e[8 * st + 3]), pk2(e[8 * st + 4], e[8 * st + 5]), pk2(e[8 * st + 6], e[8 * st + 7])}); }
        sum += __shfl_xor(sum, 32);
        const float inv = 1.f / (sum + __expf(sink - mx));
#pragma unroll
        for (int db = 0; db < 2; ++db) { f32x16 o16;
#pragma unroll
          for (int r = 0; r < 16; ++r) o16[r] = 0.f;
          bf16x8 va[10];
#pragma unroll
          for (int i = 0; i < 5; ++i)
#pragma unroll
            for (int st = 0; st < 2; ++st) { const bf16_t* vp = Vt + (db * 32 + l31) * VT_STRIDE + (kb0 + i) * 32 + 16 * st + 4 * h;
              const u32x2 lo = *(const u32x2*)vp, hi = *(const u32x2*)(vp + 8);
              va[i * 2 + st] = __builtin_bit_cast(bf16x8, (u32x4){lo[0], lo[1], hi[0], hi[1]}); }
          f32x16 o16b;
#pragma unroll
          for (int r = 0; r < 16; ++r) o16b[r] = 0.f;
#pragma unroll
          for (int i = 0; i < 5; ++i) { o16 = __builtin_amdgcn_mfma_f32_32x32x16_bf16(va[i * 2], pf[i][0], o16, 0, 0, 0); o16b = __builtin_amdgcn_mfma_f32_32x32x16_bf16(va[i * 2 + 1], pf[i][1], o16b, 0, 0, 0); }
#pragma unroll
          for (int r = 0; r < 16; ++r) o16[r] += o16b[r];
          bf16_t* op = B.on + tok * D + hq * 64 + db * 32 + 4 * h;
#pragma unroll
          for (int r4 = 0; r4 < 4; ++r4) *(u32x2*)(op + 8 * r4) = (u32x2){pk2(o16[4 * r4] * inv, o16[4 * r4 + 1] * inv), pk2(o16[4 * r4 + 2] * inv, o16[4 * r4 + 3] * inv)}; }
      }
      __syncthreads();
    }
  }
  {
    const int tid = tid_get(), lane = tid & 63, wave = tid >> 6;
#pragma unroll 1
    for (int item = 512 + blockIdx.x; item < nitems; item += gridDim.x) {
      const int sidx = item - 512, bs = sidx >> 2, kvh = sidx & 3; const size_t r = TP + bs;
      float* Ks = (float*)shm; float* Vs = Ks + 128 * 68; float* q_s = Vs + 128 * 64; float* p_s = q_s + 256; float* redm = p_s + 512; float* reds = redm + 8; float* po = reds + 8;
      const float* tb = B.tab + (size_t)4096 * 64;
      f32x4 kreg[4], vreg[4];
#pragma unroll
      for (int i = 0; i < 4; ++i) { const int e = tid + 512 * i, jr = e >> 4, c4 = (e & 15) * 4;
        if (jr < 127) { const size_t o = (((size_t)bs * 128 + jr + 1) * 4 + kvh) * 64 + c4; kreg[i] = __builtin_nontemporal_load((const f32x4*)(p->cache_k + o)); vreg[i] = __builtin_nontemporal_load((const f32x4*)(p->cache_v + o)); } }
      if (tid < 128) { const int g = tid >> 5, i = tid & 31, hq = kvh * 4 + g;
        float a = bf2f(B.qraw[r * D + hq * 64 + i]), c = bf2f(B.qraw[r * D + hq * 64 + 32 + i]);
        float ss = a * a + c * c;
#pragma unroll
        for (int o = 1; o < 32; o <<= 1) ss += __shfl_xor(ss, o);
        const float rstd = rsqrtf(ss * (1.f / 64.f) + EPS); a *= rstd * qg[i]; c *= rstd * qg[32 + i];
        const float cs = tb[i], sn = tb[32 + i];
        q_s[g * 64 + i] = (a * cs - c * sn) * 0.125f; q_s[g * 64 + 32 + i] = (c * cs + a * sn) * 0.125f;
      } else if (tid < 160) { const int i = tid & 31;
        float a = B.kvraw[r * 512 + kvh * 64 + i], c = B.kvraw[r * 512 + kvh * 64 + 32 + i];
        float ss = a * a + c * c;
#pragma unroll
        for (int o = 1; o < 32; o <<= 1) ss += __shfl_xor(ss, o);
        const float rstd = rsqrtf(ss * (1.f / 64.f) + EPS); a *= rstd * p->k_norm_g[i]; c *= rstd * p->k_norm_g[32 + i];
        const float cs = tb[i], sn = tb[32 + i];
        const float k1 = a * cs - c * sn, k2 = c * cs + a * sn, v1 = B.kvraw[r * 512 + 256 + kvh * 64 + i], v2 = B.kvraw[r * 512 + 256 + kvh * 64 + 32 + i];
        Ks[127 * 68 + i] = k1; Ks[127 * 68 + 32 + i] = k2; Vs[127 * 64 + i] = v1; Vs[127 * 64 + 32 + i] = v2;
        if (write_cache) { float* ok = p->out + O_KS + (((size_t)bs * 128 + 127) * 4 + kvh) * 64; float* ov = p->out + O_VS + (((size_t)bs * 128 + 127) * 4 + kvh) * 64;
          ok[i] = k1; ok[32 + i] = k2; ov[i] = v1; ov[32 + i] = v2; } }
#pragma unroll
      for (int i = 0; i < 4; ++i) { const int e = tid + 512 * i, jr = e >> 4, c4 = (e & 15) * 4;
        if (jr < 127) { *(f32x4*)(Ks + jr * 68 + c4) = kreg[i]; *(f32x4*)(Vs + jr * 64 + c4) = vreg[i];
          if (write_cache) { const size_t o = (((size_t)bs * 128 + jr) * 4 + kvh) * 64 + c4; __builtin_nontemporal_store(kreg[i], (f32x4*)(p->out + O_KS + o)); __builtin_nontemporal_store(vreg[i], (f32x4*)(p->out + O_VS + o)); } } }
      __syncthreads();
      const int g = tid >> 7, jk = tid & 127, hq = kvh * 4 + g; const float sink = sinkp[hq];
      float sc = 0.f;
#pragma unroll
      for (int d4 = 0; d4 < 16; ++d4) { const f32x4 kv = *(const f32x4*)(Ks + jk * 68 + 4 * d4), qv = *(const f32x4*)(q_s + g * 64 + 4 * d4); sc += kv[0] * qv[0] + kv[1] * qv[1] + kv[2] * qv[2] + kv[3] * qv[3]; }
      float mx = sc;
#pragma unroll
      for (int o = 1; o < 64; o <<= 1) mx = fmaxf(mx, __shfl_xor(mx, o));
      if (lane == 0) redm[wave] = mx;
      __syncthreads();
      mx = fmaxf(fmaxf(redm[2 * g], redm[2 * g + 1]), sink);
      const float ev = __expf(sc - mx); float sum = ev;
#pragma unroll
      for (int o = 1; o < 64; o <<= 1) sum += __shfl_xor(sum, o);
      if (lane == 0) reds[wave] = sum;
      p_s[g * 128 + jk] = ev;
      __syncthreads();
      const float inv = 1.f / (reds[2 * g] + reds[2 * g + 1] + __expf(sink - mx));
      { const int d = jk & 63, jh = jk >> 6; float o = 0.f;
#pragma unroll 8
        for (int jx = 0; jx < 64; ++jx) o += p_s[g * 128 + jh * 64 + jx] * Vs[(jh * 64 + jx) * 64 + d];
        po[tid] = o;
        __syncthreads();
        if (jh == 0) { const float tot = (o + po[tid + 64]) * inv; B.on[r * D + hq * 64 + d] = (bf16_t)f2bf(tot); } }
      __syncthreads();
    }
  }
}

#define XB_TMO      128
#define XB_XCNT(j)  (256  + 64 * (j))
#define XB_XSUB(j)  (1280 + 64 * (j))
#define XB_XGEN(j)  (2304 + 64 * (j))
#define XB_TOP      3328
#define XB_TOPGEN   3392
#define XCD_BAR_WORDS 3456
#define XB_SPIN_CAP (1u << 18)

__device__ __forceinline__ unsigned xb_ld(unsigned* p)              { return __hip_atomic_load(p, __ATOMIC_RELAXED, __HIP_MEMORY_SCOPE_AGENT); }
__device__ __forceinline__ unsigned xb_add(unsigned* p, unsigned v) { return __hip_atomic_fetch_add(p, v, __ATOMIC_RELAXED, __HIP_MEMORY_SCOPE_AGENT); }
__device__ __forceinline__ unsigned xb_xcc_id() { return (unsigned)__builtin_amdgcn_s_getreg((3 << 11) | 20) & 0xFu; }
#define XB_SPIN(cond, bar) do { unsigned _sp = 0; while (cond) { __builtin_amdgcn_s_sleep(1); \
    if ((++_sp & 255u) == 0u) { if (xb_ld(&(bar)[XB_TMO])) break; if (_sp > XB_SPIN_CAP) { atomicAdd(&(bar)[XB_TMO], 1u); break; } } } } while (0)

struct XcdBarrier {
    unsigned* bar; unsigned x;
    volatile LAS unsigned* st;
};

__device__ __forceinline__ XcdBarrier xcd_barrier_post(unsigned* bar, volatile LAS unsigned* st) {
    XcdBarrier b; b.bar = bar; b.x = xb_xcc_id(); b.st = st;
    if (threadIdx.x == 0) (void)xb_add(&bar[XB_XCNT(b.x)], 1u);
    return b;
}
__device__ __forceinline__ void xcd_barrier_complete(unsigned* bar, unsigned x, unsigned& nloc, unsigned& nx) {
    const unsigned G = gridDim.x * gridDim.y * gridDim.z;
    unsigned sum, cnt, mine, sp = 0u;
    for (;;) {
        sum = 0u; cnt = 0u; mine = 0u;
#pragma unroll
        for (unsigned j = 0; j < 16; ++j) { const unsigned c = xb_ld(&bar[XB_XCNT(j)]); sum += c; cnt += (c > 0u) ? 1u : 0u; mine = (j == x) ? c : mine; }
        if (sum == G) break;
        __builtin_amdgcn_s_sleep(1);
        if ((++sp & 255u) == 0u) { if (xb_ld(&bar[XB_TMO])) break; if (sp > XB_SPIN_CAP) { atomicAdd(&bar[XB_TMO], 1u); break; } }
    }
    nloc = mine > 0u ? mine : 1u; nx = cnt > 0u ? cnt : 1u;
}

__device__ __forceinline__ void xcd_barrier(const XcdBarrier& b) {
    asm volatile("s_waitcnt vmcnt(0)" ::: "memory");
    __syncthreads();
    if (threadIdx.x == 0) {
        unsigned* bar = b.bar;
        __builtin_amdgcn_s_waitcnt(0);
        unsigned nloc = b.st[0], nx = b.st[1];
        if (nloc == 0u) { xcd_barrier_complete(bar, b.x, nloc, nx); b.st[0] = nloc; b.st[1] = nx; }
        const unsigned old = xb_add(&bar[XB_XSUB(b.x)], 1u);
        const unsigned gen = old / nloc;
        if (old + 1u == (gen + 1u) * nloc) {
            __builtin_amdgcn_fence(__ATOMIC_RELEASE, "agent");
            asm volatile("s_waitcnt vmcnt(0)" ::: "memory");
            const unsigned og = xb_add(&bar[XB_TOP], 1u);
            const unsigned tg = og / nx;
            if (og + 1u == (tg + 1u) * nx) xb_add(&bar[XB_TOPGEN], 1u);
            else XB_SPIN(xb_ld(&bar[XB_TOPGEN]) == tg, bar);
            __builtin_amdgcn_fence(__ATOMIC_ACQUIRE, "agent");
            xb_add(&bar[XB_XGEN(b.x)], 1u);
            asm volatile("s_waitcnt vmcnt(0)" ::: "memory");
        } else {
            XB_SPIN(xb_ld(&bar[XB_XGEN(b.x)]) == gen, bar);
            __builtin_amdgcn_fence(__ATOMIC_ACQUIRE, "agent");
            asm volatile("s_waitcnt vmcnt(0)" ::: "memory");
        }
    }
    __syncthreads();
}


__global__ void __launch_bounds__(NTHREADS, 2) yoco_fwd(P parg) {
  extern __shared__ __attribute__((aligned(16))) unsigned char shm[];
  cg::grid_group grid = cg::this_grid();
  volatile LAS unsigned* xst = (volatile LAS unsigned*)((LAS unsigned char*)shm + 131072);
  if (threadIdx.x < 4) xst[threadIdx.x] = 0u;
  __syncthreads();
  { KP p0 = kp_get(); (void)xcd_barrier_post((unsigned*)(p0->ws + OFF_BAR), xst); }
  const int nMt = TP / BM;
#pragma unroll 1
  for (int step = -2; step < 32; ++step) {
    const int l = (step < 0) ? 0 : (step >> 3), sub = (step < 0) ? (8 + step + 2) : (step & 7); const bool hg = (l < 2);
    if (sub == 3 && !hg) continue;
    if (sub == 5 || (sub == 0 && l > 0)) continue;
    KP p = kp_get(); unsigned char* ws = p->ws;
#ifndef PROBE_REPS
#define PROBE_REPS 1
#endif
#ifndef PROBE_GREPS
#define PROBE_GREPS 1
#endif
    const bool is_gemm = (sub == 0 || sub == 1 || sub == 4 || sub == 6 || sub == 7 || sub == 9);
#ifndef PROBE_MASK
#define PROBE_MASK 0
#endif
    const int pcode = (sub == 2 && !hg) ? 10 : sub;
    const int reps = (((PROBE_MASK >> pcode) & 1) && !(sub == 4 || sub == 7)) ? 2 : 1;
#pragma unroll 1
    for (int rep = 0; rep < reps; ++rep) {
    if (sub == 8) {
      prep_phase(p, shm);
    } else if (sub == 0 || sub == 1 || sub == 4 || sub == 6 || sub == 7 || sub == 9) {
      float* mods = (float*)(ws + OFF_MODS);
      bf16_t* hbuf = (bf16_t*)(ws + OFF_H); bf16_t* onbuf = (bf16_t*)(ws + OFF_ON); bf16_t* ubuf = (bf16_t*)(ws + OFF_U);
      GemmJob j0, j1; EpiArgs E{}; int nj = 1; E.layer = l; E.first = 0;
      float* rssb = (float*)(ws + OFF_RSS); const float* biasb = (const float*)(ws + OFF_BIAS);
      j1.A = (const bf16_t*)(ws + OFF_X); j1.Bt = (const bf16_t*)(ws + OFF_WKV); j1.nM = nMt; j1.nN = 2; j1.K = D; j1.epi = EPI_KVRAW;
      j0.nM = nMt; j0.K = D;
      if (sub == 0) { j0.A = (const bf16_t*)(ws + OFF_ASH); j0.Bt = (const bf16_t*)ws; j0.nM = 1; j0.nN = 106; j0.epi = EPI_BIAS; j1.A = (const bf16_t*)(ws + OFF_BIAS); }
      else if (sub == 9) { j0.A = (const bf16_t*)(ws + OFF_X + (size_t)MODW * D * 2); j0.Bt = (const bf16_t*)(ws + OFF_X); j0.nM = 1; j0.nN = MODW / BM; j0.epi = EPI_ADA; E.f0 = mods; E.ash = (bf16_t*)(ws + OFF_ASH); }
      else if (sub == 1 && hg) { E.rss = rssb + (size_t)(2 * l) * T; E.bias = biasb + (size_t)132 * site_prefN(l); E.bN = 4096; j0.A = hbuf; j0.Bt = (const bf16_t*)(ws + OFF_WIN) + (size_t)l * 4096 * D; j0.nN = 16; j0.epi = EPI_HGIN;
        E.f0 = (float*)(ws + OFF_X); E.b0 = (bf16_t*)(ws + OFF_U); E.b1 = (bf16_t*)(ws + OFF_U + SZ_ACT); E.b2 = (bf16_t*)(ws + OFF_U + 2 * SZ_ACT); E.b3 = (bf16_t*)(ws + OFF_U + 3 * SZ_ACT); }
      else if (sub == 1) { E.rss = rssb + (size_t)(2 * l) * T; E.bias = biasb + (size_t)132 * site_prefN(l); E.bN = 1024; E.bias1 = biasb + (size_t)132 * site_prefN(4); E.bN1 = 512; j0.A = hbuf; j0.Bt = (const bf16_t*)(ws + OFF_WQ) + (size_t)(l - 2) * D * D; j0.nN = 4; j0.epi = EPI_QRAW;
        E.b1 = (bf16_t*)(ws + OFF_X + SZ_ACT); E.f2 = (float*)(ws + OFF_X + 2 * SZ_ACT); nj = (l == 2) ? 2 : 1; }
      else if (sub == 4) { E.rss_out = rssb + (size_t)(1 + 2 * l) * T; E.ng = p->norm2_g + l * D; E.nsc = mods + l * 6144 + 4096; E.yout = hbuf; j0.A = onbuf; j0.Bt = hg ? (const bf16_t*)(ws + OFF_WOUT) + (size_t)l * D * D : (const bf16_t*)(ws + OFF_WO) + (size_t)(l - 2) * D * D; j0.nN = 4; j0.epi = EPI_RESID;
        E.f0 = p->out + O_Y; E.f1 = mods + l * 6144 + 2048; E.first = (l == 0); }
      else if (sub == 6) { E.rss = rssb + (size_t)(1 + 2 * l) * T; E.bias = biasb + (size_t)132 * site_prefN(5 + l); E.bN = 4096; j0.A = hbuf; j0.Bt = (const bf16_t*)(ws + OFF_WUP) + (size_t)l * D * FF; j0.nN = 16; j0.epi = EPI_UP; E.b0 = ubuf; }
      else { if (l < 3) { E.rss_out = rssb + (size_t)(2 * (l + 1)) * T; E.ng = p->norm1_g + (l + 1) * D; E.nsc = mods + (l + 1) * 6144 + 1024; E.yout = hbuf;
          if (l == 1) { E.ngkv = p->kv_norm_g; E.nsckv = mods + 24576 + 1024; E.ykv = (bf16_t*)(ws + OFF_X); } }
        j0.A = ubuf; j0.Bt = (const bf16_t*)(ws + OFF_WDN) + (size_t)l * D * FF; j0.nN = 4; j0.K = FF; j0.epi = EPI_RESID; E.f0 = p->out + O_Y; E.f1 = mods + l * 6144 + 5120; }
      gemm_phase(p, (LAS unsigned char*)shm, shm, j0, j1, nj, E, sub != 9 && sub != 0);
      if (sub == 0) init_rows(p, (unsigned*)(ws + OFF_BAR) + XCD_BAR_WORDS + 100);
    } else if (sub == 2 && hg) {
      HgBufs HB; HB.q = (bf16_t*)(ws + OFF_U); HB.k = (bf16_t*)(ws + OFF_U + SZ_ACT); HB.v = (bf16_t*)(ws + OFF_U + 2 * SZ_ACT); HB.g = (bf16_t*)(ws + OFF_U + 3 * SZ_ACT);
      HB.lf = (float*)(ws + OFF_X); HB.o32 = (float*)(ws + OFF_X + 2 * SZ_ACT); HB.on = (bf16_t*)(ws + OFF_ON);
      scan_phase(p, l, HB, shm);
    } else if (sub == 2) {
      AtBufs AB; AB.qraw = (bf16_t*)(ws + OFF_X + SZ_ACT); AB.kvraw = (float*)(ws + OFF_X + 2 * SZ_ACT); AB.on = (bf16_t*)(ws + OFF_ON); AB.tab = (const float*)(ws + OFF_TAB);
      attn_phase(p, l, AB, shm);
    } else {
      HgBufs HB; HB.q = (bf16_t*)(ws + OFF_U); HB.k = (bf16_t*)(ws + OFF_U + SZ_ACT); HB.v = (bf16_t*)(ws + OFF_U + 2 * SZ_ACT); HB.g = (bf16_t*)(ws + OFF_U + 3 * SZ_ACT);
      HB.lf = (float*)(ws + OFF_X); HB.o32 = (float*)(ws + OFF_X + 2 * SZ_ACT); HB.on = (bf16_t*)(ws + OFF_ON);
      scan_passB(HB);
      { KP pb = kp_get(); XcdBarrier xb; xb.bar = (unsigned*)(pb->ws + OFF_BAR); xb.x = xb_xcc_id(); xb.st = xst; xcd_barrier(xb); }
      scan_prompt<1>(p, l, HB, shm);
    }
    }
    if (step == 31) break;
    if (step == -2) grid.sync();
    else { KP pb = kp_get(); XcdBarrier xb; xb.bar = (unsigned*)(pb->ws + OFF_BAR); xb.x = xb_xcc_id(); xb.st = xst; xcd_barrier(xb); }
  }
}

extern "C" void kernel_launch(void* const* d_in, const int* in_sizes, int n_in, void* d_out, int out_size, void* d_ws, size_t ws_size, hipStream_t stream) {
  static int grid_blocks = 0;
  if (!grid_blocks) {
    int dev = 0, cus = 0, per_cu = 0;
    hipGetDevice(&dev);
    hipDeviceGetAttribute(&cus, hipDeviceAttributeMultiprocessorCount, dev);
    if (hipFuncSetAttribute((const void*)yoco_fwd, hipFuncAttributeMaxDynamicSharedMemorySize, LDS_BYTES) != hipSuccess) fprintf(stderr, "hipFuncSetAttribute failed\n");
    if (hipOccupancyMaxActiveBlocksPerMultiprocessor(&per_cu, (const void*)yoco_fwd, NTHREADS, LDS_BYTES) != hipSuccess || per_cu < 1) { fprintf(stderr, "occupancy query failed\n"); per_cu = 1; }
    grid_blocks = cus * per_cu;
    if (ws_size < WS_NEED) fprintf(stderr, "workspace too small: %zu < %zu\n", ws_size, (size_t)WS_NEED);
  }
  P p{};
  const float** pp = (const float**)&p;
  for (int i = 0; i < 26; ++i) pp[i] = (const float*)d_in[i];
  p.out = (float*)d_out; p.ws = (unsigned char*)d_ws;
  (void)hipMemsetAsync((unsigned char*)d_ws + OFF_BAR, 0, ZERO_BYTES, stream);
  void* args[] = {&p};
  hipError_t e = hipLaunchCooperativeKernel((const void*)yoco_fwd, dim3(grid_blocks), dim3(NTHREADS), args, LDS_BYTES, stream);
  if (e != hipSuccess) fprintf(stderr, "cooperative launch failed: %s (grid %d)\n", hipGetErrorString(e), grid_blocks);
}
```

```cpp
#include <hip/hip_runtime.h>
#include <hip/hip_cooperative_groups.h>
#include <cstdio>
#include <cstdint>
namespace cg = cooperative_groups;

#define DI __device__ __forceinline__
typedef unsigned short bf16_t;
typedef short bf16x8 __attribute__((ext_vector_type(8)));
typedef float f32x4 __attribute__((ext_vector_type(4)));
typedef float f32x2 __attribute__((ext_vector_type(2)));
typedef float f32x16 __attribute__((ext_vector_type(16)));
typedef unsigned u32x4 __attribute__((ext_vector_type(4)));
typedef unsigned u32x2 __attribute__((ext_vector_type(2)));
#define LAS __attribute__((address_space(3)))

constexpr int D = 1024, FF = 4096, TP = 16384, TS = 128, T = TP + TS, TPAD = 16640, SEQ = 4096;
constexpr int NMOD = 132, MODW = 4 * 6144 + 2048;
constexpr float EPS = 1e-6f;
constexpr int NTHREADS = 512, NWAVES = 8;
constexpr int LDS_BYTES = 131072 + 16;

constexpr size_t O_Y = 0;
constexpr size_t O_HGP = (size_t)T * D;
constexpr size_t O_KP = O_HGP + (size_t)2 * 4 * 8 * 128 * 128;
constexpr size_t O_VP = O_KP + (size_t)4 * 128 * 4 * 64;
constexpr size_t O_HGS = O_VP + (size_t)4 * 128 * 4 * 64;
constexpr size_t O_KS = O_HGS + (size_t)2 * 128 * 8 * 128 * 128;
constexpr size_t O_VS = O_KS + (size_t)128 * 128 * 4 * 64;

constexpr size_t SZ_ACT = (size_t)TPAD * D * 2;
constexpr size_t OFF_WIN = 0;
constexpr size_t OFF_WOUT = OFF_WIN + (size_t)2 * 4096 * 1024 * 2;
constexpr size_t OFF_WKV = OFF_WOUT + (size_t)2 * 1024 * 1024 * 2;
constexpr size_t OFF_WQ = OFF_WKV + (size_t)512 * 1024 * 2;
constexpr size_t OFF_WO = OFF_WQ + (size_t)2 * 1024 * 1024 * 2;
constexpr size_t OFF_WUP = OFF_WO + (size_t)2 * 1024 * 1024 * 2;
constexpr size_t OFF_WDN = OFF_WUP + (size_t)4 * 4096 * 1024 * 2;
constexpr size_t OFF_MODS = OFF_WDN + (size_t)4 * 4096 * 1024 * 2;
constexpr size_t OFF_TAB = OFF_MODS + (((size_t)NMOD * MODW * 4 + 4095) & ~(size_t)4095);
constexpr size_t OFF_H = OFF_TAB + (((size_t)4097 * 64 * 4 + 4095) & ~(size_t)4095);
constexpr size_t OFF_ON = OFF_H + SZ_ACT;
constexpr size_t OFF_U = OFF_ON + SZ_ACT;
constexpr size_t OFF_X = OFF_U + 4 * SZ_ACT;
constexpr size_t OFF_BAR = OFF_X + 4 * SZ_ACT;
constexpr size_t BAR_BYTES = 16384;
constexpr size_t OFF_RSS = OFF_BAR + BAR_BYTES;
constexpr size_t ZERO_BYTES = BAR_BYTES + (size_t)9 * T * 4;
constexpr size_t OFF_ASH = OFF_BAR + ((ZERO_BYTES + 4095) & ~(size_t)4095);
constexpr size_t OFF_BIAS = OFF_ASH + (size_t)9 * 256 * 1024 * 2;
constexpr size_t WS_NEED = OFF_BIAS + (size_t)132 * 27136 * 4;

struct P {
  const float *x_prompt, *x_sample, *c_prompt, *c_sample, *state_hgrn, *cache_k, *cache_v;
  const float *w_ada, *b_ada, *norm1_g, *norm2_g, *hg_w_in, *hg_w_out, *hg_lbp, *hg_gn_g;
  const float *kv_w_ada, *kv_b_ada, *kv_norm_g, *w_kv, *k_norm_g, *w_q, *q_norm_g, *sinks, *w_o, *w_up, *w_down;
  float* out; unsigned char* ws;
};

typedef const P __attribute__((address_space(4)))* KP;
DI KP kp_get() { KP q = (KP)__builtin_amdgcn_kernarg_segment_ptr(); asm volatile("" : "+s"(q)); return q; }
DI int tid_get() { int t = threadIdx.x; asm volatile("" : "+v"(t)); return t; }
DI unsigned f2bf(float f) { unsigned u = __float_as_uint(f); return (u + 0x7fffu + ((u >> 16) & 1u)) >> 16; }
typedef __bf16 bf16x2_n __attribute__((ext_vector_type(2)));
DI unsigned pk2(float lo, float hi) { return __builtin_bit_cast(unsigned, __builtin_convertvector((f32x2){lo, hi}, bf16x2_n)); }
DI float bf2f(unsigned b) { return __uint_as_float(b << 16); }
DI float silu_f(float x) { return x * __builtin_amdgcn_rcpf(1.f + __expf(-x)); }
DI int modrow(int r) { return r < TP ? (r >> 12) : (4 + r - TP); }
DI int crow(int reg, int h) { return (reg & 3) + 8 * (reg >> 2) + 4 * h; }

constexpr int BM = 256, BK = 64, HALF = 128, HTB = HALF * BK * 2;
DI int lds_byte(int r, int c) { const int st = (r >> 4) * 2 + (c >> 5), rr = r & 15, cc = c & 31, ob = rr * 64 + cc * 2; return st * 1024 + (ob ^ (((ob >> 9) & 1) << 5)); }
DI void stage_rc(int b, int& R, int& C) { const int st = b / 1024, sb = b % 1024, swz = sb ^ (((sb >> 9) & 1) << 5); R = (st >> 1) * 16 + swz / 64; C = (st & 1) * 32 + (swz % 64) / 2; }

enum { EPI_ADA = 0, EPI_HGIN = 1, EPI_RESID = 2, EPI_UP = 3, EPI_QRAW = 4, EPI_KVRAW = 5, EPI_NOP = 6, EPI_BIAS = 7 };
struct GemmJob { const bf16_t* A; const bf16_t* Bt; int nM, nN, K, epi; };
struct EpiArgs {
  float* f0; const float* f1; float* f2; bf16_t* b0; bf16_t* b1; bf16_t* b2; bf16_t* b3; int layer; int first;
  const float* rss; const float* bias; const float* bias1; int bN, bN1;
  float* rss_out; const float* ng; const float* nsc; bf16_t* yout; const float* ngkv; const float* nsckv; bf16_t* ykv;
  bf16_t* ash;
};
DI int site_N(const int s) { return (s == 2 || s == 3) ? 1024 : (s == 4 ? 512 : 4096); }
DI int site_prefN(const int s) { return s == 0 ? 0 : s == 1 ? 4096 : s == 2 ? 8192 : s == 3 ? 9216 : s == 4 ? 10240 : 10752 + (s - 5) * 4096; }

DI void tile_of(int L, int nM, int nN, int& pm, int& pn) {
  const int nwg = nM * nN; int wgid = L;
  { const int q = nwg / 8, r = nwg % 8, xcd = wgid % 8, off = wgid / 8; wgid = (xcd < r ? xcd * (q + 1) : r * (q + 1) + (xcd - r) * q) + off; }
  const int nig = 8 * nN, gid = wgid / nig, fm = gid * 8, gsz = (nM - fm) < 8 ? (nM - fm) : 8;
  pm = fm + ((wgid % nig) % gsz); pn = (wgid % nig) / gsz;
}

DI void epi_frag(KP p, const int epi, const EpiArgs& E, const int r, const int c, const f32x4 vin) {
  if (epi == EPI_NOP) return;
  f32x4 v = vin;
  if (epi == EPI_HGIN || epi == EPI_UP || epi == EPI_QRAW || epi == EPI_KVRAW) {
    const float rstd = rsqrtf(E.rss[r] * (1.f / D) + EPS);
    const float* bp = ((epi == EPI_KVRAW) ? E.bias1 + (size_t)modrow(r) * E.bN1 : E.bias + (size_t)modrow(r) * E.bN) + c;
    v = v * rstd + *(const f32x4*)bp; }
  if (epi == EPI_HGIN) {
    const int sec = c >> 10, cc = c & 1023; const size_t o = (size_t)r * D + cc;
    if (sec == 1) { f32x4 lb = (f32x4){0.f, 0.f, 0.f, 0.f};
      if (E.layer == 1) { const f32x4 l0 = *(const f32x4*)(p->hg_lbp + cc), l1 = *(const f32x4*)(p->hg_lbp + D + cc);
#pragma unroll
        for (int j = 0; j < 4; ++j) lb[j] = __builtin_amdgcn_rcpf(1.f + __expf(l0[j] - l1[j])); }
      f32x4 lf;
#pragma unroll
      for (int j = 0; j < 4; ++j) { const float sg = __builtin_amdgcn_rcpf(1.f + __expf(-v[j])); const float fg = lb[j] + (1.f - lb[j]) * sg; lf[j] = __logf(fg); }
      *(f32x4*)(E.f0 + o) = lf;
    } else if (sec == 2) { *(u32x2*)(E.b2 + o) = (u32x2){pk2(v[0], v[1]), pk2(v[2], v[3])};
    } else { bf16_t* dst = (sec == 0) ? E.b0 : E.b3; *(u32x2*)(dst + o) = (u32x2){pk2(silu_f(v[0]), silu_f(v[1])), pk2(silu_f(v[2]), silu_f(v[3]))}; }
  } else if (epi == EPI_RESID) {
    const float* xin = E.first ? (r < TP ? p->x_prompt + (size_t)r * D : p->x_sample + (size_t)(r - TP) * D) : (E.f0 + (size_t)r * D);
    const size_t mo = (size_t)modrow(r) * MODW;
    const f32x4 xv = *(const f32x4*)(xin + c), gv = *(const f32x4*)(E.f1 + mo + c);
    const f32x4 yn = xv + gv * v;
    *(f32x4*)(E.f0 + (size_t)r * D + c) = yn;
    if (E.yout) {
      const f32x4 g = *(const f32x4*)(E.ng + c), sc = *(const f32x4*)(E.nsc + mo + c); const f32x4 y = yn * g * (sc + 1.f);
      *(u32x2*)(E.yout + (size_t)r * D + c) = (u32x2){pk2(y[0], y[1]), pk2(y[2], y[3])};
      if (E.ykv) { const f32x4 g2 = *(const f32x4*)(E.ngkv + c), sc2 = *(const f32x4*)(E.nsckv + mo + c); const f32x4 y2 = yn * g2 * (sc2 + 1.f);
        *(u32x2*)(E.ykv + (size_t)r * D + c) = (u32x2){pk2(y2[0], y2[1]), pk2(y2[2], y2[3])}; }
      float ss = yn[0] * yn[0] + yn[1] * yn[1] + yn[2] * yn[2] + yn[3] * yn[3];
      ss += __shfl_xor(ss, 1); ss += __shfl_xor(ss, 2);
      if ((tid_get() & 3) == 0) atomicAdd(E.rss_out + r, ss); }
  } else if (epi == EPI_UP) {
    f32x4 u;
#pragma unroll
    for (int j = 0; j < 4; ++j) { const float t = fmaxf(v[j], 0.f); u[j] = t * t; }
    *(u32x2*)(E.b0 + (size_t)r * FF + c) = (u32x2){pk2(u[0], u[1]), pk2(u[2], u[3])};
  } else if (epi == EPI_QRAW) { *(u32x2*)(E.b1 + (size_t)r * D + c) = (u32x2){pk2(v[0], v[1]), pk2(v[2], v[3])};
  } else if (epi == EPI_KVRAW) { *(f32x4*)(E.f2 + (size_t)r * 512 + c) = v; }
}

DI void epi_frag8(KP p, const int epi, const EpiArgs& E, const int r, const int c, const f32x4 v0, const f32x4 v1, const f32x4 lbA = (f32x4){0.f, 0.f, 0.f, 0.f}, const f32x4 lbB = (f32x4){0.f, 0.f, 0.f, 0.f}) {
  if (epi == EPI_NOP) return;
  if (epi == EPI_ADA) { if (r < NMOD) { const float* bp = (c < 24576) ? (p->b_ada + c) : (p->kv_b_ada + (c - 24576)); float* o = E.f0 + (size_t)r * MODW + c;
      const f32x4 m0 = v0 + *(const f32x4*)bp, m1 = v1 + *(const f32x4*)(bp + 4);
      *(f32x4*)o = m0; *(f32x4*)(o + 4) = m1;
      int site = -1;
      if (c < 24576) { const int l = c / 6144, part = (c - l * 6144) >> 10; site = (part == 0) ? l : (part == 3 ? 5 + l : -1); } else if (c < 25600) site = 4;
      if (site >= 0) *(u32x4*)(E.ash + ((size_t)site * 256 + r) * 1024 + (c & 1023)) = (u32x4){pk2(m0[0], m0[1]), pk2(m0[2], m0[3]), pk2(m1[0], m1[1]), pk2(m1[2], m1[3])}; }
  } else if (epi == EPI_HGIN) {
    const int sec = c >> 10, cc = c & 1023; const size_t o = (size_t)r * D + cc;
    if (sec == 1) { float lb[8];
#pragma unroll
      for (int j = 0; j < 4; ++j) { lb[j] = lbA[j]; lb[4 + j] = lbB[j]; }
      float lf[8];
#pragma unroll
      for (int j = 0; j < 8; ++j) { const float x = (j < 4) ? v0[j & 3] : v1[j & 3]; const float sg = __builtin_amdgcn_rcpf(1.f + __expf(-x)); const float fg = lb[j] + (1.f - lb[j]) * sg;
        lf[j] = __logf(fg); }
      *(f32x4*)(E.f0 + o) = (f32x4){lf[0], lf[1], lf[2], lf[3]}; *(f32x4*)(E.f0 + o + 4) = (f32x4){lf[4], lf[5], lf[6], lf[7]};
    } else if (sec == 2) { *(u32x4*)(E.b2 + o) = (u32x4){pk2(v0[0], v0[1]), pk2(v0[2], v0[3]), pk2(v1[0], v1[1]), pk2(v1[2], v1[3])};
    } else { bf16_t* dst = (sec == 0) ? E.b0 : E.b3;
      *(u32x4*)(dst + o) = (u32x4){pk2(silu_f(v0[0]), silu_f(v0[1])), pk2(silu_f(v0[2]), silu_f(v0[3])), pk2(silu_f(v1[0]), silu_f(v1[1])), pk2(silu_f(v1[2]), silu_f(v1[3]))}; }
  } else if (epi == EPI_RESID) {
    const float* xin = E.first ? (r < TP ? p->x_prompt + (size_t)r * D : p->x_sample + (size_t)(r - TP) * D) : (E.f0 + (size_t)r * D);
    const size_t mo = (size_t)modrow(r) * MODW;
    const float* gm = E.f1 + mo + c; float* o = E.f0 + (size_t)r * D + c;
    const f32x4 xa = *(const f32x4*)(xin + c), xb = *(const f32x4*)(xin + c + 4), ga = *(const f32x4*)gm, gb = *(const f32x4*)(gm + 4);
    const f32x4 ya = xa + ga * v0, yb = xb + gb * v1;
    *(f32x4*)o = ya; *(f32x4*)(o + 4) = yb;
    if (E.yout) {
      const f32x4 g0 = *(const f32x4*)(E.ng + c), g1 = *(const f32x4*)(E.ng + c + 4), s0 = *(const f32x4*)(E.nsc + mo + c), s1 = *(const f32x4*)(E.nsc + mo + c + 4);
      const f32x4 y0 = ya * g0 * (s0 + 1.f), y1 = yb * g1 * (s1 + 1.f);
      *(u32x4*)(E.yout + (size_t)r * D + c) = (u32x4){pk2(y0[0], y0[1]), pk2(y0[2], y0[3]), pk2(y1[0], y1[1]), pk2(y1[2], y1[3])};
      if (E.ykv) { const f32x4 h0 = *(const f32x4*)(E.ngkv + c), h1 = *(const f32x4*)(E.ngkv + c + 4), t0 = *(const f32x4*)(E.nsckv + mo + c), t1 = *(const f32x4*)(E.nsckv + mo + c + 4);
        const f32x4 z0 = ya * h0 * (t0 + 1.f), z1 = yb * h1 * (t1 + 1.f);
        *(u32x4*)(E.ykv + (size_t)r * D + c) = (u32x4){pk2(z0[0], z0[1]), pk2(z0[2], z0[3]), pk2(z1[0], z1[1]), pk2(z1[2], z1[3])}; }
      float ss = ya[0] * ya[0] + ya[1] * ya[1] + ya[2] * ya[2] + ya[3] * ya[3] + yb[0] * yb[0] + yb[1] * yb[1] + yb[2] * yb[2] + yb[3] * yb[3];
      ss += __shfl_xor(ss, 16); ss += __shfl_xor(ss, 32);
      if ((tid_get() & 63) < 16) atomicAdd(E.rss_out + r, ss); }
  } else if (epi == EPI_UP) {
    float u[8];
#pragma unroll
    for (int j = 0; j < 8; ++j) { const float t = fmaxf((j < 4) ? v0[j & 3] : v1[j & 3], 0.f); u[j] = t * t; }
    *(u32x4*)(E.b0 + (size_t)r * FF + c) = (u32x4){pk2(u[0], u[1]), pk2(u[2], u[3]), pk2(u[4], u[5]), pk2(u[6], u[7])};
  } else if (epi == EPI_QRAW) { *(u32x4*)(E.b1 + (size_t)r * D + c) = (u32x4){pk2(v0[0], v0[1]), pk2(v0[2], v0[3]), pk2(v1[0], v1[1]), pk2(v1[2], v1[3])};
  } else { float* o = E.f2 + (size_t)r * 512 + c; *(f32x4*)o = v0; *(f32x4*)(o + 4) = v1; }
}

template <int NMB>
DI void skinny_unit(KP p, unsigned char* shm, const bf16_t* A, const bf16_t* Bt, const int K, const int mrow0, const int n0, const int epi, const EpiArgs& E) {
  const int tid = tid_get(), lane = tid & 63, wave = tid >> 6, fr = lane & 15, fq = lane >> 4;
  const int ks = K >> 3;
  const bf16_t* ap = A + (size_t)(TP + mrow0 + fr) * K + wave * ks + fq * 8;
  const bf16_t* bp = Bt + (size_t)(n0 + fr) * K + wave * ks + fq * 8;
  f32x4 acc[NMB];
#pragma unroll
  for (int mb = 0; mb < NMB; ++mb) acc[mb] = (f32x4){0.f, 0.f, 0.f, 0.f};
#pragma unroll 2
  for (int k = 0; k < ks; k += 32) { const bf16x8 b = *(const bf16x8*)(bp + k);
#pragma unroll
    for (int mb = 0; mb < NMB; ++mb) { const bf16x8 a = *(const bf16x8*)(ap + (size_t)mb * 16 * K + k); acc[mb] = __builtin_amdgcn_mfma_f32_16x16x32_bf16(b, a, acc[mb], 0, 0, 0); } }
  float* red = (float*)shm;
#pragma unroll
  for (int mb = 0; mb < NMB; ++mb) *(f32x4*)(red + wave * (NMB * 256) + (mb * 16 + fr) * 16 + fq * 4) = acc[mb];
  __syncthreads();
  if (tid < NMB * 64) { const int row = tid >> 2, c4 = (tid & 3) * 4; f32x4 sum = (f32x4){0.f, 0.f, 0.f, 0.f};
#pragma unroll
    for (int w = 0; w < 8; ++w) sum += *(const f32x4*)(red + w * (NMB * 256) + row * 16 + c4);
    epi_frag(p, epi, E, TP + mrow0 + row, n0 + c4, sum); }
  __syncthreads();
}

DI int perm32(int rho) { const int n = rho >> 4, i = rho & 15; return 8 * (i >> 2) + 4 * n + (i & 3); }
struct UnitD { const char* A; const char* B; int pm, pn, epi; float* ob; int on; };
DI void unit_of(const int L, const GemmJob& j0, const GemmJob& j1, const int n0, const size_t tstep, UnitD& u) {
  if (j0.epi == EPI_BIAS) {
    const int st = L < 16 ? 0 : L < 32 ? 1 : L < 36 ? 2 : L < 40 ? 3 : L < 42 ? 4 : 5 + (L - 42) / 16;
    const int lb = st == 0 ? 0 : st == 1 ? 16 : st == 2 ? 32 : st == 3 ? 36 : st == 4 ? 40 : 42 + (st - 5) * 16;
    const unsigned char* wsb = (const unsigned char*)j0.Bt;
    const bf16_t* Bt = (st < 2) ? (const bf16_t*)(wsb + OFF_WIN) + (size_t)st * 4096 * D : (st < 4) ? (const bf16_t*)(wsb + OFF_WQ) + (size_t)(st - 2) * D * D
                     : (st == 4) ? (const bf16_t*)(wsb + OFF_WKV) : (const bf16_t*)(wsb + OFF_WUP) + (size_t)(st - 5) * D * FF;
    u.pm = 0; u.pn = L - lb; u.epi = EPI_BIAS; u.A = (const char*)(j0.A + (size_t)st * 256 * 1024); u.B = (const char*)Bt + (size_t)u.pn * tstep;
    u.ob = (float*)j1.A + (size_t)132 * site_prefN(st); u.on = site_N(st); return; }
  const bool second = (L >= n0); int pm, pn; tile_of(second ? L - n0 : L, second ? j1.nM : j0.nM, second ? j1.nN : j0.nN, pm, pn);
  u.pm = pm; u.pn = pn; u.epi = second ? j1.epi : j0.epi;
  u.A = (const char*)(second ? j1.A : j0.A) + (size_t)pm * tstep; u.B = (const char*)(second ? j1.Bt : j0.Bt) + (size_t)pn * tstep;
}
DI void gemm_phase(KP p, LAS unsigned char* lds, unsigned char* shm, const GemmJob& j0, const GemmJob& j1, const int njobs, const EpiArgs& E, const int skinny) {
  const int tid = tid_get(), wid = __builtin_amdgcn_readfirstlane(tid >> 6), lane = tid & 63, wr = wid >> 2, wc = wid & 3, fr = lane & 15, fq = lane >> 4;
  const int K = j0.K, nt = K / BK;
  const int n0 = j0.nM * j0.nN, n1 = (njobs > 1) ? j1.nM * j1.nN : 0, ntl = n0 + n1;
  if ((int)blockIdx.x < ntl) {
    unsigned voffA[2], voffB[2];
#pragma unroll
    for (int i = 0; i < 2; ++i) { int R, C; stage_rc(tid * 16 + i * 8192, R, C); const int Rb = (R & ~31) + perm32(R & 31);
      voffA[i] = (unsigned)(R * K + C) * 2u; voffB[i] = (unsigned)(Rb * K + C) * 2u; }
    const size_t kstep = (size_t)(BK * 2), hstep = (size_t)HALF * K * 2, tstep = 2 * hstep;
    const unsigned ldsw = (unsigned)wid * 1024u;
    const int aoff = lds_byte(wr * 64 + fr, fq * 8), boff = lds_byte(wc * 32 + fr, fq * 8);
#define G_SA(b, h) (((b) * 2 + (h)) * HTB)
#define G_SB(b, h) ((4 + (b) * 2 + (h)) * HTB)
#define G_STAGE(bufoff, gbase, voff) do { _Pragma("unroll") for (int _i = 0; _i < 2; ++_i) \
      __builtin_amdgcn_global_load_lds((const unsigned*)((const char*)(gbase) + (voff)[_i]), (LAS unsigned*)(lds + (bufoff) + ldsw + _i * 8192), 16, 0, 0); } while (0)
#define G_LDA(dst, b, h) do { _Pragma("unroll") for (int m = 0; m < 4; ++m) _Pragma("unroll") for (int k = 0; k < 2; ++k) dst[m][k] = *(const LAS bf16x8*)(lds + G_SA(b, h) + aoff + m * 2048 + k * 1024); } while (0)
#define G_LDB(dst, b, h) do { _Pragma("unroll") for (int n = 0; n < 2; ++n) _Pragma("unroll") for (int k = 0; k < 2; ++k) dst[n][k] = *(const LAS bf16x8*)(lds + G_SB(b, h) + boff + n * 2048 + k * 1024); } while (0)
#define G_MMA(ai, bj, At, Bt) do { __builtin_amdgcn_s_setprio(1); _Pragma("unroll") for (int m = 0; m < 4; ++m) _Pragma("unroll") for (int n = 0; n < 2; ++n) _Pragma("unroll") for (int k = 0; k < 2; ++k) \
      acc[ai][bj][m][n] = __builtin_amdgcn_mfma_f32_16x16x32_bf16(Bt[n][k], At[m][k], acc[ai][bj][m][n], 0, 0, 0); __builtin_amdgcn_s_setprio(0); } while (0)
#define G_WAIT_V(n) asm volatile("s_waitcnt vmcnt(" #n ")" ::: "memory")
#define G_WAIT_L(n) asm volatile("s_waitcnt lgkmcnt(" #n ")" ::: "memory")
#define G_BAR __builtin_amdgcn_s_barrier()
#define G_SCHED __builtin_amdgcn_sched_barrier(0)
    int L = blockIdx.x;
    UnitD cur, nxt; unit_of(L, j0, j1, n0, tstep, cur);
    f32x4 acc[2][2][4][2];
#pragma unroll
    for (int a = 0; a < 2; ++a)
#pragma unroll
      for (int b = 0; b < 2; ++b)
#pragma unroll
        for (int m = 0; m < 4; ++m)
#pragma unroll
          for (int n = 0; n < 2; ++n) acc[a][b][m][n] = (f32x4){0.f, 0.f, 0.f, 0.f};
    bf16x8 At[4][2], B0[2][2], B1[2][2];
    const char* cA = cur.A; const char* cB = cur.B;
    G_STAGE(G_SB(0, 0), cB, voffB); G_STAGE(G_SB(0, 1), cB + hstep, voffB); G_STAGE(G_SA(0, 0), cA, voffA); G_STAGE(G_SA(0, 1), cA + hstep, voffA);
    if (wr == 1) G_BAR;
    G_WAIT_V(2); G_BAR;
    G_STAGE(G_SB(1, 0), cB + kstep, voffB); G_STAGE(G_SA(1, 0), cA + kstep, voffA); G_STAGE(G_SB(1, 1), cB + hstep + kstep, voffB);
    G_WAIT_V(6); G_BAR;
#pragma unroll 1
    for (;;) {
      const int Ln = L + (int)gridDim.x; const bool has_next = (Ln < ntl);
      if (has_next) unit_of(Ln, j0, j1, n0, tstep, nxt);
      const char* nA = has_next ? nxt.A : cA; const char* nB = has_next ? nxt.B : cB;
#pragma unroll 1
      for (int t = 0; t < nt; t += 2) {
        const bool last = (t == nt - 2);
        const char* a1 = cA + (size_t)(t + 1) * kstep;
        const char* a2 = last ? nA : cA + (size_t)(t + 2) * kstep; const char* b2 = last ? nB : cB + (size_t)(t + 2) * kstep;
        const char* a3 = a2 + kstep; const char* b3 = b2 + kstep;
        G_LDB(B0, 0, 0); G_LDB(B1, 0, 1); G_SCHED; G_LDA(At, 0, 0); G_STAGE(G_SA(1, 1), a1 + hstep, voffA);
        G_WAIT_V(8); G_WAIT_L(0); G_BAR; G_MMA(0, 0, At, B0); G_MMA(0, 1, At, B1); G_BAR; G_SCHED;
        G_LDA(At, 0, 1); G_STAGE(G_SB(0, 0), b2, voffB); G_STAGE(G_SB(0, 1), b2 + hstep, voffB); G_STAGE(G_SA(0, 0), a2, voffA);
        G_WAIT_V(8); G_WAIT_L(0); G_BAR; G_MMA(1, 0, At, B0); G_MMA(1, 1, At, B1); G_BAR; G_SCHED;
        G_LDB(B0, 1, 0); G_LDB(B1, 1, 1); G_SCHED; G_LDA(At, 1, 0); G_STAGE(G_SA(0, 1), a2 + hstep, voffA);
        G_WAIT_V(8); G_WAIT_L(0); G_BAR; G_MMA(0, 0, At, B0); G_MMA(0, 1, At, B1); G_BAR; G_SCHED;
        G_LDA(At, 1, 1); G_STAGE(G_SB(1, 0), b3, voffB); G_STAGE(G_SB(1, 1), b3 + hstep, voffB); G_STAGE(G_SA(1, 0), a3, voffA);
        G_WAIT_V(8); G_WAIT_L(0); G_BAR; G_MMA(1, 0, At, B0); G_MMA(1, 1, At, B1); G_BAR; G_SCHED;
      }
      if (wr == 0) G_BAR;
      { const int r0 = cur.pm * BM + wr * 64 + fr, c0 = cur.pn * BM + wc * 32 + fq * 8; const int epi = cur.epi;
#define EPI_LOOP(MODE) { _Pragma("unroll") for (int ai = 0; ai < 2; ++ai) _Pragma("unroll") for (int m = 0; m < 4; ++m) _Pragma("unroll") for (int bj = 0; bj < 2; ++bj) \
          epi_frag8(p, MODE, E, r0 + ai * 128 + m * 16, c0 + bj * 128, acc[ai][bj][m][0], acc[ai][bj][m][1]); }
        if (epi == EPI_ADA) EPI_LOOP(EPI_ADA)
        else if (epi == EPI_BIAS) {
#pragma unroll
          for (int ai = 0; ai < 2; ++ai)
#pragma unroll
            for (int m = 0; m < 4; ++m) { const int r = r0 + ai * 128 + m * 16; if (r < NMOD) {
#pragma unroll
              for (int bj = 0; bj < 2; ++bj) { float* o = cur.ob + (size_t)r * cur.on + (c0 + bj * 128); *(f32x4*)o = acc[ai][bj][m][0]; *(f32x4*)(o + 4) = acc[ai][bj][m][1]; } } }
        } else if (epi == EPI_RESID) {
          const size_t mo = (size_t)modrow(r0) * MODW;
#pragma unroll
          for (int bj = 0; bj < 2; ++bj) { const int c = c0 + bj * 128;
            const f32x4 ga = *(const f32x4*)(E.f1 + mo + c), gb = *(const f32x4*)(E.f1 + mo + c + 4);
            f32x4 m0 = (f32x4){0.f, 0.f, 0.f, 0.f}, m1 = m0, k0 = m0, k1 = m0;
            if (E.yout) { const f32x4 g0 = *(const f32x4*)(E.ng + c), g1 = *(const f32x4*)(E.ng + c + 4), s0 = *(const f32x4*)(E.nsc + mo + c), s1 = *(const f32x4*)(E.nsc + mo + c + 4);
              m0 = g0 * (s0 + 1.f); m1 = g1 * (s1 + 1.f);
              if (E.ykv) { const f32x4 h0 = *(const f32x4*)(E.ngkv + c), h1 = *(const f32x4*)(E.ngkv + c + 4), t0 = *(const f32x4*)(E.nsckv + mo + c), t1 = *(const f32x4*)(E.nsckv + mo + c + 4);
                k0 = h0 * (t0 + 1.f); k1 = h1 * (t1 + 1.f); } }
#pragma unroll
            for (int ah = 0; ah < 2; ++ah) { const int ai = ah, mb = 0;
              f32x4 ya[4], yb[4];
              const float* xbase = E.first ? p->x_prompt : E.f0;
#pragma unroll
              for (int m = mb; m < mb + 4; ++m) { const unsigned off = (unsigned)(r0 + ai * 128 + m * 16) * (unsigned)D + (unsigned)c;
                ya[m] = __builtin_nontemporal_load((const f32x4*)(xbase + off)); yb[m] = __builtin_nontemporal_load((const f32x4*)(xbase + off + 4)); }
#pragma unroll
              for (int m = mb; m < mb + 4; ++m) { const int r = r0 + ai * 128 + m * 16; const unsigned off = (unsigned)r * (unsigned)D + (unsigned)c;
                const f32x4 xa = ya[m] + ga * acc[ai][bj][m][0], xb = yb[m] + gb * acc[ai][bj][m][1];
                __builtin_nontemporal_store(xa, (f32x4*)(E.f0 + off)); __builtin_nontemporal_store(xb, (f32x4*)(E.f0 + off + 4));
                if (E.yout) { const f32x4 y0 = xa * m0, y1 = xb * m1;
                  *(u32x4*)(E.yout + off) = (u32x4){pk2(y0[0], y0[1]), pk2(y0[2], y0[3]), pk2(y1[0], y1[1]), pk2(y1[2], y1[3])};
                  if (E.ykv) { const f32x4 z0 = xa * k0, z1 = xb * k1;
                    *(u32x4*)(E.ykv + off) = (u32x4){pk2(z0[0], z0[1]), pk2(z0[2], z0[3]), pk2(z1[0], z1[1]), pk2(z1[2], z1[3])}; }
                  float ss = xa[0] * xa[0] + xa[1] * xa[1] + xa[2] * xa[2] + xa[3] * xa[3] + xb[0] * xb[0] + xb[1] * xb[1] + xb[2] * xb[2] + xb[3] * xb[3];
                  ss += __shfl_xor(ss, 16); ss += __shfl_xor(ss, 32);
                  if (fq == 0) atomicAdd(E.rss_out + (unsigned)r, ss); } } } }
        } else if (epi != EPI_NOP) {
          float rstd8[8];
#pragma unroll
          for (int q = 0; q < 8; ++q) rstd8[q] = rsqrtf(E.rss[r0 + (q >> 2) * 128 + (q & 3) * 16] * (1.f / D) + EPS);
          const float* bb = (epi == EPI_KVRAW) ? E.bias1 + (size_t)modrow(r0) * E.bN1 : E.bias + (size_t)modrow(r0) * E.bN;
          f32x4 bv[2][2], lbv[2][2];
#pragma unroll
          for (int bj = 0; bj < 2; ++bj) { const int c = c0 + bj * 128; bv[bj][0] = *(const f32x4*)(bb + c); bv[bj][1] = *(const f32x4*)(bb + c + 4);
            lbv[bj][0] = (f32x4){0.f, 0.f, 0.f, 0.f}; lbv[bj][1] = (f32x4){0.f, 0.f, 0.f, 0.f};
            if (epi == EPI_HGIN && (c >> 10) == 1 && E.layer == 1) { const int cc = c & 1023;
              const f32x4 l0 = *(const f32x4*)(p->hg_lbp + cc), l1 = *(const f32x4*)(p->hg_lbp + D + cc), l2 = *(const f32x4*)(p->hg_lbp + cc + 4), l3 = *(const f32x4*)(p->hg_lbp + D + cc + 4);
#pragma unroll
              for (int jj = 0; jj < 4; ++jj) { lbv[bj][0][jj] = __builtin_amdgcn_rcpf(1.f + __expf(l0[jj] - l1[jj])); lbv[bj][1][jj] = __builtin_amdgcn_rcpf(1.f + __expf(l2[jj] - l3[jj])); } } }
#define CONS_LOOP(MODE) { _Pragma("unroll") for (int ai = 0; ai < 2; ++ai) _Pragma("unroll") for (int m = 0; m < 4; ++m) _Pragma("unroll") for (int bj = 0; bj < 2; ++bj) \
            epi_frag8(p, MODE, E, r0 + ai * 128 + m * 16, c0 + bj * 128, acc[ai][bj][m][0] * rstd8[ai * 4 + m] + bv[bj][0], acc[ai][bj][m][1] * rstd8[ai * 4 + m] + bv[bj][1], lbv[bj][0], lbv[bj][1]); }
          if (epi == EPI_HGIN) CONS_LOOP(EPI_HGIN) else if (epi == EPI_UP) CONS_LOOP(EPI_UP) else if (epi == EPI_QRAW) CONS_LOOP(EPI_QRAW) else CONS_LOOP(EPI_KVRAW)
        }
      }
      if (!has_next) break;
#pragma unroll
      for (int a = 0; a < 2; ++a)
#pragma unroll
        for (int b = 0; b < 2; ++b)
#pragma unroll
          for (int m = 0; m < 4; ++m)
#pragma unroll
            for (int n = 0; n < 2; ++n) acc[a][b][m][n] = (f32x4){0.f, 0.f, 0.f, 0.f};
      cur = nxt; cA = nA; cB = nB; L = Ln;
      if (wr == 1) G_BAR;
    }
    G_WAIT_V(0);
    G_BAR;
  }
  if (skinny) {
    __syncthreads();
    const int u0 = j0.nN * 16, u1 = (njobs > 1) ? j1.nN * 16 : 0;
    const int rs = ((u0 + u1) * 4 <= (int)gridDim.x) ? 4 : (((u0 + u1) * 2 <= (int)gridDim.x) ? 2 : 1);
#pragma unroll 1
    for (int uu = (int)gridDim.x - 1 - (int)blockIdx.x; uu < (u0 + u1) * rs; uu += gridDim.x) {
      const int u = uu / rs, rg = uu - u * rs;
      const bool second = (u >= u0);
      const bf16_t* sa = second ? j1.A : j0.A; const bf16_t* sb = second ? j1.Bt : j0.Bt; const int sk = second ? j1.K : j0.K, sn = (second ? u - u0 : u) * 16, se = second ? j1.epi : j0.epi;
      if (rs == 4) skinny_unit<2>(p, shm, sa, sb, sk, rg * 32, sn, se, E);
      else if (rs == 2) skinny_unit<4>(p, shm, sa, sb, sk, rg * 64, sn, se, E);
      else skinny_unit<8>(p, shm, sa, sb, sk, 0, sn, se, E);
    }
  }
}

__device__ const float INVF[32] = {1.000000000e+00f, 7.498942614e-01f, 5.623413324e-01f, 4.216965139e-01f, 3.162277639e-01f, 2.371373773e-01f, 1.778279394e-01f, 1.333521307e-01f, 1.000000015e-01f, 7.498941571e-02f, 5.623413250e-02f, 4.216965288e-02f, 3.162277490e-02f, 2.371373773e-02f, 1.778279431e-02f, 1.333521493e-02f, 9.999999776e-03f, 7.498941850e-03f, 5.623413250e-03f, 4.216964822e-03f, 3.162277630e-03f, 2.371373586e-03f, 1.778279431e-03f, 1.333521446e-03f, 1.000000047e-03f, 7.498942432e-04f, 5.623413017e-04f, 4.216965172e-04f, 3.162277571e-04f, 2.371373703e-04f, 1.778279402e-04f, 1.333521504e-04f};
DI void transpose_item(const float* W, int K, int N, bf16_t* WT, int row_off, float* scr, int item, int lane) {
  const int nblk = N / 32, kb = item / nblk, nb = item % nblk, k0 = 64 * kb, n0 = 32 * nb;
#pragma unroll 8
  for (int i = 0; i < 32; ++i) { const int kk = 2 * i + (lane >> 5); scr[kk * 33 + (lane & 31)] = __builtin_nontemporal_load(W + (size_t)(k0 + kk) * N + n0 + (lane & 31)); }
  asm volatile("s_waitcnt lgkmcnt(0)" ::: "memory");
  const int c = lane & 7;
#pragma unroll
  for (int j = 0; j < 4; ++j) { const int n = (lane >> 3) + 8 * j; const float* s = scr + (8 * c) * 33 + n;
    u32x4 o; o.x = pk2(s[0 * 33], s[1 * 33]); o.y = pk2(s[2 * 33], s[3 * 33]); o.z = pk2(s[4 * 33], s[5 * 33]); o.w = pk2(s[6 * 33], s[7 * 33]);
    *(u32x4*)(WT + (size_t)(row_off + n0 + n) * K + k0 + 8 * c) = o; }
  asm volatile("s_waitcnt lgkmcnt(0)" ::: "memory");
}

DI void prep_phase(KP p, unsigned char* shm) {
  const int tid = tid_get(), lane = tid & 63, wave = tid >> 6;
  const int gw = blockIdx.x * NWAVES + wave, NGW = gridDim.x * NWAVES;
  float* scr = (float*)(shm + wave * 16384);
  unsigned char* ws = p->ws;
  int base = 0;
  for (int mi = 0; mi < 22; ++mi) {
    const float* W; int K, N, row_off; bf16_t* WT;
    if (mi < 2) { W = p->hg_w_in + (size_t)mi * D * 4096; K = D; N = 4096; WT = (bf16_t*)(ws + OFF_WIN) + (size_t)mi * 4096 * D; row_off = 0; }
    else if (mi < 4) { W = p->hg_w_out + (size_t)(mi - 2) * D * D; K = D; N = D; WT = (bf16_t*)(ws + OFF_WOUT) + (size_t)(mi - 2) * D * D; row_off = 0; }
    else if (mi < 5) { W = p->w_kv; K = D; N = 512; WT = (bf16_t*)(ws + OFF_WKV); row_off = 0; }
    else if (mi < 7) { W = p->w_q + (size_t)(mi - 5) * D * D; K = D; N = D; WT = (bf16_t*)(ws + OFF_WQ) + (size_t)(mi - 5) * D * D; row_off = 0; }
    else if (mi < 9) { W = p->w_o + (size_t)(mi - 7) * D * D; K = D; N = D; WT = (bf16_t*)(ws + OFF_WO) + (size_t)(mi - 7) * D * D; row_off = 0; }
    else if (mi < 13) { W = p->w_up + (size_t)(mi - 9) * D * FF; K = D; N = FF; WT = (bf16_t*)(ws + OFF_WUP) + (size_t)(mi - 9) * D * FF; row_off = 0; }
    else if (mi < 17) { W = p->w_down + (size_t)(mi - 13) * D * FF; K = FF; N = D; WT = (bf16_t*)(ws + OFF_WDN) + (size_t)(mi - 13) * D * FF; row_off = 0; }
    else if (mi < 21) { W = p->w_ada + (size_t)(mi - 17) * D * 6144; K = D; N = 6144; WT = (bf16_t*)(ws + OFF_X); row_off = (mi - 17) * 6144; }
    else { W = p->kv_w_ada; K = D; N = 2048; WT = (bf16_t*)(ws + OFF_X); row_off = 24576; }
    const int nitems = (K / 64) * (N / 32);
    int first = (gw - (base % NGW) + NGW) % NGW;
    for (int it = first; it < nitems; it += NGW) transpose_item(W, K, N, WT, row_off, scr, it, lane);
    base += nitems;
  }
  bf16_t* Ac = (bf16_t*)(ws + OFF_X + (size_t)MODW * D * 2);
  const int gt = blockIdx.x * NTHREADS + tid, NGT = gridDim.x * NTHREADS;
  for (int e = gt; e < 256 * D / 2; e += NGT) { const int r = e / (D / 2), c = (e % (D / 2)) * 2; float a = 0.f, b = 0.f;
    if (r < NMOD) { const float* cp = (r < 4) ? p->c_prompt + (size_t)r * D : p->c_sample + (size_t)(r - 4) * D; a = silu_f(cp[c]); b = silu_f(cp[c + 1]); }
    *(unsigned*)(Ac + (size_t)r * D + c) = pk2(a, b); }
  float* tab = (float*)(ws + OFF_TAB);
  for (int e = gt; e < 4097 * 32; e += NGT) { const int pi = e >> 5, i = e & 31; const float pos = (pi < 4096) ? (float)pi : 8192.f;
    const float ang = pos * INVF[i]; float sn, cs; sincosf(ang, &sn, &cs);
    tab[pi * 64 + i] = cs; tab[pi * 64 + 32 + i] = sn; }
}

DI void init_rows(KP p, unsigned* ctr) {
  const int tid = tid_get(); const int lane = tid & 63;
  unsigned char* ws = p->ws; const float* mods = (const float*)(ws + OFF_MODS); bf16_t* yout = (bf16_t*)(ws + OFF_H); float* rss = (float*)(ws + OFF_RSS);
  const float* g = p->norm1_g; const float* msc = mods + 1024;
#pragma unroll 1
  for (;;) {
    unsigned cidx = 0; if (lane == 0) cidx = __hip_atomic_fetch_add(ctr, 1u, __ATOMIC_RELAXED, __HIP_MEMORY_SCOPE_AGENT);
    cidx = __builtin_amdgcn_readfirstlane(cidx);
    if (cidx >= (unsigned)(T / 8)) break;
#pragma unroll 1
    for (int hh = 0; hh < 2; ++hh) { const int rb = (int)cidx * 8 + hh * 4;
      f32x4 v[4][4];
#pragma unroll
      for (int q = 0; q < 4; ++q) { const int r = rb + q; const float* xr = (r < TP) ? p->x_prompt + (size_t)r * D : p->x_sample + (size_t)(r - TP) * D;
#pragma unroll
        for (int jj = 0; jj < 4; ++jj) v[q][jj] = *(const f32x4*)(xr + lane * 4 + 256 * jj); }
#pragma unroll
      for (int q = 0; q < 4; ++q) { const int r = rb + q; float a = 0.f;
#pragma unroll
        for (int jj = 0; jj < 4; ++jj) a += v[q][jj][0] * v[q][jj][0] + v[q][jj][1] * v[q][jj][1] + v[q][jj][2] * v[q][jj][2] + v[q][jj][3] * v[q][jj][3];
#pragma unroll
        for (int o = 1; o < 64; o <<= 1) a += __shfl_xor(a, o);
        if (lane == 0) rss[r] = a;
        const size_t mo = (size_t)modrow(r) * MODW;
#pragma unroll
        for (int jj = 0; jj < 4; ++jj) { const int c = lane * 4 + 256 * jj;
          const f32x4 gg = *(const f32x4*)(g + c), sc = *(const f32x4*)(msc + mo + c);
          const f32x4 h = v[q][jj] * gg * (sc + 1.f);
          *(u32x2*)(yout + (size_t)r * D + c) = (u32x2){pk2(h[0], h[1]), pk2(h[2], h[3])}; } } }
  }
}

struct HgBufs { const bf16_t *q, *k, *v, *g; const float* lf; float* o32; bf16_t* on; };

constexpr int SPAN = 256, NSPAN = SEQ / SPAN, CH = 32, NCH = SPAN / CH;
constexpr int L_CUM = 0, L_QT = 16896, L_KT = 25600, L_KE = 34304, L_VT = 44544, L_PS = 54784, L_DEC = 55808, L_HALF = 57344;
constexpr int CUS = 132, QS = 136, KES = 40;
DI bf16x8 pack8(const f32x16& x, const int s) {
  return __builtin_bit_cast(bf16x8, (u32x4){pk2(x[8 * s], x[8 * s + 1]), pk2(x[8 * s + 2], x[8 * s + 3]), pk2(x[8 * s + 4], x[8 * s + 5]), pk2(x[8 * s + 6], x[8 * s + 7])});
}
template <int MODE>
DI void scan_prompt(KP p, const int l, const HgBufs& B, unsigned char* shm) {
  const int tid = tid_get(), lane = tid & 63, wave = tid >> 6, hb = wave >> 2, th = tid & 255, vb = wave & 3, h5 = lane >> 5, l31 = lane & 31;
  unsigned char* base = shm + hb * L_HALF;
  float* cumb = (float*)(base + L_CUM); bf16_t* Qt = (bf16_t*)(base + L_QT); bf16_t* Kt = (bf16_t*)(base + L_KT);
  bf16_t* KeT = (bf16_t*)(base + L_KE); bf16_t* Vt = (bf16_t*)(base + L_VT); float* psum = (float*)(base + L_PS); float* dec = (float*)(base + L_DEC);
  float* dS = B.o32; float* Lsum = B.o32 + (size_t)512 * 16384;
#pragma unroll 1
  for (int it0 = blockIdx.x * 2; it0 < 32 * NSPAN; it0 += gridDim.x * 2) {
    const int item = it0 + hb, bh = item / NSPAN, span = item % NSPAN, b = bh >> 3, h = bh & 7;
    f32x16 S[4];
#pragma unroll
    for (int db = 0; db < 4; ++db)
#pragma unroll
      for (int r = 0; r < 16; ++r) S[db][r] = 0.f;
    if (MODE == 1) {
      const unsigned ob = (unsigned)item * 16384u + (unsigned)(vb * 32 + l31) + (unsigned)(4 * h5) * 128u;
#pragma unroll
      for (int db = 0; db < 4; ++db) {
#pragma unroll
        for (int r = 0; r < 16; ++r) S[db][r] = dS[ob + (unsigned)((32 * db + (r & 3) + 8 * (r >> 2)) * 128)];
        __builtin_amdgcn_sched_barrier(0); }
    }
    float Ltot = 0.f;
#define LBAR() do { asm volatile("s_waitcnt lgkmcnt(0)" ::: "memory"); __builtin_amdgcn_s_barrier(); asm volatile("" ::: "memory"); } while (0)
    const int d1 = th & 127, part = th >> 7, t2 = th >> 3, dg = th & 7;
    const size_t tokS = (size_t)b * SEQ + (size_t)span * SPAN;
    float lfr[16]; unsigned vr[16]; u32x4 q0, q1, g0, g1;
#define SCAN_LOAD(chx) do { const size_t o0_ = (tokS + (size_t)(chx) * CH + part * 16) * D + h * 128 + d1; \
      _Pragma("unroll") for (int i = 0; i < 16; ++i) { lfr[i] = B.lf[o0_ + (size_t)i * D]; vr[i] = B.v[o0_ + (size_t)i * D]; } \
      } while (0)
    __builtin_amdgcn_sched_barrier(0);
    SCAN_LOAD(0);
    __builtin_amdgcn_sched_barrier(0);
#pragma unroll 1
    for (int ch = 0; ch < NCH; ++ch) {
      const size_t tok0 = tokS + (size_t)ch * CH;
      if (MODE == 1) { const size_t o_ = (tok0 + t2) * D + h * 128 + dg * 16;
        q0 = *(const u32x4*)(B.q + o_); q1 = *(const u32x4*)(B.q + o_ + 8);
        g0 = *(const u32x4*)(B.g + o_); g1 = *(const u32x4*)(B.g + o_ + 8); }
      { const int d = d1;
        float c[16]; float run = 0.f;
#pragma unroll
        for (int i = 0; i < 16; ++i) { run += lfr[i]; c[i] = run; }
        psum[part * 128 + d] = run;
        LBAR();
        const float t0 = psum[d], t1 = psum[128 + d]; const float off = part ? t0 : 0.f; const float Lc = t0 + t1;
        float ke[16];
#pragma unroll
        for (int i = 0; i < 16; ++i) { const float cu = off + c[i]; if (MODE == 1) cumb[(part * 16 + i) * CUS + d] = cu; ke[i] = (1.f - __expf(lfr[i])) * __expf(Lc - cu); }
        *(u32x4*)(KeT + d * KES + part * 16) = (u32x4){pk2(ke[0], ke[1]), pk2(ke[2], ke[3]), pk2(ke[4], ke[5]), pk2(ke[6], ke[7])};
        *(u32x4*)(KeT + d * KES + part * 16 + 8) = (u32x4){pk2(ke[8], ke[9]), pk2(ke[10], ke[11]), pk2(ke[12], ke[13]), pk2(ke[14], ke[15])};
        *(u32x4*)(Vt + d * KES + part * 16) = (u32x4){vr[0] | (vr[1] << 16), vr[2] | (vr[3] << 16), vr[4] | (vr[5] << 16), vr[6] | (vr[7] << 16)};
        *(u32x4*)(Vt + d * KES + part * 16 + 8) = (u32x4){vr[8] | (vr[9] << 16), vr[10] | (vr[11] << 16), vr[12] | (vr[13] << 16), vr[14] | (vr[15] << 16)};
        if (part == 0) { dec[d] = __expf(Lc); Ltot += Lc; }
      }
      LBAR();
      if (MODE == 1) {
        const int t = t2;
        unsigned qo[8], ko[8];
#pragma unroll
        for (int g4 = 0; g4 < 4; ++g4) { const f32x4 cv = *(const f32x4*)(cumb + t * CUS + dg * 16 + 4 * g4);
          f32x4 cp = (f32x4){0.f, 0.f, 0.f, 0.f}; if (t > 0) cp = *(const f32x4*)(cumb + (t - 1) * CUS + dg * 16 + 4 * g4);
#pragma unroll
          for (int e2 = 0; e2 < 2; ++e2) { const int w = g4 * 2 + e2; const unsigned qw = (w < 4) ? q0[w & 3] : q1[w & 3];
            const float ca = cv[2 * e2], cb = cv[2 * e2 + 1];
            const float ka = 1.f - __expf(ca - cp[2 * e2]), kb = 1.f - __expf(cb - cp[2 * e2 + 1]);
            qo[w] = pk2(bf2f(qw & 0xffffu) * __expf(ca), bf2f(qw >> 16) * __expf(cb));
            ko[w] = pk2(ka * __expf(fminf(-ca, 80.f)), kb * __expf(fminf(-cb, 80.f))); } }
        *(u32x4*)(Qt + t * QS + dg * 16) = (u32x4){qo[0], qo[1], qo[2], qo[3]}; *(u32x4*)(Qt + t * QS + dg * 16 + 8) = (u32x4){qo[4], qo[5], qo[6], qo[7]};
        *(u32x4*)(Kt + t * QS + dg * 16) = (u32x4){ko[0], ko[1], ko[2], ko[3]}; *(u32x4*)(Kt + t * QS + dg * 16 + 8) = (u32x4){ko[4], ko[5], ko[6], ko[7]};
        LBAR();
      }
      { const int chn = (ch + 1 < NCH) ? ch + 1 : ch; SCAN_LOAD(chn); }
      f32x16 O;
      if (MODE == 1) {
        f32x16 X;
#pragma unroll
        for (int r = 0; r < 16; ++r) { X[r] = 0.f; O[r] = 0.f; }
#pragma unroll
        for (int ks = 0; ks < 8; ++ks) { const bf16x8 a = *(const bf16x8*)(Kt + l31 * QS + 16 * ks + 8 * h5), bq = *(const bf16x8*)(Qt + l31 * QS + 16 * ks + 8 * h5);
          X = __builtin_amdgcn_mfma_f32_32x32x16_bf16(a, bq, X, 0, 0, 0); }
#pragma unroll
        for (int r = 0; r < 16; ++r) if (crow(r, h5) > l31) X[r] = 0.f;
#pragma unroll
        for (int st = 0; st < 2; ++st) { const bf16_t* vp = Vt + (vb * 32 + l31) * KES + 16 * st + 4 * h5; const u32x2 lo = *(const u32x2*)vp, hi = *(const u32x2*)(vp + 8);
          O = __builtin_amdgcn_mfma_f32_32x32x16_bf16(pack8(X, st), __builtin_bit_cast(bf16x8, (u32x4){lo[0], lo[1], hi[0], hi[1]}), O, 0, 0, 0); }
#pragma unroll
        for (int db = 0; db < 4; ++db)
#pragma unroll
          for (int st = 0; st < 2; ++st) { const bf16_t* qp = Qt + l31 * QS + 32 * db + 16 * st + 4 * h5; const u32x2 lo = *(const u32x2*)qp, hi = *(const u32x2*)(qp + 8);
            O = __builtin_amdgcn_mfma_f32_32x32x16_bf16(__builtin_bit_cast(bf16x8, (u32x4){lo[0], lo[1], hi[0], hi[1]}), pack8(S[db], st), O, 0, 0, 0); }
      }
#pragma unroll
      for (int db = 0; db < 4; ++db) {
#pragma unroll
        for (int r4 = 0; r4 < 4; ++r4) { const f32x4 dv = *(const f32x4*)(dec + 32 * db + 8 * r4 + 4 * h5);
#pragma unroll
          for (int e = 0; e < 4; ++e) S[db][4 * r4 + e] *= dv[e]; }
#pragma unroll
        for (int st = 0; st < 2; ++st) { const bf16x8 a = *(const bf16x8*)(KeT + (32 * db + l31) * KES + 16 * st + 8 * h5), bv = *(const bf16x8*)(Vt + (vb * 32 + l31) * KES + 16 * st + 8 * h5);
          S[db] = __builtin_amdgcn_mfma_f32_32x32x16_bf16(a, bv, S[db], 0, 0, 0); } }
      if (MODE == 1) {
#pragma unroll
        for (int r = 0; r < 16; ++r) cumb[crow(r, h5) * CUS + vb * 32 + l31] = O[r];
        LBAR();
        const int t = t2, vg = dg; const size_t o = (tok0 + t) * D + h * 128 + vg * 16;
        f32x4 ov[4]; float ss = 0.f;
#pragma unroll
        for (int g4 = 0; g4 < 4; ++g4) { ov[g4] = *(const f32x4*)(cumb + t * CUS + vg * 16 + 4 * g4); ss += ov[g4][0] * ov[g4][0] + ov[g4][1] * ov[g4][1] + ov[g4][2] * ov[g4][2] + ov[g4][3] * ov[g4][3]; }
        ss += __shfl_xor(ss, 1); ss += __shfl_xor(ss, 2); ss += __shfl_xor(ss, 4);
        const float rstd = rsqrtf(ss * (1.f / 128.f) + EPS);
        unsigned w[8];
#pragma unroll
        for (int g4 = 0; g4 < 4; ++g4) { const f32x4 gn = *(const f32x4*)(p->hg_gn_g + l * 128 + vg * 16 + 4 * g4);
#pragma unroll
          for (int e2 = 0; e2 < 2; ++e2) { const int wi = g4 * 2 + e2; const unsigned gw = (wi < 4) ? g0[wi & 3] : g1[wi & 3];
            w[wi] = pk2(ov[g4][2 * e2] * rstd * gn[2 * e2] * bf2f(gw & 0xffffu), ov[g4][2 * e2 + 1] * rstd * gn[2 * e2 + 1] * bf2f(gw >> 16)); } }
        *(u32x4*)(B.on + o) = (u32x4){w[0], w[1], w[2], w[3]}; *(u32x4*)(B.on + o + 8) = (u32x4){w[4], w[5], w[6], w[7]};
      } else {
        LBAR();
      }
    }
    if (MODE == 0) {
      float* dSo = dS + (size_t)item * 16384 + vb * 32 + l31;
#pragma unroll
      for (int db = 0; db < 4; ++db)
#pragma unroll
        for (int r = 0; r < 16; ++r) dSo[(size_t)(32 * db + crow(r, h5)) * 128] = S[db][r];
      if (th < 128) Lsum[(size_t)item * 128 + th] = Ltot;
    } else if (span == NSPAN - 1) {
      float* so = p->out + O_HGP + ((size_t)((l * 4 + b) * 8 + h)) * 16384 + vb * 32 + l31;
#pragma unroll
      for (int db = 0; db < 4; ++db)
#pragma unroll
        for (int r = 0; r < 16; ++r) so[(size_t)(32 * db + crow(r, h5)) * 128] = S[db][r];
    }
    __syncthreads();
  }
}

DI void scan_passB(const HgBufs& B) {
  const int tid = tid_get();
  float* dS = B.o32; const float* Lsum = B.o32 + (size_t)512 * 16384;
  const int gt = blockIdx.x * NTHREADS + tid, NGT = gridDim.x * NTHREADS;
#pragma unroll 1
  for (int e = gt; e < 32 * 4096; e += NGT) { const int bh = e >> 12, q4 = e & 4095, d = q4 >> 5;
    float* base = dS + (size_t)bh * NSPAN * 16384 + (size_t)q4 * 4; const float* Lb = Lsum + (size_t)bh * NSPAN * 128 + d;
    f32x4 v[NSPAN]; float lv[NSPAN];
#pragma unroll
    for (int sp = 0; sp < NSPAN; ++sp) { v[sp] = *(const f32x4*)(base + (size_t)sp * 16384); lv[sp] = Lb[sp * 128]; }
    f32x4 run = (f32x4){0.f, 0.f, 0.f, 0.f};
#pragma unroll
    for (int sp = 0; sp < NSPAN; ++sp) { *(f32x4*)(base + (size_t)sp * 16384) = run; run = run * __expf(lv[sp]) + v[sp]; }
  }
}

DI void scan_phase(KP p, const int l, const HgBufs& B, unsigned char* shm) {
  scan_prompt<0>(p, l, B, shm);
  const int tid = tid_get(), lane = tid & 63, wave = tid >> 6;
  {
    float* ps = (float*)shm;
    const int v4 = (tid & 31) * 4, dq = tid >> 5;
    f32x4 sv[8], svn[8]; float lfv[8], lfn[8]; unsigned kq[8], kqn[8]; u32x2 vw, vwn;
#define SMP_LOAD(IT, SV, LF, KQ, VW) do { const int bs_ = (IT) >> 3, h_ = (IT) & 7; const size_t r_ = TP + bs_; \
      const float* s0_ = p->state_hgrn + ((size_t)((l * 128 + bs_) * 8 + h_)) * 16384; \
      VW = *(const u32x2*)(B.v + r_ * D + h_ * 128 + v4); \
      _Pragma("unroll") for (int i = 0; i < 8; ++i) { const int d_ = dq * 8 + i; const size_t o_ = r_ * D + h_ * 128 + d_; \
        LF[i] = B.lf[o_]; KQ[i] = (unsigned)B.q[o_]; SV[i] = __builtin_nontemporal_load((const f32x4*)(s0_ + d_ * 128 + v4)); } } while (0)
    int item = blockIdx.x, par = 0;
    if (item < 1024) SMP_LOAD(item, sv, lfv, kq, vw);
#pragma unroll 1
    for (; item < 1024; item += gridDim.x, par ^= 1) {
      const int bs = item >> 3, h = item & 7; const size_t r = TP + bs;
      const int nitem = item + gridDim.x;
      if (nitem < 1024) SMP_LOAD(nitem, svn, lfn, kqn, vwn);
      float* s1 = p->out + O_HGS + ((size_t)((l * 128 + bs) * 8 + h)) * 16384;
      const f32x4 vv = (f32x4){bf2f(vw[0] & 0xffffu), bf2f(vw[0] >> 16), bf2f(vw[1] & 0xffffu), bf2f(vw[1] >> 16)};
      f32x4 op = (f32x4){0.f, 0.f, 0.f, 0.f};
#pragma unroll
      for (int i = 0; i < 8; ++i) { const int d = dq * 8 + i;
        const float f = __expf(lfv[i]), kk = 1.f - f, qq = bf2f(kq[i]);
        const f32x4 sn = sv[i] * f + vv * kk;
        __builtin_nontemporal_store(sn, (f32x4*)(s1 + d * 128 + v4)); op += sn * qq; }
#pragma unroll
      for (int jx = 0; jx < 4; ++jx) op[jx] += __shfl_xor(op[jx], 32);
      float* psb = ps + par * 1024;
      if (lane < 32) *(f32x4*)(psb + wave * 128 + v4) = op;
      __syncthreads();
      if (tid < 64) { float o0 = 0.f, o1 = 0.f;
#pragma unroll
        for (int w = 0; w < 8; ++w) { const f32x2 x = *(const f32x2*)(psb + w * 128 + tid * 2); o0 += x[0]; o1 += x[1]; }
        float ss = o0 * o0 + o1 * o1;
#pragma unroll
        for (int o = 1; o < 64; o <<= 1) ss += __shfl_xor(ss, o);
        const float rstd = rsqrtf(ss * (1.f / 128.f) + EPS);
        const int vv2 = tid * 2; const size_t o = r * D + h * 128 + vv2;
        const float g0 = p->hg_gn_g[l * 128 + vv2], g1 = p->hg_gn_g[l * 128 + vv2 + 1];
        *(unsigned*)(B.on + o) = pk2(o0 * rstd * g0 * bf2f(B.g[o]), o1 * rstd * g1 * bf2f(B.g[o + 1])); }
#pragma unroll
      for (int i = 0; i < 8; ++i) { sv[i] = svn[i]; lfv[i] = lfn[i]; kq[i] = kqn[i]; }
      vw = vwn;
    }
    __syncthreads();
  }
}

constexpr int KN_STRIDE = 72, VT_STRIDE = 264;
constexpr int KN_BYTES = 256 * KN_STRIDE * 2;
struct AtBufs { const bf16_t* qraw; const float* kvraw; bf16_t* on; const float* tab; };

DI void attn_phase(KP p, const int l, const AtBufs& B, unsigned char* shm) {
  const int tid = tid_get(), lane = tid & 63, wave = tid >> 6;
  const int j = l - 2;
  const float* qg = p->q_norm_g + j * 64; const float* sinkp = p->sinks + j * 16;
  const bool write_cache = (l == 2);
  const int nitems = 512 + 512;
#pragma unroll 1
  for (int item = blockIdx.x; item < 512; item += gridDim.x) {
    {
      const int b = item >> 7, qb = (item >> 2) & 31, kvh = item & 3;
      bf16_t* Kn = (bf16_t*)shm; bf16_t* Vt = (bf16_t*)(shm + KN_BYTES);
      const int band0 = (qb - 1) * 128;
      {
        const int key = tid >> 1, part = tid & 1; const int pos = band0 + key; const bool valid = pos >= 0;
        float x1[16], x2[16];
        if (valid) { const float* kp = B.kvraw + ((size_t)b * SEQ + pos) * 512 + kvh * 64 + part * 16;
#pragma unroll
          for (int i = 0; i < 4; ++i) { const f32x4 a = *(const f32x4*)(kp + 4 * i), c = *(const f32x4*)(kp + 32 + 4 * i);
#pragma unroll
            for (int e = 0; e < 4; ++e) { x1[4 * i + e] = a[e]; x2[4 * i + e] = c[e]; } }
        } else {
#pragma unroll
          for (int i = 0; i < 16; ++i) { x1[i] = 0.f; x2[i] = 0.f; } }
        float ss = 0.f;
#pragma unroll
        for (int i = 0; i < 16; ++i) ss += x1[i] * x1[i] + x2[i] * x2[i];
        ss += __shfl_xor(ss, 1);
        const float rstd = rsqrtf(ss * (1.f / 64.f) + EPS);
        const float* tb = B.tab + (size_t)(valid ? pos : 0) * 64 + part * 16;
        float o1[16], o2[16];
#pragma unroll
        for (int i = 0; i < 16; ++i) { const float a = x1[i] * rstd * p->k_norm_g[part * 16 + i], c = x2[i] * rstd * p->k_norm_g[32 + part * 16 + i];
          const float cs = tb[i], sn = tb[32 + i]; o1[i] = a * cs - c * sn; o2[i] = c * cs + a * sn; }
        u32x4 w;
        w = (u32x4){pk2(o1[0], o1[1]), pk2(o1[2], o1[3]), pk2(o1[4], o1[5]), pk2(o1[6], o1[7])}; *(u32x4*)(Kn + key * KN_STRIDE + part * 16) = w;
        w = (u32x4){pk2(o1[8], o1[9]), pk2(o1[10], o1[11]), pk2(o1[12], o1[13]), pk2(o1[14], o1[15])}; *(u32x4*)(Kn + key * KN_STRIDE + part * 16 + 8) = w;
        w = (u32x4){pk2(o2[0], o2[1]), pk2(o2[2], o2[3]), pk2(o2[4], o2[5]), pk2(o2[6], o2[7])}; *(u32x4*)(Kn + key * KN_STRIDE + 32 + part * 16) = w;
        w = (u32x4){pk2(o2[8], o2[9]), pk2(o2[10], o2[11]), pk2(o2[12], o2[13]), pk2(o2[14], o2[15])}; *(u32x4*)(Kn + key * KN_STRIDE + 32 + part * 16 + 8) = w;
        if (write_cache && qb == 31 && key >= 128) { float* ko = p->out + O_KP + ((size_t)(b * 128 + key - 128) * 4 + kvh) * 64 + part * 16;
#pragma unroll
          for (int i = 0; i < 4; ++i) { *(f32x4*)(ko + 4 * i) = (f32x4){o1[4 * i], o1[4 * i + 1], o1[4 * i + 2], o1[4 * i + 3]};
            *(f32x4*)(ko + 32 + 4 * i) = (f32x4){o2[4 * i], o2[4 * i + 1], o2[4 * i + 2], o2[4 * i + 3]}; } }
      }
      {
        const int key = tid & 255, dh = tid >> 8; const int pos = band0 + key; const bool valid = pos >= 0;
        const float* vp = B.kvraw + ((size_t)b * SEQ + (valid ? pos : 0)) * 512 + 256 + kvh * 64 + dh * 32;
#pragma unroll
        for (int i = 0; i < 8; ++i) { f32x4 a = *(const f32x4*)(vp + 4 * i); if (!valid) a = (f32x4){0.f, 0.f, 0.f, 0.f};
#pragma unroll
          for (int e = 0; e < 4; ++e) Vt[(dh * 32 + 4 * i + e) * VT_STRIDE + key] = (bf16_t)f2bf(a[e]);
          if (write_cache && qb == 31 && key >= 128) *(f32x4*)(p->out + O_VP + ((size_t)(b * 128 + key - 128) * 4 + kvh) * 64 + dh * 32 + 4 * i) = a; }
      }
      __syncthreads();
      const int g = wave & 3, qhalf = wave >> 2, hq = kvh * 4 + g, h = lane >> 5, l31 = lane & 31;
      const float sink = sinkp[hq];
#pragma unroll 1
      for (int sub = 0; sub < 2; ++sub) {
        const int Q0 = 128 + qhalf * 64 + sub * 32, qi = Q0 + l31, pos = band0 + qi;
        const size_t tok = (size_t)b * SEQ + pos;
        float x[4][8];
        { const bf16_t* qp = B.qraw + tok * D + hq * 64 + 8 * h;
#pragma unroll
          for (int s = 0; s < 4; ++s) { const u32x4 w = *(const u32x4*)(qp + 16 * s);
#pragma unroll
            for (int e = 0; e < 4; ++e) { x[s][2 * e] = bf2f(w[e] & 0xffffu); x[s][2 * e + 1] = bf2f(w[e] >> 16); } } }
        float ss = 0.f;
#pragma unroll
        for (int s = 0; s < 4; ++s)
#pragma unroll
          for (int e = 0; e < 8; ++e) ss += x[s][e] * x[s][e];
        ss += __shfl_xor(ss, 32);
        const float rstd = rsqrtf(ss * (1.f / 64.f) + EPS) ;
#pragma unroll
        for (int s = 0; s < 4; ++s)
#pragma unroll
          for (int e = 0; e < 8; ++e) x[s][e] *= rstd * qg[16 * s + 8 * h + e];
        const float* tb = B.tab + (size_t)pos * 64;
        bf16x8 qf[4];
#pragma unroll
        for (int s = 0; s < 2; ++s) { unsigned lo[4], hi[4]; float r1[8], r2[8];
#pragma unroll
          for (int e = 0; e < 8; ++e) { const int i = 16 * s + 8 * h + e; const float cs = tb[i], sn = tb[32 + i]; const float a = x[s][e], c = x[s + 2][e];
            r1[e] = (a * cs - c * sn) * 0.125f; r2[e] = (c * cs + a * sn) * 0.125f; }
#pragma unroll
          for (int e = 0; e < 4; ++e) { lo[e] = pk2(r1[2 * e], r1[2 * e + 1]); hi[e] = pk2(r2[2 * e], r2[2 * e + 1]); }
          qf[s] = __builtin_bit_cast(bf16x8, (u32x4){lo[0], lo[1], lo[2], lo[3]}); qf[s + 2] = __builtin_bit_cast(bf16x8, (u32x4){hi[0], hi[1], hi[2], hi[3]}); }
        const int kb0 = (Q0 - 128) >> 5;
        f32x16 sacc[5]; float mx = sink;
#pragma unroll
        for (int i = 0; i < 5; ++i) { const int kb = kb0 + i; f32x16 a16;
#pragma unroll
          for (int r = 0; r < 16; ++r) a16[r] = 0.f;
          bf16x8 ka[4];
#pragma unroll
          for (int s = 0; s < 4; ++s) ka[s] = *(const bf16x8*)(Kn + (kb * 32 + l31) * KN_STRIDE + 16 * s + 8 * h);
#pragma unroll
          for (int s = 0; s < 4; ++s) a16 = __builtin_amdgcn_mfma_f32_32x32x16_bf16(ka[s], qf[s], a16, 0, 0, 0);
#pragma unroll
          for (int r = 0; r < 16; ++r) { const int key = kb * 32 + crow(r, h); const int rel = qi - key; const bool ok = (rel >= 0) && (rel < 128) && (qb > 0 || key >= 128);
            const float sv = ok ? a16[r] : -1e30f; a16[r] = sv; mx = fmaxf(mx, sv); }
          sacc[i] = a16; }
        mx = fmaxf(mx, __shfl_xor(mx, 32));
        float sum = 0.f; bf16x8 pf[5][2];
#pragma unroll
        for (int i = 0; i < 5; ++i) { float e[16];
#pragma unroll
          for (int r = 0; r < 16; ++r) { e[r] = __expf(sacc[i][r] - mx); sum += e[r]; }
#pragma unroll
          for (int st = 0; st < 2; ++st) pf[i][st] = __builtin_bit_cast(bf16x8, (u32x4){pk2(e[8 * st], e[8 * st + 1]), pk2(e[8 * st + 2], e[8 * st + 3]), pk2(e[8 * st + 4], e[8 * st + 5]), pk2(e[8 * st + 6], e[8 * st + 7])}); }
        sum += __shfl_xor(sum, 32);
        const float inv = 1.f / (sum + __expf(sink - mx));
#pragma unroll
        for (int db = 0; db < 2; ++db) { f32x16 o16;
#pragma unroll
          for (int r = 0; r < 16; ++r) o16[r] = 0.f;
          bf16x8 va[10];
#pragma unroll
          for (int i = 0; i < 5; ++i)
#pragma unroll
            for (int st = 0; st < 2; ++st) { const bf16_t* vp = Vt + (db * 32 + l31) * VT_STRIDE + (kb0 + i) * 32 + 16 * st + 4 * h;
              const u32x2 lo = *(const u32x2*)vp, hi = *(const u32x2*)(vp + 8);
              va[i * 2 + st] = __builtin_bit_cast(bf16x8, (u32x4){lo[0], lo[1], hi[0], hi[1]}); }
          f32x16 o16b;
#pragma unroll
          for (int r = 0; r < 16; ++r) o16b[r] = 0.f;
#pragma unroll
          for (int i = 0; i < 5; ++i) { o16 = __builtin_amdgcn_mfma_f32_32x32x16_bf16(va[i * 2], pf[i][0], o16, 0, 0, 0); o16b = __builtin_amdgcn_mfma_f32_32x32x16_bf16(va[i * 2 + 1], pf[i][1], o16b, 0, 0, 0); }
#pragma unroll
          for (int r = 0; r < 16; ++r) o16[r] += o16b[r];
          bf16_t* op = B.on + tok * D + hq * 64 + db * 32 + 4 * h;
#pragma unroll
          for (int r4 = 0; r4 < 4; ++r4) *(u32x2*)(op + 8 * r4) = (u32x2){pk2(o16[4 * r4] * inv, o16[4 * r4 + 1] * inv), pk2(o16[4 * r4 + 2] * inv, o16[4 * r4 + 3] * inv)}; }
      }
      __syncthreads();
    }
  }
  {
    const int tid = tid_get(), lane = tid & 63, wave = tid >> 6;
#pragma unroll 1
    for (int item = 512 + blockIdx.x; item < nitems; item += gridDim.x) {
      const int sidx = item - 512, bs = sidx >> 2, kvh = sidx & 3; const size_t r = TP + bs;
      float* Ks = (float*)shm; float* Vs = Ks + 128 * 68; float* q_s = Vs + 128 * 64; float* p_s = q_s + 256; float* redm = p_s + 512; float* reds = redm + 8; float* po = reds + 8;
      const float* tb = B.tab + (size_t)4096 * 64;
      f32x4 kreg[4], vreg[4];
#pragma unroll
      for (int i = 0; i < 4; ++i) { const int e = tid + 512 * i, jr = e >> 4, c4 = (e & 15) * 4;
        if (jr < 127) { const size_t o = (((size_t)bs * 128 + jr + 1) * 4 + kvh) * 64 + c4; kreg[i] = __builtin_nontemporal_load((const f32x4*)(p->cache_k + o)); vreg[i] = __builtin_nontemporal_load((const f32x4*)(p->cache_v + o)); } }
      if (tid < 128) { const int g = tid >> 5, i = tid & 31, hq = kvh * 4 + g;
        float a = bf2f(B.qraw[r * D + hq * 64 + i]), c = bf2f(B.qraw[r * D + hq * 64 + 32 + i]);
        float ss = a * a + c * c;
#pragma unroll
        for (int o = 1; o < 32; o <<= 1) ss += __shfl_xor(ss, o);
        const float rstd = rsqrtf(ss * (1.f / 64.f) + EPS); a *= rstd * qg[i]; c *= rstd * qg[32 + i];
        const float cs = tb[i], sn = tb[32 + i];
        q_s[g * 64 + i] = (a * cs - c * sn) * 0.125f; q_s[g * 64 + 32 + i] = (c * cs + a * sn) * 0.125f;
      } else if (tid < 160) { const int i = tid & 31;
        float a = B.kvraw[r * 512 + kvh * 64 + i], c = B.kvraw[r * 512 + kvh * 64 + 32 + i];
        float ss = a * a + c * c;
#pragma unroll
        for (int o = 1; o < 32; o <<= 1) ss += __shfl_xor(ss, o);
        const float rstd = rsqrtf(ss * (1.f / 64.f) + EPS); a *= rstd * p->k_norm_g[i]; c *= rstd * p->k_norm_g[32 + i];
        const float cs = tb[i], sn = tb[32 + i];
        const float k1 = a * cs - c * sn, k2 = c * cs + a * sn, v1 = B.kvraw[r * 512 + 256 + kvh * 64 + i], v2 = B.kvraw[r * 512 + 256 + kvh * 64 + 32 + i];
        Ks[127 * 68 + i] = k1; Ks[127 * 68 + 32 + i] = k2; Vs[127 * 64 + i] = v1; Vs[127 * 64 + 32 + i] = v2;
        if (write_cache) { float* ok = p->out + O_KS + (((size_t)bs * 128 + 127) * 4 + kvh) * 64; float* ov = p->out + O_VS + (((size_t)bs * 128 + 127) * 4 + kvh) * 64;
          ok[i] = k1; ok[32 + i] = k2; ov[i] = v1; ov[32 + i] = v2; } }
#pragma unroll
      for (int i = 0; i < 4; ++i) { const int e = tid + 512 * i, jr = e >> 4, c4 = (e & 15) * 4;
        if (jr < 127) { *(f32x4*)(Ks + jr * 68 + c4) = kreg[i]; *(f32x4*)(Vs + jr * 64 + c4) = vreg[i];
          if (write_cache) { const size_t o = (((size_t)bs * 128 + jr) * 4 + kvh) * 64 + c4; __builtin_nontemporal_store(kreg[i], (f32x4*)(p->out + O_KS + o)); __builtin_nontemporal_store(vreg[i], (f32x4*)(p->out + O_VS + o)); } } }
      __syncthreads();
      const int g = tid >> 7, jk = tid & 127, hq = kvh * 4 + g; const float sink = sinkp[hq];
      float sc = 0.f;
#pragma unroll
      for (int d4 = 0; d4 < 16; ++d4) { const f32x4 kv = *(const f32x4*)(Ks + jk * 68 + 4 * d4), qv = *(const f32x4*)(q_s + g * 64 + 4 * d4); sc += kv[0] * qv[0] + kv[1] * qv[1] + kv[2] * qv[2] + kv[3] * qv[3]; }
      float mx = sc;
#pragma unroll
      for (int o = 1; o < 64; o <<= 1) mx = fmaxf(mx, __shfl_xor(mx, o));
      if (lane == 0) redm[wave] = mx;
      __syncthreads();
      mx = fmaxf(fmaxf(redm[2 * g], redm[2 * g + 1]), sink);
      const float ev = __expf(sc - mx); float sum = ev;
#pragma unroll
      for (int o = 1; o < 64; o <<= 1) sum += __shfl_xor(sum, o);
      if (lane == 0) reds[wave] = sum;
      p_s[g * 128 + jk] = ev;
      __syncthreads();
      const float inv = 1.f / (reds[2 * g] + reds[2 * g + 1] + __expf(sink - mx));
      { const int d = jk & 63, jh = jk >> 6; float o = 0.f;
#pragma unroll 8
        for (int jx = 0; jx < 64; ++jx) o += p_s[g * 128 + jh * 64 + jx] * Vs[(jh * 64 + jx) * 64 + d];
        po[tid] = o;
        __syncthreads();
        if (jh == 0) { const float tot = (o + po[tid + 64]) * inv; B.on[r * D + hq * 64 + d] = (bf16_t)f2bf(tot); } }
      __syncthreads();
    }
  }
}

#define XB_TMO      128
#define XB_XCNT(j)  (256  + 64 * (j))
#define XB_XSUB(j)  (1280 + 64 * (j))
#define XB_XGEN(j)  (2304 + 64 * (j))
#define XB_TOP      3328
#define XB_TOPGEN   3392
#define XCD_BAR_WORDS 3456
#define XB_SPIN_CAP (1u << 18)

__device__ __forceinline__ unsigned xb_ld(unsigned* p)              { return __hip_atomic_load(p, __ATOMIC_RELAXED, __HIP_MEMORY_SCOPE_AGENT); }
__device__ __forceinline__ unsigned xb_add(unsigned* p, unsigned v) { return __hip_atomic_fetch_add(p, v, __ATOMIC_RELAXED, __HIP_MEMORY_SCOPE_AGENT); }
__device__ __forceinline__ unsigned xb_xcc_id() { return (unsigned)__builtin_amdgcn_s_getreg((3 << 11) | 20) & 0xFu; }
#define XB_SPIN(cond, bar) do { unsigned _sp = 0; while (cond) { __builtin_amdgcn_s_sleep(1); \
    if ((++_sp & 255u) == 0u) { if (xb_ld(&(bar)[XB_TMO])) break; if (_sp > XB_SPIN_CAP) { atomicAdd(&(bar)[XB_TMO], 1u); break; } } } } while (0)

struct XcdBarrier {
    unsigned* bar; unsigned x;
    volatile LAS unsigned* st;
};

__device__ __forceinline__ XcdBarrier xcd_barrier_post(unsigned* bar, volatile LAS unsigned* st) {
    XcdBarrier b; b.bar = bar; b.x = xb_xcc_id(); b.st = st;
    if (threadIdx.x == 0) (void)xb_add(&bar[XB_XCNT(b.x)], 1u);
    return b;
}
__device__ __forceinline__ void xcd_barrier_complete(unsigned* bar, unsigned x, unsigned& nloc, unsigned& nx) {
    const unsigned G = gridDim.x * gridDim.y * gridDim.z;
    unsigned sum, cnt, mine, sp = 0u;
    for (;;) {
        sum = 0u; cnt = 0u; mine = 0u;
#pragma unroll
        for (unsigned j = 0; j < 16; ++j) { const unsigned c = xb_ld(&bar[XB_XCNT(j)]); sum += c; cnt += (c > 0u) ? 1u : 0u; mine = (j == x) ? c : mine; }
        if (sum == G) break;
        __builtin_amdgcn_s_sleep(1);
        if ((++sp & 255u) == 0u) { if (xb_ld(&bar[XB_TMO])) break; if (sp > XB_SPIN_CAP) { atomicAdd(&bar[XB_TMO], 1u); break; } }
    }
    nloc = mine > 0u ? mine : 1u; nx = cnt > 0u ? cnt : 1u;
}

__device__ __forceinline__ void xcd_barrier(const XcdBarrier& b) {
    asm volatile("s_waitcnt vmcnt(0)" ::: "memory");
    __syncthreads();
    if (threadIdx.x == 0) {
        unsigned* bar = b.bar;
        __builtin_amdgcn_s_waitcnt(0);
        unsigned nloc = b.st[0], nx = b.st[1];
        if (nloc == 0u) { xcd_barrier_complete(bar, b.x, nloc, nx); b.st[0] = nloc; b.st[1] = nx; }
        const unsigned old = xb_add(&bar[XB_XSUB(b.x)], 1u);
        const unsigned gen = old / nloc;
        if (old + 1u == (gen + 1u) * nloc) {
            __builtin_amdgcn_fence(__ATOMIC_RELEASE, "agent");
            asm volatile("s_waitcnt vmcnt(0)" ::: "memory");
            const unsigned og = xb_add(&bar[XB_TOP], 1u);
            const unsigned tg = og / nx;
            if (og + 1u == (tg + 1u) * nx) xb_add(&bar[XB_TOPGEN], 1u);
            else XB_SPIN(xb_ld(&bar[XB_TOPGEN]) == tg, bar);
            __builtin_amdgcn_fence(__ATOMIC_ACQUIRE, "agent");
            xb_add(&bar[XB_XGEN(b.x)], 1u);
            asm volatile("s_waitcnt vmcnt(0)" ::: "memory");
        } else {
            XB_SPIN(xb_ld(&bar[XB_XGEN(b.x)]) == gen, bar);
            __builtin_amdgcn_fence(__ATOMIC_ACQUIRE, "agent");
            asm volatile("s_waitcnt vmcnt(0)" ::: "memory");
        }
    }
    __syncthreads();
}


__global__ void __launch_bounds__(NTHREADS, 2) yoco_fwd(P parg) {
  extern __shared__ __attribute__((aligned(16))) unsigned char shm[];
  cg::grid_group grid = cg::this_grid();
  volatile LAS unsigned* xst = (volatile LAS unsigned*)((LAS unsigned char*)shm + 131072);
  if (threadIdx.x < 4) xst[threadIdx.x] = 0u;
  __syncthreads();
  { KP p0 = kp_get(); (void)xcd_barrier_post((unsigned*)(p0->ws + OFF_BAR), xst); }
  const int nMt = TP / BM;
#pragma unroll 1
  for (int step = -2; step < 32; ++step) {
    const int l = (step < 0) ? 0 : (step >> 3), sub = (step < 0) ? (8 + step + 2) : (step & 7); const bool hg = (l < 2);
    if (sub == 3 && !hg) continue;
    if (sub == 5 || (sub == 0 && l > 0)) continue;
    KP p = kp_get(); unsigned char* ws = p->ws;
#ifndef PROBE_REPS
#define PROBE_REPS 1
#endif
#ifndef PROBE_GREPS
#define PROBE_GREPS 1
#endif
    const bool is_gemm = (sub == 0 || sub == 1 || sub == 4 || sub == 6 || sub == 7 || sub == 9);
#ifndef PROBE_MASK
#define PROBE_MASK 0
#endif
    const int pcode = (sub == 2 && !hg) ? 10 : sub;
    const int reps = (((PROBE_MASK >> pcode) & 1) && !(sub == 4 || sub == 7)) ? 2 : 1;
#pragma unroll 1
    for (int rep = 0; rep < reps; ++rep) {
    if (sub == 8) {
      prep_phase(p, shm);
    } else if (sub == 0 || sub == 1 || sub == 4 || sub == 6 || sub == 7 || sub == 9) {
      float* mods = (float*)(ws + OFF_MODS);
      bf16_t* hbuf = (bf16_t*)(ws + OFF_H); bf16_t* onbuf = (bf16_t*)(ws + OFF_ON); bf16_t* ubuf = (bf16_t*)(ws + OFF_U);
      GemmJob j0, j1; EpiArgs E{}; int nj = 1; E.layer = l; E.first = 0;
      float* rssb = (float*)(ws + OFF_RSS); const float* biasb = (const float*)(ws + OFF_BIAS);
      j1.A = (const bf16_t*)(ws + OFF_X); j1.Bt = (const bf16_t*)(ws + OFF_WKV); j1.nM = nMt; j1.nN = 2; j1.K = D; j1.epi = EPI_KVRAW;
      j0.nM = nMt; j0.K = D;
      if (sub == 0) { j0.A = (const bf16_t*)(ws + OFF_ASH); j0.Bt = (const bf16_t*)ws; j0.nM = 1; j0.nN = 106; j0.epi = EPI_BIAS; j1.A = (const bf16_t*)(ws + OFF_BIAS); }
      else if (sub == 9) { j0.A = (const bf16_t*)(ws + OFF_X + (size_t)MODW * D * 2); j0.Bt = (const bf16_t*)(ws + OFF_X); j0.nM = 1; j0.nN = MODW / BM; j0.epi = EPI_ADA; E.f0 = mods; E.ash = (bf16_t*)(ws + OFF_ASH); }
      else if (sub == 1 && hg) { E.rss = rssb + (size_t)(2 * l) * T; E.bias = biasb + (size_t)132 * site_prefN(l); E.bN = 4096; j0.A = hbuf; j0.Bt = (const bf16_t*)(ws + OFF_WIN) + (size_t)l * 4096 * D; j0.nN = 16; j0.epi = EPI_HGIN;
        E.f0 = (float*)(ws + OFF_X); E.b0 = (bf16_t*)(ws + OFF_U); E.b1 = (bf16_t*)(ws + OFF_U + SZ_ACT); E.b2 = (bf16_t*)(ws + OFF_U + 2 * SZ_ACT); E.b3 = (bf16_t*)(ws + OFF_U + 3 * SZ_ACT); }
      else if (sub == 1) { E.rss = rssb + (size_t)(2 * l) * T; E.bias = biasb + (size_t)132 * site_prefN(l); E.bN = 1024; E.bias1 = biasb + (size_t)132 * site_prefN(4); E.bN1 = 512; j0.A = hbuf; j0.Bt = (const bf16_t*)(ws + OFF_WQ) + (size_t)(l - 2) * D * D; j0.nN = 4; j0.epi = EPI_QRAW;
        E.b1 = (bf16_t*)(ws + OFF_X + SZ_ACT); E.f2 = (float*)(ws + OFF_X + 2 * SZ_ACT); nj = (l == 2) ? 2 : 1; }
      else if (sub == 4) { E.rss_out = rssb + (size_t)(1 + 2 * l) * T; E.ng = p->norm2_g + l * D; E.nsc = mods + l * 6144 + 4096; E.yout = hbuf; j0.A = onbuf; j0.Bt = hg ? (const bf16_t*)(ws + OFF_WOUT) + (size_t)l * D * D : (const bf16_t*)(ws + OFF_WO) + (size_t)(l - 2) * D * D; j0.nN = 4; j0.epi = EPI_RESID;
        E.f0 = p->out + O_Y; E.f1 = mods + l * 6144 + 2048; E.first = (l == 0); }
      else if (sub == 6) { E.rss = rssb + (size_t)(1 + 2 * l) * T; E.bias = biasb + (size_t)132 * site_prefN(5 + l); E.bN = 4096; j0.A = hbuf; j0.Bt = (const bf16_t*)(ws + OFF_WUP) + (size_t)l * D * FF; j0.nN = 16; j0.epi = EPI_UP; E.b0 = ubuf; }
      else { if (l < 3) { E.rss_out = rssb + (size_t)(2 * (l + 1)) * T; E.ng = p->norm1_g + (l + 1) * D; E.nsc = mods + (l + 1) * 6144 + 1024; E.yout = hbuf;
          if (l == 1) { E.ngkv = p->kv_norm_g; E.nsckv = mods + 24576 + 1024; E.ykv = (bf16_t*)(ws + OFF_X); } }
        j0.A = ubuf; j0.Bt = (const bf16_t*)(ws + OFF_WDN) + (size_t)l * D * FF; j0.nN = 4; j0.K = FF; j0.epi = EPI_RESID; E.f0 = p->out + O_Y; E.f1 = mods + l * 6144 + 5120; }
      gemm_phase(p, (LAS unsigned char*)shm, shm, j0, j1, nj, E, sub != 9 && sub != 0);
      if (sub == 0) init_rows(p, (unsigned*)(ws + OFF_BAR) + XCD_BAR_WORDS + 100);
    } else if (sub == 2 && hg) {
      HgBufs HB; HB.q = (bf16_t*)(ws + OFF_U); HB.k = (bf16_t*)(ws + OFF_U + SZ_ACT); HB.v = (bf16_t*)(ws + OFF_U + 2 * SZ_ACT); HB.g = (bf16_t*)(ws + OFF_U + 3 * SZ_ACT);
      HB.lf = (float*)(ws + OFF_X); HB.o32 = (float*)(ws + OFF_X + 2 * SZ_ACT); HB.on = (bf16_t*)(ws + OFF_ON);
      scan_phase(p, l, HB, shm);
    } else if (sub == 2) {
      AtBufs AB; AB.qraw = (bf16_t*)(ws + OFF_X + SZ_ACT); AB.kvraw = (float*)(ws + OFF_X + 2 * SZ_ACT); AB.on = (bf16_t*)(ws + OFF_ON); AB.tab = (const float*)(ws + OFF_TAB);
      attn_phase(p, l, AB, shm);
    } else {
      HgBufs HB; HB.q = (bf16_t*)(ws + OFF_U); HB.k = (bf16_t*)(ws + OFF_U + SZ_ACT); HB.v = (bf16_t*)(ws + OFF_U + 2 * SZ_ACT); HB.g = (bf16_t*)(ws + OFF_U + 3 * SZ_ACT);
      HB.lf = (float*)(ws + OFF_X); HB.o32 = (float*)(ws + OFF_X + 2 * SZ_ACT); HB.on = (bf16_t*)(ws + OFF_ON);
      scan_passB(HB);
      { KP pb = kp_get(); XcdBarrier xb; xb.bar = (unsigned*)(pb->ws + OFF_BAR); xb.x = xb_xcc_id(); xb.st = xst; xcd_barrier(xb); }
      scan_prompt<1>(p, l, HB, shm);
    }
    }
    if (step == 31) break;
    if (step == -2) grid.sync();
    else { KP pb = kp_get(); XcdBarrier xb; xb.bar = (unsigned*)(pb->ws + OFF_BAR); xb.x = xb_xcc_id(); xb.st = xst; xcd_barrier(xb); }
  }
}

extern "C" void kernel_launch(void* const* d_in, const int* in_sizes, int n_in, void* d_out, int out_size, void* d_ws, size_t ws_size, hipStream_t stream) {
  static int grid_blocks = 0;
  if (!grid_blocks) {
    int dev = 0, cus = 0, per_cu = 0;
    hipGetDevice(&dev);
    hipDeviceGetAttribute(&cus, hipDeviceAttributeMultiprocessorCount, dev);
    if (hipFuncSetAttribute((const void*)yoco_fwd, hipFuncAttributeMaxDynamicSharedMemorySize, LDS_BYTES) != hipSuccess) fprintf(stderr, "hipFuncSetAttribute failed\n");
    if (hipOccupancyMaxActiveBlocksPerMultiprocessor(&per_cu, (const void*)yoco_fwd, NTHREADS, LDS_BYTES) != hipSuccess || per_cu < 1) { fprintf(stderr, "occupancy query failed\n"); per_cu = 1; }
    grid_blocks = cus * per_cu;
    if (ws_size < WS_NEED) fprintf(stderr, "workspace too small: %zu < %zu\n", ws_size, (size_t)WS_NEED);
  }
  P p{};
  const float** pp = (const float**)&p;
  for (int i = 0; i < 26; ++i) pp[i] = (const float*)d_in[i];
  p.out = (float*)d_out; p.ws = (unsigned char*)d_ws;
  (void)hipMemsetAsync((unsigned char*)d_ws + OFF_BAR, 0, ZERO_BYTES, stream);
  void* args[] = {&p};
  hipError_t e = hipLaunchCooperativeKernel((const void*)yoco_fwd, dim3(grid_blocks), dim3(NTHREADS), args, LDS_BYTES, stream);
  if (e != hipSuccess) fprintf(stderr, "cooperative launch failed: %s (grid %d)\n", hipGetErrorString(e), grid_blocks);
}
```

```cpp
#include <hip/hip_runtime.h>
#include <hip/hip_cooperative_groups.h>
#include <cstdio>
#include <cstdint>
namespace cg = cooperative_groups;

#define DI __device__ __forceinline__
typedef unsigned short bf16_t;
typedef short bf16x8 __attribute__((ext_vector_type(8)));
typedef float f32x4 __attribute__((ext_vector_type(4)));
typedef float f32x2 __attribute__((ext_vector_type(2)));
typedef float f32x16 __attribute__((ext_vector_type(16)));
typedef unsigned u32x4 __attribute__((ext_vector_type(4)));
typedef unsigned u32x2 __attribute__((ext_vector_type(2)));
#define LAS __attribute__((address_space(3)))

constexpr int D = 1024, FF = 4096, TP = 16384, TS = 128, T = TP + TS, TPAD = 16640, SEQ = 4096;
constexpr int NMOD = 132, MODW = 4 * 6144 + 2048;
constexpr float EPS = 1e-6f;
constexpr int NTHREADS = 512, NWAVES = 8;
constexpr int LDS_BYTES = 131072 + 16;

constexpr size_t O_Y = 0;
constexpr size_t O_HGP = (size_t)T * D;
constexpr size_t O_KP = O_HGP + (size_t)2 * 4 * 8 * 128 * 128;
constexpr size_t O_VP = O_KP + (size_t)4 * 128 * 4 * 64;
constexpr size_t O_HGS = O_VP + (size_t)4 * 128 * 4 * 64;
constexpr size_t O_KS = O_HGS + (size_t)2 * 128 * 8 * 128 * 128;
constexpr size_t O_VS = O_KS + (size_t)128 * 128 * 4 * 64;

constexpr size_t SZ_ACT = (size_t)TPAD * D * 2;
constexpr size_t OFF_WIN = 0;
constexpr size_t OFF_WOUT = OFF_WIN + (size_t)2 * 4096 * 1024 * 2;
constexpr size_t OFF_WKV = OFF_WOUT + (size_t)2 * 1024 * 1024 * 2;
constexpr size_t OFF_WQ = OFF_WKV + (size_t)512 * 1024 * 2;
constexpr size_t OFF_WO = OFF_WQ + (size_t)2 * 1024 * 1024 * 2;
constexpr size_t OFF_WUP = OFF_WO + (size_t)2 * 1024 * 1024 * 2;
constexpr size_t OFF_WDN = OFF_WUP + (size_t)4 * 4096 * 1024 * 2;
constexpr size_t OFF_MODS = OFF_WDN + (size_t)4 * 4096 * 1024 * 2;
constexpr size_t OFF_TAB = OFF_MODS + (((size_t)NMOD * MODW * 4 + 4095) & ~(size_t)4095);
constexpr size_t OFF_H = OFF_TAB + (((size_t)4097 * 64 * 4 + 4095) & ~(size_t)4095);
constexpr size_t OFF_ON = OFF_H + SZ_ACT;
constexpr size_t OFF_U = OFF_ON + SZ_ACT;
constexpr size_t OFF_X = OFF_U + 4 * SZ_ACT;
constexpr size_t OFF_BAR = OFF_X + 4 * SZ_ACT;
constexpr size_t BAR_BYTES = 16384;
constexpr size_t OFF_RSS = OFF_BAR + BAR_BYTES;
constexpr size_t ZERO_BYTES = BAR_BYTES + (size_t)9 * T * 4;
constexpr size_t OFF_ASH = OFF_BAR + ((ZERO_BYTES + 4095) & ~(size_t)4095);
constexpr size_t OFF_BIAS = OFF_ASH + (size_t)9 * 256 * 1024 * 2;
constexpr size_t WS_NEED = OFF_BIAS + (size_t)132 * 27136 * 4;

struct P {
  const float *x_prompt, *x_sample, *c_prompt, *c_sample, *state_hgrn, *cache_k, *cache_v;
  const float *w_ada, *b_ada, *norm1_g, *norm2_g, *hg_w_in, *hg_w_out, *hg_lbp, *hg_gn_g;
  const float *kv_w_ada, *kv_b_ada, *kv_norm_g, *w_kv, *k_norm_g, *w_q, *q_norm_g, *sinks, *w_o, *w_up, *w_down;
  float* out; unsigned char* ws;
};

typedef const P __attribute__((address_space(4)))* KP;
DI KP kp_get() { KP q = (KP)__builtin_amdgcn_kernarg_segment_ptr(); asm volatile("" : "+s"(q)); return q; }
DI int tid_get() { int t = threadIdx.x; asm volatile("" : "+v"(t)); return t; }
DI unsigned f2bf(float f) { unsigned u = __float_as_uint(f); return (u + 0x7fffu + ((u >> 16) & 1u)) >> 16; }
typedef __bf16 bf16x2_n __attribute__((ext_vector_type(2)));
DI unsigned pk2(float lo, float hi) { return __builtin_bit_cast(unsigned, __builtin_convertvector((f32x2){lo, hi}, bf16x2_n)); }
DI float bf2f(unsigned b) { return __uint_as_float(b << 16); }
DI float silu_f(float x) { return x * __builtin_amdgcn_rcpf(1.f + __expf(-x)); }
DI int modrow(int r) { return r < TP ? (r >> 12) : (4 + r - TP); }
DI int crow(int reg, int h) { return (reg & 3) + 8 * (reg >> 2) + 4 * h; }

constexpr int BM = 256, BK = 64, HALF = 128, HTB = HALF * BK * 2;
DI int lds_byte(int r, int c) { const int st = (r >> 4) * 2 + (c >> 5), rr = r & 15, cc = c & 31, ob = rr * 64 + cc * 2; return st * 1024 + (ob ^ (((ob >> 9) & 1) << 5)); }
DI void stage_rc(int b, int& R, int& C) { const int st = b / 1024, sb = b % 1024, swz = sb ^ (((sb >> 9) & 1) << 5); R = (st >> 1) * 16 + swz / 64; C = (st & 1) * 32 + (swz % 64) / 2; }

enum { EPI_ADA = 0, EPI_HGIN = 1, EPI_RESID = 2, EPI_UP = 3, EPI_QRAW = 4, EPI_KVRAW = 5, EPI_NOP = 6, EPI_BIAS = 7 };
struct GemmJob { const bf16_t* A; const bf16_t* Bt; int nM, nN, K, epi; };
struct EpiArgs {
  float* f0; const float* f1; float* f2; bf16_t* b0; bf16_t* b1; bf16_t* b2; bf16_t* b3; int layer; int first;
  const float* rss; const float* bias; const float* bias1; int bN, bN1;
  float* rss_out; const float* ng; const float* nsc; bf16_t* yout; const float* ngkv; const float* nsckv; bf16_t* ykv;
  bf16_t* ash;
};
DI int site_N(const int s) { return (s == 2 || s == 3) ? 1024 : (s == 4 ? 512 : 4096); }
DI int site_prefN(const int s) { return s == 0 ? 0 : s == 1 ? 4096 : s == 2 ? 8192 : s == 3 ? 9216 : s == 4 ? 10240 : 10752 + (s - 5) * 4096; }

DI void tile_of(int L, int nM, int nN, int& pm, int& pn) {
  const int nwg = nM * nN; int wgid = L;
  { const int q = nwg / 8, r = nwg % 8, xcd = wgid % 8, off = wgid / 8; wgid = (xcd < r ? xcd * (q + 1) : r * (q + 1) + (xcd - r) * q) + off; }
  const int nig = 8 * nN, gid = wgid / nig, fm = gid * 8, gsz = (nM - fm) < 8 ? (nM - fm) : 8;
  pm = fm + ((wgid % nig) % gsz); pn = (wgid % nig) / gsz;
}

DI void epi_frag(KP p, const int epi, const EpiArgs& E, const int r, const int c, const f32x4 vin) {
  if (epi == EPI_NOP) return;
  f32x4 v = vin;
  if (epi == EPI_HGIN || epi == EPI_UP || epi == EPI_QRAW || epi == EPI_KVRAW) {
    const float rstd = rsqrtf(E.rss[r] * (1.f / D) + EPS);
    const float* bp = ((epi == EPI_KVRAW) ? E.bias1 + (size_t)modrow(r) * E.bN1 : E.bias + (size_t)modrow(r) * E.bN) + c;
    v = v * rstd + *(const f32x4*)bp; }
  if (epi == EPI_HGIN) {
    const int sec = c >> 10, cc = c & 1023; const size_t o = (size_t)r * D + cc;
    if (sec == 1) { f32x4 lb = (f32x4){0.f, 0.f, 0.f, 0.f};
      if (E.layer == 1) { const f32x4 l0 = *(const f32x4*)(p->hg_lbp + cc), l1 = *(const f32x4*)(p->hg_lbp + D + cc);
#pragma unroll
        for (int j = 0; j < 4; ++j) lb[j] = __builtin_amdgcn_rcpf(1.f + __expf(l0[j] - l1[j])); }
      f32x4 lf;
#pragma unroll
      for (int j = 0; j < 4; ++j) { const float sg = __builtin_amdgcn_rcpf(1.f + __expf(-v[j])); const float fg = lb[j] + (1.f - lb[j]) * sg; lf[j] = __logf(fg); }
      *(f32x4*)(E.f0 + o) = lf;
    } else if (sec == 2) { *(u32x2*)(E.b2 + o) = (u32x2){pk2(v[0], v[1]), pk2(v[2], v[3])};
    } else { bf16_t* dst = (sec == 0) ? E.b0 : E.b3; *(u32x2*)(dst + o) = (u32x2){pk2(silu_f(v[0]), silu_f(v[1])), pk2(silu_f(v[2]), silu_f(v[3]))}; }
  } else if (epi == EPI_RESID) {
    const float* xin = E.first ? (r < TP ? p->x_prompt + (size_t)r * D : p->x_sample + (size_t)(r - TP) * D) : (E.f0 + (size_t)r * D);
    const size_t mo = (size_t)modrow(r) * MODW;
    const f32x4 xv = *(const f32x4*)(xin + c), gv = *(const f32x4*)(E.f1 + mo + c);
    const f32x4 yn = xv + gv * v;
    *(f32x4*)(E.f0 + (size_t)r * D + c) = yn;
    if (E.yout) {
      const f32x4 g = *(const f32x4*)(E.ng + c), sc = *(const f32x4*)(E.nsc + mo + c); const f32x4 y = yn * g * (sc + 1.f);
      *(u32x2*)(E.yout + (size_t)r * D + c) = (u32x2){pk2(y[0], y[1]), pk2(y[2], y[3])};
      if (E.ykv) { const f32x4 g2 = *(const f32x4*)(E.ngkv + c), sc2 = *(const f32x4*)(E.nsckv + mo + c); const f32x4 y2 = yn * g2 * (sc2 + 1.f);
        *(u32x2*)(E.ykv + (size_t)r * D + c) = (u32x2){pk2(y2[0], y2[1]), pk2(y2[2], y2[3])}; }
      float ss = yn[0] * yn[0] + yn[1] * yn[1] + yn[2] * yn[2] + yn[3] * yn[3];
      ss += __shfl_xor(ss, 1); ss += __shfl_xor(ss, 2);
      if ((tid_get() & 3) == 0) atomicAdd(E.rss_out + r, ss); }
  } else if (epi == EPI_UP) {
    f32x4 u;
#pragma unroll
    for (int j = 0; j < 4; ++j) { const float t = fmaxf(v[j], 0.f); u[j] = t * t; }
    *(u32x2*)(E.b0 + (size_t)r * FF + c) = (u32x2){pk2(u[0], u[1]), pk2(u[2], u[3])};
  } else if (epi == EPI_QRAW) { *(u32x2*)(E.b1 + (size_t)r * D + c) = (u32x2){pk2(v[0], v[1]), pk2(v[2], v[3])};
  } else if (epi == EPI_KVRAW) { *(f32x4*)(E.f2 + (size_t)r * 512 + c) = v; }
}

DI void epi_frag8(KP p, const int epi, const EpiArgs& E, const int r, const int c, const f32x4 v0, const f32x4 v1, const f32x4 lbA = (f32x4){0.f, 0.f, 0.f, 0.f}, const f32x4 lbB = (f32x4){0.f, 0.f, 0.f, 0.f}) {
  if (epi == EPI_NOP) return;
  if (epi == EPI_ADA) { if (r < NMOD) { const float* bp = (c < 24576) ? (p->b_ada + c) : (p->kv_b_ada + (c - 24576)); float* o = E.f0 + (size_t)r * MODW + c;
      const f32x4 m0 = v0 + *(const f32x4*)bp, m1 = v1 + *(const f32x4*)(bp + 4);
      *(f32x4*)o = m0; *(f32x4*)(o + 4) = m1;
      int site = -1;
      if (c < 24576) { const int l = c / 6144, part = (c - l * 6144) >> 10; site = (part == 0) ? l : (part == 3 ? 5 + l : -1); } else if (c < 25600) site = 4;
      if (site >= 0) *(u32x4*)(E.ash + ((size_t)site * 256 + r) * 1024 + (c & 1023)) = (u32x4){pk2(m0[0], m0[1]), pk2(m0[2], m0[3]), pk2(m1[0], m1[1]), pk2(m1[2], m1[3])}; }
  } else if (epi == EPI_HGIN) {
    const int sec = c >> 10, cc = c & 1023; const size_t o = (size_t)r * D + cc;
    if (sec == 1) { float lb[8];
#pragma unroll
      for (int j = 0; j < 4; ++j) { lb[j] = lbA[j]; lb[4 + j] = lbB[j]; }
      float lf[8];
#pragma unroll
      for (int j = 0; j < 8; ++j) { const float x = (j < 4) ? v0[j & 3] : v1[j & 3]; const float sg = __builtin_amdgcn_rcpf(1.f + __expf(-x)); const float fg = lb[j] + (1.f - lb[j]) * sg;
        lf[j] = __logf(fg); }
      *(f32x4*)(E.f0 + o) = (f32x4){lf[0], lf[1], lf[2], lf[3]}; *(f32x4*)(E.f0 + o + 4) = (f32x4){lf[4], lf[5], lf[6], lf[7]};
    } else if (sec == 2) { *(u32x4*)(E.b2 + o) = (u32x4){pk2(v0[0], v0[1]), pk2(v0[2], v0[3]), pk2(v1[0], v1[1]), pk2(v1[2], v1[3])};
    } else { bf16_t* dst = (sec == 0) ? E.b0 : E.b3;
      *(u32x4*)(dst + o) = (u32x4){pk2(silu_f(v0[0]), silu_f(v0[1])), pk2(silu_f(v0[2]), silu_f(v0[3])), pk2(silu_f(v1[0]), silu_f(v1[1])), pk2(silu_f(v1[2]), silu_f(v1[3]))}; }
  } else if (epi == EPI_RESID) {
    const float* xin = E.first ? (r < TP ? p->x_prompt + (size_t)r * D : p->x_sample + (size_t)(r - TP) * D) : (E.f0 + (size_t)r * D);
    const size_t mo = (size_t)modrow(r) * MODW;
    const float* gm = E.f1 + mo + c; float* o = E.f0 + (size_t)r * D + c;
    const f32x4 xa = *(const f32x4*)(xin + c), xb = *(const f32x4*)(xin + c + 4), ga = *(const f32x4*)gm, gb = *(const f32x4*)(gm + 4);
    const f32x4 ya = xa + ga * v0, yb = xb + gb * v1;
    *(f32x4*)o = ya; *(f32x4*)(o + 4) = yb;
    if (E.yout) {
      const f32x4 g0 = *(const f32x4*)(E.ng + c), g1 = *(const f32x4*)(E.ng + c + 4), s0 = *(const f32x4*)(E.nsc + mo + c), s1 = *(const f32x4*)(E.nsc + mo + c + 4);
      const f32x4 y0 = ya * g0 * (s0 + 1.f), y1 = yb * g1 * (s1 + 1.f);
      *(u32x4*)(E.yout + (size_t)r * D + c) = (u32x4){pk2(y0[0], y0[1]), pk2(y0[2], y0[3]), pk2(y1[0], y1[1]), pk2(y1[2], y1[3])};
      if (E.ykv) { const f32x4 h0 = *(const f32x4*)(E.ngkv + c), h1 = *(const f32x4*)(E.ngkv + c + 4), t0 = *(const f32x4*)(E.nsckv + mo + c), t1 = *(const f32x4*)(E.nsckv + mo + c + 4);
        const f32x4 z0 = ya * h0 * (t0 + 1.f), z1 = yb * h1 * (t1 + 1.f);
        *(u32x4*)(E.ykv + (size_t)r * D + c) = (u32x4){pk2(z0[0], z0[1]), pk2(z0[2], z0[3]), pk2(z1[0], z1[1]), pk2(z1[2], z1[3])}; }
      float ss = ya[0] * ya[0] + ya[1] * ya[1] + ya[2] * ya[2] + ya[3] * ya[3] + yb[0] * yb[0] + yb[1] * yb[1] + yb[2] * yb[2] + yb[3] * yb[3];
      ss += __shfl_xor(ss, 16); ss += __shfl_xor(ss, 32);
      if ((tid_get() & 63) < 16) atomicAdd(E.rss_out + r, ss); }
  } else if (epi == EPI_UP) {
    float u[8];
#pragma unroll
    for (int j = 0; j < 8; ++j) { const float t = fmaxf((j < 4) ? v0[j & 3] : v1[j & 3], 0.f); u[j] = t * t; }
    *(u32x4*)(E.b0 + (size_t)r * FF + c) = (u32x4){pk2(u[0], u[1]), pk2(u[2], u[3]), pk2(u[4], u[5]), pk2(u[6], u[7])};
  } else if (epi == EPI_QRAW) { *(u32x4*)(E.b1 + (size_t)r * D + c) = (u32x4){pk2(v0[0], v0[1]), pk2(v0[2], v0[3]), pk2(v1[0], v1[1]), pk2(v1[2], v1[3])};
  } else { float* o = E.f2 + (size_t)r * 512 + c; *(f32x4*)o = v0; *(f32x4*)(o + 4) = v1; }
}

template <int NMB>
DI void skinny_unit(KP p, unsigned char* shm, const bf16_t* A, const bf16_t* Bt, const int K, const int mrow0, const int n0, const int epi, const EpiArgs& E) {
  const int tid = tid_get(), lane = tid & 63, wave = tid >> 6, fr = lane & 15, fq = lane >> 4;
  const int ks = K >> 3;
  const bf16_t* ap = A + (size_t)(TP + mrow0 + fr) * K + wave * ks + fq * 8;
  const bf16_t* bp = Bt + (size_t)(n0 + fr) * K + wave * ks + fq * 8;
  f32x4 acc[NMB];
#pragma unroll
  for (int mb = 0; mb < NMB; ++mb) acc[mb] = (f32x4){0.f, 0.f, 0.f, 0.f};
#pragma unroll 2
  for (int k = 0; k < ks; k += 32) { const bf16x8 b = *(const bf16x8*)(bp + k);
#pragma unroll
    for (int mb = 0; mb < NMB; ++mb) { const bf16x8 a = *(const bf16x8*)(ap + (size_t)mb * 16 * K + k); acc[mb] = __builtin_amdgcn_mfma_f32_16x16x32_bf16(b, a, acc[mb], 0, 0, 0); } }
  float* red = (float*)shm;
#pragma unroll
  for (int mb = 0; mb < NMB; ++mb) *(f32x4*)(red + wave * (NMB * 256) + (mb * 16 + fr) * 16 + fq * 4) = acc[mb];
  __syncthreads();
  if (tid < NMB * 64) { const int row = tid >> 2, c4 = (tid & 3) * 4; f32x4 sum = (f32x4){0.f, 0.f, 0.f, 0.f};
#pragma unroll
    for (int w = 0; w < 8; ++w) sum += *(const f32x4*)(red + w * (NMB * 256) + row * 16 + c4);
    epi_frag(p, epi, E, TP + mrow0 + row, n0 + c4, sum); }
  __syncthreads();
}

DI int perm32(int rho) { const int n = rho >> 4, i = rho & 15; return 8 * (i >> 2) + 4 * n + (i & 3); }
struct UnitD { const char* A; const char* B; int pm, pn, epi; float* ob; int on; };
DI void unit_of(const int L, const GemmJob& j0, const GemmJob& j1, const int n0, const size_t tstep, UnitD& u) {
  if (j0.epi == EPI_BIAS) {
    const int st = L < 16 ? 0 : L < 32 ? 1 : L < 36 ? 2 : L < 40 ? 3 : L < 42 ? 4 : 5 + (L - 42) / 16;
    const int lb = st == 0 ? 0 : st == 1 ? 16 : st == 2 ? 32 : st == 3 ? 36 : st == 4 ? 40 : 42 + (st - 5) * 16;
    const unsigned char* wsb = (const unsigned char*)j0.Bt;
    const bf16_t* Bt = (st < 2) ? (const bf16_t*)(wsb + OFF_WIN) + (size_t)st * 4096 * D : (st < 4) ? (const bf16_t*)(wsb + OFF_WQ) + (size_t)(st - 2) * D * D
                     : (st == 4) ? (const bf16_t*)(wsb + OFF_WKV) : (const bf16_t*)(wsb + OFF_WUP) + (size_t)(st - 5) * D * FF;
    u.pm = 0; u.pn = L - lb; u.epi = EPI_BIAS; u.A = (const char*)(j0.A + (size_t)st * 256 * 1024); u.B = (const char*)Bt + (size_t)u.pn * tstep;
    u.ob = (float*)j1.A + (size_t)132 * site_prefN(st); u.on = site_N(st); return; }
  const bool second = (L >= n0); int pm, pn; tile_of(second ? L - n0 : L, second ? j1.nM : j0.nM, second ? j1.nN : j0.nN, pm, pn);
  u.pm = pm; u.pn = pn; u.epi = second ? j1.epi : j0.epi;
  u.A = (const char*)(second ? j1.A : j0.A) + (size_t)pm * tstep; u.B = (const char*)(second ? j1.Bt : j0.Bt) + (size_t)pn * tstep;
}
DI void gemm_phase(KP p, LAS unsigned char* lds, unsigned char* shm, const GemmJob& j0, const GemmJob& j1, const int njobs, const EpiArgs& E, const int skinny) {
  const int tid = tid_get(), wid = __builtin_amdgcn_readfirstlane(tid >> 6), lane = tid & 63, wr = wid >> 2, wc = wid & 3, fr = lane & 15, fq = lane >> 4;
  const int K = j0.K, nt = K / BK;
  const int n0 = j0.nM * j0.nN, n1 = (njobs > 1) ? j1.nM * j1.nN : 0, ntl = n0 + n1;
  if ((int)blockIdx.x < ntl) {
    unsigned voffA[2], voffB[2];
#pragma unroll
    for (int i = 0; i < 2; ++i) { int R, C; stage_rc(tid * 16 + i * 8192, R, C); const int Rb = (R & ~31) + perm32(R & 31);
      voffA[i] = (unsigned)(R * K + C) * 2u; voffB[i] = (unsigned)(Rb * K + C) * 2u; }
    const size_t kstep = (size_t)(BK * 2), hstep = (size_t)HALF * K * 2, tstep = 2 * hstep;
    const unsigned ldsw = (unsigned)wid * 1024u;
    const int aoff = lds_byte(wr * 64 + fr, fq * 8), boff = lds_byte(wc * 32 + fr, fq * 8);
#define G_SA(b, h) (((b) * 2 + (h)) * HTB)
#define G_SB(b, h) ((4 + (b) * 2 + (h)) * HTB)
#define G_STAGE(bufoff, gbase, voff) do { _Pragma("unroll") for (int _i = 0; _i < 2; ++_i) \
      __builtin_amdgcn_global_load_lds((const unsigned*)((const char*)(gbase) + (voff)[_i]), (LAS unsigned*)(lds + (bufoff) + ldsw + _i * 8192), 16, 0, 0); } while (0)
#define G_LDA(dst, b, h) do { _Pragma("unroll") for (int m = 0; m < 4; ++m) _Pragma("unroll") for (int k = 0; k < 2; ++k) dst[m][k] = *(const LAS bf16x8*)(lds + G_SA(b, h) + aoff + m * 2048 + k * 1024); } while (0)
#define G_LDB(dst, b, h) do { _Pragma("unroll") for (int n = 0; n < 2; ++n) _Pragma("unroll") for (int k = 0; k < 2; ++k) dst[n][k] = *(const LAS bf16x8*)(lds + G_SB(b, h) + boff + n * 2048 + k * 1024); } while (0)
#define G_MMA(ai, bj, At, Bt) do { __builtin_amdgcn_s_setprio(1); _Pragma("unroll") for (int m = 0; m < 4; ++m) _Pragma("unroll") for (int n = 0; n < 2; ++n) _Pragma("unroll") for (int k = 0; k < 2; ++k) \
      acc[ai][bj][m][n] = __builtin_amdgcn_mfma_f32_16x16x32_bf16(Bt[n][k], At[m][k], acc[ai][bj][m][n], 0, 0, 0); __builtin_amdgcn_s_setprio(0); } while (0)
#define G_WAIT_V(n) asm volatile("s_waitcnt vmcnt(" #n ")" ::: "memory")
#define G_WAIT_L(n) asm volatile("s_waitcnt lgkmcnt(" #n ")" ::: "memory")
#define G_BAR __builtin_amdgcn_s_barrier()
#define G_SCHED __builtin_amdgcn_sched_barrier(0)
    int L = blockIdx.x;
    UnitD cur, nxt; unit_of(L, j0, j1, n0, tstep, cur);
    f32x4 acc[2][2][4][2];
#pragma unroll
    for (int a = 0; a < 2; ++a)
#pragma unroll
      for (int b = 0; b < 2; ++b)
#pragma unroll
        for (int m = 0; m < 4; ++m)
#pragma unroll
          for (int n = 0; n < 2; ++n) acc[a][b][m][n] = (f32x4){0.f, 0.f, 0.f, 0.f};
    bf16x8 At[4][2], B0[2][2], B1[2][2];
    const char* cA = cur.A; const char* cB = cur.B;
    G_STAGE(G_SB(0, 0), cB, voffB); G_STAGE(G_SB(0, 1), cB + hstep, voffB); G_STAGE(G_SA(0, 0), cA, voffA); G_STAGE(G_SA(0, 1), cA + hstep, voffA);
    if (wr == 1) G_BAR;
    G_WAIT_V(2); G_BAR;
    G_STAGE(G_SB(1, 0), cB + kstep, voffB); G_STAGE(G_SA(1, 0), cA + kstep, voffA); G_STAGE(G_SB(1, 1), cB + hstep + kstep, voffB);
    G_WAIT_V(6); G_BAR;
#pragma unroll 1
    for (;;) {
      const int Ln = L + (int)gridDim.x; const bool has_next = (Ln < ntl);
      if (has_next) unit_of(Ln, j0, j1, n0, tstep, nxt);
      const char* nA = has_next ? nxt.A : cA; const char* nB = has_next ? nxt.B : cB;
#pragma unroll 1
      for (int t = 0; t < nt; t += 2) {
        const bool last = (t == nt - 2);
        const char* a1 = cA + (size_t)(t + 1) * kstep;
        const char* a2 = last ? nA : cA + (size_t)(t + 2) * kstep; const char* b2 = last ? nB : cB + (size_t)(t + 2) * kstep;
        const char* a3 = a2 + kstep; const char* b3 = b2 + kstep;
        G_LDB(B0, 0, 0); G_LDB(B1, 0, 1); G_SCHED; G_LDA(At, 0, 0); G_STAGE(G_SA(1, 1), a1 + hstep, voffA);
        G_WAIT_V(8); G_WAIT_L(0); G_BAR; G_MMA(0, 0, At, B0); G_MMA(0, 1, At, B1); G_BAR; G_SCHED;
        G_LDA(At, 0, 1); G_STAGE(G_SB(0, 0), b2, voffB); G_STAGE(G_SB(0, 1), b2 + hstep, voffB); G_STAGE(G_SA(0, 0), a2, voffA);
        G_WAIT_V(8); G_WAIT_L(0); G_BAR; G_MMA(1, 0, At, B0); G_MMA(1, 1, At, B1); G_BAR; G_SCHED;
        G_LDB(B0, 1, 0); G_LDB(B1, 1, 1); G_SCHED; G_LDA(At, 1, 0); G_STAGE(G_SA(0, 1), a2 + hstep, voffA);
        G_WAIT_V(8); G_WAIT_L(0); G_BAR; G_MMA(0, 0, At, B0); G_MMA(0, 1, At, B1); G_BAR; G_SCHED;
        G_LDA(At, 1, 1); G_STAGE(G_SB(1, 0), b3, voffB); G_STAGE(G_SB(1, 1), b3 + hstep, voffB); G_STAGE(G_SA(1, 0), a3, voffA);
        G_WAIT_V(8); G_WAIT_L(0); G_BAR; G_MMA(1, 0, At, B0); G_MMA(1, 1, At, B1); G_BAR; G_SCHED;
      }
      if (wr == 0) G_BAR;
      { const int r0 = cur.pm * BM + wr * 64 + fr, c0 = cur.pn * BM + wc * 32 + fq * 8; const int epi = cur.epi;
#define EPI_LOOP(MODE) { _Pragma("unroll") for (int ai = 0; ai < 2; ++ai) _Pragma("unroll") for (int m = 0; m < 4; ++m) _Pragma("unroll") for (int bj = 0; bj < 2; ++bj) \
          epi_frag8(p, MODE, E, r0 + ai * 128 + m * 16, c0 + bj * 128, acc[ai][bj][m][0], acc[ai][bj][m][1]); }
        if (epi == EPI_ADA) EPI_LOOP(EPI_ADA)
        else if (epi == EPI_BIAS) {
#pragma unroll
          for (int ai = 0; ai < 2; ++ai)
#pragma unroll
            for (int m = 0; m < 4; ++m) { const int r = r0 + ai * 128 + m * 16; if (r < NMOD) {
#pragma unroll
              for (int bj = 0; bj < 2; ++bj) { float* o = cur.ob + (size_t)r * cur.on + (c0 + bj * 128); *(f32x4*)o = acc[ai][bj][m][0]; *(f32x4*)(o + 4) = acc[ai][bj][m][1]; } } }
        } else if (epi == EPI_RESID) {
          const size_t mo = (size_t)modrow(r0) * MODW;
#pragma unroll
          for (int bj = 0; bj < 2; ++bj) { const int c = c0 + bj * 128;
            const f32x4 ga = *(const f32x4*)(E.f1 + mo + c), gb = *(const f32x4*)(E.f1 + mo + c + 4);
            f32x4 m0 = (f32x4){0.f, 0.f, 0.f, 0.f}, m1 = m0, k0 = m0, k1 = m0;
            if (E.yout) { const f32x4 g0 = *(const f32x4*)(E.ng + c), g1 = *(const f32x4*)(E.ng + c + 4), s0 = *(const f32x4*)(E.nsc + mo + c), s1 = *(const f32x4*)(E.nsc + mo + c + 4);
              m0 = g0 * (s0 + 1.f); m1 = g1 * (s1 + 1.f);
              if (E.ykv) { const f32x4 h0 = *(const f32x4*)(E.ngkv + c), h1 = *(const f32x4*)(E.ngkv + c + 4), t0 = *(const f32x4*)(E.nsckv + mo + c), t1 = *(const f32x4*)(E.nsckv + mo + c + 4);
                k0 = h0 * (t0 + 1.f); k1 = h1 * (t1 + 1.f); } }
#pragma unroll
            for (int ah = 0; ah < 2; ++ah) { const int ai = ah, mb = 0;
              f32x4 ya[4], yb[4];
              const float* xbase = E.first ? p->x_prompt : E.f0;
#pragma unroll
              for (int m = mb; m < mb + 4; ++m) { const unsigned off = (unsigned)(r0 + ai * 128 + m * 16) * (unsigned)D + (unsigned)c;
                ya[m] = __builtin_nontemporal_load((const f32x4*)(xbase + off)); yb[m] = __builtin_nontemporal_load((const f32x4*)(xbase + off + 4)); }
#pragma unroll
              for (int m = mb; m < mb + 4; ++m) { const int r = r0 + ai * 128 + m * 16; const unsigned off = (unsigned)r * (unsigned)D + (unsigned)c;
                const f32x4 xa = ya[m] + ga * acc[ai][bj][m][0], xb = yb[m] + gb * acc[ai][bj][m][1];
                __builtin_nontemporal_store(xa, (f32x4*)(E.f0 + off)); __builtin_nontemporal_store(xb, (f32x4*)(E.f0 + off + 4));
                if (E.yout) { const f32x4 y0 = xa * m0, y1 = xb * m1;
                  *(u32x4*)(E.yout + off) = (u32x4){pk2(y0[0], y0[1]), pk2(y0[2], y0[3]), pk2(y1[0], y1[1]), pk2(y1[2], y1[3])};
                  if (E.ykv) { const f32x4 z0 = xa * k0, z1 = xb * k1;
                    *(u32x4*)(E.ykv + off) = (u32x4){pk2(z0[0], z0[1]), pk2(z0[2], z0[3]), pk2(z1[0], z1[1]), pk2(z1[2], z1[3])}; }
                  float ss = xa[0] * xa[0] + xa[1] * xa[1] + xa[2] * xa[2] + xa[3] * xa[3] + xb[0] * xb[0] + xb[1] * xb[1] + xb[2] * xb[2] + xb[3] * xb[3];
                  ss += __shfl_xor(ss, 16); ss += __shfl_xor(ss, 32);
                  if (fq == 0) atomicAdd(E.rss_out + (unsigned)r, ss); } } } }
        } else if (epi != EPI_NOP) {
          float rstd8[8];
#pragma unroll
          for (int q = 0; q < 8; ++q) rstd8[q] = rsqrtf(E.rss[r0 + (q >> 2) * 128 + (q & 3) * 16] * (1.f / D) + EPS);
          const float* bb = (epi == EPI_KVRAW) ? E.bias1 + (size_t)modrow(r0) * E.bN1 : E.bias + (size_t)modrow(r0) * E.bN;
          f32x4 bv[2][2], lbv[2][2];
#pragma unroll
          for (int bj = 0; bj < 2; ++bj) { const int c = c0 + bj * 128; bv[bj][0] = *(const f32x4*)(bb + c); bv[bj][1] = *(const f32x4*)(bb + c + 4);
            lbv[bj][0] = (f32x4){0.f, 0.f, 0.f, 0.f}; lbv[bj][1] = (f32x4){0.f, 0.f, 0.f, 0.f};
            if (epi == EPI_HGIN && (c >> 10) == 1 && E.layer == 1) { const int cc = c & 1023;
              const f32x4 l0 = *(const f32x4*)(p->hg_lbp + cc), l1 = *(const f32x4*)(p->hg_lbp + D + cc), l2 = *(const f32x4*)(p->hg_lbp + cc + 4), l3 = *(const f32x4*)(p->hg_lbp + D + cc + 4);
#pragma unroll
              for (int jj = 0; jj < 4; ++jj) { lbv[bj][0][jj] = __builtin_amdgcn_rcpf(1.f + __expf(l0[jj] - l1[jj])); lbv[bj][1][jj] = __builtin_amdgcn_rcpf(1.f + __expf(l2[jj] - l3[jj])); } } }
#define CONS_LOOP(MODE) { _Pragma("unroll") for (int ai = 0; ai < 2; ++ai) _Pragma("unroll") for (int m = 0; m < 4; ++m) _Pragma("unroll") for (int bj = 0; bj < 2; ++bj) \
            epi_frag8(p, MODE, E, r0 + ai * 128 + m * 16, c0 + bj * 128, acc[ai][bj][m][0] * rstd8[ai * 4 + m] + bv[bj][0], acc[ai][bj][m][1] * rstd8[ai * 4 + m] + bv[bj][1], lbv[bj][0], lbv[bj][1]); }
          if (epi == EPI_HGIN) CONS_LOOP(EPI_HGIN) else if (epi == EPI_UP) CONS_LOOP(EPI_UP) else if (epi == EPI_QRAW) CONS_LOOP(EPI_QRAW) else CONS_LOOP(EPI_KVRAW)
        }
      }
      if (!has_next) break;
#pragma unroll
      for (int a = 0; a < 2; ++a)
#pragma unroll
        for (int b = 0; b < 2; ++b)
#pragma unroll
          for (int m = 0; m < 4; ++m)
#pragma unroll
            for (int n = 0; n < 2; ++n) acc[a][b][m][n] = (f32x4){0.f, 0.f, 0.f, 0.f};
      cur = nxt; cA = nA; cB = nB; L = Ln;
      if (wr == 1) G_BAR;
    }
    G_WAIT_V(0);
    G_BAR;
  }
  if (skinny) {
    __syncthreads();
    const int u0 = j0.nN * 16, u1 = (njobs > 1) ? j1.nN * 16 : 0;
    const int rs = ((u0 + u1) * 4 <= (int)gridDim.x) ? 4 : (((u0 + u1) * 2 <= (int)gridDim.x) ? 2 : 1);
#pragma unroll 1
    for (int uu = (int)gridDim.x - 1 - (int)blockIdx.x; uu < (u0 + u1) * rs; uu += gridDim.x) {
      const int u = uu / rs, rg = uu - u * rs;
      const bool second = (u >= u0);
      const bf16_t* sa = second ? j1.A : j0.A; const bf16_t* sb = second ? j1.Bt : j0.Bt; const int sk = second ? j1.K : j0.K, sn = (second ? u - u0 : u) * 16, se = second ? j1.epi : j0.epi;
      if (rs == 4) skinny_unit<2>(p, shm, sa, sb, sk, rg * 32, sn, se, E);
      else if (rs == 2) skinny_unit<4>(p, shm, sa, sb, sk, rg * 64, sn, se, E);
      else skinny_unit<8>(p, shm, sa, sb, sk, 0, sn, se, E);
    }
  }
}

__device__ const float INVF[32] = {1.000000000e+00f, 7.498942614e-01f, 5.623413324e-01f, 4.216965139e-01f, 3.162277639e-01f, 2.371373773e-01f, 1.778279394e-01f, 1.333521307e-01f, 1.000000015e-01f, 7.498941571e-02f, 5.623413250e-02f, 4.216965288e-02f, 3.162277490e-02f, 2.371373773e-02f, 1.778279431e-02f, 1.333521493e-02f, 9.999999776e-03f, 7.498941850e-03f, 5.623413250e-03f, 4.216964822e-03f, 3.162277630e-03f, 2.371373586e-03f, 1.778279431e-03f, 1.333521446e-03f, 1.000000047e-03f, 7.498942432e-04f, 5.623413017e-04f, 4.216965172e-04f, 3.162277571e-04f, 2.371373703e-04f, 1.778279402e-04f, 1.333521504e-04f};
DI void transpose_item(const float* W, int K, int N, bf16_t* WT, int row_off, float* scr, int item, int lane) {
  const int nblk = N / 32, kb = item / nblk, nb = item % nblk, k0 = 64 * kb, n0 = 32 * nb;
#pragma unroll 8
  for (int i = 0; i < 32; ++i) { const int kk = 2 * i + (lane >> 5); scr[kk * 33 + (lane & 31)] = __builtin_nontemporal_load(W + (size_t)(k0 + kk) * N + n0 + (lane & 31)); }
  asm volatile("s_waitcnt lgkmcnt(0)" ::: "memory");
  const int c = lane & 7;
#pragma unroll
  for (int j = 0; j < 4; ++j) { const int n = (lane >> 3) + 8 * j; const float* s = scr + (8 * c) * 33 + n;
    u32x4 o; o.x = pk2(s[0 * 33], s[1 * 33]); o.y = pk2(s[2 * 33], s[3 * 33]); o.z = pk2(s[4 * 33], s[5 * 33]); o.w = pk2(s[6 * 33], s[7 * 33]);
    *(u32x4*)(WT + (size_t)(row_off + n0 + n) * K + k0 + 8 * c) = o; }
  asm volatile("s_waitcnt lgkmcnt(0)" ::: "memory");
}

DI void prep_phase(KP p, unsigned char* shm) {
  const int tid = tid_get(), lane = tid & 63, wave = tid >> 6;
  const int gw = blockIdx.x * NWAVES + wave, NGW = gridDim.x * NWAVES;
  float* scr = (float*)(shm + wave * 16384);
  unsigned char* ws = p->ws;
  int base = 0;
  for (int mi = 0; mi < 22; ++mi) {
    const float* W; int K, N, row_off; bf16_t* WT;
    if (mi < 2) { W = p->hg_w_in + (size_t)mi * D * 4096; K = D; N = 4096; WT = (bf16_t*)(ws + OFF_WIN) + (size_t)mi * 4096 * D; row_off = 0; }
    else if (mi < 4) { W = p->hg_w_out + (size_t)(mi - 2) * D * D; K = D; N = D; WT = (bf16_t*)(ws + OFF_WOUT) + (size_t)(mi - 2) * D * D; row_off = 0; }
    else if (mi < 5) { W = p->w_kv; K = D; N = 512; WT = (bf16_t*)(ws + OFF_WKV); row_off = 0; }
    else if (mi < 7) { W = p->w_q + (size_t)(mi - 5) * D * D; K = D; N = D; WT = (bf16_t*)(ws + OFF_WQ) + (size_t)(mi - 5) * D * D; row_off = 0; }
    else if (mi < 9) { W = p->w_o + (size_t)(mi - 7) * D * D; K = D; N = D; WT = (bf16_t*)(ws + OFF_WO) + (size_t)(mi - 7) * D * D; row_off = 0; }
    else if (mi < 13) { W = p->w_up + (size_t)(mi - 9) * D * FF; K = D; N = FF; WT = (bf16_t*)(ws + OFF_WUP) + (size_t)(mi - 9) * D * FF; row_off = 0; }
    else if (mi < 17) { W = p->w_down + (size_t)(mi - 13) * D * FF; K = FF; N = D; WT = (bf16_t*)(ws + OFF_WDN) + (size_t)(mi - 13) * D * FF; row_off = 0; }
    else if (mi < 21) { W = p->w_ada + (size_t)(mi - 17) * D * 6144; K = D; N = 6144; WT = (bf16_t*)(ws + OFF_X); row_off = (mi - 17) * 6144; }
    else { W = p->kv_w_ada; K = D; N = 2048; WT = (bf16_t*)(ws + OFF_X); row_off = 24576; }
    const int nitems = (K / 64) * (N / 32);
    int first = (gw - (base % NGW) + NGW) % NGW;
    for (int it = first; it < nitems; it += NGW) transpose_item(W, K, N, WT, row_off, scr, it, lane);
    base += nitems;
  }
  bf16_t* Ac = (bf16_t*)(ws + OFF_X + (size_t)MODW * D * 2);
  const int gt = blockIdx.x * NTHREADS + tid, NGT = gridDim.x * NTHREADS;
  { unsigned* z = (unsigned*)(ws + OFF_BAR); for (int e = gt; e < (int)(ZERO_BYTES / 4); e += NGT) z[e] = 0u; }
  for (int e = gt; e < 256 * D / 2; e += NGT) { const int r = e / (D / 2), c = (e % (D / 2)) * 2; float a = 0.f, b = 0.f;
    if (r < NMOD) { const float* cp = (r < 4) ? p->c_prompt + (size_t)r * D : p->c_sample + (size_t)(r - 4) * D; a = silu_f(cp[c]); b = silu_f(cp[c + 1]); }
    *(unsigned*)(Ac + (size_t)r * D + c) = pk2(a, b); }
  float* tab = (float*)(ws + OFF_TAB);
  for (int e = gt; e < 4097 * 32; e += NGT) { const int pi = e >> 5, i = e & 31; const float pos = (pi < 4096) ? (float)pi : 8192.f;
    const float ang = pos * INVF[i]; float sn, cs; sincosf(ang, &sn, &cs);
    tab[pi * 64 + i] = cs; tab[pi * 64 + 32 + i] = sn; }
}

DI void init_rows(KP p, unsigned* ctr) {
  const int tid = tid_get(); const int lane = tid & 63;
  unsigned char* ws = p->ws; const float* mods = (const float*)(ws + OFF_MODS); bf16_t* yout = (bf16_t*)(ws + OFF_H); float* rss = (float*)(ws + OFF_RSS);
  const float* g = p->norm1_g; const float* msc = mods + 1024;
#pragma unroll 1
  for (;;) {
    unsigned cidx = 0; if (lane == 0) cidx = __hip_atomic_fetch_add(ctr, 1u, __ATOMIC_RELAXED, __HIP_MEMORY_SCOPE_AGENT);
    cidx = __builtin_amdgcn_readfirstlane(cidx);
    if (cidx >= (unsigned)(T / 8)) break;
#pragma unroll 1
    for (int hh = 0; hh < 2; ++hh) { const int rb = (int)cidx * 8 + hh * 4;
      f32x4 v[4][4];
#pragma unroll
      for (int q = 0; q < 4; ++q) { const int r = rb + q; const float* xr = (r < TP) ? p->x_prompt + (size_t)r * D : p->x_sample + (size_t)(r - TP) * D;
#pragma unroll
        for (int jj = 0; jj < 4; ++jj) v[q][jj] = *(const f32x4*)(xr + lane * 4 + 256 * jj); }
#pragma unroll
      for (int q = 0; q < 4; ++q) { const int r = rb + q; float a = 0.f;
#pragma unroll
        for (int jj = 0; jj < 4; ++jj) a += v[q][jj][0] * v[q][jj][0] + v[q][jj][1] * v[q][jj][1] + v[q][jj][2] * v[q][jj][2] + v[q][jj][3] * v[q][jj][3];
#pragma unroll
        for (int o = 1; o < 64; o <<= 1) a += __shfl_xor(a, o);
        if (lane == 0) rss[r] = a;
        const size_t mo = (size_t)modrow(r) * MODW;
#pragma unroll
        for (int jj = 0; jj < 4; ++jj) { const int c = lane * 4 + 256 * jj;
          const f32x4 gg = *(const f32x4*)(g + c), sc = *(const f32x4*)(msc + mo + c);
          const f32x4 h = v[q][jj] * gg * (sc + 1.f);
          *(u32x2*)(yout + (size_t)r * D + c) = (u32x2){pk2(h[0], h[1]), pk2(h[2], h[3])}; } } }
  }
}

struct HgBufs { const bf16_t *q, *k, *v, *g; const float* lf; float* o32; bf16_t* on; };

constexpr int SPAN = 256, NSPAN = SEQ / SPAN, CH = 32, NCH = SPAN / CH;
constexpr int L_CUM = 0, L_QT = 16896, L_KT = 25600, L_KE = 34304, L_VT = 44544, L_PS = 54784, L_DEC = 55808, L_HALF = 57344;
constexpr int CUS = 132, QS = 136, KES = 40;
DI bf16x8 pack8(const f32x16& x, const int s) {
  return __builtin_bit_cast(bf16x8, (u32x4){pk2(x[8 * s], x[8 * s + 1]), pk2(x[8 * s + 2], x[8 * s + 3]), pk2(x[8 * s + 4], x[8 * s + 5]), pk2(x[8 * s + 6], x[8 * s + 7])});
}
template <int MODE>
DI void scan_prompt(KP p, const int l, const HgBufs& B, unsigned char* shm) {
  const int tid = tid_get(), lane = tid & 63, wave = tid >> 6, hb = wave >> 2, th = tid & 255, vb = wave & 3, h5 = lane >> 5, l31 = lane & 31;
  unsigned char* base = shm + hb * L_HALF;
  float* cumb = (float*)(base + L_CUM); bf16_t* Qt = (bf16_t*)(base + L_QT); bf16_t* Kt = (bf16_t*)(base + L_KT);
  bf16_t* KeT = (bf16_t*)(base + L_KE); bf16_t* Vt = (bf16_t*)(base + L_VT); float* psum = (float*)(base + L_PS); float* dec = (float*)(base + L_DEC);
  float* dS = B.o32; float* Lsum = B.o32 + (size_t)512 * 16384;
#pragma unroll 1
  for (int it0 = blockIdx.x * 2; it0 < 32 * NSPAN; it0 += gridDim.x * 2) {
    const int item = it0 + hb, bh = item / NSPAN, span = item % NSPAN, b = bh >> 3, h = bh & 7;
    f32x16 S[4];
#pragma unroll
    for (int db = 0; db < 4; ++db)
#pragma unroll
      for (int r = 0; r < 16; ++r) S[db][r] = 0.f;
    if (MODE == 1) {
      const unsigned ob = (unsigned)item * 16384u + (unsigned)(vb * 32 + l31) + (unsigned)(4 * h5) * 128u;
#pragma unroll
      for (int db = 0; db < 4; ++db) {
#pragma unroll
        for (int r = 0; r < 16; ++r) S[db][r] = dS[ob + (unsigned)((32 * db + (r & 3) + 8 * (r >> 2)) * 128)];
        __builtin_amdgcn_sched_barrier(0); }
    }
    float Ltot = 0.f;
#define LBAR() do { asm volatile("s_waitcnt lgkmcnt(0)" ::: "memory"); __builtin_amdgcn_s_barrier(); asm volatile("" ::: "memory"); } while (0)
    const int d1 = th & 127, part = th >> 7, t2 = th >> 3, dg = th & 7;
    const size_t tokS = (size_t)b * SEQ + (size_t)span * SPAN;
    float lfr[16]; unsigned vr[16]; u32x4 q0, q1, g0, g1;
#define SCAN_LOAD(chx) do { const size_t o0_ = (tokS + (size_t)(chx) * CH + part * 16) * D + h * 128 + d1; \
      _Pragma("unroll") for (int i = 0; i < 16; ++i) { lfr[i] = B.lf[o0_ + (size_t)i * D]; vr[i] = B.v[o0_ + (size_t)i * D]; } \
      } while (0)
    __builtin_amdgcn_sched_barrier(0);
    SCAN_LOAD(0);
    __builtin_amdgcn_sched_barrier(0);
#pragma unroll 1
    for (int ch = 0; ch < NCH; ++ch) {
      const size_t tok0 = tokS + (size_t)ch * CH;
      if (MODE == 1) { const size_t o_ = (tok0 + t2) * D + h * 128 + dg * 16;
        q0 = *(const u32x4*)(B.q + o_); q1 = *(const u32x4*)(B.q + o_ + 8);
        g0 = *(const u32x4*)(B.g + o_); g1 = *(const u32x4*)(B.g + o_ + 8); }
      { const int d = d1;
        float c[16]; float run = 0.f;
#pragma unroll
        for (int i = 0; i < 16; ++i) { run += lfr[i]; c[i] = run; }
        psum[part * 128 + d] = run;
        LBAR();
        const float t0 = psum[d], t1 = psum[128 + d]; const float off = part ? t0 : 0.f; const float Lc = t0 + t1;
        float ke[16];
#pragma unroll
        for (int i = 0; i < 16; ++i) { const float cu = off + c[i]; if (MODE == 1) cumb[(part * 16 + i) * CUS + d] = cu; ke[i] = (1.f - __expf(lfr[i])) * __expf(Lc - cu); }
        *(u32x4*)(KeT + d * KES + part * 16) = (u32x4){pk2(ke[0], ke[1]), pk2(ke[2], ke[3]), pk2(ke[4], ke[5]), pk2(ke[6], ke[7])};
        *(u32x4*)(KeT + d * KES + part * 16 + 8) = (u32x4){pk2(ke[8], ke[9]), pk2(ke[10], ke[11]), pk2(ke[12], ke[13]), pk2(ke[14], ke[15])};
        *(u32x4*)(Vt + d * KES + part * 16) = (u32x4){vr[0] | (vr[1] << 16), vr[2] | (vr[3] << 16), vr[4] | (vr[5] << 16), vr[6] | (vr[7] << 16)};
        *(u32x4*)(Vt + d * KES + part * 16 + 8) = (u32x4){vr[8] | (vr[9] << 16), vr[10] | (vr[11] << 16), vr[12] | (vr[13] << 16), vr[14] | (vr[15] << 16)};
        if (part == 0) { dec[d] = __expf(Lc); Ltot += Lc; }
      }
      LBAR();
      if (MODE == 1) {
        const int t = t2;
        unsigned qo[8], ko[8];
#pragma unroll
        for (int g4 = 0; g4 < 4; ++g4) { const f32x4 cv = *(const f32x4*)(cumb + t * CUS + dg * 16 + 4 * g4);
          f32x4 cp = (f32x4){0.f, 0.f, 0.f, 0.f}; if (t > 0) cp = *(const f32x4*)(cumb + (t - 1) * CUS + dg * 16 + 4 * g4);
#pragma unroll
          for (int e2 = 0; e2 < 2; ++e2) { const int w = g4 * 2 + e2; const unsigned qw = (w < 4) ? q0[w & 3] : q1[w & 3];
            const float ca = cv[2 * e2], cb = cv[2 * e2 + 1];
            const float ka = 1.f - __expf(ca - cp[2 * e2]), kb = 1.f - __expf(cb - cp[2 * e2 + 1]);
            qo[w] = pk2(bf2f(qw & 0xffffu) * __expf(ca), bf2f(qw >> 16) * __expf(cb));
            ko[w] = pk2(ka * __expf(fminf(-ca, 80.f)), kb * __expf(fminf(-cb, 80.f))); } }
        *(u32x4*)(Qt + t * QS + dg * 16) = (u32x4){qo[0], qo[1], qo[2], qo[3]}; *(u32x4*)(Qt + t * QS + dg * 16 + 8) = (u32x4){qo[4], qo[5], qo[6], qo[7]};
        *(u32x4*)(Kt + t * QS + dg * 16) = (u32x4){ko[0], ko[1], ko[2], ko[3]}; *(u32x4*)(Kt + t * QS + dg * 16 + 8) = (u32x4){ko[4], ko[5], ko[6], ko[7]};
        LBAR();
      }
      { const int chn = (ch + 1 < NCH) ? ch + 1 : ch; SCAN_LOAD(chn); }
      f32x16 O;
      if (MODE == 1) {
        f32x16 X;
#pragma unroll
        for (int r = 0; r < 16; ++r) { X[r] = 0.f; O[r] = 0.f; }
#pragma unroll
        for (int ks = 0; ks < 8; ++ks) { const bf16x8 a = *(const bf16x8*)(Kt + l31 * QS + 16 * ks + 8 * h5), bq = *(const bf16x8*)(Qt + l31 * QS + 16 * ks + 8 * h5);
          X = __builtin_amdgcn_mfma_f32_32x32x16_bf16(a, bq, X, 0, 0, 0); }
#pragma unroll
        for (int r = 0; r < 16; ++r) if (crow(r, h5) > l31) X[r] = 0.f;
#pragma unroll
        for (int st = 0; st < 2; ++st) { const bf16_t* vp = Vt + (vb * 32 + l31) * KES + 16 * st + 4 * h5; const u32x2 lo = *(const u32x2*)vp, hi = *(const u32x2*)(vp + 8);
          O = __builtin_amdgcn_mfma_f32_32x32x16_bf16(pack8(X, st), __builtin_bit_cast(bf16x8, (u32x4){lo[0], lo[1], hi[0], hi[1]}), O, 0, 0, 0); }
#pragma unroll
        for (int db = 0; db < 4; ++db)
#pragma unroll
          for (int st = 0; st < 2; ++st) { const bf16_t* qp = Qt + l31 * QS + 32 * db + 16 * st + 4 * h5; const u32x2 lo = *(const u32x2*)qp, hi = *(const u32x2*)(qp + 8);
            O = __builtin_amdgcn_mfma_f32_32x32x16_bf16(__builtin_bit_cast(bf16x8, (u32x4){lo[0], lo[1], hi[0], hi[1]}), pack8(S[db], st), O, 0, 0, 0); }
      }
#pragma unroll
      for (int db = 0; db < 4; ++db) {
#pragma unroll
        for (int r4 = 0; r4 < 4; ++r4) { const f32x4 dv = *(const f32x4*)(dec + 32 * db + 8 * r4 + 4 * h5);
#pragma unroll
          for (int e = 0; e < 4; ++e) S[db][4 * r4 + e] *= dv[e]; }
#pragma unroll
        for (int st = 0; st < 2; ++st) { const bf16x8 a = *(const bf16x8*)(KeT + (32 * db + l31) * KES + 16 * st + 8 * h5), bv = *(const bf16x8*)(Vt + (vb * 32 + l31) * KES + 16 * st + 8 * h5);
          S[db] = __builtin_amdgcn_mfma_f32_32x32x16_bf16(a, bv, S[db], 0, 0, 0); } }
      if (MODE == 1) {
#pragma unroll
        for (int r = 0; r < 16; ++r) cumb[crow(r, h5) * CUS + vb * 32 + l31] = O[r];
        LBAR();
        const int t = t2, vg = dg; const size_t o = (tok0 + t) * D + h * 128 + vg * 16;
        f32x4 ov[4]; float ss = 0.f;
#pragma unroll
        for (int g4 = 0; g4 < 4; ++g4) { ov[g4] = *(const f32x4*)(cumb + t * CUS + vg * 16 + 4 * g4); ss += ov[g4][0] * ov[g4][0] + ov[g4][1] * ov[g4][1] + ov[g4][2] * ov[g4][2] + ov[g4][3] * ov[g4][3]; }
        ss += __shfl_xor(ss, 1); ss += __shfl_xor(ss, 2); ss += __shfl_xor(ss, 4);
        const float rstd = rsqrtf(ss * (1.f / 128.f) + EPS);
        unsigned w[8];
#pragma unroll
        for (int g4 = 0; g4 < 4; ++g4) { const f32x4 gn = *(const f32x4*)(p->hg_gn_g + l * 128 + vg * 16 + 4 * g4);
#pragma unroll
          for (int e2 = 0; e2 < 2; ++e2) { const int wi = g4 * 2 + e2; const unsigned gw = (wi < 4) ? g0[wi & 3] : g1[wi & 3];
            w[wi] = pk2(ov[g4][2 * e2] * rstd * gn[2 * e2] * bf2f(gw & 0xffffu), ov[g4][2 * e2 + 1] * rstd * gn[2 * e2 + 1] * bf2f(gw >> 16)); } }
        *(u32x4*)(B.on + o) = (u32x4){w[0], w[1], w[2], w[3]}; *(u32x4*)(B.on + o + 8) = (u32x4){w[4], w[5], w[6], w[7]};
      } else {
        LBAR();
      }
    }
    if (MODE == 0) {
      float* dSo = dS + (size_t)item * 16384 + vb * 32 + l31;
#pragma unroll
      for (int db = 0; db < 4; ++db)
#pragma unroll
        for (int r = 0; r < 16; ++r) dSo[(size_t)(32 * db + crow(r, h5)) * 128] = S[db][r];
      if (th < 128) Lsum[(size_t)item * 128 + th] = Ltot;
    } else if (span == NSPAN - 1) {
      float* so = p->out + O_HGP + ((size_t)((l * 4 + b) * 8 + h)) * 16384 + vb * 32 + l31;
#pragma unroll
      for (int db = 0; db < 4; ++db)
#pragma unroll
        for (int r = 0; r < 16; ++r) so[(size_t)(32 * db + crow(r, h5)) * 128] = S[db][r];
    }
    __syncthreads();
  }
}

DI void scan_passB(const HgBufs& B) {
  const int tid = tid_get();
  float* dS = B.o32; const float* Lsum = B.o32 + (size_t)512 * 16384;
  const int gt = blockIdx.x * NTHREADS + tid, NGT = gridDim.x * NTHREADS;
#pragma unroll 1
  for (int e = gt; e < 32 * 4096; e += NGT) { const int bh = e >> 12, q4 = e & 4095, d = q4 >> 5;
    float* base = dS + (size_t)bh * NSPAN * 16384 + (size_t)q4 * 4; const float* Lb = Lsum + (size_t)bh * NSPAN * 128 + d;
    f32x4 v[NSPAN]; float lv[NSPAN];
#pragma unroll
    for (int sp = 0; sp < NSPAN; ++sp) { v[sp] = *(const f32x4*)(base + (size_t)sp * 16384); lv[sp] = Lb[sp * 128]; }
    f32x4 run = (f32x4){0.f, 0.f, 0.f, 0.f};
#pragma unroll
    for (int sp = 0; sp < NSPAN; ++sp) { *(f32x4*)(base + (size_t)sp * 16384) = run; run = run * __expf(lv[sp]) + v[sp]; }
  }
}

DI void scan_phase(KP p, const int l, const HgBufs& B, unsigned char* shm) {
  scan_prompt<0>(p, l, B, shm);
  const int tid = tid_get(), lane = tid & 63, wave = tid >> 6;
  {
    float* ps = (float*)shm;
    const int v4 = (tid & 31) * 4, dq = tid >> 5;
    f32x4 sv[8], svn[8]; float lfv[8], lfn[8]; unsigned kq[8], kqn[8]; u32x2 vw, vwn;
#define SMP_LOAD(IT, SV, LF, KQ, VW) do { const int bs_ = (IT) >> 3, h_ = (IT) & 7; const size_t r_ = TP + bs_; \
      const float* s0_ = p->state_hgrn + ((size_t)((l * 128 + bs_) * 8 + h_)) * 16384; \
      VW = *(const u32x2*)(B.v + r_ * D + h_ * 128 + v4); \
      _Pragma("unroll") for (int i = 0; i < 8; ++i) { const int d_ = dq * 8 + i; const size_t o_ = r_ * D + h_ * 128 + d_; \
        LF[i] = B.lf[o_]; KQ[i] = (unsigned)B.q[o_]; SV[i] = __builtin_nontemporal_load((const f32x4*)(s0_ + d_ * 128 + v4)); } } while (0)
    int item = blockIdx.x, par = 0;
    if (item < 1024) SMP_LOAD(item, sv, lfv, kq, vw);
#pragma unroll 1
    for (; item < 1024; item += gridDim.x, par ^= 1) {
      const int bs = item >> 3, h = item & 7; const size_t r = TP + bs;
      const int nitem = item + gridDim.x;
      if (nitem < 1024) SMP_LOAD(nitem, svn, lfn, kqn, vwn);
      float* s1 = p->out + O_HGS + ((size_t)((l * 128 + bs) * 8 + h)) * 16384;
      const f32x4 vv = (f32x4){bf2f(vw[0] & 0xffffu), bf2f(vw[0] >> 16), bf2f(vw[1] & 0xffffu), bf2f(vw[1] >> 16)};
      f32x4 op = (f32x4){0.f, 0.f, 0.f, 0.f};
#pragma unroll
      for (int i = 0; i < 8; ++i) { const int d = dq * 8 + i;
        const float f = __expf(lfv[i]), kk = 1.f - f, qq = bf2f(kq[i]);
        const f32x4 sn = sv[i] * f + vv * kk;
        __builtin_nontemporal_store(sn, (f32x4*)(s1 + d * 128 + v4)); op += sn * qq; }
#pragma unroll
      for (int jx = 0; jx < 4; ++jx) op[jx] += __shfl_xor(op[jx], 32);
      float* psb = ps + par * 1024;
      if (lane < 32) *(f32x4*)(psb + wave * 128 + v4) = op;
      __syncthreads();
      if (tid < 64) { float o0 = 0.f, o1 = 0.f;
#pragma unroll
        for (int w = 0; w < 8; ++w) { const f32x2 x = *(const f32x2*)(psb + w * 128 + tid * 2); o0 += x[0]; o1 += x[1]; }
        float ss = o0 * o0 + o1 * o1;
#pragma unroll
        for (int o = 1; o < 64; o <<= 1) ss += __shfl_xor(ss, o);
        const float rstd = rsqrtf(ss * (1.f / 128.f) + EPS);
        const int vv2 = tid * 2; const size_t o = r * D + h * 128 + vv2;
        const float g0 = p->hg_gn_g[l * 128 + vv2], g1 = p->hg_gn_g[l * 128 + vv2 + 1];
        *(unsigned*)(B.on + o) = pk2(o0 * rstd * g0 * bf2f(B.g[o]), o1 * rstd * g1 * bf2f(B.g[o + 1])); }
#pragma unroll
      for (int i = 0; i < 8; ++i) { sv[i] = svn[i]; lfv[i] = lfn[i]; kq[i] = kqn[i]; }
      vw = vwn;
    }
    __syncthreads();
  }
}

constexpr int KN_STRIDE = 72, VT_STRIDE = 264;
constexpr int KN_BYTES = 256 * KN_STRIDE * 2;
struct AtBufs { const bf16_t* qraw; const float* kvraw; bf16_t* on; const float* tab; };

DI void attn_phase(KP p, const int l, const AtBufs& B, unsigned char* shm) {
  const int tid = tid_get(), lane = tid & 63, wave = tid >> 6;
  const int j = l - 2;
  const float* qg = p->q_norm_g + j * 64; const float* sinkp = p->sinks + j * 16;
  const bool write_cache = (l == 2);
  const int nitems = 512 + 512;
#pragma unroll 1
  for (int item = blockIdx.x; item < 512; item += gridDim.x) {
    {
      const int b = item >> 7, qb = (item >> 2) & 31, kvh = item & 3;
      bf16_t* Kn = (bf16_t*)shm; bf16_t* Vt = (bf16_t*)(shm + KN_BYTES);
      const int band0 = (qb - 1) * 128;
      {
        const int key = tid >> 1, part = tid & 1; const int pos = band0 + key; const bool valid = pos >= 0;
        float x1[16], x2[16];
        if (valid) { const float* kp = B.kvraw + ((size_t)b * SEQ + pos) * 512 + kvh * 64 + part * 16;
#pragma unroll
          for (int i = 0; i < 4; ++i) { const f32x4 a = *(const f32x4*)(kp + 4 * i), c = *(const f32x4*)(kp + 32 + 4 * i);
#pragma unroll
            for (int e = 0; e < 4; ++e) { x1[4 * i + e] = a[e]; x2[4 * i + e] = c[e]; } }
        } else {
#pragma unroll
          for (int i = 0; i < 16; ++i) { x1[i] = 0.f; x2[i] = 0.f; } }
        float ss = 0.f;
#pragma unroll
        for (int i = 0; i < 16; ++i) ss += x1[i] * x1[i] + x2[i] * x2[i];
        ss += __shfl_xor(ss, 1);
        const float rstd = rsqrtf(ss * (1.f / 64.f) + EPS);
        const float* tb = B.tab + (size_t)(valid ? pos : 0) * 64 + part * 16;
        float o1[16], o2[16];
#pragma unroll
        for (int i = 0; i < 16; ++i) { const float a = x1[i] * rstd * p->k_norm_g[part * 16 + i], c = x2[i] * rstd * p->k_norm_g[32 + part * 16 + i];
          const float cs = tb[i], sn = tb[32 + i]; o1[i] = a * cs - c * sn; o2[i] = c * cs + a * sn; }
        u32x4 w;
        w = (u32x4){pk2(o1[0], o1[1]), pk2(o1[2], o1[3]), pk2(o1[4], o1[5]), pk2(o1[6], o1[7])}; *(u32x4*)(Kn + key * KN_STRIDE + part * 16) = w;
        w = (u32x4){pk2(o1[8], o1[9]), pk2(o1[10], o1[11]), pk2(o1[12], o1[13]), pk2(o1[14], o1[15])}; *(u32x4*)(Kn + key * KN_STRIDE + part * 16 + 8) = w;
        w = (u32x4){pk2(o2[0], o2[1]), pk2(o2[2], o2[3]), pk2(o2[4], o2[5]), pk2(o2[6], o2[7])}; *(u32x4*)(Kn + key * KN_STRIDE + 32 + part * 16) = w;
        w = (u32x4){pk2(o2[8], o2[9]), pk2(o2[10], o2[11]), pk2(o2[12], o2[13]), pk2(o2[14], o2[15])}; *(u32x4*)(Kn + key * KN_STRIDE + 32 + part * 16 + 8) = w;
        if (write_cache && qb == 31 && key >= 128) { float* ko = p->out + O_KP + ((size_t)(b * 128 + key - 128) * 4 + kvh) * 64 + part * 16;
#pragma unroll
          for (int i = 0; i < 4; ++i) { *(f32x4*)(ko + 4 * i) = (f32x4){o1[4 * i], o1[4 * i + 1], o1[4 * i + 2], o1[4 * i + 3]};
            *(f32x4*)(ko + 32 + 4 * i) = (f32x4){o2[4 * i], o2[4 * i + 1], o2[4 * i + 2], o2[4 * i + 3]}; } }
      }
      {
        const int key = tid & 255, dh = tid >> 8; const int pos = band0 + key; const bool valid = pos >= 0;
        const float* vp = B.kvraw + ((size_t)b * SEQ + (valid ? pos : 0)) * 512 + 256 + kvh * 64 + dh * 32;
#pragma unroll
        for (int i = 0; i < 8; ++i) { f32x4 a = *(const f32x4*)(vp + 4 * i); if (!valid) a = (f32x4){0.f, 0.f, 0.f, 0.f};
#pragma unroll
          for (int e = 0; e < 4; ++e) Vt[(dh * 32 + 4 * i + e) * VT_STRIDE + key] = (bf16_t)f2bf(a[e]);
          if (write_cache && qb == 31 && key >= 128) *(f32x4*)(p->out + O_VP + ((size_t)(b * 128 + key - 128) * 4 + kvh) * 64 + dh * 32 + 4 * i) = a; }
      }
      __syncthreads();
      const int g = wave & 3, qhalf = wave >> 2, hq = kvh * 4 + g, h = lane >> 5, l31 = lane & 31;
      const float sink = sinkp[hq];
#pragma unroll 1
      for (int sub = 0; sub < 2; ++sub) {
        const int Q0 = 128 + qhalf * 64 + sub * 32, qi = Q0 + l31, pos = band0 + qi;
        const size_t tok = (size_t)b * SEQ + pos;
        float x[4][8];
        { const bf16_t* qp = B.qraw + tok * D + hq * 64 + 8 * h;
#pragma unroll
          for (int s = 0; s < 4; ++s) { const u32x4 w = *(const u32x4*)(qp + 16 * s);
#pragma unroll
            for (int e = 0; e < 4; ++e) { x[s][2 * e] = bf2f(w[e] & 0xffffu); x[s][2 * e + 1] = bf2f(w[e] >> 16); } } }
        float ss = 0.f;
#pragma unroll
        for (int s = 0; s < 4; ++s)
#pragma unroll
          for (int e = 0; e < 8; ++e) ss += x[s][e] * x[s][e];
        ss += __shfl_xor(ss, 32);
        const float rstd = rsqrtf(ss * (1.f / 64.f) + EPS) ;
#pragma unroll
        for (int s = 0; s < 4; ++s)
#pragma unroll
          for (int e = 0; e < 8; ++e) x[s][e] *= rstd * qg[16 * s + 8 * h + e];
        const float* tb = B.tab + (size_t)pos * 64;
        bf16x8 qf[4];
#pragma unroll
        for (int s = 0; s < 2; ++s) { unsigned lo[4], hi[4]; float r1[8], r2[8];
#pragma unroll
          for (int e = 0; e < 8; ++e) { const int i = 16 * s + 8 * h + e; const float cs = tb[i], sn = tb[32 + i]; const float a = x[s][e], c = x[s + 2][e];
            r1[e] = (a * cs - c * sn) * 0.125f; r2[e] = (c * cs + a * sn) * 0.125f; }
#pragma unroll
          for (int e = 0; e < 4; ++e) { lo[e] = pk2(r1[2 * e], r1[2 * e + 1]); hi[e] = pk2(r2[2 * e], r2[2 * e + 1]); }
          qf[s] = __builtin_bit_cast(bf16x8, (u32x4){lo[0], lo[1], lo[2], lo[3]}); qf[s + 2] = __builtin_bit_cast(bf16x8, (u32x4){hi[0], hi[1], hi[2], hi[3]}); }
        const int kb0 = (Q0 - 128) >> 5;
        f32x16 sacc[5]; float mx = sink;
#pragma unroll
        for (int i = 0; i < 5; ++i) { const int kb = kb0 + i; f32x16 a16;
#pragma unroll
          for (int r = 0; r < 16; ++r) a16[r] = 0.f;
          bf16x8 ka[4];
#pragma unroll
          for (int s = 0; s < 4; ++s) ka[s] = *(const bf16x8*)(Kn + (kb * 32 + l31) * KN_STRIDE + 16 * s + 8 * h);
#pragma unroll
          for (int s = 0; s < 4; ++s) a16 = __builtin_amdgcn_mfma_f32_32x32x16_bf16(ka[s], qf[s], a16, 0, 0, 0);
#pragma unroll
          for (int r = 0; r < 16; ++r) { const int key = kb * 32 + crow(r, h); const int rel = qi - key; const bool ok = (rel >= 0) && (rel < 128) && (qb > 0 || key >= 128);
            const float sv = ok ? a16[r] : -1e30f; a16[r] = sv; mx = fmaxf(mx, sv); }
          sacc[i] = a16; }
        mx = fmaxf(mx, __shfl_xor(mx, 32));
        float sum = 0.f; bf16x8 pf[5][2];
#pragma unroll
        for (int i = 0; i < 5; ++i) { float e[16];
#pragma unroll
          for (int r = 0; r < 16; ++r) { e[r] = __expf(sacc[i][r] - mx); sum += e[r]; }
#pragma unroll
          for (int st = 0; st < 2; ++st) pf[i][st] = __builtin_bit_cast(bf16x8, (u32x4){pk2(e[8 * st], e[8 * st + 1]), pk2(e[8 * st + 2], e[8 * st + 3]), pk2(e[8 * st + 4], e[8 * st + 5]), pk2(e[8 * st + 6], e[8 * st + 7])}); }
        sum += __shfl_xor(sum, 32);
        const float inv = 1.f / (sum + __expf(sink - mx));
#pragma unroll
        for (int db = 0; db < 2; ++db) { f32x16 o16;
#pragma unroll
          for (int r = 0; r < 16; ++r) o16[r] = 0.f;
          bf16x8 va[10];
#pragma unroll
          for (int i = 0; i < 5; ++i)
#pragma unroll
            for (int st = 0; st < 2; ++st) { const bf16_t* vp = Vt + (db * 32 + l31) * VT_STRIDE + (kb0 + i) * 32 + 16 * st + 4 * h;
              const u32x2 lo = *(const u32x2*)vp, hi = *(const u32x2*)(vp + 8);
              va[i * 2 + st] = __builtin_bit_cast(bf16x8, (u32x4){lo[0], lo[1], hi[0], hi[1]}); }
          f32x16 o16b;
#pragma unroll
          for (int r = 0; r < 16; ++r) o16b[r] = 0.f;
#pragma unroll
          for (int i = 0; i < 5; ++i) { o16 = __builtin_amdgcn_mfma_f32_32x32x16_bf16(va[i * 2], pf[i][0], o16, 0, 0, 0); o16b = __builtin_amdgcn_mfma_f32_32x32x16_bf16(va[i * 2 + 1], pf[i][1], o16b, 0, 0, 0); }
#pragma unroll
          for (int r = 0; r < 16; ++r) o16[r] += o16b[r];
          bf16_t* op = B.on + tok * D + hq * 64 + db * 32 + 4 * h;
#pragma unroll
          for (int r4 = 0; r4 < 4; ++r4) *(u32x2*)(op + 8 * r4) = (u32x2){pk2(o16[4 * r4] * inv, o16[4 * r4 + 1] * inv), pk2(o16[4 * r4 + 2] * inv, o16[4 * r4 + 3] * inv)}; }
      }
      __syncthreads();
    }
  }
  {
    const int tid = tid_get(), lane = tid & 63, wave = tid >> 6;
#pragma unroll 1
    for (int item = 512 + blockIdx.x; item < nitems; item += gridDim.x) {
      const int sidx = item - 512, bs = sidx >> 2, kvh = sidx & 3; const size_t r = TP + bs;
      float* Ks = (float*)shm; float* Vs = Ks + 128 * 68; float* q_s = Vs + 128 * 64; float* p_s = q_s + 256; float* redm = p_s + 512; float* reds = redm + 8; float* po = reds + 8;
      const float* tb = B.tab + (size_t)4096 * 64;
      f32x4 kreg[4], vreg[4];
#pragma unroll
      for (int i = 0; i < 4; ++i) { const int e = tid + 512 * i, jr = e >> 4, c4 = (e & 15) * 4;
        if (jr < 127) { const size_t o = (((size_t)bs * 128 + jr + 1) * 4 + kvh) * 64 + c4; kreg[i] = __builtin_nontemporal_load((const f32x4*)(p->cache_k + o)); vreg[i] = __builtin_nontemporal_load((const f32x4*)(p->cache_v + o)); } }
      if (tid < 128) { const int g = tid >> 5, i = tid & 31, hq = kvh * 4 + g;
        float a = bf2f(B.qraw[r * D + hq * 64 + i]), c = bf2f(B.qraw[r * D + hq * 64 + 32 + i]);
        float ss = a * a + c * c;
#pragma unroll
        for (int o = 1; o < 32; o <<= 1) ss += __shfl_xor(ss, o);
        const float rstd = rsqrtf(ss * (1.f / 64.f) + EPS); a *= rstd * qg[i]; c *= rstd * qg[32 + i];
        const float cs = tb[i], sn = tb[32 + i];
        q_s[g * 64 + i] = (a * cs - c * sn) * 0.125f; q_s[g * 64 + 32 + i] = (c * cs + a * sn) * 0.125f;
      } else if (tid < 160) { const int i = tid & 31;
        float a = B.kvraw[r * 512 + kvh * 64 + i], c = B.kvraw[r * 512 + kvh * 64 + 32 + i];
        float ss = a * a + c * c;
#pragma unroll
        for (int o = 1; o < 32; o <<= 1) ss += __shfl_xor(ss, o);
        const float rstd = rsqrtf(ss * (1.f / 64.f) + EPS); a *= rstd * p->k_norm_g[i]; c *= rstd * p->k_norm_g[32 + i];
        const float cs = tb[i], sn = tb[32 + i];
        const float k1 = a * cs - c * sn, k2 = c * cs + a * sn, v1 = B.kvraw[r * 512 + 256 + kvh * 64 + i], v2 = B.kvraw[r * 512 + 256 + kvh * 64 + 32 + i];
        Ks[127 * 68 + i] = k1; Ks[127 * 68 + 32 + i] = k2; Vs[127 * 64 + i] = v1; Vs[127 * 64 + 32 + i] = v2;
        if (write_cache) { float* ok = p->out + O_KS + (((size_t)bs * 128 + 127) * 4 + kvh) * 64; float* ov = p->out + O_VS + (((size_t)bs * 128 + 127) * 4 + kvh) * 64;
          ok[i] = k1; ok[32 + i] = k2; ov[i] = v1; ov[32 + i] = v2; } }
#pragma unroll
      for (int i = 0; i < 4; ++i) { const int e = tid + 512 * i, jr = e >> 4, c4 = (e & 15) * 4;
        if (jr < 127) { *(f32x4*)(Ks + jr * 68 + c4) = kreg[i]; *(f32x4*)(Vs + jr * 64 + c4) = vreg[i];
          if (write_cache) { const size_t o = (((size_t)bs * 128 + jr) * 4 + kvh) * 64 + c4; __builtin_nontemporal_store(kreg[i], (f32x4*)(p->out + O_KS + o)); __builtin_nontemporal_store(vreg[i], (f32x4*)(p->out + O_VS + o)); } } }
      __syncthreads();
      const int g = tid >> 7, jk = tid & 127, hq = kvh * 4 + g; const float sink = sinkp[hq];
      float sc = 0.f;
#pragma unroll
      for (int d4 = 0; d4 < 16; ++d4) { const f32x4 kv = *(const f32x4*)(Ks + jk * 68 + 4 * d4), qv = *(const f32x4*)(q_s + g * 64 + 4 * d4); sc += kv[0] * qv[0] + kv[1] * qv[1] + kv[2] * qv[2] + kv[3] * qv[3]; }
      float mx = sc;
#pragma unroll
      for (int o = 1; o < 64; o <<= 1) mx = fmaxf(mx, __shfl_xor(mx, o));
      if (lane == 0) redm[wave] = mx;
      __syncthreads();
      mx = fmaxf(fmaxf(redm[2 * g], redm[2 * g + 1]), sink);
      const float ev = __expf(sc - mx); float sum = ev;
#pragma unroll
      for (int o = 1; o < 64; o <<= 1) sum += __shfl_xor(sum, o);
      if (lane == 0) reds[wave] = sum;
      p_s[g * 128 + jk] = ev;
      __syncthreads();
      const float inv = 1.f / (reds[2 * g] + reds[2 * g + 1] + __expf(sink - mx));
      { const int d = jk & 63, jh = jk >> 6; float o = 0.f;
#pragma unroll 8
        for (int jx = 0; jx < 64; ++jx) o += p_s[g * 128 + jh * 64 + jx] * Vs[(jh * 64 + jx) * 64 + d];
        po[tid] = o;
        __syncthreads();
        if (jh == 0) { const float tot = (o + po[tid + 64]) * inv; B.on[r * D + hq * 64 + d] = (bf16_t)f2bf(tot); } }
      __syncthreads();
    }
  }
}

#define XB_TMO      128
#define XB_XCNT(j)  (256  + 64 * (j))
#define XB_XSUB(j)  (1280 + 64 * (j))
#define XB_XGEN(j)  (2304 + 64 * (j))
#define XB_TOP      3328
#define XB_TOPGEN   3392
#define XCD_BAR_WORDS 3456
#define XB_SPIN_CAP (1u << 18)

__device__ __forceinline__ unsigned xb_ld(unsigned* p)              { return __hip_atomic_load(p, __ATOMIC_RELAXED, __HIP_MEMORY_SCOPE_AGENT); }
__device__ __forceinline__ unsigned xb_add(unsigned* p, unsigned v) { return __hip_atomic_fetch_add(p, v, __ATOMIC_RELAXED, __HIP_MEMORY_SCOPE_AGENT); }
__device__ __forceinline__ unsigned xb_xcc_id() { return (unsigned)__builtin_amdgcn_s_getreg((3 << 11) | 20) & 0xFu; }
#define XB_SPIN(cond, bar) do { unsigned _sp = 0; while (cond) { __builtin_amdgcn_s_sleep(1); \
    if ((++_sp & 255u) == 0u) { if (xb_ld(&(bar)[XB_TMO])) break; if (_sp > XB_SPIN_CAP) { atomicAdd(&(bar)[XB_TMO], 1u); break; } } } } while (0)

struct XcdBarrier {
    unsigned* bar; unsigned x;
    volatile LAS unsigned* st;
};

__device__ __forceinline__ XcdBarrier xcd_barrier_post(unsigned* bar, volatile LAS unsigned* st) {
    XcdBarrier b; b.bar = bar; b.x = xb_xcc_id(); b.st = st;
    if (threadIdx.x == 0) (void)xb_add(&bar[XB_XCNT(b.x)], 1u);
    return b;
}
__device__ __forceinline__ void xcd_barrier_complete(unsigned* bar, unsigned x, unsigned& nloc, unsigned& nx) {
    const unsigned G = gridDim.x * gridDim.y * gridDim.z;
    unsigned sum, cnt, mine, sp = 0u;
    for (;;) {
        sum = 0u; cnt = 0u; mine = 0u;
#pragma unroll
        for (unsigned j = 0; j < 16; ++j) { const unsigned c = xb_ld(&bar[XB_XCNT(j)]); sum += c; cnt += (c > 0u) ? 1u : 0u; mine = (j == x) ? c : mine; }
        if (sum == G) break;
        __builtin_amdgcn_s_sleep(1);
        if ((++sp & 255u) == 0u) { if (xb_ld(&bar[XB_TMO])) break; if (sp > XB_SPIN_CAP) { atomicAdd(&bar[XB_TMO], 1u); break; } }
    }
    nloc = mine > 0u ? mine : 1u; nx = cnt > 0u ? cnt : 1u;
}

__device__ __forceinline__ void xcd_barrier(const XcdBarrier& b) {
    asm volatile("s_waitcnt vmcnt(0)" ::: "memory");
    __syncthreads();
    if (threadIdx.x == 0) {
        unsigned* bar = b.bar;
        __builtin_amdgcn_s_waitcnt(0);
        unsigned nloc = b.st[0], nx = b.st[1];
        if (nloc == 0u) { xcd_barrier_complete(bar, b.x, nloc, nx); b.st[0] = nloc; b.st[1] = nx; }
        const unsigned old = xb_add(&bar[XB_XSUB(b.x)], 1u);
        const unsigned gen = old / nloc;
        if (old + 1u == (gen + 1u) * nloc) {
            __builtin_amdgcn_fence(__ATOMIC_RELEASE, "agent");
            asm volatile("s_waitcnt vmcnt(0)" ::: "memory");
            const unsigned og = xb_add(&bar[XB_TOP], 1u);
            const unsigned tg = og / nx;
            if (og + 1u == (tg + 1u) * nx) xb_add(&bar[XB_TOPGEN], 1u);
            else XB_SPIN(xb_ld(&bar[XB_TOPGEN]) == tg, bar);
            __builtin_amdgcn_fence(__ATOMIC_ACQUIRE, "agent");
            xb_add(&bar[XB_XGEN(b.x)], 1u);
            asm volatile("s_waitcnt vmcnt(0)" ::: "memory");
        } else {
            XB_SPIN(xb_ld(&bar[XB_XGEN(b.x)]) == gen, bar);
            __builtin_amdgcn_fence(__ATOMIC_ACQUIRE, "agent");
            asm volatile("s_waitcnt vmcnt(0)" ::: "memory");
        }
    }
    __syncthreads();
}


__global__ void __launch_bounds__(NTHREADS, 2) yoco_fwd(P parg) {
  extern __shared__ __attribute__((aligned(16))) unsigned char shm[];
  cg::grid_group grid = cg::this_grid();
  volatile LAS unsigned* xst = (volatile LAS unsigned*)((LAS unsigned char*)shm + 131072);
  if (threadIdx.x < 4) xst[threadIdx.x] = 0u;
  __syncthreads();
  const int nMt = TP / BM;
#pragma unroll 1
  for (int step = -2; step < 32; ++step) {
    const int l = (step < 0) ? 0 : (step >> 3), sub = (step < 0) ? (8 + step + 2) : (step & 7); const bool hg = (l < 2);
    if (sub == 3 && !hg) continue;
    if (sub == 5 || (sub == 0 && l > 0)) continue;
    KP p = kp_get(); unsigned char* ws = p->ws;
#ifndef PROBE_REPS
#define PROBE_REPS 1
#endif
#ifndef PROBE_GREPS
#define PROBE_GREPS 1
#endif
    const bool is_gemm = (sub == 0 || sub == 1 || sub == 4 || sub == 6 || sub == 7 || sub == 9);
#ifndef PROBE_MASK
#define PROBE_MASK 0
#endif
    const int pcode = (sub == 2 && !hg) ? 10 : sub;
    const int reps = (((PROBE_MASK >> pcode) & 1) && !(sub == 4 || sub == 7)) ? 2 : 1;
#pragma unroll 1
    for (int rep = 0; rep < reps; ++rep) {
    if (sub == 8) {
      prep_phase(p, shm);
    } else if (sub == 0 || sub == 1 || sub == 4 || sub == 6 || sub == 7 || sub == 9) {
      float* mods = (float*)(ws + OFF_MODS);
      bf16_t* hbuf = (bf16_t*)(ws + OFF_H); bf16_t* onbuf = (bf16_t*)(ws + OFF_ON); bf16_t* ubuf = (bf16_t*)(ws + OFF_U);
      GemmJob j0, j1; EpiArgs E{}; int nj = 1; E.layer = l; E.first = 0;
      float* rssb = (float*)(ws + OFF_RSS); const float* biasb = (const float*)(ws + OFF_BIAS);
      j1.A = (const bf16_t*)(ws + OFF_X); j1.Bt = (const bf16_t*)(ws + OFF_WKV); j1.nM = nMt; j1.nN = 2; j1.K = D; j1.epi = EPI_KVRAW;
      j0.nM = nMt; j0.K = D;
      if (sub == 0) { j0.A = (const bf16_t*)(ws + OFF_ASH); j0.Bt = (const bf16_t*)ws; j0.nM = 1; j0.nN = 106; j0.epi = EPI_BIAS; j1.A = (const bf16_t*)(ws + OFF_BIAS); }
      else if (sub == 9) { j0.A = (const bf16_t*)(ws + OFF_X + (size_t)MODW * D * 2); j0.Bt = (const bf16_t*)(ws + OFF_X); j0.nM = 1; j0.nN = MODW / BM; j0.epi = EPI_ADA; E.f0 = mods; E.ash = (bf16_t*)(ws + OFF_ASH); }
      else if (sub == 1 && hg) { E.rss = rssb + (size_t)(2 * l) * T; E.bias = biasb + (size_t)132 * site_prefN(l); E.bN = 4096; j0.A = hbuf; j0.Bt = (const bf16_t*)(ws + OFF_WIN) + (size_t)l * 4096 * D; j0.nN = 16; j0.epi = EPI_HGIN;
        E.f0 = (float*)(ws + OFF_X); E.b0 = (bf16_t*)(ws + OFF_U); E.b1 = (bf16_t*)(ws + OFF_U + SZ_ACT); E.b2 = (bf16_t*)(ws + OFF_U + 2 * SZ_ACT); E.b3 = (bf16_t*)(ws + OFF_U + 3 * SZ_ACT); }
      else if (sub == 1) { E.rss = rssb + (size_t)(2 * l) * T; E.bias = biasb + (size_t)132 * site_prefN(l); E.bN = 1024; E.bias1 = biasb + (size_t)132 * site_prefN(4); E.bN1 = 512; j0.A = hbuf; j0.Bt = (const bf16_t*)(ws + OFF_WQ) + (size_t)(l - 2) * D * D; j0.nN = 4; j0.epi = EPI_QRAW;
        E.b1 = (bf16_t*)(ws + OFF_X + SZ_ACT); E.f2 = (float*)(ws + OFF_X + 2 * SZ_ACT); nj = (l == 2) ? 2 : 1; }
      else if (sub == 4) { E.rss_out = rssb + (size_t)(1 + 2 * l) * T; E.ng = p->norm2_g + l * D; E.nsc = mods + l * 6144 + 4096; E.yout = hbuf; j0.A = onbuf; j0.Bt = hg ? (const bf16_t*)(ws + OFF_WOUT) + (size_t)l * D * D : (const bf16_t*)(ws + OFF_WO) + (size_t)(l - 2) * D * D; j0.nN = 4; j0.epi = EPI_RESID;
        E.f0 = p->out + O_Y; E.f1 = mods + l * 6144 + 2048; E.first = (l == 0); }
      else if (sub == 6) { E.rss = rssb + (size_t)(1 + 2 * l) * T; E.bias = biasb + (size_t)132 * site_prefN(5 + l); E.bN = 4096; j0.A = hbuf; j0.Bt = (const bf16_t*)(ws + OFF_WUP) + (size_t)l * D * FF; j0.nN = 16; j0.epi = EPI_UP; E.b0 = ubuf; }
      else { if (l < 3) { E.rss_out = rssb + (size_t)(2 * (l + 1)) * T; E.ng = p->norm1_g + (l + 1) * D; E.nsc = mods + (l + 1) * 6144 + 1024; E.yout = hbuf;
          if (l == 1) { E.ngkv = p->kv_norm_g; E.nsckv = mods + 24576 + 1024; E.ykv = (bf16_t*)(ws + OFF_X); } }
        j0.A = ubuf; j0.Bt = (const bf16_t*)(ws + OFF_WDN) + (size_t)l * D * FF; j0.nN = 4; j0.K = FF; j0.epi = EPI_RESID; E.f0 = p->out + O_Y; E.f1 = mods + l * 6144 + 5120; }
      gemm_phase(p, (LAS unsigned char*)shm, shm, j0, j1, nj, E, sub != 9 && sub != 0);
      if (sub == 0) init_rows(p, (unsigned*)(ws + OFF_BAR) + XCD_BAR_WORDS + 100);
    } else if (sub == 2 && hg) {
      HgBufs HB; HB.q = (bf16_t*)(ws + OFF_U); HB.k = (bf16_t*)(ws + OFF_U + SZ_ACT); HB.v = (bf16_t*)(ws + OFF_U + 2 * SZ_ACT); HB.g = (bf16_t*)(ws + OFF_U + 3 * SZ_ACT);
      HB.lf = (float*)(ws + OFF_X); HB.o32 = (float*)(ws + OFF_X + 2 * SZ_ACT); HB.on = (bf16_t*)(ws + OFF_ON);
      scan_phase(p, l, HB, shm);
    } else if (sub == 2) {
      AtBufs AB; AB.qraw = (bf16_t*)(ws + OFF_X + SZ_ACT); AB.kvraw = (float*)(ws + OFF_X + 2 * SZ_ACT); AB.on = (bf16_t*)(ws + OFF_ON); AB.tab = (const float*)(ws + OFF_TAB);
      attn_phase(p, l, AB, shm);
    } else {
      HgBufs HB; HB.q = (bf16_t*)(ws + OFF_U); HB.k = (bf16_t*)(ws + OFF_U + SZ_ACT); HB.v = (bf16_t*)(ws + OFF_U + 2 * SZ_ACT); HB.g = (bf16_t*)(ws + OFF_U + 3 * SZ_ACT);
      HB.lf = (float*)(ws + OFF_X); HB.o32 = (float*)(ws + OFF_X + 2 * SZ_ACT); HB.on = (bf16_t*)(ws + OFF_ON);
      scan_passB(HB);
      { KP pb = kp_get(); XcdBarrier xb; xb.bar = (unsigned*)(pb->ws + OFF_BAR); xb.x = xb_xcc_id(); xb.st = xst; xcd_barrier(xb); }
      scan_prompt<1>(p, l, HB, shm);
    }
    }
    if (step == 31) break;
    if (step == -2) { grid.sync(); KP p0 = kp_get(); if (tid_get() == 0) (void)xb_add((unsigned*)(p0->ws + OFF_BAR) + XB_XCNT(xb_xcc_id()), 1u); }
    else { KP pb = kp_get(); XcdBarrier xb; xb.bar = (unsigned*)(pb->ws + OFF_BAR); xb.x = xb_xcc_id(); xb.st = xst; xcd_barrier(xb); }
  }
}

extern "C" void kernel_launch(void* const* d_in, const int* in_sizes, int n_in, void* d_out, int out_size, void* d_ws, size_t ws_size, hipStream_t stream) {
  static int grid_blocks = 0;
  if (!grid_blocks) {
    int dev = 0, cus = 0, per_cu = 0;
    hipGetDevice(&dev);
    hipDeviceGetAttribute(&cus, hipDeviceAttributeMultiprocessorCount, dev);
    if (hipFuncSetAttribute((const void*)yoco_fwd, hipFuncAttributeMaxDynamicSharedMemorySize, LDS_BYTES) != hipSuccess) fprintf(stderr, "hipFuncSetAttribute failed\n");
    if (hipOccupancyMaxActiveBlocksPerMultiprocessor(&per_cu, (const void*)yoco_fwd, NTHREADS, LDS_BYTES) != hipSuccess || per_cu < 1) { fprintf(stderr, "occupancy query failed\n"); per_cu = 1; }
    grid_blocks = cus * per_cu;
    if (ws_size < WS_NEED) fprintf(stderr, "workspace too small: %zu < %zu\n", ws_size, (size_t)WS_NEED);
  }
  P p{};
  const float** pp = (const float**)&p;
  for (int i = 0; i < 26; ++i) pp[i] = (const float*)d_in[i];
  p.out = (float*)d_out; p.ws = (unsigned char*)d_ws;
  void* args[] = {&p};
  hipError_t e = hipLaunchCooperativeKernel((const void*)yoco_fwd, dim3(grid_blocks), dim3(NTHREADS), args, LDS_BYTES, stream);
  if (e != hipSuccess) fprintf(stderr, "cooperative launch failed: %s (grid %d)\n", hipGetErrorString(e), grid_blocks);
}
```

```cpp
#include <hip/hip_runtime.h>
#include <hip/hip_cooperative_groups.h>
#include <cstdio>
#include <cstdint>
namespace cg = cooperative_groups;

#define DI __device__ __forceinline__
typedef unsigned short bf16_t;
typedef short bf16x8 __attribute__((ext_vector_type(8)));
typedef float f32x4 __attribute__((ext_vector_type(4)));
typedef float f32x2 __attribute__((ext_vector_type(2)));
typedef float f32x16 __attribute__((ext_vector_type(16)));
typedef unsigned u32x4 __attribute__((ext_vector_type(4)));
typedef unsigned u32x2 __attribute__((ext_vector_type(2)));
#define LAS __attribute__((address_space(3)))

constexpr int D = 1024, FF = 4096, TP = 16384, TS = 128, T = TP + TS, TPAD = 16640, SEQ = 4096;
constexpr int NMOD = 132, MODW = 4 * 6144 + 2048;
constexpr float EPS = 1e-6f;
constexpr int NTHREADS = 512, NWAVES = 8;
constexpr int LDS_BYTES = 131072 + 16;

constexpr size_t O_Y = 0;
constexpr size_t O_HGP = (size_t)T * D;
constexpr size_t O_KP = O_HGP + (size_t)2 * 4 * 8 * 128 * 128;
constexpr size_t O_VP = O_KP + (size_t)4 * 128 * 4 * 64;
constexpr size_t O_HGS = O_VP + (size_t)4 * 128 * 4 * 64;
constexpr size_t O_KS = O_HGS + (size_t)2 * 128 * 8 * 128 * 128;
constexpr size_t O_VS = O_KS + (size_t)128 * 128 * 4 * 64;

constexpr size_t SZ_ACT = (size_t)TPAD * D * 2;
constexpr size_t OFF_WIN = 0;
constexpr size_t OFF_WOUT = OFF_WIN + (size_t)2 * 4096 * 1024 * 2;
constexpr size_t OFF_WKV = OFF_WOUT + (size_t)2 * 1024 * 1024 * 2;
constexpr size_t OFF_WQ = OFF_WKV + (size_t)512 * 1024 * 2;
constexpr size_t OFF_WO = OFF_WQ + (size_t)2 * 1024 * 1024 * 2;
constexpr size_t OFF_WUP = OFF_WO + (size_t)2 * 1024 * 1024 * 2;
constexpr size_t OFF_WDN = OFF_WUP + (size_t)4 * 4096 * 1024 * 2;
constexpr size_t OFF_MODS = OFF_WDN + (size_t)4 * 4096 * 1024 * 2;
constexpr size_t OFF_TAB = OFF_MODS + (((size_t)NMOD * MODW * 4 + 4095) & ~(size_t)4095);
constexpr size_t OFF_H = OFF_TAB + (((size_t)4097 * 64 * 4 + 4095) & ~(size_t)4095);
constexpr size_t OFF_ON = OFF_H + SZ_ACT;
constexpr size_t OFF_U = OFF_ON + SZ_ACT;
constexpr size_t OFF_X = OFF_U + 4 * SZ_ACT;
constexpr size_t OFF_BAR = OFF_X + 4 * SZ_ACT;
constexpr size_t BAR_BYTES = 16384;
constexpr size_t OFF_RSS = OFF_BAR + BAR_BYTES;
constexpr size_t ZERO_BYTES = BAR_BYTES + (size_t)9 * T * 4;
constexpr size_t OFF_ASH = OFF_BAR + ((ZERO_BYTES + 4095) & ~(size_t)4095);
constexpr size_t OFF_BIAS = OFF_ASH + (size_t)9 * 256 * 1024 * 2;
constexpr size_t WS_NEED = OFF_BIAS + (size_t)132 * 27136 * 4;

struct P {
  const float *x_prompt, *x_sample, *c_prompt, *c_sample, *state_hgrn, *cache_k, *cache_v;
  const float *w_ada, *b_ada, *norm1_g, *norm2_g, *hg_w_in, *hg_w_out, *hg_lbp, *hg_gn_g;
  const float *kv_w_ada, *kv_b_ada, *kv_norm_g, *w_kv, *k_norm_g, *w_q, *q_norm_g, *sinks, *w_o, *w_up, *w_down;
  float* out; unsigned char* ws;
};

typedef const P __attribute__((address_space(4)))* KP;
DI KP kp_get() { KP q = (KP)__builtin_amdgcn_kernarg_segment_ptr(); asm volatile("" : "+s"(q)); return q; }
DI int tid_get() { int t = threadIdx.x; asm volatile("" : "+v"(t)); return t; }
DI unsigned f2bf(float f) { unsigned u = __float_as_uint(f); return (u + 0x7fffu + ((u >> 16) & 1u)) >> 16; }
typedef __bf16 bf16x2_n __attribute__((ext_vector_type(2)));
DI unsigned pk2(float lo, float hi) { return __builtin_bit_cast(unsigned, __builtin_convertvector((f32x2){lo, hi}, bf16x2_n)); }
DI float bf2f(unsigned b) { return __uint_as_float(b << 16); }
DI float silu_f(float x) { return x * __builtin_amdgcn_rcpf(1.f + __expf(-x)); }
DI int modrow(int r) { return r < TP ? (r >> 12) : (4 + r - TP); }
DI int crow(int reg, int h) { return (reg & 3) + 8 * (reg >> 2) + 4 * h; }

constexpr int BM = 256, BK = 64, HALF = 128, HTB = HALF * BK * 2;
DI int lds_byte(int r, int c) { const int st = (r >> 4) * 2 + (c >> 5), rr = r & 15, cc = c & 31, ob = rr * 64 + cc * 2; return st * 1024 + (ob ^ (((ob >> 9) & 1) << 5)); }
DI void stage_rc(int b, int& R, int& C) { const int st = b / 1024, sb = b % 1024, swz = sb ^ (((sb >> 9) & 1) << 5); R = (st >> 1) * 16 + swz / 64; C = (st & 1) * 32 + (swz % 64) / 2; }

enum { EPI_ADA = 0, EPI_HGIN = 1, EPI_RESID = 2, EPI_UP = 3, EPI_QRAW = 4, EPI_KVRAW = 5, EPI_NOP = 6, EPI_BIAS = 7 };
struct GemmJob { const bf16_t* A; const bf16_t* Bt; int nM, nN, K, epi; };
struct EpiArgs {
  float* f0; const float* f1; float* f2; bf16_t* b0; bf16_t* b1; bf16_t* b2; bf16_t* b3; int layer; int first;
  const float* rss; const float* bias; const float* bias1; int bN, bN1;
  float* rss_out; const float* ng; const float* nsc; bf16_t* yout; const float* ngkv; const float* nsckv; bf16_t* ykv;
  bf16_t* ash;
};
DI int site_N(const int s) { return (s == 2 || s == 3) ? 1024 : (s == 4 ? 512 : 4096); }
DI int site_prefN(const int s) { return s == 0 ? 0 : s == 1 ? 4096 : s == 2 ? 8192 : s == 3 ? 9216 : s == 4 ? 10240 : 10752 + (s - 5) * 4096; }

DI void tile_of(int L, int nM, int nN, int& pm, int& pn) {
  const int nwg = nM * nN; int wgid = L;
  { const int q = nwg / 8, r = nwg % 8, xcd = wgid % 8, off = wgid / 8; wgid = (xcd < r ? xcd * (q + 1) : r * (q + 1) + (xcd - r) * q) + off; }
  const int nig = 8 * nN, gid = wgid / nig, fm = gid * 8, gsz = (nM - fm) < 8 ? (nM - fm) : 8;
  pm = fm + ((wgid % nig) % gsz); pn = (wgid % nig) / gsz;
}

DI void epi_frag(KP p, const int epi, const EpiArgs& E, const int r, const int c, const f32x4 vin) {
  if (epi == EPI_NOP) return;
  f32x4 v = vin;
  if (epi == EPI_HGIN || epi == EPI_UP || epi == EPI_QRAW || epi == EPI_KVRAW) {
    const float rstd = rsqrtf(E.rss[r] * (1.f / D) + EPS);
    const float* bp = ((epi == EPI_KVRAW) ? E.bias1 + (size_t)modrow(r) * E.bN1 : E.bias + (size_t)modrow(r) * E.bN) + c;
    v = v * rstd + *(const f32x4*)bp; }
  if (epi == EPI_HGIN) {
    const int sec = c >> 10, cc = c & 1023; const size_t o = (size_t)r * D + cc;
    if (sec == 1) { f32x4 lb = (f32x4){0.f, 0.f, 0.f, 0.f};
      if (E.layer == 1) { const f32x4 l0 = *(const f32x4*)(p->hg_lbp + cc), l1 = *(const f32x4*)(p->hg_lbp + D + cc);
#pragma unroll
        for (int j = 0; j < 4; ++j) lb[j] = __builtin_amdgcn_rcpf(1.f + __expf(l0[j] - l1[j])); }
      f32x4 lf;
#pragma unroll
      for (int j = 0; j < 4; ++j) { const float sg = __builtin_amdgcn_rcpf(1.f + __expf(-v[j])); const float fg = lb[j] + (1.f - lb[j]) * sg; lf[j] = __logf(fg); }
      *(f32x4*)(E.f0 + o) = lf;
    } else if (sec == 2) { *(u32x2*)(E.b2 + o) = (u32x2){pk2(v[0], v[1]), pk2(v[2], v[3])};
    } else { bf16_t* dst = (sec == 0) ? E.b0 : E.b3; *(u32x2*)(dst + o) = (u32x2){pk2(silu_f(v[0]), silu_f(v[1])), pk2(silu_f(v[2]), silu_f(v[3]))}; }
  } else if (epi == EPI_RESID) {
    const float* xin = E.first ? (r < TP ? p->x_prompt + (size_t)r * D : p->x_sample + (size_t)(r - TP) * D) : (E.f0 + (size_t)r * D);
    const size_t mo = (size_t)modrow(r) * MODW;
    const f32x4 xv = *(const f32x4*)(xin + c), gv = *(const f32x4*)(E.f1 + mo + c);
    const f32x4 yn = xv + gv * v;
    *(f32x4*)(E.f0 + (size_t)r * D + c) = yn;
    if (E.yout) {
      const f32x4 g = *(const f32x4*)(E.ng + c), sc = *(const f32x4*)(E.nsc + mo + c); const f32x4 y = yn * g * (sc + 1.f);
      *(u32x2*)(E.yout + (size_t)r * D + c) = (u32x2){pk2(y[0], y[1]), pk2(y[2], y[3])};
      if (E.ykv) { const f32x4 g2 = *(const f32x4*)(E.ngkv + c), sc2 = *(const f32x4*)(E.nsckv + mo + c); const f32x4 y2 = yn * g2 * (sc2 + 1.f);
        *(u32x2*)(E.ykv + (size_t)r * D + c) = (u32x2){pk2(y2[0], y2[1]), pk2(y2[2], y2[3])}; }
      float ss = yn[0] * yn[0] + yn[1] * yn[1] + yn[2] * yn[2] + yn[3] * yn[3];
      ss += __shfl_xor(ss, 1); ss += __shfl_xor(ss, 2);
      if ((tid_get() & 3) == 0) atomicAdd(E.rss_out + r, ss); }
  } else if (epi == EPI_UP) {
    f32x4 u;
#pragma unroll
    for (int j = 0; j < 4; ++j) { const float t = fmaxf(v[j], 0.f); u[j] = t * t; }
    *(u32x2*)(E.b0 + (size_t)r * FF + c) = (u32x2){pk2(u[0], u[1]), pk2(u[2], u[3])};
  } else if (epi == EPI_QRAW) { *(u32x2*)(E.b1 + (size_t)r * D + c) = (u32x2){pk2(v[0], v[1]), pk2(v[2], v[3])};
  } else if (epi == EPI_KVRAW) { *(f32x4*)(E.f2 + (size_t)r * 512 + c) = v; }
}

DI void epi_frag8(KP p, const int epi, const EpiArgs& E, const int r, const int c, const f32x4 v0, const f32x4 v1, const f32x4 lbA = (f32x4){0.f, 0.f, 0.f, 0.f}, const f32x4 lbB = (f32x4){0.f, 0.f, 0.f, 0.f}) {
  if (epi == EPI_NOP) return;
  if (epi == EPI_ADA) { if (r < NMOD) { const float* bp = (c < 24576) ? (p->b_ada + c) : (p->kv_b_ada + (c - 24576)); float* o = E.f0 + (size_t)r * MODW + c;
      const f32x4 m0 = v0 + *(const f32x4*)bp, m1 = v1 + *(const f32x4*)(bp + 4);
      *(f32x4*)o = m0; *(f32x4*)(o + 4) = m1;
      int site = -1;
      if (c < 24576) { const int l = c / 6144, part = (c - l * 6144) >> 10; site = (part == 0) ? l : (part == 3 ? 5 + l : -1); } else if (c < 25600) site = 4;
      if (site >= 0) *(u32x4*)(E.ash + ((size_t)site * 256 + r) * 1024 + (c & 1023)) = (u32x4){pk2(m0[0], m0[1]), pk2(m0[2], m0[3]), pk2(m1[0], m1[1]), pk2(m1[2], m1[3])}; }
  } else if (epi == EPI_HGIN) {
    const int sec = c >> 10, cc = c & 1023; const size_t o = (size_t)r * D + cc;
    if (sec == 1) { float lb[8];
#pragma unroll
      for (int j = 0; j < 4; ++j) { lb[j] = lbA[j]; lb[4 + j] = lbB[j]; }
      float lf[8];
#pragma unroll
      for (int j = 0; j < 8; ++j) { const float x = (j < 4) ? v0[j & 3] : v1[j & 3]; const float sg = __builtin_amdgcn_rcpf(1.f + __expf(-x)); const float fg = lb[j] + (1.f - lb[j]) * sg;
        lf[j] = __logf(fg); }
      *(f32x4*)(E.f0 + o) = (f32x4){lf[0], lf[1], lf[2], lf[3]}; *(f32x4*)(E.f0 + o + 4) = (f32x4){lf[4], lf[5], lf[6], lf[7]};
    } else if (sec == 2) { *(u32x4*)(E.b2 + o) = (u32x4){pk2(v0[0], v0[1]), pk2(v0[2], v0[3]), pk2(v1[0], v1[1]), pk2(v1[2], v1[3])};
    } else { bf16_t* dst = (sec == 0) ? E.b0 : E.b3;
      *(u32x4*)(dst + o) = (u32x4){pk2(silu_f(v0[0]), silu_f(v0[1])), pk2(silu_f(v0[2]), silu_f(v0[3])), pk2(silu_f(v1[0]), silu_f(v1[1])), pk2(silu_f(v1[2]), silu_f(v1[3]))}; }
  } else if (epi == EPI_RESID) {
    const float* xin = E.first ? (r < TP ? p->x_prompt + (size_t)r * D : p->x_sample + (size_t)(r - TP) * D) : (E.f0 + (size_t)r * D);
    const size_t mo = (size_t)modrow(r) * MODW;
    const float* gm = E.f1 + mo + c; float* o = E.f0 + (size_t)r * D + c;
    const f32x4 xa = *(const f32x4*)(xin + c), xb = *(const f32x4*)(xin + c + 4), ga = *(const f32x4*)gm, gb = *(const f32x4*)(gm + 4);
    const f32x4 ya = xa + ga * v0, yb = xb + gb * v1;
    *(f32x4*)o = ya; *(f32x4*)(o + 4) = yb;
    if (E.yout) {
      const f32x4 g0 = *(const f32x4*)(E.ng + c), g1 = *(const f32x4*)(E.ng + c + 4), s0 = *(const f32x4*)(E.nsc + mo + c), s1 = *(const f32x4*)(E.nsc + mo + c + 4);
      const f32x4 y0 = ya * g0 * (s0 + 1.f), y1 = yb * g1 * (s1 + 1.f);
      *(u32x4*)(E.yout + (size_t)r * D + c) = (u32x4){pk2(y0[0], y0[1]), pk2(y0[2], y0[3]), pk2(y1[0], y1[1]), pk2(y1[2], y1[3])};
      if (E.ykv) { const f32x4 h0 = *(const f32x4*)(E.ngkv + c), h1 = *(const f32x4*)(E.ngkv + c + 4), t0 = *(const f32x4*)(E.nsckv + mo + c), t1 = *(const f32x4*)(E.nsckv + mo + c + 4);
        const f32x4 z0 = ya * h0 * (t0 + 1.f), z1 = yb * h1 * (t1 + 1.f);
        *(u32x4*)(E.ykv + (size_t)r * D + c) = (u32x4){pk2(z0[0], z0[1]), pk2(z0[2], z0[3]), pk2(z1[0], z1[1]), pk2(z1[2], z1[3])}; }
      float ss = ya[0] * ya[0] + ya[1] * ya[1] + ya[2] * ya[2] + ya[3] * ya[3] + yb[0] * yb[0] + yb[1] * yb[1] + yb[2] * yb[2] + yb[3] * yb[3];
      ss += __shfl_xor(ss, 16); ss += __shfl_xor(ss, 32);
      if ((tid_get() & 63) < 16) atomicAdd(E.rss_out + r, ss); }
  } else if (epi == EPI_UP) {
    float u[8];
#pragma unroll
    for (int j = 0; j < 8; ++j) { const float t = fmaxf((j < 4) ? v0[j & 3] : v1[j & 3], 0.f); u[j] = t * t; }
    *(u32x4*)(E.b0 + (size_t)r * FF + c) = (u32x4){pk2(u[0], u[1]), pk2(u[2], u[3]), pk2(u[4], u[5]), pk2(u[6], u[7])};
  } else if (epi == EPI_QRAW) { *(u32x4*)(E.b1 + (size_t)r * D + c) = (u32x4){pk2(v0[0], v0[1]), pk2(v0[2], v0[3]), pk2(v1[0], v1[1]), pk2(v1[2], v1[3])};
  } else { float* o = E.f2 + (size_t)r * 512 + c; *(f32x4*)o = v0; *(f32x4*)(o + 4) = v1; }
}

template <int NMB>
DI void skinny_unit(KP p, unsigned char* shm, const bf16_t* A, const bf16_t* Bt, const int K, const int mrow0, const int n0, const int epi, const EpiArgs& E) {
  const int tid = tid_get(), lane = tid & 63, wave = tid >> 6, fr = lane & 15, fq = lane >> 4;
  const int ks = K >> 3;
  const bf16_t* ap = A + (size_t)(TP + mrow0 + fr) * K + wave * ks + fq * 8;
  const bf16_t* bp = Bt + (size_t)(n0 + fr) * K + wave * ks + fq * 8;
  f32x4 acc[NMB];
#pragma unroll
  for (int mb = 0; mb < NMB; ++mb) acc[mb] = (f32x4){0.f, 0.f, 0.f, 0.f};
#pragma unroll 2
  for (int k = 0; k < ks; k += 32) { const bf16x8 b = *(const bf16x8*)(bp + k);
#pragma unroll
    for (int mb = 0; mb < NMB; ++mb) { const bf16x8 a = *(const bf16x8*)(ap + (size_t)mb * 16 * K + k); acc[mb] = __builtin_amdgcn_mfma_f32_16x16x32_bf16(b, a, acc[mb], 0, 0, 0); } }
  float* red = (float*)shm;
#pragma unroll
  for (int mb = 0; mb < NMB; ++mb) *(f32x4*)(red + wave * (NMB * 256) + (mb * 16 + fr) * 16 + fq * 4) = acc[mb];
  __syncthreads();
  if (tid < NMB * 64) { const int row = tid >> 2, c4 = (tid & 3) * 4; f32x4 sum = (f32x4){0.f, 0.f, 0.f, 0.f};
#pragma unroll
    for (int w = 0; w < 8; ++w) sum += *(const f32x4*)(red + w * (NMB * 256) + row * 16 + c4);
    epi_frag(p, epi, E, TP + mrow0 + row, n0 + c4, sum); }
  __syncthreads();
}

DI int perm32(int rho) { const int n = rho >> 4, i = rho & 15; return 8 * (i >> 2) + 4 * n + (i & 3); }
struct UnitD { const char* A; const char* B; int pm, pn, epi; float* ob; int on; };
DI void unit_of(const int L, const GemmJob& j0, const GemmJob& j1, const int n0, const size_t tstep, UnitD& u) {
  if (j0.epi == EPI_BIAS) {
    const int st = L < 16 ? 0 : L < 32 ? 1 : L < 36 ? 2 : L < 40 ? 3 : L < 42 ? 4 : 5 + (L - 42) / 16;
    const int lb = st == 0 ? 0 : st == 1 ? 16 : st == 2 ? 32 : st == 3 ? 36 : st == 4 ? 40 : 42 + (st - 5) * 16;
    const unsigned char* wsb = (const unsigned char*)j0.Bt;
    const bf16_t* Bt = (st < 2) ? (const bf16_t*)(wsb + OFF_WIN) + (size_t)st * 4096 * D : (st < 4) ? (const bf16_t*)(wsb + OFF_WQ) + (size_t)(st - 2) * D * D
                     : (st == 4) ? (const bf16_t*)(wsb + OFF_WKV) : (const bf16_t*)(wsb + OFF_WUP) + (size_t)(st - 5) * D * FF;
    u.pm = 0; u.pn = L - lb; u.epi = EPI_BIAS; u.A = (const char*)(j0.A + (size_t)st * 256 * 1024); u.B = (const char*)Bt + (size_t)u.pn * tstep;
    u.ob = (float*)j1.A + (size_t)132 * site_prefN(st); u.on = site_N(st); return; }
  const bool second = (L >= n0); int pm, pn; tile_of(second ? L - n0 : L, second ? j1.nM : j0.nM, second ? j1.nN : j0.nN, pm, pn);
  u.pm = pm; u.pn = pn; u.epi = second ? j1.epi : j0.epi;
  u.A = (const char*)(second ? j1.A : j0.A) + (size_t)pm * tstep; u.B = (const char*)(second ? j1.Bt : j0.Bt) + (size_t)pn * tstep;
}
DI void gemm_phase(KP p, LAS unsigned char* lds, unsigned char* shm, const GemmJob& j0, const GemmJob& j1, const int njobs, const EpiArgs& E, const int skinny) {
  const int tid = tid_get(), wid = __builtin_amdgcn_readfirstlane(tid >> 6), lane = tid & 63, wr = wid >> 2, wc = wid & 3, fr = lane & 15, fq = lane >> 4;
  const int K = j0.K, nt = K / BK;
  const int n0 = j0.nM * j0.nN, n1 = (njobs > 1) ? j1.nM * j1.nN : 0, ntl = n0 + n1;
  if ((int)blockIdx.x < ntl) {
    unsigned voffA[2], voffB[2];
#pragma unroll
    for (int i = 0; i < 2; ++i) { int R, C; stage_rc(tid * 16 + i * 8192, R, C); const int Rb = (R & ~31) + perm32(R & 31);
      voffA[i] = (unsigned)(R * K + C) * 2u; voffB[i] = (unsigned)(Rb * K + C) * 2u; }
    const size_t kstep = (size_t)(BK * 2), hstep = (size_t)HALF * K * 2, tstep = 2 * hstep;
    const unsigned ldsw = (unsigned)wid * 1024u;
    const int aoff = lds_byte(wr * 64 + fr, fq * 8), boff = lds_byte(wc * 32 + fr, fq * 8);
#define G_SA(b, h) (((b) * 2 + (h)) * HTB)
#define G_SB(b, h) ((4 + (b) * 2 + (h)) * HTB)
#define G_STAGE(bufoff, gbase, voff) do { _Pragma("unroll") for (int _i = 0; _i < 2; ++_i) \
      __builtin_amdgcn_global_load_lds((const unsigned*)((const char*)(gbase) + (voff)[_i]), (LAS unsigned*)(lds + (bufoff) + ldsw + _i * 8192), 16, 0, 0); } while (0)
#define G_LDA(dst, b, h) do { _Pragma("unroll") for (int m = 0; m < 4; ++m) _Pragma("unroll") for (int k = 0; k < 2; ++k) dst[m][k] = *(const LAS bf16x8*)(lds + G_SA(b, h) + aoff + m * 2048 + k * 1024); } while (0)
#define G_LDB(dst, b, h) do { _Pragma("unroll") for (int n = 0; n < 2; ++n) _Pragma("unroll") for (int k = 0; k < 2; ++k) dst[n][k] = *(const LAS bf16x8*)(lds + G_SB(b, h) + boff + n * 2048 + k * 1024); } while (0)
#define G_MMA(ai, bj, At, Bt) do { __builtin_amdgcn_s_setprio(1); _Pragma("unroll") for (int m = 0; m < 4; ++m) _Pragma("unroll") for (int n = 0; n < 2; ++n) _Pragma("unroll") for (int k = 0; k < 2; ++k) \
      acc[ai][bj][m][n] = __builtin_amdgcn_mfma_f32_16x16x32_bf16(Bt[n][k], At[m][k], acc[ai][bj][m][n], 0, 0, 0); __builtin_amdgcn_s_setprio(0); } while (0)
#define G_WAIT_V(n) asm volatile("s_waitcnt vmcnt(" #n ")" ::: "memory")
#define G_WAIT_L(n) asm volatile("s_waitcnt lgkmcnt(" #n ")" ::: "memory")
#define G_BAR __builtin_amdgcn_s_barrier()
#define G_SCHED __builtin_amdgcn_sched_barrier(0)
    int L = blockIdx.x;
    UnitD cur, nxt; unit_of(L, j0, j1, n0, tstep, cur);
    f32x4 acc[2][2][4][2];
#pragma unroll
    for (int a = 0; a < 2; ++a)
#pragma unroll
      for (int b = 0; b < 2; ++b)
#pragma unroll
        for (int m = 0; m < 4; ++m)
#pragma unroll
          for (int n = 0; n < 2; ++n) acc[a][b][m][n] = (f32x4){0.f, 0.f, 0.f, 0.f};
    bf16x8 At[4][2], B0[2][2], B1[2][2];
    const char* cA = cur.A; const char* cB = cur.B;
    G_STAGE(G_SB(0, 0), cB, voffB); G_STAGE(G_SB(0, 1), cB + hstep, voffB); G_STAGE(G_SA(0, 0), cA, voffA); G_STAGE(G_SA(0, 1), cA + hstep, voffA);
    if (wr == 1) G_BAR;
    G_WAIT_V(2); G_BAR;
    G_STAGE(G_SB(1, 0), cB + kstep, voffB); G_STAGE(G_SA(1, 0), cA + kstep, voffA); G_STAGE(G_SB(1, 1), cB + hstep + kstep, voffB);
    G_WAIT_V(6); G_BAR;
#pragma unroll 1
    for (;;) {
      const int Ln = L + (int)gridDim.x; const bool has_next = (Ln < ntl);
      if (has_next) unit_of(Ln, j0, j1, n0, tstep, nxt);
      const char* nA = has_next ? nxt.A : cA; const char* nB = has_next ? nxt.B : cB;
#pragma unroll 1
      for (int t = 0; t < nt; t += 2) {
        const bool last = (t == nt - 2);
        const char* a1 = cA + (size_t)(t + 1) * kstep;
        const char* a2 = last ? nA : cA + (size_t)(t + 2) * kstep; const char* b2 = last ? nB : cB + (size_t)(t + 2) * kstep;
        const char* a3 = a2 + kstep; const char* b3 = b2 + kstep;
        G_LDB(B0, 0, 0); G_LDB(B1, 0, 1); G_SCHED; G_LDA(At, 0, 0); G_STAGE(G_SA(1, 1), a1 + hstep, voffA);
        G_WAIT_V(8); G_WAIT_L(0); G_BAR; G_MMA(0, 0, At, B0); G_MMA(0, 1, At, B1); G_BAR; G_SCHED;
        G_LDA(At, 0, 1); G_STAGE(G_SB(0, 0), b2, voffB); G_STAGE(G_SB(0, 1), b2 + hstep, voffB); G_STAGE(G_SA(0, 0), a2, voffA);
        G_WAIT_V(8); G_WAIT_L(0); G_BAR; G_MMA(1, 0, At, B0); G_MMA(1, 1, At, B1); G_BAR; G_SCHED;
        G_LDB(B0, 1, 0); G_LDB(B1, 1, 1); G_SCHED; G_LDA(At, 1, 0); G_STAGE(G_SA(0, 1), a2 + hstep, voffA);
        G_WAIT_V(8); G_WAIT_L(0); G_BAR; G_MMA(0, 0, At, B0); G_MMA(0, 1, At, B1); G_BAR; G_SCHED;
        G_LDA(At, 1, 1); G_STAGE(G_SB(1, 0), b3, voffB); G_STAGE(G_SB(1, 1), b3 + hstep, voffB); G_STAGE(G_SA(1, 0), a3, voffA);
        G_WAIT_V(8); G_WAIT_L(0); G_BAR; G_MMA(1, 0, At, B0); G_MMA(1, 1, At, B1); G_BAR; G_SCHED;
      }
      if (wr == 0) G_BAR;
      { const int r0 = cur.pm * BM + wr * 64 + fr, c0 = cur.pn * BM + wc * 32 + fq * 8; const int epi = cur.epi;
#define EPI_LOOP(MODE) { _Pragma("unroll") for (int ai = 0; ai < 2; ++ai) _Pragma("unroll") for (int m = 0; m < 4; ++m) _Pragma("unroll") for (int bj = 0; bj < 2; ++bj) \
          epi_frag8(p, MODE, E, r0 + ai * 128 + m * 16, c0 + bj * 128, acc[ai][bj][m][0], acc[ai][bj][m][1]); }
        if (epi == EPI_ADA) EPI_LOOP(EPI_ADA)
        else if (epi == EPI_BIAS) {
#pragma unroll
          for (int ai = 0; ai < 2; ++ai)
#pragma unroll
            for (int m = 0; m < 4; ++m) { const int r = r0 + ai * 128 + m * 16; if (r < NMOD) {
#pragma unroll
              for (int bj = 0; bj < 2; ++bj) { float* o = cur.ob + (size_t)r * cur.on + (c0 + bj * 128); *(f32x4*)o = acc[ai][bj][m][0]; *(f32x4*)(o + 4) = acc[ai][bj][m][1]; } } }
        } else if (epi == EPI_RESID) {
          const size_t mo = (size_t)modrow(r0) * MODW;
#pragma unroll
          for (int bj = 0; bj < 2; ++bj) { const int c = c0 + bj * 128;
            const f32x4 ga = *(const f32x4*)(E.f1 + mo + c), gb = *(const f32x4*)(E.f1 + mo + c + 4);
            f32x4 m0 = (f32x4){0.f, 0.f, 0.f, 0.f}, m1 = m0, k0 = m0, k1 = m0;
            if (E.yout) { const f32x4 g0 = *(const f32x4*)(E.ng + c), g1 = *(const f32x4*)(E.ng + c + 4), s0 = *(const f32x4*)(E.nsc + mo + c), s1 = *(const f32x4*)(E.nsc + mo + c + 4);
              m0 = g0 * (s0 + 1.f); m1 = g1 * (s1 + 1.f);
              if (E.ykv) { const f32x4 h0 = *(const f32x4*)(E.ngkv + c), h1 = *(const f32x4*)(E.ngkv + c + 4), t0 = *(const f32x4*)(E.nsckv + mo + c), t1 = *(const f32x4*)(E.nsckv + mo + c + 4);
                k0 = h0 * (t0 + 1.f); k1 = h1 * (t1 + 1.f); } }
#pragma unroll
            for (int ah = 0; ah < 2; ++ah) { const int ai = ah, mb = 0;
              f32x4 ya[4], yb[4];
              const float* xbase = E.first ? p->x_prompt : E.f0;
#pragma unroll
              for (int m = mb; m < mb + 4; ++m) { const unsigned off = (unsigned)(r0 + ai * 128 + m * 16) * (unsigned)D + (unsigned)c;
                ya[m] = __builtin_nontemporal_load((const f32x4*)(xbase + off)); yb[m] = __builtin_nontemporal_load((const f32x4*)(xbase + off + 4)); }
#pragma unroll
              for (int m = mb; m < mb + 4; ++m) { const int r = r0 + ai * 128 + m * 16; const unsigned off = (unsigned)r * (unsigned)D + (unsigned)c;
                const f32x4 xa = ya[m] + ga * acc[ai][bj][m][0], xb = yb[m] + gb * acc[ai][bj][m][1];
                __builtin_nontemporal_store(xa, (f32x4*)(E.f0 + off)); __builtin_nontemporal_store(xb, (f32x4*)(E.f0 + off + 4));
                if (E.yout) { const f32x4 y0 = xa * m0, y1 = xb * m1;
                  *(u32x4*)(E.yout + off) = (u32x4){pk2(y0[0], y0[1]), pk2(y0[2], y0[3]), pk2(y1[0], y1[1]), pk2(y1[2], y1[3])};
                  if (E.ykv) { const f32x4 z0 = xa * k0, z1 = xb * k1;
                    *(u32x4*)(E.ykv + off) = (u32x4){pk2(z0[0], z0[1]), pk2(z0[2], z0[3]), pk2(z1[0], z1[1]), pk2(z1[2], z1[3])}; }
                  float ss = xa[0] * xa[0] + xa[1] * xa[1] + xa[2] * xa[2] + xa[3] * xa[3] + xb[0] * xb[0] + xb[1] * xb[1] + xb[2] * xb[2] + xb[3] * xb[3];
                  ss += __shfl_xor(ss, 16); ss += __shfl_xor(ss, 32);
                  if (fq == 0) atomicAdd(E.rss_out + (unsigned)r, ss); } } } }
        } else if (epi != EPI_NOP) {
          float rstd8[8];
#pragma unroll
          for (int q = 0; q < 8; ++q) rstd8[q] = rsqrtf(E.rss[r0 + (q >> 2) * 128 + (q & 3) * 16] * (1.f / D) + EPS);
          const float* bb = (epi == EPI_KVRAW) ? E.bias1 + (size_t)modrow(r0) * E.bN1 : E.bias + (size_t)modrow(r0) * E.bN;
          f32x4 bv[2][2], lbv[2][2];
#pragma unroll
          for (int bj = 0; bj < 2; ++bj) { const int c = c0 + bj * 128; bv[bj][0] = *(const f32x4*)(bb + c); bv[bj][1] = *(const f32x4*)(bb + c + 4);
            lbv[bj][0] = (f32x4){0.f, 0.f, 0.f, 0.f}; lbv[bj][1] = (f32x4){0.f, 0.f, 0.f, 0.f};
            if (epi == EPI_HGIN && (c >> 10) == 1 && E.layer == 1) { const int cc = c & 1023;
              const f32x4 l0 = *(const f32x4*)(p->hg_lbp + cc), l1 = *(const f32x4*)(p->hg_lbp + D + cc), l2 = *(const f32x4*)(p->hg_lbp + cc + 4), l3 = *(const f32x4*)(p->hg_lbp + D + cc + 4);
#pragma unroll
              for (int jj = 0; jj < 4; ++jj) { lbv[bj][0][jj] = __builtin_amdgcn_rcpf(1.f + __expf(l0[jj] - l1[jj])); lbv[bj][1][jj] = __builtin_amdgcn_rcpf(1.f + __expf(l2[jj] - l3[jj])); } } }
#define CONS_LOOP(MODE) { _Pragma("unroll") for (int ai = 0; ai < 2; ++ai) _Pragma("unroll") for (int m = 0; m < 4; ++m) _Pragma("unroll") for (int bj = 0; bj < 2; ++bj) \
            epi_frag8(p, MODE, E, r0 + ai * 128 + m * 16, c0 + bj * 128, acc[ai][bj][m][0] * rstd8[ai * 4 + m] + bv[bj][0], acc[ai][bj][m][1] * rstd8[ai * 4 + m] + bv[bj][1], lbv[bj][0], lbv[bj][1]); }
          if (epi == EPI_HGIN) CONS_LOOP(EPI_HGIN) else if (epi == EPI_UP) CONS_LOOP(EPI_UP) else if (epi == EPI_QRAW) CONS_LOOP(EPI_QRAW) else CONS_LOOP(EPI_KVRAW)
        }
      }
      if (!has_next) break;
#pragma unroll
      for (int a = 0; a < 2; ++a)
#pragma unroll
        for (int b = 0; b < 2; ++b)
#pragma unroll
          for (int m = 0; m < 4; ++m)
#pragma unroll
            for (int n = 0; n < 2; ++n) acc[a][b][m][n] = (f32x4){0.f, 0.f, 0.f, 0.f};
      cur = nxt; cA = nA; cB = nB; L = Ln;
      if (wr == 1) G_BAR;
    }
    G_WAIT_V(0);
    G_BAR;
  }
  if (skinny) {
    __syncthreads();
    const int u0 = j0.nN * 16, u1 = (njobs > 1) ? j1.nN * 16 : 0;
    const int rs = ((u0 + u1) * 4 <= (int)gridDim.x) ? 4 : (((u0 + u1) * 2 <= (int)gridDim.x) ? 2 : 1);
#pragma unroll 1
    for (int uu = (int)gridDim.x - 1 - (int)blockIdx.x; uu < (u0 + u1) * rs; uu += gridDim.x) {
      const int u = uu / rs, rg = uu - u * rs;
      const bool second = (u >= u0);
      const bf16_t* sa = second ? j1.A : j0.A; const bf16_t* sb = second ? j1.Bt : j0.Bt; const int sk = second ? j1.K : j0.K, sn = (second ? u - u0 : u) * 16, se = second ? j1.epi : j0.epi;
      if (rs == 4) skinny_unit<2>(p, shm, sa, sb, sk, rg * 32, sn, se, E);
      else if (rs == 2) skinny_unit<4>(p, shm, sa, sb, sk, rg * 64, sn, se, E);
      else skinny_unit<8>(p, shm, sa, sb, sk, 0, sn, se, E);
    }
  }
}

__device__ const float INVF[32] = {1.000000000e+00f, 7.498942614e-01f, 5.623413324e-01f, 4.216965139e-01f, 3.162277639e-01f, 2.371373773e-01f, 1.778279394e-01f, 1.333521307e-01f, 1.000000015e-01f, 7.498941571e-02f, 5.623413250e-02f, 4.216965288e-02f, 3.162277490e-02f, 2.371373773e-02f, 1.778279431e-02f, 1.333521493e-02f, 9.999999776e-03f, 7.498941850e-03f, 5.623413250e-03f, 4.216964822e-03f, 3.162277630e-03f, 2.371373586e-03f, 1.778279431e-03f, 1.333521446e-03f, 1.000000047e-03f, 7.498942432e-04f, 5.623413017e-04f, 4.216965172e-04f, 3.162277571e-04f, 2.371373703e-04f, 1.778279402e-04f, 1.333521504e-04f};
DI void transpose_item(const float* W, int K, int N, bf16_t* WT, int row_off, float* scr, int item, int lane) {
  const int nblk = N / 32, kb = item / nblk, nb = item % nblk, k0 = 64 * kb, n0 = 32 * nb;
#pragma unroll 8
  for (int i = 0; i < 32; ++i) { const int kk = 2 * i + (lane >> 5); scr[kk * 33 + (lane & 31)] = __builtin_nontemporal_load(W + (size_t)(k0 + kk) * N + n0 + (lane & 31)); }
  asm volatile("s_waitcnt lgkmcnt(0)" ::: "memory");
  const int c = lane & 7;
#pragma unroll
  for (int j = 0; j < 4; ++j) { const int n = (lane >> 3) + 8 * j; const float* s = scr + (8 * c) * 33 + n;
    u32x4 o; o.x = pk2(s[0 * 33], s[1 * 33]); o.y = pk2(s[2 * 33], s[3 * 33]); o.z = pk2(s[4 * 33], s[5 * 33]); o.w = pk2(s[6 * 33], s[7 * 33]);
    *(u32x4*)(WT + (size_t)(row_off + n0 + n) * K + k0 + 8 * c) = o; }
  asm volatile("s_waitcnt lgkmcnt(0)" ::: "memory");
}

DI void prep_phase(KP p, unsigned char* shm) {
  const int tid = tid_get(), lane = tid & 63, wave = tid >> 6;
  const int gw = blockIdx.x * NWAVES + wave, NGW = gridDim.x * NWAVES;
  float* scr = (float*)(shm + wave * 16384);
  unsigned char* ws = p->ws;
  int base = 0;
  for (int mi = 0; mi < 22; ++mi) {
    const float* W; int K, N, row_off; bf16_t* WT;
    if (mi < 2) { W = p->hg_w_in + (size_t)mi * D * 4096; K = D; N = 4096; WT = (bf16_t*)(ws + OFF_WIN) + (size_t)mi * 4096 * D; row_off = 0; }
    else if (mi < 4) { W = p->hg_w_out + (size_t)(mi - 2) * D * D; K = D; N = D; WT = (bf16_t*)(ws + OFF_WOUT) + (size_t)(mi - 2) * D * D; row_off = 0; }
    else if (mi < 5) { W = p->w_kv; K = D; N = 512; WT = (bf16_t*)(ws + OFF_WKV); row_off = 0; }
    else if (mi < 7) { W = p->w_q + (size_t)(mi - 5) * D * D; K = D; N = D; WT = (bf16_t*)(ws + OFF_WQ) + (size_t)(mi - 5) * D * D; row_off = 0; }
    else if (mi < 9) { W = p->w_o + (size_t)(mi - 7) * D * D; K = D; N = D; WT = (bf16_t*)(ws + OFF_WO) + (size_t)(mi - 7) * D * D; row_off = 0; }
    else if (mi < 13) { W = p->w_up + (size_t)(mi - 9) * D * FF; K = D; N = FF; WT = (bf16_t*)(ws + OFF_WUP) + (size_t)(mi - 9) * D * FF; row_off = 0; }
    else if (mi < 17) { W = p->w_down + (size_t)(mi - 13) * D * FF; K = FF; N = D; WT = (bf16_t*)(ws + OFF_WDN) + (size_t)(mi - 13) * D * FF; row_off = 0; }
    else if (mi < 21) { W = p->w_ada + (size_t)(mi - 17) * D * 6144; K = D; N = 6144; WT = (bf16_t*)(ws + OFF_X); row_off = (mi - 17) * 6144; }
    else { W = p->kv_w_ada; K = D; N = 2048; WT = (bf16_t*)(ws + OFF_X); row_off = 24576; }
    const int nitems = (K / 64) * (N / 32);
    int first = (gw - (base % NGW) + NGW) % NGW;
    for (int it = first; it < nitems; it += NGW) transpose_item(W, K, N, WT, row_off, scr, it, lane);
    base += nitems;
  }
  bf16_t* Ac = (bf16_t*)(ws + OFF_X + (size_t)MODW * D * 2);
  const int gt = blockIdx.x * NTHREADS + tid, NGT = gridDim.x * NTHREADS;
  { unsigned* z = (unsigned*)(ws + OFF_BAR); for (int e = gt; e < (int)(ZERO_BYTES / 4); e += NGT) z[e] = 0u; }
  for (int e = gt; e < 256 * D / 2; e += NGT) { const int r = e / (D / 2), c = (e % (D / 2)) * 2; float a = 0.f, b = 0.f;
    if (r < NMOD) { const float* cp = (r < 4) ? p->c_prompt + (size_t)r * D : p->c_sample + (size_t)(r - 4) * D; a = silu_f(cp[c]); b = silu_f(cp[c + 1]); }
    *(unsigned*)(Ac + (size_t)r * D + c) = pk2(a, b); }
  float* tab = (float*)(ws + OFF_TAB);
  for (int e = gt; e < 4097 * 32; e += NGT) { const int pi = e >> 5, i = e & 31; const float pos = (pi < 4096) ? (float)pi : 8192.f;
    const float ang = pos * INVF[i]; float sn, cs; sincosf(ang, &sn, &cs);
    tab[pi * 64 + i] = cs; tab[pi * 64 + 32 + i] = sn; }
}

DI void init_rows(KP p, unsigned* ctr) {
  const int tid = tid_get(); const int lane = tid & 63;
  unsigned char* ws = p->ws; const float* mods = (const float*)(ws + OFF_MODS); bf16_t* yout = (bf16_t*)(ws + OFF_H); float* rss = (float*)(ws + OFF_RSS);
  const float* g = p->norm1_g; const float* msc = mods + 1024;
#pragma unroll 1
  for (;;) {
    unsigned cidx = 0; if (lane == 0) cidx = __hip_atomic_fetch_add(ctr, 1u, __ATOMIC_RELAXED, __HIP_MEMORY_SCOPE_AGENT);
    cidx = __builtin_amdgcn_readfirstlane(cidx);
    if (cidx >= (unsigned)(T / 8)) break;
#pragma unroll 1
    for (int hh = 0; hh < 2; ++hh) { const int rb = (int)cidx * 8 + hh * 4;
      f32x4 v[4][4];
#pragma unroll
      for (int q = 0; q < 4; ++q) { const int r = rb + q; const float* xr = (r < TP) ? p->x_prompt + (size_t)r * D : p->x_sample + (size_t)(r - TP) * D;
#pragma unroll
        for (int jj = 0; jj < 4; ++jj) v[q][jj] = *(const f32x4*)(xr + lane * 4 + 256 * jj); }
#pragma unroll
      for (int q = 0; q < 4; ++q) { const int r = rb + q; float a = 0.f;
#pragma unroll
        for (int jj = 0; jj < 4; ++jj) a += v[q][jj][0] * v[q][jj][0] + v[q][jj][1] * v[q][jj][1] + v[q][jj][2] * v[q][jj][2] + v[q][jj][3] * v[q][jj][3];
#pragma unroll
        for (int o = 1; o < 64; o <<= 1) a += __shfl_xor(a, o);
        if (lane == 0) rss[r] = a;
        const size_t mo = (size_t)modrow(r) * MODW;
#pragma unroll
        for (int jj = 0; jj < 4; ++jj) { const int c = lane * 4 + 256 * jj;
          const f32x4 gg = *(const f32x4*)(g + c), sc = *(const f32x4*)(msc + mo + c);
          const f32x4 h = v[q][jj] * gg * (sc + 1.f);
          *(u32x2*)(yout + (size_t)r * D + c) = (u32x2){pk2(h[0], h[1]), pk2(h[2], h[3])}; } } }
  }
}

struct HgBufs { const bf16_t *q, *k, *v, *g; const float* lf; float* o32; bf16_t* on; };

constexpr int SPAN = 256, NSPAN = SEQ / SPAN, CH = 32, NCH = SPAN / CH;
constexpr int L_CUM = 0, L_QT = 16896, L_KT = 25600, L_KE = 34304, L_VT = 44544, L_PS = 54784, L_DEC = 55808, L_HALF = 57344;
constexpr int CUS = 132, QS = 136, KES = 40;
DI bf16x8 pack8(const f32x16& x, const int s) {
  return __builtin_bit_cast(bf16x8, (u32x4){pk2(x[8 * s], x[8 * s + 1]), pk2(x[8 * s + 2], x[8 * s + 3]), pk2(x[8 * s + 4], x[8 * s + 5]), pk2(x[8 * s + 6], x[8 * s + 7])});
}
template <int MODE>
DI void scan_prompt(KP p, const int l, const HgBufs& B, unsigned char* shm) {
  const int tid = tid_get(), lane = tid & 63, wave = tid >> 6, hb = wave >> 2, th = tid & 255, vb = wave & 3, h5 = lane >> 5, l31 = lane & 31;
  unsigned char* base = shm + hb * L_HALF;
  float* cumb = (float*)(base + L_CUM); bf16_t* Qt = (bf16_t*)(base + L_QT); bf16_t* Kt = (bf16_t*)(base + L_KT);
  bf16_t* KeT = (bf16_t*)(base + L_KE); bf16_t* Vt = (bf16_t*)(base + L_VT); float* psum = (float*)(base + L_PS); float* dec = (float*)(base + L_DEC);
  float* dS = B.o32; float* Lsum = B.o32 + (size_t)512 * 16384;
#pragma unroll 1
  for (int it0 = blockIdx.x * 2; it0 < 32 * NSPAN; it0 += gridDim.x * 2) {
    const int item = it0 + hb, bh = item / NSPAN, span = item % NSPAN, b = bh >> 3, h = bh & 7;
    f32x16 S[4];
#pragma unroll
    for (int db = 0; db < 4; ++db)
#pragma unroll
      for (int r = 0; r < 16; ++r) S[db][r] = 0.f;
    if (MODE == 1) {
      const unsigned ob = (unsigned)item * 16384u + (unsigned)(vb * 32 + l31) + (unsigned)(4 * h5) * 128u;
#pragma unroll
      for (int db = 0; db < 4; ++db) {
#pragma unroll
        for (int r = 0; r < 16; ++r) S[db][r] = dS[ob + (unsigned)((32 * db + (r & 3) + 8 * (r >> 2)) * 128)];
        __builtin_amdgcn_sched_barrier(0); }
    }
    float Ltot = 0.f;
#define LBAR() do { asm volatile("s_waitcnt lgkmcnt(0)" ::: "memory"); __builtin_amdgcn_s_barrier(); asm volatile("" ::: "memory"); } while (0)
    const int d1 = th & 127, part = th >> 7, t2 = th >> 3, dg = th & 7;
    const size_t tokS = (size_t)b * SEQ + (size_t)span * SPAN;
    float lfr[16]; unsigned vr[16]; u32x4 q0, q1, g0, g1;
#define SCAN_LOAD(chx) do { const size_t o0_ = (tokS + (size_t)(chx) * CH + part * 16) * D + h * 128 + d1; \
      _Pragma("unroll") for (int i = 0; i < 16; ++i) { lfr[i] = B.lf[o0_ + (size_t)i * D]; vr[i] = B.v[o0_ + (size_t)i * D]; } \
      } while (0)
    __builtin_amdgcn_sched_barrier(0);
    SCAN_LOAD(0);
    __builtin_amdgcn_sched_barrier(0);
#pragma unroll 1
    for (int ch = 0; ch < NCH; ++ch) {
      const size_t tok0 = tokS + (size_t)ch * CH;
      if (MODE == 1) { const size_t o_ = (tok0 + t2) * D + h * 128 + dg * 16;
        q0 = *(const u32x4*)(B.q + o_); q1 = *(const u32x4*)(B.q + o_ + 8);
        g0 = *(const u32x4*)(B.g + o_); g1 = *(const u32x4*)(B.g + o_ + 8); }
      { const int d = d1;
        float c[16]; float run = 0.f;
#pragma unroll
        for (int i = 0; i < 16; ++i) { run += lfr[i]; c[i] = run; }
        psum[part * 128 + d] = run;
        LBAR();
        const float t0 = psum[d], t1 = psum[128 + d]; const float off = part ? t0 : 0.f; const float Lc = t0 + t1;
        float ke[16];
#pragma unroll
        for (int i = 0; i < 16; ++i) { const float cu = off + c[i]; if (MODE == 1) cumb[(part * 16 + i) * CUS + d] = cu; ke[i] = (1.f - __expf(lfr[i])) * __expf(Lc - cu); }
        *(u32x4*)(KeT + d * KES + part * 16) = (u32x4){pk2(ke[0], ke[1]), pk2(ke[2], ke[3]), pk2(ke[4], ke[5]), pk2(ke[6], ke[7])};
        *(u32x4*)(KeT + d * KES + part * 16 + 8) = (u32x4){pk2(ke[8], ke[9]), pk2(ke[10], ke[11]), pk2(ke[12], ke[13]), pk2(ke[14], ke[15])};
        *(u32x4*)(Vt + d * KES + part * 16) = (u32x4){vr[0] | (vr[1] << 16), vr[2] | (vr[3] << 16), vr[4] | (vr[5] << 16), vr[6] | (vr[7] << 16)};
        *(u32x4*)(Vt + d * KES + part * 16 + 8) = (u32x4){vr[8] | (vr[9] << 16), vr[10] | (vr[11] << 16), vr[12] | (vr[13] << 16), vr[14] | (vr[15] << 16)};
        if (part == 0) { dec[d] = __expf(Lc); Ltot += Lc; }
      }
      LBAR();
      if (MODE == 1) {
        const int t = t2;
        unsigned qo[8], ko[8];
#pragma unroll
        for (int g4 = 0; g4 < 4; ++g4) { const f32x4 cv = *(const f32x4*)(cumb + t * CUS + dg * 16 + 4 * g4);
          f32x4 cp = (f32x4){0.f, 0.f, 0.f, 0.f}; if (t > 0) cp = *(const f32x4*)(cumb + (t - 1) * CUS + dg * 16 + 4 * g4);
#pragma unroll
          for (int e2 = 0; e2 < 2; ++e2) { const int w = g4 * 2 + e2; const unsigned qw = (w < 4) ? q0[w & 3] : q1[w & 3];
            const float ca = cv[2 * e2], cb = cv[2 * e2 + 1];
            const float ka = 1.f - __expf(ca - cp[2 * e2]), kb = 1.f - __expf(cb - cp[2 * e2 + 1]);
            qo[w] = pk2(bf2f(qw & 0xffffu) * __expf(ca), bf2f(qw >> 16) * __expf(cb));
            ko[w] = pk2(ka * __expf(fminf(-ca, 80.f)), kb * __expf(fminf(-cb, 80.f))); } }
        *(u32x4*)(Qt + t * QS + dg * 16) = (u32x4){qo[0], qo[1], qo[2], qo[3]}; *(u32x4*)(Qt + t * QS + dg * 16 + 8) = (u32x4){qo[4], qo[5], qo[6], qo[7]};
        *(u32x4*)(Kt + t * QS + dg * 16) = (u32x4){ko[0], ko[1], ko[2], ko[3]}; *(u32x4*)(Kt + t * QS + dg * 16 + 8) = (u32x4){ko[4], ko[5], ko[6], ko[7]};
        LBAR();
      }
      { const int chn = (ch + 1 < NCH) ? ch + 1 : ch; SCAN_LOAD(chn); }
      f32x16 O;
      if (MODE == 1) {
        f32x16 X;
#pragma unroll
        for (int r = 0; r < 16; ++r) { X[r] = 0.f; O[r] = 0.f; }
#pragma unroll
        for (int ks = 0; ks < 8; ++ks) { const bf16x8 a = *(const bf16x8*)(Kt + l31 * QS + 16 * ks + 8 * h5), bq = *(const bf16x8*)(Qt + l31 * QS + 16 * ks + 8 * h5);
          X = __builtin_amdgcn_mfma_f32_32x32x16_bf16(a, bq, X, 0, 0, 0); }
#pragma unroll
        for (int r = 0; r < 16; ++r) if (crow(r, h5) > l31) X[r] = 0.f;
#pragma unroll
        for (int st = 0; st < 2; ++st) { const bf16_t* vp = Vt + (vb * 32 + l31) * KES + 16 * st + 4 * h5; const u32x2 lo = *(const u32x2*)vp, hi = *(const u32x2*)(vp + 8);
          O = __builtin_amdgcn_mfma_f32_32x32x16_bf16(pack8(X, st), __builtin_bit_cast(bf16x8, (u32x4){lo[0], lo[1], hi[0], hi[1]}), O, 0, 0, 0); }
#pragma unroll
        for (int db = 0; db < 4; ++db)
#pragma unroll
          for (int st = 0; st < 2; ++st) { const bf16_t* qp = Qt + l31 * QS + 32 * db + 16 * st + 4 * h5; const u32x2 lo = *(const u32x2*)qp, hi = *(const u32x2*)(qp + 8);
            O = __builtin_amdgcn_mfma_f32_32x32x16_bf16(__builtin_bit_cast(bf16x8, (u32x4){lo[0], lo[1], hi[0], hi[1]}), pack8(S[db], st), O, 0, 0, 0); }
      }
#pragma unroll
      for (int db = 0; db < 4; ++db) {
#pragma unroll
        for (int r4 = 0; r4 < 4; ++r4) { const f32x4 dv = *(const f32x4*)(dec + 32 * db + 8 * r4 + 4 * h5);
#pragma unroll
          for (int e = 0; e < 4; ++e) S[db][4 * r4 + e] *= dv[e]; }
#pragma unroll
        for (int st = 0; st < 2; ++st) { const bf16x8 a = *(const bf16x8*)(KeT + (32 * db + l31) * KES + 16 * st + 8 * h5), bv = *(const bf16x8*)(Vt + (vb * 32 + l31) * KES + 16 * st + 8 * h5);
          S[db] = __builtin_amdgcn_mfma_f32_32x32x16_bf16(a, bv, S[db], 0, 0, 0); } }
      if (MODE == 1) {
#pragma unroll
        for (int r = 0; r < 16; ++r) cumb[crow(r, h5) * CUS + vb * 32 + l31] = O[r];
        LBAR();
        const int t = t2, vg = dg; const size_t o = (tok0 + t) * D + h * 128 + vg * 16;
        f32x4 ov[4]; float ss = 0.f;
#pragma unroll
        for (int g4 = 0; g4 < 4; ++g4) { ov[g4] = *(const f32x4*)(cumb + t * CUS + vg * 16 + 4 * g4); ss += ov[g4][0] * ov[g4][0] + ov[g4][1] * ov[g4][1] + ov[g4][2] * ov[g4][2] + ov[g4][3] * ov[g4][3]; }
        ss += __shfl_xor(ss, 1); ss += __shfl_xor(ss, 2); ss += __shfl_xor(ss, 4);
        const float rstd = rsqrtf(ss * (1.f / 128.f) + EPS);
        unsigned w[8];
#pragma unroll
        for (int g4 = 0; g4 < 4; ++g4) { const f32x4 gn = *(const f32x4*)(p->hg_gn_g + l * 128 + vg * 16 + 4 * g4);
#pragma unroll
          for (int e2 = 0; e2 < 2; ++e2) { const int wi = g4 * 2 + e2; const unsigned gw = (wi < 4) ? g0[wi & 3] : g1[wi & 3];
            w[wi] = pk2(ov[g4][2 * e2] * rstd * gn[2 * e2] * bf2f(gw & 0xffffu), ov[g4][2 * e2 + 1] * rstd * gn[2 * e2 + 1] * bf2f(gw >> 16)); } }
        *(u32x4*)(B.on + o) = (u32x4){w[0], w[1], w[2], w[3]}; *(u32x4*)(B.on + o + 8) = (u32x4){w[4], w[5], w[6], w[7]};
      } else {
        LBAR();
      }
    }
    if (MODE == 0) {
      float* dSo = dS + (size_t)item * 16384 + vb * 32 + l31;
#pragma unroll
      for (int db = 0; db < 4; ++db)
#pragma unroll
        for (int r = 0; r < 16; ++r) dSo[(size_t)(32 * db + crow(r, h5)) * 128] = S[db][r];
      if (th < 128) Lsum[(size_t)item * 128 + th] = Ltot;
    } else if (span == NSPAN - 1) {
      float* so = p->out + O_HGP + ((size_t)((l * 4 + b) * 8 + h)) * 16384 + vb * 32 + l31;
#pragma unroll
      for (int db = 0; db < 4; ++db)
#pragma unroll
        for (int r = 0; r < 16; ++r) so[(size_t)(32 * db + crow(r, h5)) * 128] = S[db][r];
    }
    __syncthreads();
  }
}

DI void scan_passB(const HgBufs& B) {
  const int tid = tid_get();
  float* dS = B.o32; const float* Lsum = B.o32 + (size_t)512 * 16384;
  const int gt = blockIdx.x * NTHREADS + tid, NGT = gridDim.x * NTHREADS;
#pragma unroll 1
  for (int e = gt; e < 32 * 4096; e += NGT) { const int bh = e >> 12, q4 = e & 4095, d = q4 >> 5;
    float* base = dS + (size_t)bh * NSPAN * 16384 + (size_t)q4 * 4; const float* Lb = Lsum + (size_t)bh * NSPAN * 128 + d;
    f32x4 v[NSPAN]; float lv[NSPAN];
#pragma unroll
    for (int sp = 0; sp < NSPAN; ++sp) { v[sp] = *(const f32x4*)(base + (size_t)sp * 16384); lv[sp] = Lb[sp * 128]; }
    f32x4 run = (f32x4){0.f, 0.f, 0.f, 0.f};
#pragma unroll
    for (int sp = 0; sp < NSPAN; ++sp) { *(f32x4*)(base + (size_t)sp * 16384) = run; run = run * __expf(lv[sp]) + v[sp]; }
  }
}

DI void scan_phase(KP p, const int l, const HgBufs& B, unsigned char* shm) {
  const bool sample_first = (blockIdx.x & 1) != 0;
  if (!sample_first) scan_prompt<0>(p, l, B, shm);
  const int tid = tid_get(), lane = tid & 63, wave = tid >> 6;
  {
    float* ps = (float*)shm;
    const int v4 = (tid & 31) * 4, dq = tid >> 5;
    f32x4 sv[8], svn[8]; float lfv[8], lfn[8]; unsigned kq[8], kqn[8]; u32x2 vw, vwn;
#define SMP_LOAD(IT, SV, LF, KQ, VW) do { const int bs_ = (IT) >> 3, h_ = (IT) & 7; const size_t r_ = TP + bs_; \
      const float* s0_ = p->state_hgrn + ((size_t)((l * 128 + bs_) * 8 + h_)) * 16384; \
      VW = *(const u32x2*)(B.v + r_ * D + h_ * 128 + v4); \
      _Pragma("unroll") for (int i = 0; i < 8; ++i) { const int d_ = dq * 8 + i; const size_t o_ = r_ * D + h_ * 128 + d_; \
        LF[i] = B.lf[o_]; KQ[i] = (unsigned)B.q[o_]; SV[i] = __builtin_nontemporal_load((const f32x4*)(s0_ + d_ * 128 + v4)); } } while (0)
    int item = blockIdx.x, par = 0;
    if (item < 1024) SMP_LOAD(item, sv, lfv, kq, vw);
#pragma unroll 1
    for (; item < 1024; item += gridDim.x, par ^= 1) {
      const int bs = item >> 3, h = item & 7; const size_t r = TP + bs;
      const int nitem = item + gridDim.x;
      if (nitem < 1024) SMP_LOAD(nitem, svn, lfn, kqn, vwn);
      float* s1 = p->out + O_HGS + ((size_t)((l * 128 + bs) * 8 + h)) * 16384;
      const f32x4 vv = (f32x4){bf2f(vw[0] & 0xffffu), bf2f(vw[0] >> 16), bf2f(vw[1] & 0xffffu), bf2f(vw[1] >> 16)};
      f32x4 op = (f32x4){0.f, 0.f, 0.f, 0.f};
#pragma unroll
      for (int i = 0; i < 8; ++i) { const int d = dq * 8 + i;
        const float f = __expf(lfv[i]), kk = 1.f - f, qq = bf2f(kq[i]);
        const f32x4 sn = sv[i] * f + vv * kk;
        __builtin_nontemporal_store(sn, (f32x4*)(s1 + d * 128 + v4)); op += sn * qq; }
#pragma unroll
      for (int jx = 0; jx < 4; ++jx) op[jx] += __shfl_xor(op[jx], 32);
      float* psb = ps + par * 1024;
      if (lane < 32) *(f32x4*)(psb + wave * 128 + v4) = op;
      __syncthreads();
      if (tid < 64) { float o0 = 0.f, o1 = 0.f;
#pragma unroll
        for (int w = 0; w < 8; ++w) { const f32x2 x = *(const f32x2*)(psb + w * 128 + tid * 2); o0 += x[0]; o1 += x[1]; }
        float ss = o0 * o0 + o1 * o1;
#pragma unroll
        for (int o = 1; o < 64; o <<= 1) ss += __shfl_xor(ss, o);
        const float rstd = rsqrtf(ss * (1.f / 128.f) + EPS);
        const int vv2 = tid * 2; const size_t o = r * D + h * 128 + vv2;
        const float g0 = p->hg_gn_g[l * 128 + vv2], g1 = p->hg_gn_g[l * 128 + vv2 + 1];
        *(unsigned*)(B.on + o) = pk2(o0 * rstd * g0 * bf2f(B.g[o]), o1 * rstd * g1 * bf2f(B.g[o + 1])); }
#pragma unroll
      for (int i = 0; i < 8; ++i) { sv[i] = svn[i]; lfv[i] = lfn[i]; kq[i] = kqn[i]; }
      vw = vwn;
    }
    __syncthreads();
  }
  if (sample_first) scan_prompt<0>(p, l, B, shm);
}

constexpr int KN_STRIDE = 72, VT_STRIDE = 264;
constexpr int KN_BYTES = 256 * KN_STRIDE * 2;
struct AtBufs { const bf16_t* qraw; const float* kvraw; bf16_t* on; const float* tab; };

DI void attn_phase(KP p, const int l, const AtBufs& B, unsigned char* shm) {
  const int tid = tid_get(), lane = tid & 63, wave = tid >> 6;
  const int j = l - 2;
  const float* qg = p->q_norm_g + j * 64; const float* sinkp = p->sinks + j * 16;
  const bool write_cache = (l == 2);
  const int nitems = 512 + 512;
#pragma unroll 1
  for (int item = blockIdx.x; item < 512; item += gridDim.x) {
    {
      const int b = item >> 7, qb = (item >> 2) & 31, kvh = item & 3;
      bf16_t* Kn = (bf16_t*)shm; bf16_t* Vt = (bf16_t*)(shm + KN_BYTES);
      const int band0 = (qb - 1) * 128;
      {
        const int key = tid >> 1, part = tid & 1; const int pos = band0 + key; const bool valid = pos >= 0;
        float x1[16], x2[16];
        if (valid) { const float* kp = B.kvraw + ((size_t)b * SEQ + pos) * 512 + kvh * 64 + part * 16;
#pragma unroll
          for (int i = 0; i < 4; ++i) { const f32x4 a = *(const f32x4*)(kp + 4 * i), c = *(const f32x4*)(kp + 32 + 4 * i);
#pragma unroll
            for (int e = 0; e < 4; ++e) { x1[4 * i + e] = a[e]; x2[4 * i + e] = c[e]; } }
        } else {
#pragma unroll
          for (int i = 0; i < 16; ++i) { x1[i] = 0.f; x2[i] = 0.f; } }
        float ss = 0.f;
#pragma unroll
        for (int i = 0; i < 16; ++i) ss += x1[i] * x1[i] + x2[i] * x2[i];
        ss += __shfl_xor(ss, 1);
        const float rstd = rsqrtf(ss * (1.f / 64.f) + EPS);
        const float* tb = B.tab + (size_t)(valid ? pos : 0) * 64 + part * 16;
        float o1[16], o2[16];
#pragma unroll
        for (int i = 0; i < 16; ++i) { const float a = x1[i] * rstd * p->k_norm_g[part * 16 + i], c = x2[i] * rstd * p->k_norm_g[32 + part * 16 + i];
          const float cs = tb[i], sn = tb[32 + i]; o1[i] = a * cs - c * sn; o2[i] = c * cs + a * sn; }
        u32x4 w;
        w = (u32x4){pk2(o1[0], o1[1]), pk2(o1[2], o1[3]), pk2(o1[4], o1[5]), pk2(o1[6], o1[7])}; *(u32x4*)(Kn + key * KN_STRIDE + part * 16) = w;
        w = (u32x4){pk2(o1[8], o1[9]), pk2(o1[10], o1[11]), pk2(o1[12], o1[13]), pk2(o1[14], o1[15])}; *(u32x4*)(Kn + key * KN_STRIDE + part * 16 + 8) = w;
        w = (u32x4){pk2(o2[0], o2[1]), pk2(o2[2], o2[3]), pk2(o2[4], o2[5]), pk2(o2[6], o2[7])}; *(u32x4*)(Kn + key * KN_STRIDE + 32 + part * 16) = w;
        w = (u32x4){pk2(o2[8], o2[9]), pk2(o2[10], o2[11]), pk2(o2[12], o2[13]), pk2(o2[14], o2[15])}; *(u32x4*)(Kn + key * KN_STRIDE + 32 + part * 16 + 8) = w;
        if (write_cache && qb == 31 && key >= 128) { float* ko = p->out + O_KP + ((size_t)(b * 128 + key - 128) * 4 + kvh) * 64 + part * 16;
#pragma unroll
          for (int i = 0; i < 4; ++i) { *(f32x4*)(ko + 4 * i) = (f32x4){o1[4 * i], o1[4 * i + 1], o1[4 * i + 2], o1[4 * i + 3]};
            *(f32x4*)(ko + 32 + 4 * i) = (f32x4){o2[4 * i], o2[4 * i + 1], o2[4 * i + 2], o2[4 * i + 3]}; } }
      }
      {
        const int key = tid & 255, dh = tid >> 8; const int pos = band0 + key; const bool valid = pos >= 0;
        const float* vp = B.kvraw + ((size_t)b * SEQ + (valid ? pos : 0)) * 512 + 256 + kvh * 64 + dh * 32;
#pragma unroll
        for (int i = 0; i < 8; ++i) { f32x4 a = *(const f32x4*)(vp + 4 * i); if (!valid) a = (f32x4){0.f, 0.f, 0.f, 0.f};
#pragma unroll
          for (int e = 0; e < 4; ++e) Vt[(dh * 32 + 4 * i + e) * VT_STRIDE + key] = (bf16_t)f2bf(a[e]);
          if (write_cache && qb == 31 && key >= 128) *(f32x4*)(p->out + O_VP + ((size_t)(b * 128 + key - 128) * 4 + kvh) * 64 + dh * 32 + 4 * i) = a; }
      }
      __syncthreads();
      const int g = wave & 3, qhalf = wave >> 2, hq = kvh * 4 + g, h = lane >> 5, l31 = lane & 31;
      const float sink = sinkp[hq];
#pragma unroll 1
      for (int sub = 0; sub < 2; ++sub) {
        const int Q0 = 128 + qhalf * 64 + sub * 32, qi = Q0 + l31, pos = band0 + qi;
        const size_t tok = (size_t)b * SEQ + pos;
        float x[4][8];
        { const bf16_t* qp = B.qraw + tok * D + hq * 64 + 8 * h;
#pragma unroll
          for (int s = 0; s < 4; ++s) { const u32x4 w = *(const u32x4*)(qp + 16 * s);
#pragma unroll
            for (int e = 0; e < 4; ++e) { x[s][2 * e] = bf2f(w[e] & 0xffffu); x[s][2 * e + 1] = bf2f(w[e] >> 16); } } }
        float ss = 0.f;
#pragma unroll
        for (int s = 0; s < 4; ++s)
#pragma unroll
          for (int e = 0; e < 8; ++e) ss += x[s][e] * x[s][e];
        ss += __shfl_xor(ss, 32);
        const float rstd = rsqrtf(ss * (1.f / 64.f) + EPS) ;
#pragma unroll
        for (int s = 0; s < 4; ++s)
#pragma unroll
          for (int e = 0; e < 8; ++e) x[s][e] *= rstd * qg[16 * s + 8 * h + e];
        const float* tb = B.tab + (size_t)pos * 64;
        bf16x8 qf[4];
#pragma unroll
        for (int s = 0; s < 2; ++s) { unsigned lo[4], hi[4]; float r1[8], r2[8];
#pragma unroll
          for (int e = 0; e < 8; ++e) { const int i = 16 * s + 8 * h + e; const float cs = tb[i], sn = tb[32 + i]; const float a = x[s][e], c = x[s + 2][e];
            r1[e] = (a * cs - c * sn) * 0.125f; r2[e] = (c * cs + a * sn) * 0.125f; }
#pragma unroll
          for (int e = 0; e < 4; ++e) { lo[e] = pk2(r1[2 * e], r1[2 * e + 1]); hi[e] = pk2(r2[2 * e], r2[2 * e + 1]); }
          qf[s] = __builtin_bit_cast(bf16x8, (u32x4){lo[0], lo[1], lo[2], lo[3]}); qf[s + 2] = __builtin_bit_cast(bf16x8, (u32x4){hi[0], hi[1], hi[2], hi[3]}); }
        const int kb0 = (Q0 - 128) >> 5;
        f32x16 sacc[5]; float mx = sink;
#pragma unroll
        for (int i = 0; i < 5; ++i) { const int kb = kb0 + i; f32x16 a16;
#pragma unroll
          for (int r = 0; r < 16; ++r) a16[r] = 0.f;
          bf16x8 ka[4];
#pragma unroll
          for (int s = 0; s < 4; ++s) ka[s] = *(const bf16x8*)(Kn + (kb * 32 + l31) * KN_STRIDE + 16 * s + 8 * h);
#pragma unroll
          for (int s = 0; s < 4; ++s) a16 = __builtin_amdgcn_mfma_f32_32x32x16_bf16(ka[s], qf[s], a16, 0, 0, 0);
#pragma unroll
          for (int r = 0; r < 16; ++r) { const int key = kb * 32 + crow(r, h); const int rel = qi - key; const bool ok = (rel >= 0) && (rel < 128) && (qb > 0 || key >= 128);
            const float sv = ok ? a16[r] : -1e30f; a16[r] = sv; mx = fmaxf(mx, sv); }
          sacc[i] = a16; }
        mx = fmaxf(mx, __shfl_xor(mx, 32));
        float sum = 0.f; bf16x8 pf[5][2];
#pragma unroll
        for (int i = 0; i < 5; ++i) { float e[16];
#pragma unroll
          for (int r = 0; r < 16; ++r) { e[r] = __expf(sacc[i][r] - mx); sum += e[r]; }
#pragma unroll
          for (int st = 0; st < 2; ++st) pf[i][st] = __builtin_bit_cast(bf16x8, (u32x4){pk2(e[8 * st], e[8 * st + 1]), pk2(e[8 * st + 2], e[8 * st + 3]), pk2(e[8 * st + 4], e[8 * st + 5]), pk2(e[8 * st + 6], e[8 * st + 7])}); }
        sum += __shfl_xor(sum, 32);
        const float inv = 1.f / (sum + __expf(sink - mx));
#pragma unroll
        for (int db = 0; db < 2; ++db) { f32x16 o16;
#pragma unroll
          for (int r = 0; r < 16; ++r) o16[r] = 0.f;
          bf16x8 va[10];
#pragma unroll
          for (int i = 0; i < 5; ++i)
#pragma unroll
            for (int st = 0; st < 2; ++st) { const bf16_t* vp = Vt + (db * 32 + l31) * VT_STRIDE + (kb0 + i) * 32 + 16 * st + 4 * h;
              const u32x2 lo = *(const u32x2*)vp, hi = *(const u32x2*)(vp + 8);
              va[i * 2 + st] = __builtin_bit_cast(bf16x8, (u32x4){lo[0], lo[1], hi[0], hi[1]}); }
          f32x16 o16b;
#pragma unroll
          for (int r = 0; r < 16; ++r) o16b[r] = 0.f;
#pragma unroll
          for (int i = 0; i < 5; ++i) { o16 = __builtin_amdgcn_mfma_f32_32x32x16_bf16(va[i * 2], pf[i][0], o16, 0, 0, 0); o16b = __builtin_amdgcn_mfma_f32_32x32x16_bf16(va[i * 2 + 1], pf[i][1], o16b, 0, 0, 0); }
#pragma unroll
          for (int r = 0; r < 16; ++r) o16[r] += o16b[r];
          bf16_t* op = B.on + tok * D + hq * 64 + db * 32 + 4 * h;
#pragma unroll
          for (int r4 = 0; r4 < 4; ++r4) *(u32x2*)(op + 8 * r4) = (u32x2){pk2(o16[4 * r4] * inv, o16[4 * r4 + 1] * inv), pk2(o16[4 * r4 + 2] * inv, o16[4 * r4 + 3] * inv)}; }
      }
      __syncthreads();
    }
  }
  {
    const int tid = tid_get(), lane = tid & 63, wave = tid >> 6;
#pragma unroll 1
    for (int item = 512 + blockIdx.x; item < nitems; item += gridDim.x) {
      const int sidx = item - 512, bs = sidx >> 2, kvh = sidx & 3; const size_t r = TP + bs;
      float* Ks = (float*)shm; float* Vs = Ks + 128 * 68; float* q_s = Vs + 128 * 64; float* p_s = q_s + 256; float* redm = p_s + 512; float* reds = redm + 8; float* po = reds + 8;
      const float* tb = B.tab + (size_t)4096 * 64;
      f32x4 kreg[4], vreg[4];
#pragma unroll
      for (int i = 0; i < 4; ++i) { const int e = tid + 512 * i, jr = e >> 4, c4 = (e & 15) * 4;
        if (jr < 127) { const size_t o = (((size_t)bs * 128 + jr + 1) * 4 + kvh) * 64 + c4; kreg[i] = __builtin_nontemporal_load((const f32x4*)(p->cache_k + o)); vreg[i] = __builtin_nontemporal_load((const f32x4*)(p->cache_v + o)); } }
      if (tid < 128) { const int g = tid >> 5, i = tid & 31, hq = kvh * 4 + g;
        float a = bf2f(B.qraw[r * D + hq * 64 + i]), c = bf2f(B.qraw[r * D + hq * 64 + 32 + i]);
        float ss = a * a + c * c;
#pragma unroll
        for (int o = 1; o < 32; o <<= 1) ss += __shfl_xor(ss, o);
        const float rstd = rsqrtf(ss * (1.f / 64.f) + EPS); a *= rstd * qg[i]; c *= rstd * qg[32 + i];
        const float cs = tb[i], sn = tb[32 + i];
        q_s[g * 64 + i] = (a * cs - c * sn) * 0.125f; q_s[g * 64 + 32 + i] = (c * cs + a * sn) * 0.125f;
      } else if (tid < 160) { const int i = tid & 31;
        float a = B.kvraw[r * 512 + kvh * 64 + i], c = B.kvraw[r * 512 + kvh * 64 + 32 + i];
        float ss = a * a + c * c;
#pragma unroll
        for (int o = 1; o < 32; o <<= 1) ss += __shfl_xor(ss, o);
        const float rstd = rsqrtf(ss * (1.f / 64.f) + EPS); a *= rstd * p->k_norm_g[i]; c *= rstd * p->k_norm_g[32 + i];
        const float cs = tb[i], sn = tb[32 + i];
        const float k1 = a * cs - c * sn, k2 = c * cs + a * sn, v1 = B.kvraw[r * 512 + 256 + kvh * 64 + i], v2 = B.kvraw[r * 512 + 256 + kvh * 64 + 32 + i];
        Ks[127 * 68 + i] = k1; Ks[127 * 68 + 32 + i] = k2; Vs[127 * 64 + i] = v1; Vs[127 * 64 + 32 + i] = v2;
        if (write_cache) { float* ok = p->out + O_KS + (((size_t)bs * 128 + 127) * 4 + kvh) * 64; float* ov = p->out + O_VS + (((size_t)bs * 128 + 127) * 4 + kvh) * 64;
          ok[i] = k1; ok[32 + i] = k2; ov[i] = v1; ov[32 + i] = v2; } }
#pragma unroll
      for (int i = 0; i < 4; ++i) { const int e = tid + 512 * i, jr = e >> 4, c4 = (e & 15) * 4;
        if (jr < 127) { *(f32x4*)(Ks + jr * 68 + c4) = kreg[i]; *(f32x4*)(Vs + jr * 64 + c4) = vreg[i];
          if (write_cache) { const size_t o = (((size_t)bs * 128 + jr) * 4 + kvh) * 64 + c4; __builtin_nontemporal_store(kreg[i], (f32x4*)(p->out + O_KS + o)); __builtin_nontemporal_store(vreg[i], (f32x4*)(p->out + O_VS + o)); } } }
      __syncthreads();
      const int g = tid >> 7, jk = tid & 127, hq = kvh * 4 + g; const float sink = sinkp[hq];
      float sc = 0.f;
#pragma unroll
      for (int d4 = 0; d4 < 16; ++d4) { const f32x4 kv = *(const f32x4*)(Ks + jk * 68 + 4 * d4), qv = *(const f32x4*)(q_s + g * 64 + 4 * d4); sc += kv[0] * qv[0] + kv[1] * qv[1] + kv[2] * qv[2] + kv[3] * qv[3]; }
      float mx = sc;
#pragma unroll
      for (int o = 1; o < 64; o <<= 1) mx = fmaxf(mx, __shfl_xor(mx, o));
      if (lane == 0) redm[wave] = mx;
      __syncthreads();
      mx = fmaxf(fmaxf(redm[2 * g], redm[2 * g + 1]), sink);
      const float ev = __expf(sc - mx); float sum = ev;
#pragma unroll
      for (int o = 1; o < 64; o <<= 1) sum += __shfl_xor(sum, o);
      if (lane == 0) reds[wave] = sum;
      p_s[g * 128 + jk] = ev;
      __syncthreads();
      const float inv = 1.f / (reds[2 * g] + reds[2 * g + 1] + __expf(sink - mx));
      { const int d = jk & 63, jh = jk >> 6; float o = 0.f;
#pragma unroll 8
        for (int jx = 0; jx < 64; ++jx) o += p_s[g * 128 + jh * 64 + jx] * Vs[(jh * 64 + jx) * 64 + d];
        po[tid] = o;
        __syncthreads();
        if (jh == 0) { const float tot = (o + po[tid + 64]) * inv; B.on[r * D + hq * 64 + d] = (bf16_t)f2bf(tot); } }
      __syncthreads();
    }
  }
}

#define XB_TMO      128
#define XB_XCNT(j)  (256  + 64 * (j))
#define XB_XSUB(j)  (1280 + 64 * (j))
#define XB_XGEN(j)  (2304 + 64 * (j))
#define XB_TOP      3328
#define XB_TOPGEN   3392
#define XCD_BAR_WORDS 3456
#define XB_SPIN_CAP (1u << 18)

__device__ __forceinline__ unsigned xb_ld(unsigned* p)              { return __hip_atomic_load(p, __ATOMIC_RELAXED, __HIP_MEMORY_SCOPE_AGENT); }
__device__ __forceinline__ unsigned xb_add(unsigned* p, unsigned v) { return __hip_atomic_fetch_add(p, v, __ATOMIC_RELAXED, __HIP_MEMORY_SCOPE_AGENT); }
__device__ __forceinline__ unsigned xb_xcc_id() { return (unsigned)__builtin_amdgcn_s_getreg((3 << 11) | 20) & 0xFu; }
#define XB_SPIN(cond, bar) do { unsigned _sp = 0; while (cond) { __builtin_amdgcn_s_sleep(1); \
    if ((++_sp & 255u) == 0u) { if (xb_ld(&(bar)[XB_TMO])) break; if (_sp > XB_SPIN_CAP) { atomicAdd(&(bar)[XB_TMO], 1u); break; } } } } while (0)

struct XcdBarrier {
    unsigned* bar; unsigned x;
    volatile LAS unsigned* st;
};

__device__ __forceinline__ XcdBarrier xcd_barrier_post(unsigned* bar, volatile LAS unsigned* st) {
    XcdBarrier b; b.bar = bar; b.x = xb_xcc_id(); b.st = st;
    if (threadIdx.x == 0) (void)xb_add(&bar[XB_XCNT(b.x)], 1u);
    return b;
}
__device__ __forceinline__ void xcd_barrier_complete(unsigned* bar, unsigned x, unsigned& nloc, unsigned& nx) {
    const unsigned G = gridDim.x * gridDim.y * gridDim.z;
    unsigned sum, cnt, mine, sp = 0u;
    for (;;) {
        sum = 0u; cnt = 0u; mine = 0u;
#pragma unroll
        for (unsigned j = 0; j < 16; ++j) { const unsigned c = xb_ld(&bar[XB_XCNT(j)]); sum += c; cnt += (c > 0u) ? 1u : 0u; mine = (j == x) ? c : mine; }
        if (sum == G) break;
        __builtin_amdgcn_s_sleep(1);
        if ((++sp & 255u) == 0u) { if (xb_ld(&bar[XB_TMO])) break; if (sp > XB_SPIN_CAP) { atomicAdd(&bar[XB_TMO], 1u); break; } }
    }
    nloc = mine > 0u ? mine : 1u; nx = cnt > 0u ? cnt : 1u;
}

__device__ __forceinline__ void xcd_barrier(const XcdBarrier& b) {
    asm volatile("s_waitcnt vmcnt(0)" ::: "memory");
    __syncthreads();
    if (threadIdx.x == 0) {
        unsigned* bar = b.bar;
        __builtin_amdgcn_s_waitcnt(0);
        unsigned nloc = b.st[0], nx = b.st[1];
        if (nloc == 0u) { xcd_barrier_complete(bar, b.x, nloc, nx); b.st[0] = nloc; b.st[1] = nx; }
        const unsigned old = xb_add(&bar[XB_XSUB(b.x)], 1u);
        const unsigned gen = old / nloc;
        if (old + 1u == (gen + 1u) * nloc) {
            __builtin_amdgcn_fence(__ATOMIC_RELEASE, "agent");
            asm volatile("s_waitcnt vmcnt(0)" ::: "memory");
            const unsigned og = xb_add(&bar[XB_TOP], 1u);
            const unsigned tg = og / nx;
            if (og + 1u == (tg + 1u) * nx) xb_add(&bar[XB_TOPGEN], 1u);
            else XB_SPIN(xb_ld(&bar[XB_TOPGEN]) == tg, bar);
            __builtin_amdgcn_fence(__ATOMIC_ACQUIRE, "agent");
            xb_add(&bar[XB_XGEN(b.x)], 1u);
            asm volatile("s_waitcnt vmcnt(0)" ::: "memory");
        } else {
            XB_SPIN(xb_ld(&bar[XB_XGEN(b.x)]) == gen, bar);
            __builtin_amdgcn_fence(__ATOMIC_ACQUIRE, "agent");
            asm volatile("s_waitcnt vmcnt(0)" ::: "memory");
        }
    }
    __syncthreads();
}


__global__ void __launch_bounds__(NTHREADS, 2) yoco_fwd(P parg) {
  extern __shared__ __attribute__((aligned(16))) unsigned char shm[];
  cg::grid_group grid = cg::this_grid();
  volatile LAS unsigned* xst = (volatile LAS unsigned*)((LAS unsigned char*)shm + 131072);
  if (threadIdx.x < 4) xst[threadIdx.x] = 0u;
  __syncthreads();
  const int nMt = TP / BM;
#pragma unroll 1
  for (int step = -2; step < 32; ++step) {
    const int l = (step < 0) ? 0 : (step >> 3), sub = (step < 0) ? (8 + step + 2) : (step & 7); const bool hg = (l < 2);
    if (sub == 3 && !hg) continue;
    if (sub == 5 || (sub == 0 && l > 0)) continue;
    KP p = kp_get(); unsigned char* ws = p->ws;
#ifndef PROBE_REPS
#define PROBE_REPS 1
#endif
#ifndef PROBE_GREPS
#define PROBE_GREPS 1
#endif
    const bool is_gemm = (sub == 0 || sub == 1 || sub == 4 || sub == 6 || sub == 7 || sub == 9);
#ifndef PROBE_MASK
#define PROBE_MASK 0
#endif
    const int pcode = (sub == 2 && !hg) ? 10 : sub;
    const int reps = (((PROBE_MASK >> pcode) & 1) && !(sub == 4 || sub == 7)) ? 2 : 1;
#pragma unroll 1
    for (int rep = 0; rep < reps; ++rep) {
    if (sub == 8) {
      prep_phase(p, shm);
    } else if (sub == 0 || sub == 1 || sub == 4 || sub == 6 || sub == 7 || sub == 9) {
      float* mods = (float*)(ws + OFF_MODS);
      bf16_t* hbuf = (bf16_t*)(ws + OFF_H); bf16_t* onbuf = (bf16_t*)(ws + OFF_ON); bf16_t* ubuf = (bf16_t*)(ws + OFF_U);
      GemmJob j0, j1; EpiArgs E{}; int nj = 1; E.layer = l; E.first = 0;
      float* rssb = (float*)(ws + OFF_RSS); const float* biasb = (const float*)(ws + OFF_BIAS);
      j1.A = (const bf16_t*)(ws + OFF_X); j1.Bt = (const bf16_t*)(ws + OFF_WKV); j1.nM = nMt; j1.nN = 2; j1.K = D; j1.epi = EPI_KVRAW;
      j0.nM = nMt; j0.K = D;
      if (sub == 0) { j0.A = (const bf16_t*)(ws + OFF_ASH); j0.Bt = (const bf16_t*)ws; j0.nM = 1; j0.nN = 106; j0.epi = EPI_BIAS; j1.A = (const bf16_t*)(ws + OFF_BIAS); }
      else if (sub == 9) { j0.A = (const bf16_t*)(ws + OFF_X + (size_t)MODW * D * 2); j0.Bt = (const bf16_t*)(ws + OFF_X); j0.nM = 1; j0.nN = MODW / BM; j0.epi = EPI_ADA; E.f0 = mods; E.ash = (bf16_t*)(ws + OFF_ASH); }
      else if (sub == 1 && hg) { E.rss = rssb + (size_t)(2 * l) * T; E.bias = biasb + (size_t)132 * site_prefN(l); E.bN = 4096; j0.A = hbuf; j0.Bt = (const bf16_t*)(ws + OFF_WIN) + (size_t)l * 4096 * D; j0.nN = 16; j0.epi = EPI_HGIN;
        E.f0 = (float*)(ws + OFF_X); E.b0 = (bf16_t*)(ws + OFF_U); E.b1 = (bf16_t*)(ws + OFF_U + SZ_ACT); E.b2 = (bf16_t*)(ws + OFF_U + 2 * SZ_ACT); E.b3 = (bf16_t*)(ws + OFF_U + 3 * SZ_ACT); }
      else if (sub == 1) { E.rss = rssb + (size_t)(2 * l) * T; E.bias = biasb + (size_t)132 * site_prefN(l); E.bN = 1024; E.bias1 = biasb + (size_t)132 * site_prefN(4); E.bN1 = 512; j0.A = hbuf; j0.Bt = (const bf16_t*)(ws + OFF_WQ) + (size_t)(l - 2) * D * D; j0.nN = 4; j0.epi = EPI_QRAW;
        E.b1 = (bf16_t*)(ws + OFF_X + SZ_ACT); E.f2 = (float*)(ws + OFF_X + 2 * SZ_ACT); nj = (l == 2) ? 2 : 1; }
      else if (sub == 4) { E.rss_out = rssb + (size_t)(1 + 2 * l) * T; E.ng = p->norm2_g + l * D; E.nsc = mods + l * 6144 + 4096; E.yout = hbuf; j0.A = onbuf; j0.Bt = hg ? (const bf16_t*)(ws + OFF_WOUT) + (size_t)l * D * D : (const bf16_t*)(ws + OFF_WO) + (size_t)(l - 2) * D * D; j0.nN = 4; j0.epi = EPI_RESID;
        E.f0 = p->out + O_Y; E.f1 = mods + l * 6144 + 2048; E.first = (l == 0); }
      else if (sub == 6) { E.rss = rssb + (size_t)(1 + 2 * l) * T; E.bias = biasb + (size_t)132 * site_prefN(5 + l); E.bN = 4096; j0.A = hbuf; j0.Bt = (const bf16_t*)(ws + OFF_WUP) + (size_t)l * D * FF; j0.nN = 16; j0.epi = EPI_UP; E.b0 = ubuf; }
      else { if (l < 3) { E.rss_out = rssb + (size_t)(2 * (l + 1)) * T; E.ng = p->norm1_g + (l + 1) * D; E.nsc = mods + (l + 1) * 6144 + 1024; E.yout = hbuf;
          if (l == 1) { E.ngkv = p->kv_norm_g; E.nsckv = mods + 24576 + 1024; E.ykv = (bf16_t*)(ws + OFF_X); } }
        j0.A = ubuf; j0.Bt = (const bf16_t*)(ws + OFF_WDN) + (size_t)l * D * FF; j0.nN = 4; j0.K = FF; j0.epi = EPI_RESID; E.f0 = p->out + O_Y; E.f1 = mods + l * 6144 + 5120; }
      gemm_phase(p, (LAS unsigned char*)shm, shm, j0, j1, nj, E, sub != 9 && sub != 0);
      if (sub == 0) init_rows(p, (unsigned*)(ws + OFF_BAR) + XCD_BAR_WORDS + 100);
    } else if (sub == 2 && hg) {
      HgBufs HB; HB.q = (bf16_t*)(ws + OFF_U); HB.k = (bf16_t*)(ws + OFF_U + SZ_ACT); HB.v = (bf16_t*)(ws + OFF_U + 2 * SZ_ACT); HB.g = (bf16_t*)(ws + OFF_U + 3 * SZ_ACT);
      HB.lf = (float*)(ws + OFF_X); HB.o32 = (float*)(ws + OFF_X + 2 * SZ_ACT); HB.on = (bf16_t*)(ws + OFF_ON);
      scan_phase(p, l, HB, shm);
    } else if (sub == 2) {
      AtBufs AB; AB.qraw = (bf16_t*)(ws + OFF_X + SZ_ACT); AB.kvraw = (float*)(ws + OFF_X + 2 * SZ_ACT); AB.on = (bf16_t*)(ws + OFF_ON); AB.tab = (const float*)(ws + OFF_TAB);
      attn_phase(p, l, AB, shm);
    } else {
      HgBufs HB; HB.q = (bf16_t*)(ws + OFF_U); HB.k = (bf16_t*)(ws + OFF_U + SZ_ACT); HB.v = (bf16_t*)(ws + OFF_U + 2 * SZ_ACT); HB.g = (bf16_t*)(ws + OFF_U + 3 * SZ_ACT);
      HB.lf = (float*)(ws + OFF_X); HB.o32 = (float*)(ws + OFF_X + 2 * SZ_ACT); HB.on = (bf16_t*)(ws + OFF_ON);
      scan_passB(HB);
      { KP pb = kp_get(); XcdBarrier xb; xb.bar = (unsigned*)(pb->ws + OFF_BAR); xb.x = xb_xcc_id(); xb.st = xst; xcd_barrier(xb); }
      scan_prompt<1>(p, l, HB, shm);
    }
    }
    if (step == 31) break;
    if (step == -2) { grid.sync(); KP p0 = kp_get(); if (tid_get() == 0) (void)xb_add((unsigned*)(p0->ws + OFF_BAR) + XB_XCNT(xb_xcc_id()), 1u); }
    else { KP pb = kp_get(); XcdBarrier xb; xb.bar = (unsigned*)(pb->ws + OFF_BAR); xb.x = xb_xcc_id(); xb.st = xst; xcd_barrier(xb); }
  }
}

extern "C" void kernel_launch(void* const* d_in, const int* in_sizes, int n_in, void* d_out, int out_size, void* d_ws, size_t ws_size, hipStream_t stream) {
  static int grid_blocks = 0;
  if (!grid_blocks) {
    int dev = 0, cus = 0, per_cu = 0;
    hipGetDevice(&dev);
    hipDeviceGetAttribute(&cus, hipDeviceAttributeMultiprocessorCount, dev);
    if (hipFuncSetAttribute((const void*)yoco_fwd, hipFuncAttributeMaxDynamicSharedMemorySize, LDS_BYTES) != hipSuccess) fprintf(stderr, "hipFuncSetAttribute failed\n");
    if (hipOccupancyMaxActiveBlocksPerMultiprocessor(&per_cu, (const void*)yoco_fwd, NTHREADS, LDS_BYTES) != hipSuccess || per_cu < 1) { fprintf(stderr, "occupancy query failed\n"); per_cu = 1; }
    grid_blocks = cus * per_cu;
    if (ws_size < WS_NEED) fprintf(stderr, "workspace too small: %zu < %zu\n", ws_size, (size_t)WS_NEED);
  }
  P p{};
  const float** pp = (const float**)&p;
  for (int i = 0; i < 26; ++i) pp[i] = (const float*)d_in[i];
  p.out = (float*)d_out; p.ws = (unsigned char*)d_ws;
  void* args[] = {&p};
  hipError_t e = hipLaunchCooperativeKernel((const void*)yoco_fwd, dim3(grid_blocks), dim3(NTHREADS), args, LDS_BYTES, stream);
  if (e != hipSuccess) fprintf(stderr, "cooperative launch failed: %s (grid %d)\n", hipGetErrorString(e), grid_blocks);
}
```

```cpp
#include <hip/hip_runtime.h>
#include <hip/hip_cooperative_groups.h>
#include <cstdio>
#include <cstdint>
namespace cg = cooperative_groups;

#define DI __device__ __forceinline__
typedef unsigned short bf16_t;
typedef short bf16x8 __attribute__((ext_vector_type(8)));
typedef float f32x4 __attribute__((ext_vector_type(4)));
typedef float f32x2 __attribute__((ext_vector_type(2)));
typedef float f32x16 __attribute__((ext_vector_type(16)));
typedef unsigned u32x4 __attribute__((ext_vector_type(4)));
typedef unsigned u32x2 __attribute__((ext_vector_type(2)));
#define LAS __attribute__((address_space(3)))

constexpr int D = 1024, FF = 4096, TP = 16384, TS = 128, T = TP + TS, TPAD = 16640, SEQ = 4096;
constexpr int NMOD = 132, MODW = 4 * 6144 + 2048;
constexpr float EPS = 1e-6f;
constexpr int NTHREADS = 512, NWAVES = 8;
constexpr int LDS_BYTES = 131072 + 16;

constexpr size_t O_Y = 0;
constexpr size_t O_HGP = (size_t)T * D;
constexpr size_t O_KP = O_HGP + (size_t)2 * 4 * 8 * 128 * 128;
constexpr size_t O_VP = O_KP + (size_t)4 * 128 * 4 * 64;
constexpr size_t O_HGS = O_VP + (size_t)4 * 128 * 4 * 64;
constexpr size_t O_KS = O_HGS + (size_t)2 * 128 * 8 * 128 * 128;
constexpr size_t O_VS = O_KS + (size_t)128 * 128 * 4 * 64;

constexpr size_t SZ_ACT = (size_t)TPAD * D * 2;
constexpr size_t OFF_WIN = 0;
constexpr size_t OFF_WOUT = OFF_WIN + (size_t)2 * 4096 * 1024 * 2;
constexpr size_t OFF_WKV = OFF_WOUT + (size_t)2 * 1024 * 1024 * 2;
constexpr size_t OFF_WQ = OFF_WKV + (size_t)512 * 1024 * 2;
constexpr size_t OFF_WO = OFF_WQ + (size_t)2 * 1024 * 1024 * 2;
constexpr size_t OFF_WUP = OFF_WO + (size_t)2 * 1024 * 1024 * 2;
constexpr size_t OFF_WDN = OFF_WUP + (size_t)4 * 4096 * 1024 * 2;
constexpr size_t OFF_MODS = OFF_WDN + (size_t)4 * 4096 * 1024 * 2;
constexpr size_t OFF_TAB = OFF_MODS + (((size_t)NMOD * MODW * 4 + 4095) & ~(size_t)4095);
constexpr size_t OFF_H = OFF_TAB + (((size_t)4097 * 64 * 4 + 4095) & ~(size_t)4095);
constexpr size_t OFF_ON = OFF_H + SZ_ACT;
constexpr size_t OFF_U = OFF_ON + SZ_ACT;
constexpr size_t OFF_X = OFF_U + 4 * SZ_ACT;
constexpr size_t OFF_BAR = OFF_X + 4 * SZ_ACT;
constexpr size_t BAR_BYTES = 16384;
constexpr size_t OFF_RSS = OFF_BAR + BAR_BYTES;
constexpr size_t ZERO_BYTES = BAR_BYTES + (size_t)9 * T * 4;
constexpr size_t OFF_ASH = OFF_BAR + ((ZERO_BYTES + 4095) & ~(size_t)4095);
constexpr size_t OFF_BIAS = OFF_ASH + (size_t)9 * 256 * 1024 * 2;
constexpr size_t WS_NEED = OFF_BIAS + (size_t)132 * 27136 * 4;

struct P {
  const float *x_prompt, *x_sample, *c_prompt, *c_sample, *state_hgrn, *cache_k, *cache_v;
  const float *w_ada, *b_ada, *norm1_g, *norm2_g, *hg_w_in, *hg_w_out, *hg_lbp, *hg_gn_g;
  const float *kv_w_ada, *kv_b_ada, *kv_norm_g, *w_kv, *k_norm_g, *w_q, *q_norm_g, *sinks, *w_o, *w_up, *w_down;
  float* out; unsigned char* ws;
};

typedef const P __attribute__((address_space(4)))* KP;
DI KP kp_get() { KP q = (KP)__builtin_amdgcn_kernarg_segment_ptr(); asm volatile("" : "+s"(q)); return q; }
DI int tid_get() { int t = threadIdx.x; asm volatile("" : "+v"(t)); return t; }
DI unsigned f2bf(float f) { unsigned u = __float_as_uint(f); return (u + 0x7fffu + ((u >> 16) & 1u)) >> 16; }
typedef __bf16 bf16x2_n __attribute__((ext_vector_type(2)));
DI unsigned pk2(float lo, float hi) { return __builtin_bit_cast(unsigned, __builtin_convertvector((f32x2){lo, hi}, bf16x2_n)); }
DI float bf2f(unsigned b) { return __uint_as_float(b << 16); }
DI float silu_f(float x) { return x * __builtin_amdgcn_rcpf(1.f + __expf(-x)); }
DI int modrow(int r) { return r < TP ? (r >> 12) : (4 + r - TP); }
DI int crow(int reg, int h) { return (reg & 3) + 8 * (reg >> 2) + 4 * h; }

constexpr int BM = 256, BK = 64, HALF = 128, HTB = HALF * BK * 2;
DI int lds_byte(int r, int c) { const int st = (r >> 4) * 2 + (c >> 5), rr = r & 15, cc = c & 31, ob = rr * 64 + cc * 2; return st * 1024 + (ob ^ (((ob >> 9) & 1) << 5)); }
DI void stage_rc(int b, int& R, int& C) { const int st = b / 1024, sb = b % 1024, swz = sb ^ (((sb >> 9) & 1) << 5); R = (st >> 1) * 16 + swz / 64; C = (st & 1) * 32 + (swz % 64) / 2; }

enum { EPI_ADA = 0, EPI_HGIN = 1, EPI_RESID = 2, EPI_UP = 3, EPI_QRAW = 4, EPI_KVRAW = 5, EPI_NOP = 6, EPI_BIAS = 7 };
struct GemmJob { const bf16_t* A; const bf16_t* Bt; int nM, nN, K, epi; };
struct EpiArgs {
  float* f0; const float* f1; float* f2; bf16_t* b0; bf16_t* b1; bf16_t* b2; bf16_t* b3; int layer; int first;
  const float* rss; const float* bias; const float* bias1; int bN, bN1;
  float* rss_out; const float* ng; const float* nsc; bf16_t* yout; const float* ngkv; const float* nsckv; bf16_t* ykv;
  bf16_t* ash;
};
DI int site_N(const int s) { return (s == 2 || s == 3) ? 1024 : (s == 4 ? 512 : 4096); }
DI int site_prefN(const int s) { return s == 0 ? 0 : s == 1 ? 4096 : s == 2 ? 8192 : s == 3 ? 9216 : s == 4 ? 10240 : 10752 + (s - 5) * 4096; }

DI void tile_of(int L, int nM, int nN, int& pm, int& pn) {
  const int nwg = nM * nN; int wgid = L;
  { const int q = nwg / 8, r = nwg % 8, xcd = wgid % 8, off = wgid / 8; wgid = (xcd < r ? xcd * (q + 1) : r * (q + 1) + (xcd - r) * q) + off; }
  const int nig = 8 * nN, gid = wgid / nig, fm = gid * 8, gsz = (nM - fm) < 8 ? (nM - fm) : 8;
  pm = fm + ((wgid % nig) % gsz); pn = (wgid % nig) / gsz;
}

DI void epi_frag(KP p, const int epi, const EpiArgs& E, const int r, const int c, const f32x4 vin) {
  if (epi == EPI_NOP) return;
  f32x4 v = vin;
  if (epi == EPI_HGIN || epi == EPI_UP || epi == EPI_QRAW || epi == EPI_KVRAW) {
    const float rstd = rsqrtf(E.rss[r] * (1.f / D) + EPS);
    const float* bp = ((epi == EPI_KVRAW) ? E.bias1 + (size_t)modrow(r) * E.bN1 : E.bias + (size_t)modrow(r) * E.bN) + c;
    v = v * rstd + *(const f32x4*)bp; }
  if (epi == EPI_HGIN) {
    const int sec = c >> 10, cc = c & 1023; const size_t o = (size_t)r * D + cc;
    if (sec == 1) { f32x4 lb = (f32x4){0.f, 0.f, 0.f, 0.f};
      if (E.layer == 1) { const f32x4 l0 = *(const f32x4*)(p->hg_lbp + cc), l1 = *(const f32x4*)(p->hg_lbp + D + cc);
#pragma unroll
        for (int j = 0; j < 4; ++j) lb[j] = __builtin_amdgcn_rcpf(1.f + __expf(l0[j] - l1[j])); }
      f32x4 lf;
#pragma unroll
      for (int j = 0; j < 4; ++j) { const float sg = __builtin_amdgcn_rcpf(1.f + __expf(-v[j])); const float fg = lb[j] + (1.f - lb[j]) * sg; lf[j] = __logf(fg); }
      *(f32x4*)(E.f0 + o) = lf;
    } else if (sec == 2) { *(u32x2*)(E.b2 + o) = (u32x2){pk2(v[0], v[1]), pk2(v[2], v[3])};
    } else { bf16_t* dst = (sec == 0) ? E.b0 : E.b3; *(u32x2*)(dst + o) = (u32x2){pk2(silu_f(v[0]), silu_f(v[1])), pk2(silu_f(v[2]), silu_f(v[3]))}; }
  } else if (epi == EPI_RESID) {
    const float* xin = E.first ? (r < TP ? p->x_prompt + (size_t)r * D : p->x_sample + (size_t)(r - TP) * D) : (E.f0 + (size_t)r * D);
    const size_t mo = (size_t)modrow(r) * MODW;
    const f32x4 xv = *(const f32x4*)(xin + c), gv = *(const f32x4*)(E.f1 + mo + c);
    const f32x4 yn = xv + gv * v;
    *(f32x4*)(E.f0 + (size_t)r * D + c) = yn;
    if (E.yout) {
      const f32x4 g = *(const f32x4*)(E.ng + c), sc = *(const f32x4*)(E.nsc + mo + c); const f32x4 y = yn * g * (sc + 1.f);
      *(u32x2*)(E.yout + (size_t)r * D + c) = (u32x2){pk2(y[0], y[1]), pk2(y[2], y[3])};
      if (E.ykv) { const f32x4 g2 = *(const f32x4*)(E.ngkv + c), sc2 = *(const f32x4*)(E.nsckv + mo + c); const f32x4 y2 = yn * g2 * (sc2 + 1.f);
        *(u32x2*)(E.ykv + (size_t)r * D + c) = (u32x2){pk2(y2[0], y2[1]), pk2(y2[2], y2[3])}; }
      float ss = yn[0] * yn[0] + yn[1] * yn[1] + yn[2] * yn[2] + yn[3] * yn[3];
      ss += __shfl_xor(ss, 1); ss += __shfl_xor(ss, 2);
      if ((tid_get() & 3) == 0) atomicAdd(E.rss_out + r, ss); }
  } else if (epi == EPI_UP) {
    f32x4 u;
#pragma unroll
    for (int j = 0; j < 4; ++j) { const float t = fmaxf(v[j], 0.f); u[j] = t * t; }
    *(u32x2*)(E.b0 + (size_t)r * FF + c) = (u32x2){pk2(u[0], u[1]), pk2(u[2], u[3])};
  } else if (epi == EPI_QRAW) { *(u32x2*)(E.b1 + (size_t)r * D + c) = (u32x2){pk2(v[0], v[1]), pk2(v[2], v[3])};
  } else if (epi == EPI_KVRAW) { *(f32x4*)(E.f2 + (size_t)r * 512 + c) = v; }
}

DI void epi_frag8(KP p, const int epi, const EpiArgs& E, const int r, const int c, const f32x4 v0, const f32x4 v1, const f32x4 lbA = (f32x4){0.f, 0.f, 0.f, 0.f}, const f32x4 lbB = (f32x4){0.f, 0.f, 0.f, 0.f}) {
  if (epi == EPI_NOP) return;
  if (epi == EPI_ADA) { if (r < NMOD) { const float* bp = (c < 24576) ? (p->b_ada + c) : (p->kv_b_ada + (c - 24576)); float* o = E.f0 + (size_t)r * MODW + c;
      const f32x4 m0 = v0 + *(const f32x4*)bp, m1 = v1 + *(const f32x4*)(bp + 4);
      *(f32x4*)o = m0; *(f32x4*)(o + 4) = m1;
      int site = -1;
      if (c < 24576) { const int l = c / 6144, part = (c - l * 6144) >> 10; site = (part == 0) ? l : (part == 3 ? 5 + l : -1); } else if (c < 25600) site = 4;
      if (site >= 0) *(u32x4*)(E.ash + ((size_t)site * 256 + r) * 1024 + (c & 1023)) = (u32x4){pk2(m0[0], m0[1]), pk2(m0[2], m0[3]), pk2(m1[0], m1[1]), pk2(m1[2], m1[3])}; }
  } else if (epi == EPI_HGIN) {
    const int sec = c >> 10, cc = c & 1023; const size_t o = (size_t)r * D + cc;
    if (sec == 1) { float lb[8];
#pragma unroll
      for (int j = 0; j < 4; ++j) { lb[j] = lbA[j]; lb[4 + j] = lbB[j]; }
      float lf[8];
#pragma unroll
      for (int j = 0; j < 8; ++j) { const float x = (j < 4) ? v0[j & 3] : v1[j & 3]; const float sg = __builtin_amdgcn_rcpf(1.f + __expf(-x)); const float fg = lb[j] + (1.f - lb[j]) * sg;
        lf[j] = __logf(fg); }
      *(f32x4*)(E.f0 + o) = (f32x4){lf[0], lf[1], lf[2], lf[3]}; *(f32x4*)(E.f0 + o + 4) = (f32x4){lf[4], lf[5], lf[6], lf[7]};
    } else if (sec == 2) { *(u32x4*)(E.b2 + o) = (u32x4){pk2(v0[0], v0[1]), pk2(v0[2], v0[3]), pk2(v1[0], v1[1]), pk2(v1[2], v1[3])};
    } else { bf16_t* dst = (sec == 0) ? E.b0 : E.b3;
      *(u32x4*)(dst + o) = (u32x4){pk2(silu_f(v0[0]), silu_f(v0[1])), pk2(silu_f(v0[2]), silu_f(v0[3])), pk2(silu_f(v1[0]), silu_f(v1[1])), pk2(silu_f(v1[2]), silu_f(v1[3]))}; }
  } else if (epi == EPI_RESID) {
    const float* xin = E.first ? (r < TP ? p->x_prompt + (size_t)r * D : p->x_sample + (size_t)(r - TP) * D) : (E.f0 + (size_t)r * D);
    const size_t mo = (size_t)modrow(r) * MODW;
    const float* gm = E.f1 + mo + c; float* o = E.f0 + (size_t)r * D + c;
    const f32x4 xa = *(const f32x4*)(xin + c), xb = *(const f32x4*)(xin + c + 4), ga = *(const f32x4*)gm, gb = *(const f32x4*)(gm + 4);
    const f32x4 ya = xa + ga * v0, yb = xb + gb * v1;
    *(f32x4*)o = ya; *(f32x4*)(o + 4) = yb;
    if (E.yout) {
      const f32x4 g0 = *(const f32x4*)(E.ng + c), g1 = *(const f32x4*)(E.ng + c + 4), s0 = *(const f32x4*)(E.nsc + mo + c), s1 = *(const f32x4*)(E.nsc + mo + c + 4);
      const f32x4 y0 = ya * g0 * (s0 + 1.f), y1 = yb * g1 * (s1 + 1.f);
      *(u32x4*)(E.yout + (size_t)r * D + c) = (u32x4){pk2(y0[0], y0[1]), pk2(y0[2], y0[3]), pk2(y1[0], y1[1]), pk2(y1[2], y1[3])};
      if (E.ykv) { const f32x4 h0 = *(const f32x4*)(E.ngkv + c), h1 = *(const f32x4*)(E.ngkv + c + 4), t0 = *(const f32x4*)(E.nsckv + mo + c), t1 = *(const f32x4*)(E.nsckv + mo + c + 4);
        const f32x4 z0 = ya * h0 * (t0 + 1.f), z1 = yb * h1 * (t1 + 1.f);
        *(u32x4*)(E.ykv + (size_t)r * D + c) = (u32x4){pk2(z0[0], z0[1]), pk2(z0[2], z0[3]), pk2(z1[0], z1[1]), pk2(z1[2], z1[3])}; }
      float ss = ya[0] * ya[0] + ya[1] * ya[1] + ya[2] * ya[2] + ya[3] * ya[3] + yb[0] * yb[0] + yb[1] * yb[1] + yb[2] * yb[2] + yb[3] * yb[3];
      ss += __shfl_xor(ss, 16); ss += __shfl_xor(ss, 32);
      if ((tid_get() & 63) < 16) atomicAdd(E.rss_out + r, ss); }
  } else if (epi == EPI_UP) {
    float u[8];
#pragma unroll
    for (int j = 0; j < 8; ++j) { const float t = fmaxf((j < 4) ? v0[j & 3] : v1[j & 3], 0.f); u[j] = t * t; }
    *(u32x4*)(E.b0 + (size_t)r * FF + c) = (u32x4){pk2(u[0], u[1]), pk2(u[2], u[3]), pk2(u[4], u[5]), pk2(u[6], u[7])};
  } else if (epi == EPI_QRAW) { *(u32x4*)(E.b1 + (size_t)r * D + c) = (u32x4){pk2(v0[0], v0[1]), pk2(v0[2], v0[3]), pk2(v1[0], v1[1]), pk2(v1[2], v1[3])};
  } else { float* o = E.f2 + (size_t)r * 512 + c; *(f32x4*)o = v0; *(f32x4*)(o + 4) = v1; }
}

template <int NMB>
DI void skinny_unit(KP p, unsigned char* shm, const bf16_t* A, const bf16_t* Bt, const int K, const int mrow0, const int n0, const int epi, const EpiArgs& E) {
  const int tid = tid_get(), lane = tid & 63, wave = tid >> 6, fr = lane & 15, fq = lane >> 4;
  const int ks = K >> 3;
  const bf16_t* ap = A + (size_t)(TP + mrow0 + fr) * K + wave * ks + fq * 8;
  const bf16_t* bp = Bt + (size_t)(n0 + fr) * K + wave * ks + fq * 8;
  f32x4 acc[NMB];
#pragma unroll
  for (int mb = 0; mb < NMB; ++mb) acc[mb] = (f32x4){0.f, 0.f, 0.f, 0.f};
#pragma unroll 2
  for (int k = 0; k < ks; k += 32) { const bf16x8 b = *(const bf16x8*)(bp + k);
#pragma unroll
    for (int mb = 0; mb < NMB; ++mb) { const bf16x8 a = *(const bf16x8*)(ap + (size_t)mb * 16 * K + k); acc[mb] = __builtin_amdgcn_mfma_f32_16x16x32_bf16(b, a, acc[mb], 0, 0, 0); } }
  float* red = (float*)shm;
#pragma unroll
  for (int mb = 0; mb < NMB; ++mb) *(f32x4*)(red + wave * (NMB * 256) + (mb * 16 + fr) * 16 + fq * 4) = acc[mb];
  __syncthreads();
  if (tid < NMB * 64) { const int row = tid >> 2, c4 = (tid & 3) * 4; f32x4 sum = (f32x4){0.f, 0.f, 0.f, 0.f};
#pragma unroll
    for (int w = 0; w < 8; ++w) sum += *(const f32x4*)(red + w * (NMB * 256) + row * 16 + c4);
    epi_frag(p, epi, E, TP + mrow0 + row, n0 + c4, sum); }
  __syncthreads();
}

DI int perm32(int rho) { const int n = rho >> 4, i = rho & 15; return 8 * (i >> 2) + 4 * n + (i & 3); }
struct UnitD { const char* A; const char* B; int pm, pn, epi; float* ob; int on; };
DI void unit_of(const int L, const GemmJob& j0, const GemmJob& j1, const int n0, const size_t tstep, UnitD& u) {
  if (j0.epi == EPI_BIAS) {
    const int st = L < 16 ? 0 : L < 32 ? 1 : L < 36 ? 2 : L < 40 ? 3 : L < 42 ? 4 : 5 + (L - 42) / 16;
    const int lb = st == 0 ? 0 : st == 1 ? 16 : st == 2 ? 32 : st == 3 ? 36 : st == 4 ? 40 : 42 + (st - 5) * 16;
    const unsigned char* wsb = (const unsigned char*)j0.Bt;
    const bf16_t* Bt = (st < 2) ? (const bf16_t*)(wsb + OFF_WIN) + (size_t)st * 4096 * D : (st < 4) ? (const bf16_t*)(wsb + OFF_WQ) + (size_t)(st - 2) * D * D
                     : (st == 4) ? (const bf16_t*)(wsb + OFF_WKV) : (const bf16_t*)(wsb + OFF_WUP) + (size_t)(st - 5) * D * FF;
    u.pm = 0; u.pn = L - lb; u.epi = EPI_BIAS; u.A = (const char*)(j0.A + (size_t)st * 256 * 1024); u.B = (const char*)Bt + (size_t)u.pn * tstep;
    u.ob = (float*)j1.A + (size_t)132 * site_prefN(st); u.on = site_N(st); return; }
  const bool second = (L >= n0); int pm, pn; tile_of(second ? L - n0 : L, second ? j1.nM : j0.nM, second ? j1.nN : j0.nN, pm, pn);
  u.pm = pm; u.pn = pn; u.epi = second ? j1.epi : j0.epi;
  u.A = (const char*)(second ? j1.A : j0.A) + (size_t)pm * tstep; u.B = (const char*)(second ? j1.Bt : j0.Bt) + (size_t)pn * tstep;
}
DI void gemm_phase(KP p, LAS unsigned char* lds, unsigned char* shm, const GemmJob& j0, const GemmJob& j1, const int njobs, const EpiArgs& E, const int skinny) {
  const int tid = tid_get(), wid = __builtin_amdgcn_readfirstlane(tid >> 6), lane = tid & 63, wr = wid >> 2, wc = wid & 3, fr = lane & 15, fq = lane >> 4;
  const int K = j0.K, nt = K / BK;
  const int n0 = j0.nM * j0.nN, n1 = (njobs > 1) ? j1.nM * j1.nN : 0, ntl = n0 + n1;
  if ((int)blockIdx.x < ntl) {
    unsigned voffA[2], voffB[2];
#pragma unroll
    for (int i = 0; i < 2; ++i) { int R, C; stage_rc(tid * 16 + i * 8192, R, C); const int Rb = (R & ~31) + perm32(R & 31);
      voffA[i] = (unsigned)(R * K + C) * 2u; voffB[i] = (unsigned)(Rb * K + C) * 2u; }
    const size_t kstep = (size_t)(BK * 2), hstep = (size_t)HALF * K * 2, tstep = 2 * hstep;
    const unsigned ldsw = (unsigned)wid * 1024u;
    const int aoff = lds_byte(wr * 64 + fr, fq * 8), boff = lds_byte(wc * 32 + fr, fq * 8);
#define G_SA(b, h) (((b) * 2 + (h)) * HTB)
#define G_SB(b, h) ((4 + (b) * 2 + (h)) * HTB)
#define G_STAGE(bufoff, gbase, voff) do { _Pragma("unroll") for (int _i = 0; _i < 2; ++_i) \
      __builtin_amdgcn_global_load_lds((const unsigned*)((const char*)(gbase) + (voff)[_i]), (LAS unsigned*)(lds + (bufoff) + ldsw + _i * 8192), 16, 0, 0); } while (0)
#define G_LDA(dst, b, h) do { _Pragma("unroll") for (int m = 0; m < 4; ++m) _Pragma("unroll") for (int k = 0; k < 2; ++k) dst[m][k] = *(const LAS bf16x8*)(lds + G_SA(b, h) + aoff + m * 2048 + k * 1024); } while (0)
#define G_LDB(dst, b, h) do { _Pragma("unroll") for (int n = 0; n < 2; ++n) _Pragma("unroll") for (int k = 0; k < 2; ++k) dst[n][k] = *(const LAS bf16x8*)(lds + G_SB(b, h) + boff + n * 2048 + k * 1024); } while (0)
#define G_MMA(ai, bj, At, Bt) do { __builtin_amdgcn_s_setprio(1); _Pragma("unroll") for (int m = 0; m < 4; ++m) _Pragma("unroll") for (int n = 0; n < 2; ++n) _Pragma("unroll") for (int k = 0; k < 2; ++k) \
      acc[ai][bj][m][n] = __builtin_amdgcn_mfma_f32_16x16x32_bf16(Bt[n][k], At[m][k], acc[ai][bj][m][n], 0, 0, 0); __builtin_amdgcn_s_setprio(0); } while (0)
#define G_WAIT_V(n) asm volatile("s_waitcnt vmcnt(" #n ")" ::: "memory")
#define G_WAIT_L(n) asm volatile("s_waitcnt lgkmcnt(" #n ")" ::: "memory")
#define G_BAR __builtin_amdgcn_s_barrier()
#define G_SCHED __builtin_amdgcn_sched_barrier(0)
    int L = blockIdx.x;
    UnitD cur, nxt; unit_of(L, j0, j1, n0, tstep, cur);
    f32x4 acc[2][2][4][2];
#pragma unroll
    for (int a = 0; a < 2; ++a)
#pragma unroll
      for (int b = 0; b < 2; ++b)
#pragma unroll
        for (int m = 0; m < 4; ++m)
#pragma unroll
          for (int n = 0; n < 2; ++n) acc[a][b][m][n] = (f32x4){0.f, 0.f, 0.f, 0.f};
    bf16x8 At[4][2], B0[2][2], B1[2][2];
    const char* cA = cur.A; const char* cB = cur.B;
    G_STAGE(G_SB(0, 0), cB, voffB); G_STAGE(G_SB(0, 1), cB + hstep, voffB); G_STAGE(G_SA(0, 0), cA, voffA); G_STAGE(G_SA(0, 1), cA + hstep, voffA);
    if (wr == 1) G_BAR;
    G_WAIT_V(2); G_BAR;
    G_STAGE(G_SB(1, 0), cB + kstep, voffB); G_STAGE(G_SA(1, 0), cA + kstep, voffA); G_STAGE(G_SB(1, 1), cB + hstep + kstep, voffB);
    G_WAIT_V(6); G_BAR;
#pragma unroll 1
    for (;;) {
      const int Ln = L + (int)gridDim.x; const bool has_next = (Ln < ntl);
      if (has_next) unit_of(Ln, j0, j1, n0, tstep, nxt);
      const char* nA = has_next ? nxt.A : cA; const char* nB = has_next ? nxt.B : cB;
#pragma unroll 1
      for (int t = 0; t < nt; t += 2) {
        const bool last = (t == nt - 2);
        const bool tail = last && !has_next;
        const char* a1 = cA + (size_t)(t + 1) * kstep;
        const char* a2 = last ? nA : cA + (size_t)(t + 2) * kstep; const char* b2 = last ? nB : cB + (size_t)(t + 2) * kstep;
        const char* a3 = a2 + kstep; const char* b3 = b2 + kstep;
        G_LDB(B0, 0, 0); G_LDB(B1, 0, 1); G_SCHED; G_LDA(At, 0, 0); G_STAGE(G_SA(1, 1), a1 + hstep, voffA);
        G_WAIT_V(8); G_WAIT_L(0); G_BAR; G_MMA(0, 0, At, B0); G_MMA(0, 1, At, B1); G_BAR; G_SCHED;
        G_LDA(At, 0, 1); if (!tail) { G_STAGE(G_SB(0, 0), b2, voffB); G_STAGE(G_SB(0, 1), b2 + hstep, voffB); G_STAGE(G_SA(0, 0), a2, voffA); }
        if (tail) G_WAIT_V(2); else G_WAIT_V(8);
        G_WAIT_L(0); G_BAR; G_MMA(1, 0, At, B0); G_MMA(1, 1, At, B1); G_BAR; G_SCHED;
        G_LDB(B0, 1, 0); G_LDB(B1, 1, 1); G_SCHED; G_LDA(At, 1, 0); if (!tail) G_STAGE(G_SA(0, 1), a2 + hstep, voffA);
        if (tail) G_WAIT_V(0); else G_WAIT_V(8);
        G_WAIT_L(0); G_BAR; G_MMA(0, 0, At, B0); G_MMA(0, 1, At, B1); G_BAR; G_SCHED;
        G_LDA(At, 1, 1); if (!tail) { G_STAGE(G_SB(1, 0), b3, voffB); G_STAGE(G_SB(1, 1), b3 + hstep, voffB); G_STAGE(G_SA(1, 0), a3, voffA); }
        if (tail) G_WAIT_V(0); else G_WAIT_V(8);
        G_WAIT_L(0); G_BAR; G_MMA(1, 0, At, B0); G_MMA(1, 1, At, B1); G_BAR; G_SCHED;
      }
      if (wr == 0) G_BAR;
      { const int r0 = cur.pm * BM + wr * 64 + fr, c0 = cur.pn * BM + wc * 32 + fq * 8; const int epi = cur.epi;
#define EPI_LOOP(MODE) { _Pragma("unroll") for (int ai = 0; ai < 2; ++ai) _Pragma("unroll") for (int m = 0; m < 4; ++m) _Pragma("unroll") for (int bj = 0; bj < 2; ++bj) \
          epi_frag8(p, MODE, E, r0 + ai * 128 + m * 16, c0 + bj * 128, acc[ai][bj][m][0], acc[ai][bj][m][1]); }
        if (epi == EPI_ADA) EPI_LOOP(EPI_ADA)
        else if (epi == EPI_BIAS) {
#pragma unroll
          for (int ai = 0; ai < 2; ++ai)
#pragma unroll
            for (int m = 0; m < 4; ++m) { const int r = r0 + ai * 128 + m * 16; if (r < NMOD) {
#pragma unroll
              for (int bj = 0; bj < 2; ++bj) { float* o = cur.ob + (size_t)r * cur.on + (c0 + bj * 128); *(f32x4*)o = acc[ai][bj][m][0]; *(f32x4*)(o + 4) = acc[ai][bj][m][1]; } } }
        } else if (epi == EPI_RESID) {
          const size_t mo = (size_t)modrow(r0) * MODW;
#pragma unroll
          for (int bj = 0; bj < 2; ++bj) { const int c = c0 + bj * 128;
            const f32x4 ga = *(const f32x4*)(E.f1 + mo + c), gb = *(const f32x4*)(E.f1 + mo + c + 4);
            f32x4 m0 = (f32x4){0.f, 0.f, 0.f, 0.f}, m1 = m0, k0 = m0, k1 = m0;
            if (E.yout) { const f32x4 g0 = *(const f32x4*)(E.ng + c), g1 = *(const f32x4*)(E.ng + c + 4), s0 = *(const f32x4*)(E.nsc + mo + c), s1 = *(const f32x4*)(E.nsc + mo + c + 4);
              m0 = g0 * (s0 + 1.f); m1 = g1 * (s1 + 1.f);
              if (E.ykv) { const f32x4 h0 = *(const f32x4*)(E.ngkv + c), h1 = *(const f32x4*)(E.ngkv + c + 4), t0 = *(const f32x4*)(E.nsckv + mo + c), t1 = *(const f32x4*)(E.nsckv + mo + c + 4);
                k0 = h0 * (t0 + 1.f); k1 = h1 * (t1 + 1.f); } }
#pragma unroll
            for (int ah = 0; ah < 2; ++ah) { const int ai = ah, mb = 0;
              f32x4 ya[4], yb[4];
              const float* xbase = E.first ? p->x_prompt : E.f0;
#pragma unroll
              for (int m = mb; m < mb + 4; ++m) { const unsigned off = (unsigned)(r0 + ai * 128 + m * 16) * (unsigned)D + (unsigned)c;
                ya[m] = __builtin_nontemporal_load((const f32x4*)(xbase + off)); yb[m] = __builtin_nontemporal_load((const f32x4*)(xbase + off + 4)); }
#pragma unroll
              for (int m = mb; m < mb + 4; ++m) { const int r = r0 + ai * 128 + m * 16; const unsigned off = (unsigned)r * (unsigned)D + (unsigned)c;
                const f32x4 xa = ya[m] + ga * acc[ai][bj][m][0], xb = yb[m] + gb * acc[ai][bj][m][1];
                __builtin_nontemporal_store(xa, (f32x4*)(E.f0 + off)); __builtin_nontemporal_store(xb, (f32x4*)(E.f0 + off + 4));
                if (E.yout) { const f32x4 y0 = xa * m0, y1 = xb * m1;
                  *(u32x4*)(E.yout + off) = (u32x4){pk2(y0[0], y0[1]), pk2(y0[2], y0[3]), pk2(y1[0], y1[1]), pk2(y1[2], y1[3])};
                  if (E.ykv) { const f32x4 z0 = xa * k0, z1 = xb * k1;
                    *(u32x4*)(E.ykv + off) = (u32x4){pk2(z0[0], z0[1]), pk2(z0[2], z0[3]), pk2(z1[0], z1[1]), pk2(z1[2], z1[3])}; }
                  float ss = xa[0] * xa[0] + xa[1] * xa[1] + xa[2] * xa[2] + xa[3] * xa[3] + xb[0] * xb[0] + xb[1] * xb[1] + xb[2] * xb[2] + xb[3] * xb[3];
                  ss += __shfl_xor(ss, 16); ss += __shfl_xor(ss, 32);
                  if (fq == 0) atomicAdd(E.rss_out + (unsigned)r, ss); } } } }
        } else if (epi != EPI_NOP) {
          float rstd8[8];
#pragma unroll
          for (int q = 0; q < 8; ++q) rstd8[q] = rsqrtf(E.rss[r0 + (q >> 2) * 128 + (q & 3) * 16] * (1.f / D) + EPS);
          const float* bb = (epi == EPI_KVRAW) ? E.bias1 + (size_t)modrow(r0) * E.bN1 : E.bias + (size_t)modrow(r0) * E.bN;
          f32x4 bv[2][2], lbv[2][2];
#pragma unroll
          for (int bj = 0; bj < 2; ++bj) { const int c = c0 + bj * 128; bv[bj][0] = *(const f32x4*)(bb + c); bv[bj][1] = *(const f32x4*)(bb + c + 4);
            lbv[bj][0] = (f32x4){0.f, 0.f, 0.f, 0.f}; lbv[bj][1] = (f32x4){0.f, 0.f, 0.f, 0.f};
            if (epi == EPI_HGIN && (c >> 10) == 1 && E.layer == 1) { const int cc = c & 1023;
              const f32x4 l0 = *(const f32x4*)(p->hg_lbp + cc), l1 = *(const f32x4*)(p->hg_lbp + D + cc), l2 = *(const f32x4*)(p->hg_lbp + cc + 4), l3 = *(const f32x4*)(p->hg_lbp + D + cc + 4);
#pragma unroll
              for (int jj = 0; jj < 4; ++jj) { lbv[bj][0][jj] = __builtin_amdgcn_rcpf(1.f + __expf(l0[jj] - l1[jj])); lbv[bj][1][jj] = __builtin_amdgcn_rcpf(1.f + __expf(l2[jj] - l3[jj])); } } }
#define CONS_LOOP(MODE) { _Pragma("unroll") for (int ai = 0; ai < 2; ++ai) _Pragma("unroll") for (int m = 0; m < 4; ++m) _Pragma("unroll") for (int bj = 0; bj < 2; ++bj) \
            epi_frag8(p, MODE, E, r0 + ai * 128 + m * 16, c0 + bj * 128, acc[ai][bj][m][0] * rstd8[ai * 4 + m] + bv[bj][0], acc[ai][bj][m][1] * rstd8[ai * 4 + m] + bv[bj][1], lbv[bj][0], lbv[bj][1]); }
          if (epi == EPI_HGIN) CONS_LOOP(EPI_HGIN) else if (epi == EPI_UP) CONS_LOOP(EPI_UP) else if (epi == EPI_QRAW) CONS_LOOP(EPI_QRAW) else CONS_LOOP(EPI_KVRAW)
        }
      }
      if (!has_next) break;
#pragma unroll
      for (int a = 0; a < 2; ++a)
#pragma unroll
        for (int b = 0; b < 2; ++b)
#pragma unroll
          for (int m = 0; m < 4; ++m)
#pragma unroll
            for (int n = 0; n < 2; ++n) acc[a][b][m][n] = (f32x4){0.f, 0.f, 0.f, 0.f};
      cur = nxt; cA = nA; cB = nB; L = Ln;
      if (wr == 1) G_BAR;
    }
    G_WAIT_V(0);
    G_BAR;
  }
  if (skinny) {
    __syncthreads();
    const int u0 = j0.nN * 16, u1 = (njobs > 1) ? j1.nN * 16 : 0;
    const int rs = ((u0 + u1) * 4 <= (int)gridDim.x) ? 4 : (((u0 + u1) * 2 <= (int)gridDim.x) ? 2 : 1);
#pragma unroll 1
    for (int uu = (int)gridDim.x - 1 - (int)blockIdx.x; uu < (u0 + u1) * rs; uu += gridDim.x) {
      const int u = uu / rs, rg = uu - u * rs;
      const bool second = (u >= u0);
      const bf16_t* sa = second ? j1.A : j0.A; const bf16_t* sb = second ? j1.Bt : j0.Bt; const int sk = second ? j1.K : j0.K, sn = (second ? u - u0 : u) * 16, se = second ? j1.epi : j0.epi;
      if (rs == 4) skinny_unit<2>(p, shm, sa, sb, sk, rg * 32, sn, se, E);
      else if (rs == 2) skinny_unit<4>(p, shm, sa, sb, sk, rg * 64, sn, se, E);
      else skinny_unit<8>(p, shm, sa, sb, sk, 0, sn, se, E);
    }
  }
}

__device__ const float INVF[32] = {1.000000000e+00f, 7.498942614e-01f, 5.623413324e-01f, 4.216965139e-01f, 3.162277639e-01f, 2.371373773e-01f, 1.778279394e-01f, 1.333521307e-01f, 1.000000015e-01f, 7.498941571e-02f, 5.623413250e-02f, 4.216965288e-02f, 3.162277490e-02f, 2.371373773e-02f, 1.778279431e-02f, 1.333521493e-02f, 9.999999776e-03f, 7.498941850e-03f, 5.623413250e-03f, 4.216964822e-03f, 3.162277630e-03f, 2.371373586e-03f, 1.778279431e-03f, 1.333521446e-03f, 1.000000047e-03f, 7.498942432e-04f, 5.623413017e-04f, 4.216965172e-04f, 3.162277571e-04f, 2.371373703e-04f, 1.778279402e-04f, 1.333521504e-04f};
DI void transpose_item(const float* W, int K, int N, bf16_t* WT, int row_off, float* scr, int item, int lane) {
  const int nblk = N / 32, kb = item / nblk, nb = item % nblk, k0 = 64 * kb, n0 = 32 * nb;
#pragma unroll 8
  for (int i = 0; i < 32; ++i) { const int kk = 2 * i + (lane >> 5); scr[kk * 33 + (lane & 31)] = __builtin_nontemporal_load(W + (size_t)(k0 + kk) * N + n0 + (lane & 31)); }
  asm volatile("s_waitcnt lgkmcnt(0)" ::: "memory");
  const int c = lane & 7;
#pragma unroll
  for (int j = 0; j < 4; ++j) { const int n = (lane >> 3) + 8 * j; const float* s = scr + (8 * c) * 33 + n;
    u32x4 o; o.x = pk2(s[0 * 33], s[1 * 33]); o.y = pk2(s[2 * 33], s[3 * 33]); o.z = pk2(s[4 * 33], s[5 * 33]); o.w = pk2(s[6 * 33], s[7 * 33]);
    *(u32x4*)(WT + (size_t)(row_off + n0 + n) * K + k0 + 8 * c) = o; }
  asm volatile("s_waitcnt lgkmcnt(0)" ::: "memory");
}

DI void prep_phase(KP p, unsigned char* shm) {
  const int tid = tid_get(), lane = tid & 63, wave = tid >> 6;
  const int gw = blockIdx.x * NWAVES + wave, NGW = gridDim.x * NWAVES;
  float* scr = (float*)(shm + wave * 16384);
  unsigned char* ws = p->ws;
  int base = 0;
  for (int mi = 0; mi < 22; ++mi) {
    const float* W; int K, N, row_off; bf16_t* WT;
    if (mi < 2) { W = p->hg_w_in + (size_t)mi * D * 4096; K = D; N = 4096; WT = (bf16_t*)(ws + OFF_WIN) + (size_t)mi * 4096 * D; row_off = 0; }
    else if (mi < 4) { W = p->hg_w_out + (size_t)(mi - 2) * D * D; K = D; N = D; WT = (bf16_t*)(ws + OFF_WOUT) + (size_t)(mi - 2) * D * D; row_off = 0; }
    else if (mi < 5) { W = p->w_kv; K = D; N = 512; WT = (bf16_t*)(ws + OFF_WKV); row_off = 0; }
    else if (mi < 7) { W = p->w_q + (size_t)(mi - 5) * D * D; K = D; N = D; WT = (bf16_t*)(ws + OFF_WQ) + (size_t)(mi - 5) * D * D; row_off = 0; }
    else if (mi < 9) { W = p->w_o + (size_t)(mi - 7) * D * D; K = D; N = D; WT = (bf16_t*)(ws + OFF_WO) + (size_t)(mi - 7) * D * D; row_off = 0; }
    else if (mi < 13) { W = p->w_up + (size_t)(mi - 9) * D * FF; K = D; N = FF; WT = (bf16_t*)(ws + OFF_WUP) + (size_t)(mi - 9) * D * FF; row_off = 0; }
    else if (mi < 17) { W = p->w_down + (size_t)(mi - 13) * D * FF; K = FF; N = D; WT = (bf16_t*)(ws + OFF_WDN) + (size_t)(mi - 13) * D * FF; row_off = 0; }
    else if (mi < 21) { W = p->w_ada + (size_t)(mi - 17) * D * 6144; K = D; N = 6144; WT = (bf16_t*)(ws + OFF_X); row_off = (mi - 17) * 6144; }
    else { W = p->kv_w_ada; K = D; N = 2048; WT = (bf16_t*)(ws + OFF_X); row_off = 24576; }
    const int nitems = (K / 64) * (N / 32);
    int first = (gw - (base % NGW) + NGW) % NGW;
    for (int it = first; it < nitems; it += NGW) transpose_item(W, K, N, WT, row_off, scr, it, lane);
    base += nitems;
  }
  bf16_t* Ac = (bf16_t*)(ws + OFF_X + (size_t)MODW * D * 2);
  const int gt = blockIdx.x * NTHREADS + tid, NGT = gridDim.x * NTHREADS;
  { unsigned* z = (unsigned*)(ws + OFF_BAR); for (int e = gt; e < (int)(ZERO_BYTES / 4); e += NGT) z[e] = 0u; }
  for (int e = gt; e < 256 * D / 2; e += NGT) { const int r = e / (D / 2), c = (e % (D / 2)) * 2; float a = 0.f, b = 0.f;
    if (r < NMOD) { const float* cp = (r < 4) ? p->c_prompt + (size_t)r * D : p->c_sample + (size_t)(r - 4) * D; a = silu_f(cp[c]); b = silu_f(cp[c + 1]); }
    *(unsigned*)(Ac + (size_t)r * D + c) = pk2(a, b); }
  float* tab = (float*)(ws + OFF_TAB);
  for (int e = gt; e < 4097 * 32; e += NGT) { const int pi = e >> 5, i = e & 31; const float pos = (pi < 4096) ? (float)pi : 8192.f;
    const float ang = pos * INVF[i]; float sn, cs; sincosf(ang, &sn, &cs);
    tab[pi * 64 + i] = cs; tab[pi * 64 + 32 + i] = sn; }
}

DI void init_rows(KP p, unsigned* ctr) {
  const int tid = tid_get(); const int lane = tid & 63;
  unsigned char* ws = p->ws; const float* mods = (const float*)(ws + OFF_MODS); bf16_t* yout = (bf16_t*)(ws + OFF_H); float* rss = (float*)(ws + OFF_RSS);
  const float* g = p->norm1_g; const float* msc = mods + 1024;
#pragma unroll 1
  for (;;) {
    unsigned cidx = 0; if (lane == 0) cidx = __hip_atomic_fetch_add(ctr, 1u, __ATOMIC_RELAXED, __HIP_MEMORY_SCOPE_AGENT);
    cidx = __builtin_amdgcn_readfirstlane(cidx);
    if (cidx >= (unsigned)(T / 8)) break;
#pragma unroll 1
    for (int hh = 0; hh < 2; ++hh) { const int rb = (int)cidx * 8 + hh * 4;
      f32x4 v[4][4];
#pragma unroll
      for (int q = 0; q < 4; ++q) { const int r = rb + q; const float* xr = (r < TP) ? p->x_prompt + (size_t)r * D : p->x_sample + (size_t)(r - TP) * D;
#pragma unroll
        for (int jj = 0; jj < 4; ++jj) v[q][jj] = *(const f32x4*)(xr + lane * 4 + 256 * jj); }
#pragma unroll
      for (int q = 0; q < 4; ++q) { const int r = rb + q; float a = 0.f;
#pragma unroll
        for (int jj = 0; jj < 4; ++jj) a += v[q][jj][0] * v[q][jj][0] + v[q][jj][1] * v[q][jj][1] + v[q][jj][2] * v[q][jj][2] + v[q][jj][3] * v[q][jj][3];
#pragma unroll
        for (int o = 1; o < 64; o <<= 1) a += __shfl_xor(a, o);
        if (lane == 0) rss[r] = a;
        const size_t mo = (size_t)modrow(r) * MODW;
#pragma unroll
        for (int jj = 0; jj < 4; ++jj) { const int c = lane * 4 + 256 * jj;
          const f32x4 gg = *(const f32x4*)(g + c), sc = *(const f32x4*)(msc + mo + c);
          const f32x4 h = v[q][jj] * gg * (sc + 1.f);
          *(u32x2*)(yout + (size_t)r * D + c) = (u32x2){pk2(h[0], h[1]), pk2(h[2], h[3])}; } } }
  }
}

struct HgBufs { const bf16_t *q, *k, *v, *g; const float* lf; float* o32; bf16_t* on; };

constexpr int SPAN = 256, NSPAN = SEQ / SPAN, CH = 32, NCH = SPAN / CH;
constexpr int L_CUM = 0, L_QT = 16896, L_KT = 25600, L_KE = 34304, L_VT = 44544, L_PS = 54784, L_DEC = 55808, L_HALF = 57344;
constexpr int CUS = 132, QS = 136, KES = 40;
DI bf16x8 pack8(const f32x16& x, const int s) {
  return __builtin_bit_cast(bf16x8, (u32x4){pk2(x[8 * s], x[8 * s + 1]), pk2(x[8 * s + 2], x[8 * s + 3]), pk2(x[8 * s + 4], x[8 * s + 5]), pk2(x[8 * s + 6], x[8 * s + 7])});
}
template <int MODE>
DI void scan_prompt(KP p, const int l, const HgBufs& B, unsigned char* shm) {
  const int tid = tid_get(), lane = tid & 63, wave = tid >> 6, hb = wave >> 2, th = tid & 255, vb = wave & 3, h5 = lane >> 5, l31 = lane & 31;
  unsigned char* base = shm + hb * L_HALF;
  float* cumb = (float*)(base + L_CUM); bf16_t* Qt = (bf16_t*)(base + L_QT); bf16_t* Kt = (bf16_t*)(base + L_KT);
  bf16_t* KeT = (bf16_t*)(base + L_KE); bf16_t* Vt = (bf16_t*)(base + L_VT); float* psum = (float*)(base + L_PS); float* dec = (float*)(base + L_DEC);
  float* dS = B.o32; float* Lsum = B.o32 + (size_t)512 * 16384;
#pragma unroll 1
  for (int it0 = blockIdx.x * 2; it0 < 32 * NSPAN; it0 += gridDim.x * 2) {
    const int item = it0 + hb, bh = item / NSPAN, span = item % NSPAN, b = bh >> 3, h = bh & 7;
    f32x16 S[4];
#pragma unroll
    for (int db = 0; db < 4; ++db)
#pragma unroll
      for (int r = 0; r < 16; ++r) S[db][r] = 0.f;
    if (MODE == 1) {
      const unsigned ob = (unsigned)item * 16384u + (unsigned)(vb * 32 + l31) + (unsigned)(4 * h5) * 128u;
#pragma unroll
      for (int db = 0; db < 4; ++db) {
#pragma unroll
        for (int r = 0; r < 16; ++r) S[db][r] = dS[ob + (unsigned)((32 * db + (r & 3) + 8 * (r >> 2)) * 128)];
        __builtin_amdgcn_sched_barrier(0); }
    }
    float Ltot = 0.f;
#define LBAR() do { asm volatile("s_waitcnt lgkmcnt(0)" ::: "memory"); __builtin_amdgcn_s_barrier(); asm volatile("" ::: "memory"); } while (0)
    const int d1 = th & 127, part = th >> 7, t2 = th >> 3, dg = th & 7;
    const size_t tokS = (size_t)b * SEQ + (size_t)span * SPAN;
    float lfr[16]; unsigned vr[16]; u32x4 q0, q1, g0, g1;
#define SCAN_LOAD(chx) do { const size_t o0_ = (tokS + (size_t)(chx) * CH + part * 16) * D + h * 128 + d1; \
      _Pragma("unroll") for (int i = 0; i < 16; ++i) { lfr[i] = B.lf[o0_ + (size_t)i * D]; vr[i] = B.v[o0_ + (size_t)i * D]; } \
      } while (0)
    __builtin_amdgcn_sched_barrier(0);
    SCAN_LOAD(0);
    __builtin_amdgcn_sched_barrier(0);
#pragma unroll 1
    for (int ch = 0; ch < NCH; ++ch) {
      const size_t tok0 = tokS + (size_t)ch * CH;
      if (MODE == 1) { const size_t o_ = (tok0 + t2) * D + h * 128 + dg * 16;
        q0 = *(const u32x4*)(B.q + o_); q1 = *(const u32x4*)(B.q + o_ + 8);
        g0 = *(const u32x4*)(B.g + o_); g1 = *(const u32x4*)(B.g + o_ + 8); }
      { const int d = d1;
        float c[16]; float run = 0.f;
#pragma unroll
        for (int i = 0; i < 16; ++i) { run += lfr[i]; c[i] = run; }
        psum[part * 128 + d] = run;
        LBAR();
        const float t0 = psum[d], t1 = psum[128 + d]; const float off = part ? t0 : 0.f; const float Lc = t0 + t1;
        float ke[16];
#pragma unroll
        for (int i = 0; i < 16; ++i) { const float cu = off + c[i]; if (MODE == 1) cumb[(part * 16 + i) * CUS + d] = cu; ke[i] = (1.f - __expf(lfr[i])) * __expf(Lc - cu); }
        *(u32x4*)(KeT + d * KES + part * 16) = (u32x4){pk2(ke[0], ke[1]), pk2(ke[2], ke[3]), pk2(ke[4], ke[5]), pk2(ke[6], ke[7])};
        *(u32x4*)(KeT + d * KES + part * 16 + 8) = (u32x4){pk2(ke[8], ke[9]), pk2(ke[10], ke[11]), pk2(ke[12], ke[13]), pk2(ke[14], ke[15])};
        *(u32x4*)(Vt + d * KES + part * 16) = (u32x4){vr[0] | (vr[1] << 16), vr[2] | (vr[3] << 16), vr[4] | (vr[5] << 16), vr[6] | (vr[7] << 16)};
        *(u32x4*)(Vt + d * KES + part * 16 + 8) = (u32x4){vr[8] | (vr[9] << 16), vr[10] | (vr[11] << 16), vr[12] | (vr[13] << 16), vr[14] | (vr[15] << 16)};
        if (part == 0) { dec[d] = __expf(Lc); Ltot += Lc; }
      }
      LBAR();
      if (MODE == 1) {
        const int t = t2;
        unsigned qo[8], ko[8];
#pragma unroll
        for (int g4 = 0; g4 < 4; ++g4) { const f32x4 cv = *(const f32x4*)(cumb + t * CUS + dg * 16 + 4 * g4);
          f32x4 cp = (f32x4){0.f, 0.f, 0.f, 0.f}; if (t > 0) cp = *(const f32x4*)(cumb + (t - 1) * CUS + dg * 16 + 4 * g4);
#pragma unroll
          for (int e2 = 0; e2 < 2; ++e2) { const int w = g4 * 2 + e2; const unsigned qw = (w < 4) ? q0[w & 3] : q1[w & 3];
            const float ca = cv[2 * e2], cb = cv[2 * e2 + 1];
            const float ka = 1.f - __expf(ca - cp[2 * e2]), kb = 1.f - __expf(cb - cp[2 * e2 + 1]);
            qo[w] = pk2(bf2f(qw & 0xffffu) * __expf(ca), bf2f(qw >> 16) * __expf(cb));
            ko[w] = pk2(ka * __expf(fminf(-ca, 80.f)), kb * __expf(fminf(-cb, 80.f))); } }
        *(u32x4*)(Qt + t * QS + dg * 16) = (u32x4){qo[0], qo[1], qo[2], qo[3]}; *(u32x4*)(Qt + t * QS + dg * 16 + 8) = (u32x4){qo[4], qo[5], qo[6], qo[7]};
        *(u32x4*)(Kt + t * QS + dg * 16) = (u32x4){ko[0], ko[1], ko[2], ko[3]}; *(u32x4*)(Kt + t * QS + dg * 16 + 8) = (u32x4){ko[4], ko[5], ko[6], ko[7]};
        LBAR();
      }
      { const int chn = (ch + 1 < NCH) ? ch + 1 : ch; SCAN_LOAD(chn); }
      f32x16 O;
      if (MODE == 1) {
        f32x16 X;
#pragma unroll
        for (int r = 0; r < 16; ++r) { X[r] = 0.f; O[r] = 0.f; }
#pragma unroll
        for (int ks = 0; ks < 8; ++ks) { const bf16x8 a = *(const bf16x8*)(Kt + l31 * QS + 16 * ks + 8 * h5), bq = *(const bf16x8*)(Qt + l31 * QS + 16 * ks + 8 * h5);
          X = __builtin_amdgcn_mfma_f32_32x32x16_bf16(a, bq, X, 0, 0, 0); }
#pragma unroll
        for (int r = 0; r < 16; ++r) if (crow(r, h5) > l31) X[r] = 0.f;
#pragma unroll
        for (int st = 0; st < 2; ++st) { const bf16_t* vp = Vt + (vb * 32 + l31) * KES + 16 * st + 4 * h5; const u32x2 lo = *(const u32x2*)vp, hi = *(const u32x2*)(vp + 8);
          O = __builtin_amdgcn_mfma_f32_32x32x16_bf16(pack8(X, st), __builtin_bit_cast(bf16x8, (u32x4){lo[0], lo[1], hi[0], hi[1]}), O, 0, 0, 0); }
#pragma unroll
        for (int db = 0; db < 4; ++db)
#pragma unroll
          for (int st = 0; st < 2; ++st) { const bf16_t* qp = Qt + l31 * QS + 32 * db + 16 * st + 4 * h5; const u32x2 lo = *(const u32x2*)qp, hi = *(const u32x2*)(qp + 8);
            O = __builtin_amdgcn_mfma_f32_32x32x16_bf16(__builtin_bit_cast(bf16x8, (u32x4){lo[0], lo[1], hi[0], hi[1]}), pack8(S[db], st), O, 0, 0, 0); }
      }
#pragma unroll
      for (int db = 0; db < 4; ++db) {
#pragma unroll
        for (int r4 = 0; r4 < 4; ++r4) { const f32x4 dv = *(const f32x4*)(dec + 32 * db + 8 * r4 + 4 * h5);
#pragma unroll
          for (int e = 0; e < 4; ++e) S[db][4 * r4 + e] *= dv[e]; }
#pragma unroll
        for (int st = 0; st < 2; ++st) { const bf16x8 a = *(const bf16x8*)(KeT + (32 * db + l31) * KES + 16 * st + 8 * h5), bv = *(const bf16x8*)(Vt + (vb * 32 + l31) * KES + 16 * st + 8 * h5);
          S[db] = __builtin_amdgcn_mfma_f32_32x32x16_bf16(a, bv, S[db], 0, 0, 0); } }
      if (MODE == 1) {
#pragma unroll
        for (int r = 0; r < 16; ++r) cumb[crow(r, h5) * CUS + vb * 32 + l31] = O[r];
        LBAR();
        const int t = t2, vg = dg; const size_t o = (tok0 + t) * D + h * 128 + vg * 16;
        f32x4 ov[4]; float ss = 0.f;
#pragma unroll
        for (int g4 = 0; g4 < 4; ++g4) { ov[g4] = *(const f32x4*)(cumb + t * CUS + vg * 16 + 4 * g4); ss += ov[g4][0] * ov[g4][0] + ov[g4][1] * ov[g4][1] + ov[g4][2] * ov[g4][2] + ov[g4][3] * ov[g4][3]; }
        ss += __shfl_xor(ss, 1); ss += __shfl_xor(ss, 2); ss += __shfl_xor(ss, 4);
        const float rstd = rsqrtf(ss * (1.f / 128.f) + EPS);
        unsigned w[8];
#pragma unroll
        for (int g4 = 0; g4 < 4; ++g4) { const f32x4 gn = *(const f32x4*)(p->hg_gn_g + l * 128 + vg * 16 + 4 * g4);
#pragma unroll
          for (int e2 = 0; e2 < 2; ++e2) { const int wi = g4 * 2 + e2; const unsigned gw = (wi < 4) ? g0[wi & 3] : g1[wi & 3];
            w[wi] = pk2(ov[g4][2 * e2] * rstd * gn[2 * e2] * bf2f(gw & 0xffffu), ov[g4][2 * e2 + 1] * rstd * gn[2 * e2 + 1] * bf2f(gw >> 16)); } }
        *(u32x4*)(B.on + o) = (u32x4){w[0], w[1], w[2], w[3]}; *(u32x4*)(B.on + o + 8) = (u32x4){w[4], w[5], w[6], w[7]};
      } else {
        LBAR();
      }
    }
    if (MODE == 0) {
      float* dSo = dS + (size_t)item * 16384 + vb * 32 + l31;
#pragma unroll
      for (int db = 0; db < 4; ++db)
#pragma unroll
        for (int r = 0; r < 16; ++r) dSo[(size_t)(32 * db + crow(r, h5)) * 128] = S[db][r];
      if (th < 128) Lsum[(size_t)item * 128 + th] = Ltot;
    } else if (span == NSPAN - 1) {
      float* so = p->out + O_HGP + ((size_t)((l * 4 + b) * 8 + h)) * 16384 + vb * 32 + l31;
#pragma unroll
      for (int db = 0; db < 4; ++db)
#pragma unroll
        for (int r = 0; r < 16; ++r) so[(size_t)(32 * db + crow(r, h5)) * 128] = S[db][r];
    }
    __syncthreads();
  }
}

DI void scan_passB(const HgBufs& B) {
  const int tid = tid_get();
  float* dS = B.o32; const float* Lsum = B.o32 + (size_t)512 * 16384;
  const int gt = blockIdx.x * NTHREADS + tid, NGT = gridDim.x * NTHREADS;
#pragma unroll 1
  for (int e = gt; e < 32 * 4096; e += NGT) { const int bh = e >> 12, q4 = e & 4095, d = q4 >> 5;
    float* base = dS + (size_t)bh * NSPAN * 16384 + (size_t)q4 * 4; const float* Lb = Lsum + (size_t)bh * NSPAN * 128 + d;
    f32x4 v[NSPAN]; float lv[NSPAN];
#pragma unroll
    for (int sp = 0; sp < NSPAN; ++sp) { v[sp] = *(const f32x4*)(base + (size_t)sp * 16384); lv[sp] = Lb[sp * 128]; }
    f32x4 run = (f32x4){0.f, 0.f, 0.f, 0.f};
#pragma unroll
    for (int sp = 0; sp < NSPAN; ++sp) { *(f32x4*)(base + (size_t)sp * 16384) = run; run = run * __expf(lv[sp]) + v[sp]; }
  }
}

DI void scan_phase(KP p, const int l, const HgBufs& B, unsigned char* shm) {
  const bool sample_first = (blockIdx.x & 1) != 0;
  if (!sample_first) scan_prompt<0>(p, l, B, shm);
  const int tid = tid_get(), lane = tid & 63, wave = tid >> 6;
  {
    float* ps = (float*)shm;
    const int v4 = (tid & 31) * 4, dq = tid >> 5;
    f32x4 sv[8], svn[8]; float lfv[8], lfn[8]; unsigned kq[8], kqn[8]; u32x2 vw, vwn;
#define SMP_LOAD(IT, SV, LF, KQ, VW) do { const int bs_ = (IT) >> 3, h_ = (IT) & 7; const size_t r_ = TP + bs_; \
      const float* s0_ = p->state_hgrn + ((size_t)((l * 128 + bs_) * 8 + h_)) * 16384; \
      VW = *(const u32x2*)(B.v + r_ * D + h_ * 128 + v4); \
      _Pragma("unroll") for (int i = 0; i < 8; ++i) { const int d_ = dq * 8 + i; const size_t o_ = r_ * D + h_ * 128 + d_; \
        LF[i] = B.lf[o_]; KQ[i] = (unsigned)B.q[o_]; SV[i] = __builtin_nontemporal_load((const f32x4*)(s0_ + d_ * 128 + v4)); } } while (0)
    int item = blockIdx.x, par = 0;
    if (item < 1024) SMP_LOAD(item, sv, lfv, kq, vw);
#pragma unroll 1
    for (; item < 1024; item += gridDim.x, par ^= 1) {
      const int bs = item >> 3, h = item & 7; const size_t r = TP + bs;
      const int nitem = item + gridDim.x;
      if (nitem < 1024) SMP_LOAD(nitem, svn, lfn, kqn, vwn);
      float* s1 = p->out + O_HGS + ((size_t)((l * 128 + bs) * 8 + h)) * 16384;
      const f32x4 vv = (f32x4){bf2f(vw[0] & 0xffffu), bf2f(vw[0] >> 16), bf2f(vw[1] & 0xffffu), bf2f(vw[1] >> 16)};
      f32x4 op = (f32x4){0.f, 0.f, 0.f, 0.f};
#pragma unroll
      for (int i = 0; i < 8; ++i) { const int d = dq * 8 + i;
        const float f = __expf(lfv[i]), kk = 1.f - f, qq = bf2f(kq[i]);
        const f32x4 sn = sv[i] * f + vv * kk;
        __builtin_nontemporal_store(sn, (f32x4*)(s1 + d * 128 + v4)); op += sn * qq; }
#pragma unroll
      for (int jx = 0; jx < 4; ++jx) op[jx] += __shfl_xor(op[jx], 32);
      float* psb = ps + par * 1024;
      if (lane < 32) *(f32x4*)(psb + wave * 128 + v4) = op;
      __syncthreads();
      if (tid < 64) { float o0 = 0.f, o1 = 0.f;
#pragma unroll
        for (int w = 0; w < 8; ++w) { const f32x2 x = *(const f32x2*)(psb + w * 128 + tid * 2); o0 += x[0]; o1 += x[1]; }
        float ss = o0 * o0 + o1 * o1;
#pragma unroll
        for (int o = 1; o < 64; o <<= 1) ss += __shfl_xor(ss, o);
        const float rstd = rsqrtf(ss * (1.f / 128.f) + EPS);
        const int vv2 = tid * 2; const size_t o = r * D + h * 128 + vv2;
        const float g0 = p->hg_gn_g[l * 128 + vv2], g1 = p->hg_gn_g[l * 128 + vv2 + 1];
        *(unsigned*)(B.on + o) = pk2(o0 * rstd * g0 * bf2f(B.g[o]), o1 * rstd * g1 * bf2f(B.g[o + 1])); }
#pragma unroll
      for (int i = 0; i < 8; ++i) { sv[i] = svn[i]; lfv[i] = lfn[i]; kq[i] = kqn[i]; }
      vw = vwn;
    }
    __syncthreads();
  }
  if (sample_first) scan_prompt<0>(p, l, B, shm);
}

constexpr int KN_STRIDE = 72, VT_STRIDE = 264;
constexpr int KN_BYTES = 256 * KN_STRIDE * 2;
struct AtBufs { const bf16_t* qraw; const float* kvraw; bf16_t* on; const float* tab; };

DI void attn_phase(KP p, const int l, const AtBufs& B, unsigned char* shm) {
  const int tid = tid_get(), lane = tid & 63, wave = tid >> 6;
  const int j = l - 2;
  const float* qg = p->q_norm_g + j * 64; const float* sinkp = p->sinks + j * 16;
  const bool write_cache = (l == 2);
  const int nitems = 512 + 512;
#pragma unroll 1
  for (int item = blockIdx.x; item < 512; item += gridDim.x) {
    {
      const int b = item >> 7, qb = (item >> 2) & 31, kvh = item & 3;
      bf16_t* Kn = (bf16_t*)shm; bf16_t* Vt = (bf16_t*)(shm + KN_BYTES);
      const int band0 = (qb - 1) * 128;
      {
        const int key = tid >> 1, part = tid & 1; const int pos = band0 + key; const bool valid = pos >= 0;
        float x1[16], x2[16];
        if (valid) { const float* kp = B.kvraw + ((size_t)b * SEQ + pos) * 512 + kvh * 64 + part * 16;
#pragma unroll
          for (int i = 0; i < 4; ++i) { const f32x4 a = *(const f32x4*)(kp + 4 * i), c = *(const f32x4*)(kp + 32 + 4 * i);
#pragma unroll
            for (int e = 0; e < 4; ++e) { x1[4 * i + e] = a[e]; x2[4 * i + e] = c[e]; } }
        } else {
#pragma unroll
          for (int i = 0; i < 16; ++i) { x1[i] = 0.f; x2[i] = 0.f; } }
        float ss = 0.f;
#pragma unroll
        for (int i = 0; i < 16; ++i) ss += x1[i] * x1[i] + x2[i] * x2[i];
        ss += __shfl_xor(ss, 1);
        const float rstd = rsqrtf(ss * (1.f / 64.f) + EPS);
        const float* tb = B.tab + (size_t)(valid ? pos : 0) * 64 + part * 16;
        float o1[16], o2[16];
#pragma unroll
        for (int i = 0; i < 16; ++i) { const float a = x1[i] * rstd * p->k_norm_g[part * 16 + i], c = x2[i] * rstd * p->k_norm_g[32 + part * 16 + i];
          const float cs = tb[i], sn = tb[32 + i]; o1[i] = a * cs - c * sn; o2[i] = c * cs + a * sn; }
        u32x4 w;
        w = (u32x4){pk2(o1[0], o1[1]), pk2(o1[2], o1[3]), pk2(o1[4], o1[5]), pk2(o1[6], o1[7])}; *(u32x4*)(Kn + key * KN_STRIDE + part * 16) = w;
        w = (u32x4){pk2(o1[8], o1[9]), pk2(o1[10], o1[11]), pk2(o1[12], o1[13]), pk2(o1[14], o1[15])}; *(u32x4*)(Kn + key * KN_STRIDE + part * 16 + 8) = w;
        w = (u32x4){pk2(o2[0], o2[1]), pk2(o2[2], o2[3]), pk2(o2[4], o2[5]), pk2(o2[6], o2[7])}; *(u32x4*)(Kn + key * KN_STRIDE + 32 + part * 16) = w;
        w = (u32x4){pk2(o2[8], o2[9]), pk2(o2[10], o2[11]), pk2(o2[12], o2[13]), pk2(o2[14], o2[15])}; *(u32x4*)(Kn + key * KN_STRIDE + 32 + part * 16 + 8) = w;
        if (write_cache && qb == 31 && key >= 128) { float* ko = p->out + O_KP + ((size_t)(b * 128 + key - 128) * 4 + kvh) * 64 + part * 16;
#pragma unroll
          for (int i = 0; i < 4; ++i) { *(f32x4*)(ko + 4 * i) = (f32x4){o1[4 * i], o1[4 * i + 1], o1[4 * i + 2], o1[4 * i + 3]};
            *(f32x4*)(ko + 32 + 4 * i) = (f32x4){o2[4 * i], o2[4 * i + 1], o2[4 * i + 2], o2[4 * i + 3]}; } }
      }
      {
        const int key = tid & 255, dh = tid >> 8; const int pos = band0 + key; const bool valid = pos >= 0;
        const float* vp = B.kvraw + ((size_t)b * SEQ + (valid ? pos : 0)) * 512 + 256 + kvh * 64 + dh * 32;
#pragma unroll
        for (int i = 0; i < 8; ++i) { f32x4 a = *(const f32x4*)(vp + 4 * i); if (!valid) a = (f32x4){0.f, 0.f, 0.f, 0.f};
#pragma unroll
          for (int e = 0; e < 4; ++e) Vt[(dh * 32 + 4 * i + e) * VT_STRIDE + key] = (bf16_t)f2bf(a[e]);
          if (write_cache && qb == 31 && key >= 128) *(f32x4*)(p->out + O_VP + ((size_t)(b * 128 + key - 128) * 4 + kvh) * 64 + dh * 32 + 4 * i) = a; }
      }
      __syncthreads();
      const int g = wave & 3, qhalf = wave >> 2, hq = kvh * 4 + g, h = lane >> 5, l31 = lane & 31;
      const float sink = sinkp[hq];
#pragma unroll 1
      for (int sub = 0; sub < 2; ++sub) {
        const int Q0 = 128 + qhalf * 64 + sub * 32, qi = Q0 + l31, pos = band0 + qi;
        const size_t tok = (size_t)b * SEQ + pos;
        float x[4][8];
        { const bf16_t* qp = B.qraw + tok * D + hq * 64 + 8 * h;
#pragma unroll
          for (int s = 0; s < 4; ++s) { const u32x4 w = *(const u32x4*)(qp + 16 * s);
#pragma unroll
            for (int e = 0; e < 4; ++e) { x[s][2 * e] = bf2f(w[e] & 0xffffu); x[s][2 * e + 1] = bf2f(w[e] >> 16); } } }
        float ss = 0.f;
#pragma unroll
        for (int s = 0; s < 4; ++s)
#pragma unroll
          for (int e = 0; e < 8; ++e) ss += x[s][e] * x[s][e];
        ss += __shfl_xor(ss, 32);
        const float rstd = rsqrtf(ss * (1.f / 64.f) + EPS) ;
#pragma unroll
        for (int s = 0; s < 4; ++s)
#pragma unroll
          for (int e = 0; e < 8; ++e) x[s][e] *= rstd * qg[16 * s + 8 * h + e];
        const float* tb = B.tab + (size_t)pos * 64;
        bf16x8 qf[4];
#pragma unroll
        for (int s = 0; s < 2; ++s) { unsigned lo[4], hi[4]; float r1[8], r2[8];
#pragma unroll
          for (int e = 0; e < 8; ++e) { const int i = 16 * s + 8 * h + e; const float cs = tb[i], sn = tb[32 + i]; const float a = x[s][e], c = x[s + 2][e];
            r1[e] = (a * cs - c * sn) * 0.125f; r2[e] = (c * cs + a * sn) * 0.125f; }
#pragma unroll
          for (int e = 0; e < 4; ++e) { lo[e] = pk2(r1[2 * e], r1[2 * e + 1]); hi[e] = pk2(r2[2 * e], r2[2 * e + 1]); }
          qf[s] = __builtin_bit_cast(bf16x8, (u32x4){lo[0], lo[1], lo[2], lo[3]}); qf[s + 2] = __builtin_bit_cast(bf16x8, (u32x4){hi[0], hi[1], hi[2], hi[3]}); }
        const int kb0 = (Q0 - 128) >> 5;
        f32x16 sacc[5]; float mx = sink;
#pragma unroll
        for (int i = 0; i < 5; ++i) { const int kb = kb0 + i; f32x16 a16;
#pragma unroll
          for (int r = 0; r < 16; ++r) a16[r] = 0.f;
          bf16x8 ka[4];
#pragma unroll
          for (int s = 0; s < 4; ++s) ka[s] = *(const bf16x8*)(Kn + (kb * 32 + l31) * KN_STRIDE + 16 * s + 8 * h);
#pragma unroll
          for (int s = 0; s < 4; ++s) a16 = __builtin_amdgcn_mfma_f32_32x32x16_bf16(ka[s], qf[s], a16, 0, 0, 0);
#pragma unroll
          for (int r = 0; r < 16; ++r) { const int key = kb * 32 + crow(r, h); const int rel = qi - key; const bool ok = (rel >= 0) && (rel < 128) && (qb > 0 || key >= 128);
            const float sv = ok ? a16[r] : -1e30f; a16[r] = sv; mx = fmaxf(mx, sv); }
          sacc[i] = a16; }
        mx = fmaxf(mx, __shfl_xor(mx, 32));
        float sum = 0.f; bf16x8 pf[5][2];
#pragma unroll
        for (int i = 0; i < 5; ++i) { float e[16];
#pragma unroll
          for (int r = 0; r < 16; ++r) { e[r] = __expf(sacc[i][r] - mx); sum += e[r]; }
#pragma unroll
          for (int st = 0; st < 2; ++st) pf[i][st] = __builtin_bit_cast(bf16x8, (u32x4){pk2(e[8 * st], e[8 * st + 1]), pk2(e[8 * st + 2], e[8 * st + 3]), pk2(e[8 * st + 4], e[8 * st + 5]), pk2(e[8 * st + 6], e[8 * st + 7])}); }
        sum += __shfl_xor(sum, 32);
        const float inv = 1.f / (sum + __expf(sink - mx));
#pragma unroll
        for (int db = 0; db < 2; ++db) { f32x16 o16;
#pragma unroll
          for (int r = 0; r < 16; ++r) o16[r] = 0.f;
          bf16x8 va[10];
#pragma unroll
          for (int i = 0; i < 5; ++i)
#pragma unroll
            for (int st = 0; st < 2; ++st) { const bf16_t* vp = Vt + (db * 32 + l31) * VT_STRIDE + (kb0 + i) * 32 + 16 * st + 4 * h;
              const u32x2 lo = *(const u32x2*)vp, hi = *(const u32x2*)(vp + 8);
              va[i * 2 + st] = __builtin_bit_cast(bf16x8, (u32x4){lo[0], lo[1], hi[0], hi[1]}); }
          f32x16 o16b;
#pragma unroll
          for (int r = 0; r < 16; ++r) o16b[r] = 0.f;
#pragma unroll
          for (int i = 0; i < 5; ++i) { o16 = __builtin_amdgcn_mfma_f32_32x32x16_bf16(va[i * 2], pf[i][0], o16, 0, 0, 0); o16b = __builtin_amdgcn_mfma_f32_32x32x16_bf16(va[i * 2 + 1], pf[i][1], o16b, 0, 0, 0); }
#pragma unroll
          for (int r = 0; r < 16; ++r) o16[r] += o16b[r];
          bf16_t* op = B.on + tok * D + hq * 64 + db * 32 + 4 * h;
#pragma unroll
          for (int r4 = 0; r4 < 4; ++r4) *(u32x2*)(op + 8 * r4) = (u32x2){pk2(o16[4 * r4] * inv, o16[4 * r4 + 1] * inv), pk2(o16[4 * r4 + 2] * inv, o16[4 * r4 + 3] * inv)}; }
      }
      __syncthreads();
    }
  }
  {
    const int tid = tid_get(), lane = tid & 63, wave = tid >> 6;
#pragma unroll 1
    for (int item = 512 + blockIdx.x; item < nitems; item += gridDim.x) {
      const int sidx = item - 512, bs = sidx >> 2, kvh = sidx & 3; const size_t r = TP + bs;
      float* Ks = (float*)shm; float* Vs = Ks + 128 * 68; float* q_s = Vs + 128 * 64; float* p_s = q_s + 256; float* redm = p_s + 512; float* reds = redm + 8; float* po = reds + 8;
      const float* tb = B.tab + (size_t)4096 * 64;
      f32x4 kreg[4], vreg[4];
#pragma unroll
      for (int i = 0; i < 4; ++i) { const int e = tid + 512 * i, jr = e >> 4, c4 = (e & 15) * 4;
        if (jr < 127) { const size_t o = (((size_t)bs * 128 + jr + 1) * 4 + kvh) * 64 + c4; kreg[i] = __builtin_nontemporal_load((const f32x4*)(p->cache_k + o)); vreg[i] = __builtin_nontemporal_load((const f32x4*)(p->cache_v + o)); } }
      if (tid < 128) { const int g = tid >> 5, i = tid & 31, hq = kvh * 4 + g;
        float a = bf2f(B.qraw[r * D + hq * 64 + i]), c = bf2f(B.qraw[r * D + hq * 64 + 32 + i]);
        float ss = a * a + c * c;
#pragma unroll
        for (int o = 1; o < 32; o <<= 1) ss += __shfl_xor(ss, o);
        const float rstd = rsqrtf(ss * (1.f / 64.f) + EPS); a *= rstd * qg[i]; c *= rstd * qg[32 + i];
        const float cs = tb[i], sn = tb[32 + i];
        q_s[g * 64 + i] = (a * cs - c * sn) * 0.125f; q_s[g * 64 + 32 + i] = (c * cs + a * sn) * 0.125f;
      } else if (tid < 160) { const int i = tid & 31;
        float a = B.kvraw[r * 512 + kvh * 64 + i], c = B.kvraw[r * 512 + kvh * 64 + 32 + i];
        float ss = a * a + c * c;
#pragma unroll
        for (int o = 1; o < 32; o <<= 1) ss += __shfl_xor(ss, o);
        const float rstd = rsqrtf(ss * (1.f / 64.f) + EPS); a *= rstd * p->k_norm_g[i]; c *= rstd * p->k_norm_g[32 + i];
        const float cs = tb[i], sn = tb[32 + i];
        const float k1 = a * cs - c * sn, k2 = c * cs + a * sn, v1 = B.kvraw[r * 512 + 256 + kvh * 64 + i], v2 = B.kvraw[r * 512 + 256 + kvh * 64 + 32 + i];
        Ks[127 * 68 + i] = k1; Ks[127 * 68 + 32 + i] = k2; Vs[127 * 64 + i] = v1; Vs[127 * 64 + 32 + i] = v2;
        if (write_cache) { float* ok = p->out + O_KS + (((size_t)bs * 128 + 127) * 4 + kvh) * 64; float* ov = p->out + O_VS + (((size_t)bs * 128 + 127) * 4 + kvh) * 64;
          ok[i] = k1; ok[32 + i] = k2; ov[i] = v1; ov[32 + i] = v2; } }
#pragma unroll
      for (int i = 0; i < 4; ++i) { const int e = tid + 512 * i, jr = e >> 4, c4 = (e & 15) * 4;
        if (jr < 127) { *(f32x4*)(Ks + jr * 68 + c4) = kreg[i]; *(f32x4*)(Vs + jr * 64 + c4) = vreg[i];
          if (write_cache) { const size_t o = (((size_t)bs * 128 + jr) * 4 + kvh) * 64 + c4; __builtin_nontemporal_store(kreg[i], (f32x4*)(p->out + O_KS + o)); __builtin_nontemporal_store(vreg[i], (f32x4*)(p->out + O_VS + o)); } } }
      __syncthreads();
      const int g = tid >> 7, jk = tid & 127, hq = kvh * 4 + g; const float sink = sinkp[hq];
      float sc = 0.f;
#pragma unroll
      for (int d4 = 0; d4 < 16; ++d4) { const f32x4 kv = *(const f32x4*)(Ks + jk * 68 + 4 * d4), qv = *(const f32x4*)(q_s + g * 64 + 4 * d4); sc += kv[0] * qv[0] + kv[1] * qv[1] + kv[2] * qv[2] + kv[3] * qv[3]; }
      float mx = sc;
#pragma unroll
      for (int o = 1; o < 64; o <<= 1) mx = fmaxf(mx, __shfl_xor(mx, o));
      if (lane == 0) redm[wave] = mx;
      __syncthreads();
      mx = fmaxf(fmaxf(redm[2 * g], redm[2 * g + 1]), sink);
      const float ev = __expf(sc - mx); float sum = ev;
#pragma unroll
      for (int o = 1; o < 64; o <<= 1) sum += __shfl_xor(sum, o);
      if (lane == 0) reds[wave] = sum;
      p_s[g * 128 + jk] = ev;
      __syncthreads();
      const float inv = 1.f / (reds[2 * g] + reds[2 * g + 1] + __expf(sink - mx));
      { const int d = jk & 63, jh = jk >> 6; float o = 0.f;
#pragma unroll 8
        for (int jx = 0; jx < 64; ++jx) o += p_s[g * 128 + jh * 64 + jx] * Vs[(jh * 64 + jx) * 64 + d];
        po[tid] = o;
        __syncthreads();
        if (jh == 0) { const float tot = (o + po[tid + 64]) * inv; B.on[r * D + hq * 64 + d] = (bf16_t)f2bf(tot); } }
      __syncthreads();
    }
  }
}

#define XB_TMO      128
#define XB_XCNT(j)  (256  + 64 * (j))
#define XB_XSUB(j)  (1280 + 64 * (j))
#define XB_XGEN(j)  (2304 + 64 * (j))
#define XB_TOP      3328
#define XB_TOPGEN   3392
#define XCD_BAR_WORDS 3456
#define XB_SPIN_CAP (1u << 18)

__device__ __forceinline__ unsigned xb_ld(unsigned* p)              { return __hip_atomic_load(p, __ATOMIC_RELAXED, __HIP_MEMORY_SCOPE_AGENT); }
__device__ __forceinline__ unsigned xb_add(unsigned* p, unsigned v) { return __hip_atomic_fetch_add(p, v, __ATOMIC_RELAXED, __HIP_MEMORY_SCOPE_AGENT); }
__device__ __forceinline__ unsigned xb_xcc_id() { return (unsigned)__builtin_amdgcn_s_getreg((3 << 11) | 20) & 0xFu; }
#define XB_SPIN(cond, bar) do { unsigned _sp = 0; while (cond) { __builtin_amdgcn_s_sleep(1); \
    if ((++_sp & 255u) == 0u) { if (xb_ld(&(bar)[XB_TMO])) break; if (_sp > XB_SPIN_CAP) { atomicAdd(&(bar)[XB_TMO], 1u); break; } } } } while (0)

struct XcdBarrier {
    unsigned* bar; unsigned x;
    volatile LAS unsigned* st;
};

__device__ __forceinline__ XcdBarrier xcd_barrier_post(unsigned* bar, volatile LAS unsigned* st) {
    XcdBarrier b; b.bar = bar; b.x = xb_xcc_id(); b.st = st;
    if (threadIdx.x == 0) (void)xb_add(&bar[XB_XCNT(b.x)], 1u);
    return b;
}
__device__ __forceinline__ void xcd_barrier_complete(unsigned* bar, unsigned x, unsigned& nloc, unsigned& nx) {
    const unsigned G = gridDim.x * gridDim.y * gridDim.z;
    unsigned sum, cnt, mine, sp = 0u;
    for (;;) {
        sum = 0u; cnt = 0u; mine = 0u;
#pragma unroll
        for (unsigned j = 0; j < 16; ++j) { const unsigned c = xb_ld(&bar[XB_XCNT(j)]); sum += c; cnt += (c > 0u) ? 1u : 0u; mine = (j == x) ? c : mine; }
        if (sum == G) break;
        __builtin_amdgcn_s_sleep(1);
        if ((++sp & 255u) == 0u) { if (xb_ld(&bar[XB_TMO])) break; if (sp > XB_SPIN_CAP) { atomicAdd(&bar[XB_TMO], 1u); break; } }
    }
    nloc = mine > 0u ? mine : 1u; nx = cnt > 0u ? cnt : 1u;
}

__device__ __forceinline__ void xcd_barrier(const XcdBarrier& b) {
    asm volatile("s_waitcnt vmcnt(0)" ::: "memory");
    __syncthreads();
    if (threadIdx.x == 0) {
        unsigned* bar = b.bar;
        __builtin_amdgcn_s_waitcnt(0);
        unsigned nloc = b.st[0], nx = b.st[1];
        if (nloc == 0u) { xcd_barrier_complete(bar, b.x, nloc, nx); b.st[0] = nloc; b.st[1] = nx; }
        const unsigned old = xb_add(&bar[XB_XSUB(b.x)], 1u);
        const unsigned gen = old / nloc;
        if (old + 1u == (gen + 1u) * nloc) {
            __builtin_amdgcn_fence(__ATOMIC_RELEASE, "agent");
            asm volatile("s_waitcnt vmcnt(0)" ::: "memory");
            const unsigned og = xb_add(&bar[XB_TOP], 1u);
            const unsigned tg = og / nx;
            if (og + 1u == (tg + 1u) * nx) xb_add(&bar[XB_TOPGEN], 1u);
            else XB_SPIN(xb_ld(&bar[XB_TOPGEN]) == tg, bar);
            __builtin_amdgcn_fence(__ATOMIC_ACQUIRE, "agent");
            xb_add(&bar[XB_XGEN(b.x)], 1u);
            asm volatile("s_waitcnt vmcnt(0)" ::: "memory");
        } else {
            XB_SPIN(xb_ld(&bar[XB_XGEN(b.x)]) == gen, bar);
            __builtin_amdgcn_fence(__ATOMIC_ACQUIRE, "agent");
            asm volatile("s_waitcnt vmcnt(0)" ::: "memory");
        }
    }
    __syncthreads();
}


__global__ void __launch_bounds__(NTHREADS, 2) yoco_fwd(P parg) {
  extern __shared__ __attribute__((aligned(16))) unsigned char shm[];
  cg::grid_group grid = cg::this_grid();
  volatile LAS unsigned* xst = (volatile LAS unsigned*)((LAS unsigned char*)shm + 131072);
  if (threadIdx.x < 4) xst[threadIdx.x] = 0u;
  __syncthreads();
  const int nMt = TP / BM;
#pragma unroll 1
  for (int step = -2; step < 32; ++step) {
    const int l = (step < 0) ? 0 : (step >> 3), sub = (step < 0) ? (8 + step + 2) : (step & 7); const bool hg = (l < 2);
    if (sub == 3 && !hg) continue;
    if (sub == 5 || (sub == 0 && l > 0)) continue;
    KP p = kp_get(); unsigned char* ws = p->ws;
#ifndef PROBE_REPS
#define PROBE_REPS 1
#endif
#ifndef PROBE_GREPS
#define PROBE_GREPS 1
#endif
    const bool is_gemm = (sub == 0 || sub == 1 || sub == 4 || sub == 6 || sub == 7 || sub == 9);
#ifndef PROBE_MASK
#define PROBE_MASK 0
#endif
    const int pcode = (sub == 2 && !hg) ? 10 : sub;
    const int reps = (((PROBE_MASK >> pcode) & 1) && !(sub == 4 || sub == 7)) ? 2 : 1;
#pragma unroll 1
    for (int rep = 0; rep < reps; ++rep) {
    if (sub == 8) {
      prep_phase(p, shm);
    } else if (sub == 0 || sub == 1 || sub == 4 || sub == 6 || sub == 7 || sub == 9) {
      float* mods = (float*)(ws + OFF_MODS);
      bf16_t* hbuf = (bf16_t*)(ws + OFF_H); bf16_t* onbuf = (bf16_t*)(ws + OFF_ON); bf16_t* ubuf = (bf16_t*)(ws + OFF_U);
      GemmJob j0, j1; EpiArgs E{}; int nj = 1; E.layer = l; E.first = 0;
      float* rssb = (float*)(ws + OFF_RSS); const float* biasb = (const float*)(ws + OFF_BIAS);
      j1.A = (const bf16_t*)(ws + OFF_X); j1.Bt = (const bf16_t*)(ws + OFF_WKV); j1.nM = nMt; j1.nN = 2; j1.K = D; j1.epi = EPI_KVRAW;
      j0.nM = nMt; j0.K = D;
      if (sub == 0) { j0.A = (const bf16_t*)(ws + OFF_ASH); j0.Bt = (const bf16_t*)ws; j0.nM = 1; j0.nN = 106; j0.epi = EPI_BIAS; j1.A = (const bf16_t*)(ws + OFF_BIAS); }
      else if (sub == 9) { j0.A = (const bf16_t*)(ws + OFF_X + (size_t)MODW * D * 2); j0.Bt = (const bf16_t*)(ws + OFF_X); j0.nM = 1; j0.nN = MODW / BM; j0.epi = EPI_ADA; E.f0 = mods; E.ash = (bf16_t*)(ws + OFF_ASH); }
      else if (sub == 1 && hg) { E.rss = rssb + (size_t)(2 * l) * T; E.bias = biasb + (size_t)132 * site_prefN(l); E.bN = 4096; j0.A = hbuf; j0.Bt = (const bf16_t*)(ws + OFF_WIN) + (size_t)l * 4096 * D; j0.nN = 16; j0.epi = EPI_HGIN;
        E.f0 = (float*)(ws + OFF_X); E.b0 = (bf16_t*)(ws + OFF_U); E.b1 = (bf16_t*)(ws + OFF_U + SZ_ACT); E.b2 = (bf16_t*)(ws + OFF_U + 2 * SZ_ACT); E.b3 = (bf16_t*)(ws + OFF_U + 3 * SZ_ACT); }
      else if (sub == 1) { E.rss = rssb + (size_t)(2 * l) * T; E.bias = biasb + (size_t)132 * site_prefN(l); E.bN = 1024; E.bias1 = biasb + (size_t)132 * site_prefN(4); E.bN1 = 512; j0.A = hbuf; j0.Bt = (const bf16_t*)(ws + OFF_WQ) + (size_t)(l - 2) * D * D; j0.nN = 4; j0.epi = EPI_QRAW;
        E.b1 = (bf16_t*)(ws + OFF_X + SZ_ACT); E.f2 = (float*)(ws + OFF_X + 2 * SZ_ACT); nj = (l == 2) ? 2 : 1; }
      else if (sub == 4) { E.rss_out = rssb + (size_t)(1 + 2 * l) * T; E.ng = p->norm2_g + l * D; E.nsc = mods + l * 6144 + 4096; E.yout = hbuf; j0.A = onbuf; j0.Bt = hg ? (const bf16_t*)(ws + OFF_WOUT) + (size_t)l * D * D : (const bf16_t*)(ws + OFF_WO) + (size_t)(l - 2) * D * D; j0.nN = 4; j0.epi = EPI_RESID;
        E.f0 = p->out + O_Y; E.f1 = mods + l * 6144 + 2048; E.first = (l == 0); }
      else if (sub == 6) { E.rss = rssb + (size_t)(1 + 2 * l) * T; E.bias = biasb + (size_t)132 * site_prefN(5 + l); E.bN = 4096; j0.A = hbuf; j0.Bt = (const bf16_t*)(ws + OFF_WUP) + (size_t)l * D * FF; j0.nN = 16; j0.epi = EPI_UP; E.b0 = ubuf; }
      else { if (l < 3) { E.rss_out = rssb + (size_t)(2 * (l + 1)) * T; E.ng = p->norm1_g + (l + 1) * D; E.nsc = mods + (l + 1) * 6144 + 1024; E.yout = hbuf;
          if (l == 1) { E.ngkv = p->kv_norm_g; E.nsckv = mods + 24576 + 1024; E.ykv = (bf16_t*)(ws + OFF_X); } }
        j0.A = ubuf; j0.Bt = (const bf16_t*)(ws + OFF_WDN) + (size_t)l * D * FF; j0.nN = 4; j0.K = FF; j0.epi = EPI_RESID; E.f0 = p->out + O_Y; E.f1 = mods + l * 6144 + 5120; }
      gemm_phase(p, (LAS unsigned char*)shm, shm, j0, j1, nj, E, sub != 9 && sub != 0);
      if (sub == 0) init_rows(p, (unsigned*)(ws + OFF_BAR) + XCD_BAR_WORDS + 100);
    } else if (sub == 2 && hg) {
      HgBufs HB; HB.q = (bf16_t*)(ws + OFF_U); HB.k = (bf16_t*)(ws + OFF_U + SZ_ACT); HB.v = (bf16_t*)(ws + OFF_U + 2 * SZ_ACT); HB.g = (bf16_t*)(ws + OFF_U + 3 * SZ_ACT);
      HB.lf = (float*)(ws + OFF_X); HB.o32 = (float*)(ws + OFF_X + 2 * SZ_ACT); HB.on = (bf16_t*)(ws + OFF_ON);
      scan_phase(p, l, HB, shm);
    } else if (sub == 2) {
      AtBufs AB; AB.qraw = (bf16_t*)(ws + OFF_X + SZ_ACT); AB.kvraw = (float*)(ws + OFF_X + 2 * SZ_ACT); AB.on = (bf16_t*)(ws + OFF_ON); AB.tab = (const float*)(ws + OFF_TAB);
      attn_phase(p, l, AB, shm);
    } else {
      HgBufs HB; HB.q = (bf16_t*)(ws + OFF_U); HB.k = (bf16_t*)(ws + OFF_U + SZ_ACT); HB.v = (bf16_t*)(ws + OFF_U + 2 * SZ_ACT); HB.g = (bf16_t*)(ws + OFF_U + 3 * SZ_ACT);
      HB.lf = (float*)(ws + OFF_X); HB.o32 = (float*)(ws + OFF_X + 2 * SZ_ACT); HB.on = (bf16_t*)(ws + OFF_ON);
      scan_passB(HB);
      { KP pb = kp_get(); XcdBarrier xb; xb.bar = (unsigned*)(pb->ws + OFF_BAR); xb.x = xb_xcc_id(); xb.st = xst; xcd_barrier(xb); }
      scan_prompt<1>(p, l, HB, shm);
    }
    }
    if (step == 31) break;
    if (step == -2) { grid.sync(); KP p0 = kp_get(); if (tid_get() == 0) (void)xb_add((unsigned*)(p0->ws + OFF_BAR) + XB_XCNT(xb_xcc_id()), 1u); }
    else { KP pb = kp_get(); XcdBarrier xb; xb.bar = (unsigned*)(pb->ws + OFF_BAR); xb.x = xb_xcc_id(); xb.st = xst; xcd_barrier(xb); }
  }
}

extern "C" void kernel_launch(void* const* d_in, const int* in_sizes, int n_in, void* d_out, int out_size, void* d_ws, size_t ws_size, hipStream_t stream) {
  static int grid_blocks = 0;
  if (!grid_blocks) {
    int dev = 0, cus = 0, per_cu = 0;
    hipGetDevice(&dev);
    hipDeviceGetAttribute(&cus, hipDeviceAttributeMultiprocessorCount, dev);
    if (hipFuncSetAttribute((const void*)yoco_fwd, hipFuncAttributeMaxDynamicSharedMemorySize, LDS_BYTES) != hipSuccess) fprintf(stderr, "hipFuncSetAttribute failed\n");
    if (hipOccupancyMaxActiveBlocksPerMultiprocessor(&per_cu, (const void*)yoco_fwd, NTHREADS, LDS_BYTES) != hipSuccess || per_cu < 1) { fprintf(stderr, "occupancy query failed\n"); per_cu = 1; }
    grid_blocks = cus * per_cu;
    if (ws_size < WS_NEED) fprintf(stderr, "workspace too small: %zu < %zu\n", ws_size, (size_t)WS_NEED);
  }
  P p{};
  const float** pp = (const float**)&p;
  for (int i = 0; i < 26; ++i) pp[i] = (const float*)d_in[i];
  p.out = (float*)d_out; p.ws = (unsigned char*)d_ws;
  void* args[] = {&p};
  hipError_t e = hipLaunchCooperativeKernel((const void*)yoco_fwd, dim3(grid_blocks), dim3(NTHREADS), args, LDS_BYTES, stream);
  if (e != hipSuccess) fprintf(stderr, "cooperative launch failed: %s (grid %d)\n", hipGetErrorString(e), grid_blocks);
}
```

```cpp
#include <hip/hip_runtime.h>
#include <hip/hip_cooperative_groups.h>
#include <cstdio>
#include <cstdint>
namespace cg = cooperative_groups;

#define DI __device__ __forceinline__
typedef unsigned short bf16_t;
typedef short bf16x8 __attribute__((ext_vector_type(8)));
typedef float f32x4 __attribute__((ext_vector_type(4)));
typedef float f32x2 __attribute__((ext_vector_type(2)));
typedef float f32x16 __attribute__((ext_vector_type(16)));
typedef unsigned u32x4 __attribute__((ext_vector_type(4)));
typedef unsigned u32x2 __attribute__((ext_vector_type(2)));
#define LAS __attribute__((address_space(3)))

constexpr int D = 1024, FF = 4096, TP = 16384, TS = 128, T = TP + TS, TPAD = 16640, SEQ = 4096;
constexpr int NMOD = 132, MODW = 4 * 6144 + 2048;
constexpr float EPS = 1e-6f;
constexpr int NTHREADS = 512, NWAVES = 8;
constexpr int LDS_BYTES = 131072 + 16;

constexpr size_t O_Y = 0;
constexpr size_t O_HGP = (size_t)T * D;
constexpr size_t O_KP = O_HGP + (size_t)2 * 4 * 8 * 128 * 128;
constexpr size_t O_VP = O_KP + (size_t)4 * 128 * 4 * 64;
constexpr size_t O_HGS = O_VP + (size_t)4 * 128 * 4 * 64;
constexpr size_t O_KS = O_HGS + (size_t)2 * 128 * 8 * 128 * 128;
constexpr size_t O_VS = O_KS + (size_t)128 * 128 * 4 * 64;

constexpr size_t SZ_ACT = (size_t)TPAD * D * 2;
constexpr size_t OFF_WIN = 0;
constexpr size_t OFF_WOUT = OFF_WIN + (size_t)2 * 4096 * 1024 * 2;
constexpr size_t OFF_WKV = OFF_WOUT + (size_t)2 * 1024 * 1024 * 2;
constexpr size_t OFF_WQ = OFF_WKV + (size_t)512 * 1024 * 2;
constexpr size_t OFF_WO = OFF_WQ + (size_t)2 * 1024 * 1024 * 2;
constexpr size_t OFF_WUP = OFF_WO + (size_t)2 * 1024 * 1024 * 2;
constexpr size_t OFF_WDN = OFF_WUP + (size_t)4 * 4096 * 1024 * 2;
constexpr size_t OFF_MODS = OFF_WDN + (size_t)4 * 4096 * 1024 * 2;
constexpr size_t OFF_TAB = OFF_MODS + (((size_t)NMOD * MODW * 4 + 4095) & ~(size_t)4095);
constexpr size_t OFF_H = OFF_TAB + (((size_t)4097 * 64 * 4 + 4095) & ~(size_t)4095);
constexpr size_t OFF_ON = OFF_H + SZ_ACT;
constexpr size_t OFF_U = OFF_ON + SZ_ACT;
constexpr size_t OFF_X = OFF_U + 4 * SZ_ACT;
constexpr size_t OFF_BAR = OFF_X + 4 * SZ_ACT;
constexpr size_t BAR_BYTES = 16384;
constexpr size_t OFF_RSS = OFF_BAR + BAR_BYTES;
constexpr size_t ZERO_BYTES = BAR_BYTES + (size_t)9 * T * 4;
constexpr size_t OFF_ASH = OFF_BAR + ((ZERO_BYTES + 4095) & ~(size_t)4095);
constexpr size_t OFF_BIAS = OFF_ASH + (size_t)9 * 256 * 1024 * 2;
constexpr size_t WS_NEED = OFF_BIAS + (size_t)132 * 27136 * 4;

struct P {
  const float *x_prompt, *x_sample, *c_prompt, *c_sample, *state_hgrn, *cache_k, *cache_v;
  const float *w_ada, *b_ada, *norm1_g, *norm2_g, *hg_w_in, *hg_w_out, *hg_lbp, *hg_gn_g;
  const float *kv_w_ada, *kv_b_ada, *kv_norm_g, *w_kv, *k_norm_g, *w_q, *q_norm_g, *sinks, *w_o, *w_up, *w_down;
  float* out; unsigned char* ws;
};

typedef const P __attribute__((address_space(4)))* KP;
DI KP kp_get() { KP q = (KP)__builtin_amdgcn_kernarg_segment_ptr(); asm volatile("" : "+s"(q)); return q; }
DI int tid_get() { int t = threadIdx.x; asm volatile("" : "+v"(t)); return t; }
DI unsigned f2bf(float f) { unsigned u = __float_as_uint(f); return (u + 0x7fffu + ((u >> 16) & 1u)) >> 16; }
typedef __bf16 bf16x2_n __attribute__((ext_vector_type(2)));
DI unsigned pk2(float lo, float hi) { return __builtin_bit_cast(unsigned, __builtin_convertvector((f32x2){lo, hi}, bf16x2_n)); }
DI float bf2f(unsigned b) { return __uint_as_float(b << 16); }
DI float silu_f(float x) { return x * __builtin_amdgcn_rcpf(1.f + __expf(-x)); }
DI int modrow(int r) { return r < TP ? (r >> 12) : (4 + r - TP); }
DI int crow(int reg, int h) { return (reg & 3) + 8 * (reg >> 2) + 4 * h; }

constexpr int BM = 256, BK = 64, HALF = 128, HTB = HALF * BK * 2;
DI int lds_byte(int r, int c) { const int st = (r >> 4) * 2 + (c >> 5), rr = r & 15, cc = c & 31, ob = rr * 64 + cc * 2; return st * 1024 + (ob ^ (((ob >> 9) & 1) << 5)); }
DI void stage_rc(int b, int& R, int& C) { const int st = b / 1024, sb = b % 1024, swz = sb ^ (((sb >> 9) & 1) << 5); R = (st >> 1) * 16 + swz / 64; C = (st & 1) * 32 + (swz % 64) / 2; }

enum { EPI_ADA = 0, EPI_HGIN = 1, EPI_RESID = 2, EPI_UP = 3, EPI_QRAW = 4, EPI_KVRAW = 5, EPI_NOP = 6, EPI_BIAS = 7 };
struct GemmJob { const bf16_t* A; const bf16_t* Bt; int nM, nN, K, epi; };
struct EpiArgs {
  float* f0; const float* f1; float* f2; bf16_t* b0; bf16_t* b1; bf16_t* b2; bf16_t* b3; int layer; int first;
  const float* rss; const float* bias; const float* bias1; int bN, bN1;
  float* rss_out; const float* ng; const float* nsc; bf16_t* yout; const float* ngkv; const float* nsckv; bf16_t* ykv;
  bf16_t* ash;
};
DI int site_N(const int s) { return (s == 2 || s == 3) ? 1024 : (s == 4 ? 512 : 4096); }
DI int site_prefN(const int s) { return s == 0 ? 0 : s == 1 ? 4096 : s == 2 ? 8192 : s == 3 ? 9216 : s == 4 ? 10240 : 10752 + (s - 5) * 4096; }

DI void tile_of(int L, int nM, int nN, int& pm, int& pn) {
  const int nwg = nM * nN; int wgid = L;
  { const int q = nwg / 8, r = nwg % 8, xcd = wgid % 8, off = wgid / 8; wgid = (xcd < r ? xcd * (q + 1) : r * (q + 1) + (xcd - r) * q) + off; }
  const int nig = 8 * nN, gid = wgid / nig, fm = gid * 8, gsz = (nM - fm) < 8 ? (nM - fm) : 8;
  pm = fm + ((wgid % nig) % gsz); pn = (wgid % nig) / gsz;
}

DI void epi_frag(KP p, const int epi, const EpiArgs& E, const int r, const int c, const f32x4 vin) {
  if (epi == EPI_NOP) return;
  f32x4 v = vin;
  if (epi == EPI_HGIN || epi == EPI_UP || epi == EPI_QRAW || epi == EPI_KVRAW) {
    const float rstd = rsqrtf(E.rss[r] * (1.f / D) + EPS);
    const float* bp = ((epi == EPI_KVRAW) ? E.bias1 + (size_t)modrow(r) * E.bN1 : E.bias + (size_t)modrow(r) * E.bN) + c;
    v = v * rstd + *(const f32x4*)bp; }
  if (epi == EPI_HGIN) {
    const int sec = c >> 10, cc = c & 1023; const size_t o = (size_t)r * D + cc;
    if (sec == 1) { f32x4 lb = (f32x4){0.f, 0.f, 0.f, 0.f};
      if (E.layer == 1) { const f32x4 l0 = *(const f32x4*)(p->hg_lbp + cc), l1 = *(const f32x4*)(p->hg_lbp + D + cc);
#pragma unroll
        for (int j = 0; j < 4; ++j) lb[j] = __builtin_amdgcn_rcpf(1.f + __expf(l0[j] - l1[j])); }
      f32x4 lf;
#pragma unroll
      for (int j = 0; j < 4; ++j) { const float sg = __builtin_amdgcn_rcpf(1.f + __expf(-v[j])); const float fg = lb[j] + (1.f - lb[j]) * sg; lf[j] = __logf(fg); }
      *(f32x4*)(E.f0 + o) = lf;
    } else if (sec == 2) { *(u32x2*)(E.b2 + o) = (u32x2){pk2(v[0], v[1]), pk2(v[2], v[3])};
    } else { bf16_t* dst = (sec == 0) ? E.b0 : E.b3; *(u32x2*)(dst + o) = (u32x2){pk2(silu_f(v[0]), silu_f(v[1])), pk2(silu_f(v[2]), silu_f(v[3]))}; }
  } else if (epi == EPI_RESID) {
    const float* xin = E.first ? (r < TP ? p->x_prompt + (size_t)r * D : p->x_sample + (size_t)(r - TP) * D) : (E.f0 + (size_t)r * D);
    const size_t mo = (size_t)modrow(r) * MODW;
    const f32x4 xv = *(const f32x4*)(xin + c), gv = *(const f32x4*)(E.f1 + mo + c);
    const f32x4 yn = xv + gv * v;
    *(f32x4*)(E.f0 + (size_t)r * D + c) = yn;
    if (E.yout) {
      const f32x4 g = *(const f32x4*)(E.ng + c), sc = *(const f32x4*)(E.nsc + mo + c); const f32x4 y = yn * g * (sc + 1.f);
      *(u32x2*)(E.yout + (size_t)r * D + c) = (u32x2){pk2(y[0], y[1]), pk2(y[2], y[3])};
      if (E.ykv) { const f32x4 g2 = *(const f32x4*)(E.ngkv + c), sc2 = *(const f32x4*)(E.nsckv + mo + c); const f32x4 y2 = yn * g2 * (sc2 + 1.f);
        *(u32x2*)(E.ykv + (size_t)r * D + c) = (u32x2){pk2(y2[0], y2[1]), pk2(y2[2], y2[3])}; }
      float ss = yn[0] * yn[0] + yn[1] * yn[1] + yn[2] * yn[2] + yn[3] * yn[3];
      ss += __shfl_xor(ss, 1); ss += __shfl_xor(ss, 2);
      if ((tid_get() & 3) == 0) atomicAdd(E.rss_out + r, ss); }
  } else if (epi == EPI_UP) {
    f32x4 u;
#pragma unroll
    for (int j = 0; j < 4; ++j) { const float t = fmaxf(v[j], 0.f); u[j] = t * t; }
    *(u32x2*)(E.b0 + (size_t)r * FF + c) = (u32x2){pk2(u[0], u[1]), pk2(u[2], u[3])};
  } else if (epi == EPI_QRAW) { *(u32x2*)(E.b1 + (size_t)r * D + c) = (u32x2){pk2(v[0], v[1]), pk2(v[2], v[3])};
  } else if (epi == EPI_KVRAW) { *(f32x4*)(E.f2 + (size_t)r * 512 + c) = v; }
}

DI void epi_frag8(KP p, const int epi, const EpiArgs& E, const int r, const int c, const f32x4 v0, const f32x4 v1, const f32x4 lbA = (f32x4){0.f, 0.f, 0.f, 0.f}, const f32x4 lbB = (f32x4){0.f, 0.f, 0.f, 0.f}) {
  if (epi == EPI_NOP) return;
  if (epi == EPI_ADA) { if (r < NMOD) { const float* bp = (c < 24576) ? (p->b_ada + c) : (p->kv_b_ada + (c - 24576)); float* o = E.f0 + (size_t)r * MODW + c;
      const f32x4 m0 = v0 + *(const f32x4*)bp, m1 = v1 + *(const f32x4*)(bp + 4);
      *(f32x4*)o = m0; *(f32x4*)(o + 4) = m1;
      int site = -1;
      if (c < 24576) { const int l = c / 6144, part = (c - l * 6144) >> 10; site = (part == 0) ? l : (part == 3 ? 5 + l : -1); } else if (c < 25600) site = 4;
      if (site >= 0) *(u32x4*)(E.ash + ((size_t)site * 256 + r) * 1024 + (c & 1023)) = (u32x4){pk2(m0[0], m0[1]), pk2(m0[2], m0[3]), pk2(m1[0], m1[1]), pk2(m1[2], m1[3])}; }
  } else if (epi == EPI_HGIN) {
    const int sec = c >> 10, cc = c & 1023; const size_t o = (size_t)r * D + cc;
    if (sec == 1) { float lb[8];
#pragma unroll
      for (int j = 0; j < 4; ++j) { lb[j] = lbA[j]; lb[4 + j] = lbB[j]; }
      float lf[8];
#pragma unroll
      for (int j = 0; j < 8; ++j) { const float x = (j < 4) ? v0[j & 3] : v1[j & 3]; const float sg = __builtin_amdgcn_rcpf(1.f + __expf(-x)); const float fg = lb[j] + (1.f - lb[j]) * sg;
        lf[j] = __logf(fg); }
      *(f32x4*)(E.f0 + o) = (f32x4){lf[0], lf[1], lf[2], lf[3]}; *(f32x4*)(E.f0 + o + 4) = (f32x4){lf[4], lf[5], lf[6], lf[7]};
    } else if (sec == 2) { *(u32x4*)(E.b2 + o) = (u32x4){pk2(v0[0], v0[1]), pk2(v0[2], v0[3]), pk2(v1[0], v1[1]), pk2(v1[2], v1[3])};
    } else { bf16_t* dst = (sec == 0) ? E.b0 : E.b3;
      *(u32x4*)(dst + o) = (u32x4){pk2(silu_f(v0[0]), silu_f(v0[1])), pk2(silu_f(v0[2]), silu_f(v0[3])), pk2(silu_f(v1[0]), silu_f(v1[1])), pk2(silu_f(v1[2]), silu_f(v1[3]))}; }
  } else if (epi == EPI_RESID) {
    const float* xin = E.first ? (r < TP ? p->x_prompt + (size_t)r * D : p->x_sample + (size_t)(r - TP) * D) : (E.f0 + (size_t)r * D);
    const size_t mo = (size_t)modrow(r) * MODW;
    const float* gm = E.f1 + mo + c; float* o = E.f0 + (size_t)r * D + c;
    const f32x4 xa = *(const f32x4*)(xin + c), xb = *(const f32x4*)(xin + c + 4), ga = *(const f32x4*)gm, gb = *(const f32x4*)(gm + 4);
    const f32x4 ya = xa + ga * v0, yb = xb + gb * v1;
    *(f32x4*)o = ya; *(f32x4*)(o + 4) = yb;
    if (E.yout) {
      const f32x4 g0 = *(const f32x4*)(E.ng + c), g1 = *(const f32x4*)(E.ng + c + 4), s0 = *(const f32x4*)(E.nsc + mo + c), s1 = *(const f32x4*)(E.nsc + mo + c + 4);
      const f32x4 y0 = ya * g0 * (s0 + 1.f), y1 = yb * g1 * (s1 + 1.f);
      *(u32x4*)(E.yout + (size_t)r * D + c) = (u32x4){pk2(y0[0], y0[1]), pk2(y0[2], y0[3]), pk2(y1[0], y1[1]), pk2(y1[2], y1[3])};
      if (E.ykv) { const f32x4 h0 = *(const f32x4*)(E.ngkv + c), h1 = *(const f32x4*)(E.ngkv + c + 4), t0 = *(const f32x4*)(E.nsckv + mo + c), t1 = *(const f32x4*)(E.nsckv + mo + c + 4);
        const f32x4 z0 = ya * h0 * (t0 + 1.f), z1 = yb * h1 * (t1 + 1.f);
        *(u32x4*)(E.ykv + (size_t)r * D + c) = (u32x4){pk2(z0[0], z0[1]), pk2(z0[2], z0[3]), pk2(z1[0], z1[1]), pk2(z1[2], z1[3])}; }
      float ss = ya[0] * ya[0] + ya[1] * ya[1] + ya[2] * ya[2] + ya[3] * ya[3] + yb[0] * yb[0] + yb[1] * yb[1] + yb[2] * yb[2] + yb[3] * yb[3];
      ss += __shfl_xor(ss, 16); ss += __shfl_xor(ss, 32);
      if ((tid_get() & 63) < 16) atomicAdd(E.rss_out + r, ss); }
  } else if (epi == EPI_UP) {
    float u[8];
#pragma unroll
    for (int j = 0; j < 8; ++j) { const float t = fmaxf((j < 4) ? v0[j & 3] : v1[j & 3], 0.f); u[j] = t * t; }
    *(u32x4*)(E.b0 + (size_t)r * FF + c) = (u32x4){pk2(u[0], u[1]), pk2(u[2], u[3]), pk2(u[4], u[5]), pk2(u[6], u[7])};
  } else if (epi == EPI_QRAW) { *(u32x4*)(E.b1 + (size_t)r * D + c) = (u32x4){pk2(v0[0], v0[1]), pk2(v0[2], v0[3]), pk2(v1[0], v1[1]), pk2(v1[2], v1[3])};
  } else { float* o = E.f2 + (size_t)r * 512 + c; *(f32x4*)o = v0; *(f32x4*)(o + 4) = v1; }
}

template <int NMB>
DI void skinny_unit(KP p, unsigned char* shm, const bf16_t* A, const bf16_t* Bt, const int K, const int mrow0, const int n0, const int epi, const EpiArgs& E) {
  const int tid = tid_get(), lane = tid & 63, wave = tid >> 6, fr = lane & 15, fq = lane >> 4;
  const int ks = K >> 3;
  const bf16_t* ap = A + (size_t)(TP + mrow0 + fr) * K + wave * ks + fq * 8;
  const bf16_t* bp = Bt + (size_t)(n0 + fr) * K + wave * ks + fq * 8;
  f32x4 acc[NMB];
#pragma unroll
  for (int mb = 0; mb < NMB; ++mb) acc[mb] = (f32x4){0.f, 0.f, 0.f, 0.f};
#pragma unroll 2
  for (int k = 0; k < ks; k += 32) { const bf16x8 b = *(const bf16x8*)(bp + k);
#pragma unroll
    for (int mb = 0; mb < NMB; ++mb) { const bf16x8 a = *(const bf16x8*)(ap + (size_t)mb * 16 * K + k); acc[mb] = __builtin_amdgcn_mfma_f32_16x16x32_bf16(b, a, acc[mb], 0, 0, 0); } }
  float* red = (float*)shm;
#pragma unroll
  for (int mb = 0; mb < NMB; ++mb) *(f32x4*)(red + wave * (NMB * 256) + (mb * 16 + fr) * 16 + fq * 4) = acc[mb];
  __syncthreads();
  if (tid < NMB * 64) { const int row = tid >> 2, c4 = (tid & 3) * 4; f32x4 sum = (f32x4){0.f, 0.f, 0.f, 0.f};
#pragma unroll
    for (int w = 0; w < 8; ++w) sum += *(const f32x4*)(red + w * (NMB * 256) + row * 16 + c4);
    epi_frag(p, epi, E, TP + mrow0 + row, n0 + c4, sum); }
  __syncthreads();
}

DI int perm32(int rho) { const int n = rho >> 4, i = rho & 15; return 8 * (i >> 2) + 4 * n + (i & 3); }
struct UnitD { const char* A; const char* B; int pm, pn, epi; float* ob; int on; };
DI void unit_of(const int L, const GemmJob& j0, const GemmJob& j1, const int n0, const size_t tstep, UnitD& u) {
  if (j0.epi == EPI_BIAS) {
    const int st = L < 16 ? 0 : L < 32 ? 1 : L < 36 ? 2 : L < 40 ? 3 : L < 42 ? 4 : 5 + (L - 42) / 16;
    const int lb = st == 0 ? 0 : st == 1 ? 16 : st == 2 ? 32 : st == 3 ? 36 : st == 4 ? 40 : 42 + (st - 5) * 16;
    const unsigned char* wsb = (const unsigned char*)j0.Bt;
    const bf16_t* Bt = (st < 2) ? (const bf16_t*)(wsb + OFF_WIN) + (size_t)st * 4096 * D : (st < 4) ? (const bf16_t*)(wsb + OFF_WQ) + (size_t)(st - 2) * D * D
                     : (st == 4) ? (const bf16_t*)(wsb + OFF_WKV) : (const bf16_t*)(wsb + OFF_WUP) + (size_t)(st - 5) * D * FF;
    u.pm = 0; u.pn = L - lb; u.epi = EPI_BIAS; u.A = (const char*)(j0.A + (size_t)st * 256 * 1024); u.B = (const char*)Bt + (size_t)u.pn * tstep;
    u.ob = (float*)j1.A + (size_t)132 * site_prefN(st); u.on = site_N(st); return; }
  const bool second = (L >= n0); int pm, pn; tile_of(second ? L - n0 : L, second ? j1.nM : j0.nM, second ? j1.nN : j0.nN, pm, pn);
  u.pm = pm; u.pn = pn; u.epi = second ? j1.epi : j0.epi;
  u.A = (const char*)(second ? j1.A : j0.A) + (size_t)pm * tstep; u.B = (const char*)(second ? j1.Bt : j0.Bt) + (size_t)pn * tstep;
}
DI void gemm_phase(KP p, LAS unsigned char* lds, unsigned char* shm, const GemmJob& j0, const GemmJob& j1, const int njobs, const EpiArgs& E, const int skinny) {
  const int tid = tid_get(), wid = __builtin_amdgcn_readfirstlane(tid >> 6), lane = tid & 63, wr = wid >> 2, wc = wid & 3, fr = lane & 15, fq = lane >> 4;
  const int K = j0.K, nt = K / BK;
  const int n0 = j0.nM * j0.nN, n1 = (njobs > 1) ? j1.nM * j1.nN : 0, ntl = n0 + n1;
  if ((int)blockIdx.x < ntl) {
    unsigned voffA[2], voffB[2];
#pragma unroll
    for (int i = 0; i < 2; ++i) { int R, C; stage_rc(tid * 16 + i * 8192, R, C); const int Rb = (R & ~31) + perm32(R & 31);
      voffA[i] = (unsigned)(R * K + C) * 2u; voffB[i] = (unsigned)(Rb * K + C) * 2u; }
    const size_t kstep = (size_t)(BK * 2), hstep = (size_t)HALF * K * 2, tstep = 2 * hstep;
    const unsigned ldsw = (unsigned)wid * 1024u;
    const int aoff = lds_byte(wr * 64 + fr, fq * 8), boff = lds_byte(wc * 32 + fr, fq * 8);
#define G_SA(b, h) (((b) * 2 + (h)) * HTB)
#define G_SB(b, h) ((4 + (b) * 2 + (h)) * HTB)
#define G_STAGE(bufoff, gbase, voff) do { _Pragma("unroll") for (int _i = 0; _i < 2; ++_i) \
      __builtin_amdgcn_global_load_lds((const unsigned*)((const char*)(gbase) + (voff)[_i]), (LAS unsigned*)(lds + (bufoff) + ldsw + _i * 8192), 16, 0, 0); } while (0)
#define G_LDA(dst, b, h) do { _Pragma("unroll") for (int m = 0; m < 4; ++m) _Pragma("unroll") for (int k = 0; k < 2; ++k) dst[m][k] = *(const LAS bf16x8*)(lds + G_SA(b, h) + aoff + m * 2048 + k * 1024); } while (0)
#define G_LDB(dst, b, h) do { _Pragma("unroll") for (int n = 0; n < 2; ++n) _Pragma("unroll") for (int k = 0; k < 2; ++k) dst[n][k] = *(const LAS bf16x8*)(lds + G_SB(b, h) + boff + n * 2048 + k * 1024); } while (0)
#define G_MMA(ai, bj, At, Bt) do { __builtin_amdgcn_s_setprio(1); _Pragma("unroll") for (int m = 0; m < 4; ++m) _Pragma("unroll") for (int n = 0; n < 2; ++n) _Pragma("unroll") for (int k = 0; k < 2; ++k) \
      acc[ai][bj][m][n] = __builtin_amdgcn_mfma_f32_16x16x32_bf16(Bt[n][k], At[m][k], acc[ai][bj][m][n], 0, 0, 0); __builtin_amdgcn_s_setprio(0); } while (0)
#define G_WAIT_V(n) asm volatile("s_waitcnt vmcnt(" #n ")" ::: "memory")
#define G_WAIT_L(n) asm volatile("s_waitcnt lgkmcnt(" #n ")" ::: "memory")
#define G_BAR __builtin_amdgcn_s_barrier()
#define G_SCHED __builtin_amdgcn_sched_barrier(0)
    int L = blockIdx.x;
    UnitD cur, nxt; unit_of(L, j0, j1, n0, tstep, cur);
    f32x4 acc[2][2][4][2];
#pragma unroll
    for (int a = 0; a < 2; ++a)
#pragma unroll
      for (int b = 0; b < 2; ++b)
#pragma unroll
        for (int m = 0; m < 4; ++m)
#pragma unroll
          for (int n = 0; n < 2; ++n) acc[a][b][m][n] = (f32x4){0.f, 0.f, 0.f, 0.f};
    bf16x8 At[4][2], B0[2][2], B1[2][2];
    const char* cA = cur.A; const char* cB = cur.B;
    G_STAGE(G_SB(0, 0), cB, voffB); G_STAGE(G_SB(0, 1), cB + hstep, voffB); G_STAGE(G_SA(0, 0), cA, voffA); G_STAGE(G_SA(0, 1), cA + hstep, voffA);
    if (wr == 1) G_BAR;
    G_WAIT_V(2); G_BAR;
    G_STAGE(G_SB(1, 0), cB + kstep, voffB); G_STAGE(G_SA(1, 0), cA + kstep, voffA); G_STAGE(G_SB(1, 1), cB + hstep + kstep, voffB);
    G_WAIT_V(6); G_BAR;
#pragma unroll 1
    for (;;) {
      const int Ln = L + (int)gridDim.x; const bool has_next = (Ln < ntl);
      if (has_next) unit_of(Ln, j0, j1, n0, tstep, nxt);
      const char* nA = has_next ? nxt.A : cA; const char* nB = has_next ? nxt.B : cB;
#pragma unroll 1
      for (int t = 0; t < nt; t += 2) {
        const bool last = (t == nt - 2);
        const bool tail = last && !has_next;
        const char* a1 = cA + (size_t)(t + 1) * kstep;
        const char* a2 = last ? nA : cA + (size_t)(t + 2) * kstep; const char* b2 = last ? nB : cB + (size_t)(t + 2) * kstep;
        const char* a3 = a2 + kstep; const char* b3 = b2 + kstep;
        G_LDB(B0, 0, 0); G_LDB(B1, 0, 1); G_SCHED; G_LDA(At, 0, 0); G_STAGE(G_SA(1, 1), a1 + hstep, voffA);
        G_WAIT_V(8); G_WAIT_L(0); G_BAR; G_MMA(0, 0, At, B0); G_MMA(0, 1, At, B1); G_BAR; G_SCHED;
        G_LDA(At, 0, 1); if (!tail) { G_STAGE(G_SB(0, 0), b2, voffB); G_STAGE(G_SB(0, 1), b2 + hstep, voffB); G_STAGE(G_SA(0, 0), a2, voffA); }
        if (tail) G_WAIT_V(2); else G_WAIT_V(8);
        G_WAIT_L(0); G_BAR; G_MMA(1, 0, At, B0); G_MMA(1, 1, At, B1); G_BAR; G_SCHED;
        G_LDB(B0, 1, 0); G_LDB(B1, 1, 1); G_SCHED; G_LDA(At, 1, 0); if (!tail) G_STAGE(G_SA(0, 1), a2 + hstep, voffA);
        if (tail) G_WAIT_V(0); else G_WAIT_V(8);
        G_WAIT_L(0); G_BAR; G_MMA(0, 0, At, B0); G_MMA(0, 1, At, B1); G_BAR; G_SCHED;
        G_LDA(At, 1, 1); if (!tail) { G_STAGE(G_SB(1, 0), b3, voffB); G_STAGE(G_SB(1, 1), b3 + hstep, voffB); G_STAGE(G_SA(1, 0), a3, voffA); }
        if (tail) G_WAIT_V(0); else G_WAIT_V(8);
        G_WAIT_L(0); G_BAR; G_MMA(1, 0, At, B0); G_MMA(1, 1, At, B1); G_BAR; G_SCHED;
      }
      if (wr == 0) G_BAR;
      { const int r0 = cur.pm * BM + wr * 64 + fr, c0 = cur.pn * BM + wc * 32 + fq * 8; const int epi = cur.epi;
#define EPI_LOOP(MODE) { _Pragma("unroll") for (int ai = 0; ai < 2; ++ai) _Pragma("unroll") for (int m = 0; m < 4; ++m) _Pragma("unroll") for (int bj = 0; bj < 2; ++bj) \
          epi_frag8(p, MODE, E, r0 + ai * 128 + m * 16, c0 + bj * 128, acc[ai][bj][m][0], acc[ai][bj][m][1]); }
        if (epi == EPI_ADA) EPI_LOOP(EPI_ADA)
        else if (epi == EPI_BIAS) {
#pragma unroll
          for (int ai = 0; ai < 2; ++ai)
#pragma unroll
            for (int m = 0; m < 4; ++m) { const int r = r0 + ai * 128 + m * 16; if (r < NMOD) {
#pragma unroll
              for (int bj = 0; bj < 2; ++bj) { float* o = cur.ob + (size_t)r * cur.on + (c0 + bj * 128); *(f32x4*)o = acc[ai][bj][m][0]; *(f32x4*)(o + 4) = acc[ai][bj][m][1]; } } }
        } else if (epi == EPI_RESID) {
          const size_t mo = (size_t)modrow(r0) * MODW;
#pragma unroll
          for (int bj = 0; bj < 2; ++bj) { const int c = c0 + bj * 128;
            const f32x4 ga = *(const f32x4*)(E.f1 + mo + c), gb = *(const f32x4*)(E.f1 + mo + c + 4);
            f32x4 m0 = (f32x4){0.f, 0.f, 0.f, 0.f}, m1 = m0, k0 = m0, k1 = m0;
            if (E.yout) { const f32x4 g0 = *(const f32x4*)(E.ng + c), g1 = *(const f32x4*)(E.ng + c + 4), s0 = *(const f32x4*)(E.nsc + mo + c), s1 = *(const f32x4*)(E.nsc + mo + c + 4);
              m0 = g0 * (s0 + 1.f); m1 = g1 * (s1 + 1.f);
              if (E.ykv) { const f32x4 h0 = *(const f32x4*)(E.ngkv + c), h1 = *(const f32x4*)(E.ngkv + c + 4), t0 = *(const f32x4*)(E.nsckv + mo + c), t1 = *(const f32x4*)(E.nsckv + mo + c + 4);
                k0 = h0 * (t0 + 1.f); k1 = h1 * (t1 + 1.f); } }
#pragma unroll
            for (int ah = 0; ah < 2; ++ah) { const int ai = ah, mb = 0;
              f32x4 ya[4], yb[4];
              const float* xbase = E.first ? p->x_prompt : E.f0;
#pragma unroll
              for (int m = mb; m < mb + 4; ++m) { const unsigned off = (unsigned)(r0 + ai * 128 + m * 16) * (unsigned)D + (unsigned)c;
                ya[m] = __builtin_nontemporal_load((const f32x4*)(xbase + off)); yb[m] = __builtin_nontemporal_load((const f32x4*)(xbase + off + 4)); }
#pragma unroll
              for (int m = mb; m < mb + 4; ++m) { const int r = r0 + ai * 128 + m * 16; const unsigned off = (unsigned)r * (unsigned)D + (unsigned)c;
                const f32x4 xa = ya[m] + ga * acc[ai][bj][m][0], xb = yb[m] + gb * acc[ai][bj][m][1];
                __builtin_nontemporal_store(xa, (f32x4*)(E.f0 + off)); __builtin_nontemporal_store(xb, (f32x4*)(E.f0 + off + 4));
                if (E.yout) { const f32x4 y0 = xa * m0, y1 = xb * m1;
                  *(u32x4*)(E.yout + off) = (u32x4){pk2(y0[0], y0[1]), pk2(y0[2], y0[3]), pk2(y1[0], y1[1]), pk2(y1[2], y1[3])};
                  if (E.ykv) { const f32x4 z0 = xa * k0, z1 = xb * k1;
                    *(u32x4*)(E.ykv + off) = (u32x4){pk2(z0[0], z0[1]), pk2(z0[2], z0[3]), pk2(z1[0], z1[1]), pk2(z1[2], z1[3])}; }
                  float ss = xa[0] * xa[0] + xa[1] * xa[1] + xa[2] * xa[2] + xa[3] * xa[3] + xb[0] * xb[0] + xb[1] * xb[1] + xb[2] * xb[2] + xb[3] * xb[3];
                  ss += __shfl_xor(ss, 16); ss += __shfl_xor(ss, 32);
                  if (fq == 0) atomicAdd(E.rss_out + (unsigned)r, ss); } } } }
        } else if (epi != EPI_NOP) {
          float rstd8[8];
#pragma unroll
          for (int q = 0; q < 8; ++q) rstd8[q] = rsqrtf(E.rss[r0 + (q >> 2) * 128 + (q & 3) * 16] * (1.f / D) + EPS);
          const float* bb = (epi == EPI_KVRAW) ? E.bias1 + (size_t)modrow(r0) * E.bN1 : E.bias + (size_t)modrow(r0) * E.bN;
          f32x4 bv[2][2], lbv[2][2];
#pragma unroll
          for (int bj = 0; bj < 2; ++bj) { const int c = c0 + bj * 128; bv[bj][0] = *(const f32x4*)(bb + c); bv[bj][1] = *(const f32x4*)(bb + c + 4);
            lbv[bj][0] = (f32x4){0.f, 0.f, 0.f, 0.f}; lbv[bj][1] = (f32x4){0.f, 0.f, 0.f, 0.f};
            if (epi == EPI_HGIN && (c >> 10) == 1 && E.layer == 1) { const int cc = c & 1023;
              const f32x4 l0 = *(const f32x4*)(p->hg_lbp + cc), l1 = *(const f32x4*)(p->hg_lbp + D + cc), l2 = *(const f32x4*)(p->hg_lbp + cc + 4), l3 = *(const f32x4*)(p->hg_lbp + D + cc + 4);
#pragma unroll
              for (int jj = 0; jj < 4; ++jj) { lbv[bj][0][jj] = __builtin_amdgcn_rcpf(1.f + __expf(l0[jj] - l1[jj])); lbv[bj][1][jj] = __builtin_amdgcn_rcpf(1.f + __expf(l2[jj] - l3[jj])); } } }
#define CONS_LOOP(MODE) { _Pragma("unroll") for (int ai = 0; ai < 2; ++ai) _Pragma("unroll") for (int m = 0; m < 4; ++m) _Pragma("unroll") for (int bj = 0; bj < 2; ++bj) \
            epi_frag8(p, MODE, E, r0 + ai * 128 + m * 16, c0 + bj * 128, acc[ai][bj][m][0] * rstd8[ai * 4 + m] + bv[bj][0], acc[ai][bj][m][1] * rstd8[ai * 4 + m] + bv[bj][1], lbv[bj][0], lbv[bj][1]); }
          if (epi == EPI_HGIN) CONS_LOOP(EPI_HGIN) else if (epi == EPI_UP) CONS_LOOP(EPI_UP) else if (epi == EPI_QRAW) CONS_LOOP(EPI_QRAW) else CONS_LOOP(EPI_KVRAW)
        }
      }
      if (!has_next) break;
#pragma unroll
      for (int a = 0; a < 2; ++a)
#pragma unroll
        for (int b = 0; b < 2; ++b)
#pragma unroll
          for (int m = 0; m < 4; ++m)
#pragma unroll
            for (int n = 0; n < 2; ++n) acc[a][b][m][n] = (f32x4){0.f, 0.f, 0.f, 0.f};
      cur = nxt; cA = nA; cB = nB; L = Ln;
      if (wr == 1) G_BAR;
    }
    G_WAIT_V(0);
    G_BAR;
  }
  if (skinny) {
    __syncthreads();
    const int u0 = j0.nN * 16, u1 = (njobs > 1) ? j1.nN * 16 : 0;
    const int rs = ((u0 + u1) * 4 <= (int)gridDim.x) ? 4 : (((u0 + u1) * 2 <= (int)gridDim.x) ? 2 : 1);
#pragma unroll 1
    for (int uu = (int)gridDim.x - 1 - (int)blockIdx.x; uu < (u0 + u1) * rs; uu += gridDim.x) {
      const int u = uu / rs, rg = uu - u * rs;
      const bool second = (u >= u0);
      const bf16_t* sa = second ? j1.A : j0.A; const bf16_t* sb = second ? j1.Bt : j0.Bt; const int sk = second ? j1.K : j0.K, sn = (second ? u - u0 : u) * 16, se = second ? j1.epi : j0.epi;
      if (rs == 4) skinny_unit<2>(p, shm, sa, sb, sk, rg * 32, sn, se, E);
      else if (rs == 2) skinny_unit<4>(p, shm, sa, sb, sk, rg * 64, sn, se, E);
      else skinny_unit<8>(p, shm, sa, sb, sk, 0, sn, se, E);
    }
  }
}

__device__ const float INVF[32] = {1.000000000e+00f, 7.498942614e-01f, 5.623413324e-01f, 4.216965139e-01f, 3.162277639e-01f, 2.371373773e-01f, 1.778279394e-01f, 1.333521307e-01f, 1.000000015e-01f, 7.498941571e-02f, 5.623413250e-02f, 4.216965288e-02f, 3.162277490e-02f, 2.371373773e-02f, 1.778279431e-02f, 1.333521493e-02f, 9.999999776e-03f, 7.498941850e-03f, 5.623413250e-03f, 4.216964822e-03f, 3.162277630e-03f, 2.371373586e-03f, 1.778279431e-03f, 1.333521446e-03f, 1.000000047e-03f, 7.498942432e-04f, 5.623413017e-04f, 4.216965172e-04f, 3.162277571e-04f, 2.371373703e-04f, 1.778279402e-04f, 1.333521504e-04f};
DI void transpose_item(const float* W, int K, int N, bf16_t* WT, int row_off, float* scr, int item, int lane) {
  const int nblk = N / 32, kb = item / nblk, nb = item % nblk, k0 = 64 * kb, n0 = 32 * nb;
#pragma unroll 8
  for (int i = 0; i < 32; ++i) { const int kk = 2 * i + (lane >> 5); scr[kk * 33 + (lane & 31)] = __builtin_nontemporal_load(W + (size_t)(k0 + kk) * N + n0 + (lane & 31)); }
  asm volatile("s_waitcnt lgkmcnt(0)" ::: "memory");
  const int c = lane & 7;
#pragma unroll
  for (int j = 0; j < 4; ++j) { const int n = (lane >> 3) + 8 * j; const float* s = scr + (8 * c) * 33 + n;
    u32x4 o; o.x = pk2(s[0 * 33], s[1 * 33]); o.y = pk2(s[2 * 33], s[3 * 33]); o.z = pk2(s[4 * 33], s[5 * 33]); o.w = pk2(s[6 * 33], s[7 * 33]);
    *(u32x4*)(WT + (size_t)(row_off + n0 + n) * K + k0 + 8 * c) = o; }
  asm volatile("s_waitcnt lgkmcnt(0)" ::: "memory");
}

DI void prep_phase(KP p, unsigned char* shm) {
  const int tid = tid_get(), lane = tid & 63, wave = tid >> 6;
  const int gw = blockIdx.x * NWAVES + wave, NGW = gridDim.x * NWAVES;
  float* scr = (float*)(shm + wave * 16384);
  unsigned char* ws = p->ws;
  int base = 0;
  for (int mi = 0; mi < 22; ++mi) {
    const float* W; int K, N, row_off; bf16_t* WT;
    if (mi < 2) { W = p->hg_w_in + (size_t)mi * D * 4096; K = D; N = 4096; WT = (bf16_t*)(ws + OFF_WIN) + (size_t)mi * 4096 * D; row_off = 0; }
    else if (mi < 4) { W = p->hg_w_out + (size_t)(mi - 2) * D * D; K = D; N = D; WT = (bf16_t*)(ws + OFF_WOUT) + (size_t)(mi - 2) * D * D; row_off = 0; }
    else if (mi < 5) { W = p->w_kv; K = D; N = 512; WT = (bf16_t*)(ws + OFF_WKV); row_off = 0; }
    else if (mi < 7) { W = p->w_q + (size_t)(mi - 5) * D * D; K = D; N = D; WT = (bf16_t*)(ws + OFF_WQ) + (size_t)(mi - 5) * D * D; row_off = 0; }
    else if (mi < 9) { W = p->w_o + (size_t)(mi - 7) * D * D; K = D; N = D; WT = (bf16_t*)(ws + OFF_WO) + (size_t)(mi - 7) * D * D; row_off = 0; }
    else if (mi < 13) { W = p->w_up + (size_t)(mi - 9) * D * FF; K = D; N = FF; WT = (bf16_t*)(ws + OFF_WUP) + (size_t)(mi - 9) * D * FF; row_off = 0; }
    else if (mi < 17) { W = p->w_down + (size_t)(mi - 13) * D * FF; K = FF; N = D; WT = (bf16_t*)(ws + OFF_WDN) + (size_t)(mi - 13) * D * FF; row_off = 0; }
    else if (mi < 21) { W = p->w_ada + (size_t)(mi - 17) * D * 6144; K = D; N = 6144; WT = (bf16_t*)(ws + OFF_X); row_off = (mi - 17) * 6144; }
    else { W = p->kv_w_ada; K = D; N = 2048; WT = (bf16_t*)(ws + OFF_X); row_off = 24576; }
    const int nitems = (K / 64) * (N / 32);
    int first = (gw - (base % NGW) + NGW) % NGW;
    for (int it = first; it < nitems; it += NGW) transpose_item(W, K, N, WT, row_off, scr, it, lane);
    base += nitems;
  }
  bf16_t* Ac = (bf16_t*)(ws + OFF_X + (size_t)MODW * D * 2);
  const int gt = blockIdx.x * NTHREADS + tid, NGT = gridDim.x * NTHREADS;
  { unsigned* z = (unsigned*)(ws + OFF_BAR); for (int e = gt; e < (int)(ZERO_BYTES / 4); e += NGT) z[e] = 0u; }
  for (int e = gt; e < 256 * D / 2; e += NGT) { const int r = e / (D / 2), c = (e % (D / 2)) * 2; float a = 0.f, b = 0.f;
    if (r < NMOD) { const float* cp = (r < 4) ? p->c_prompt + (size_t)r * D : p->c_sample + (size_t)(r - 4) * D; a = silu_f(cp[c]); b = silu_f(cp[c + 1]); }
    *(unsigned*)(Ac + (size_t)r * D + c) = pk2(a, b); }
  float* tab = (float*)(ws + OFF_TAB);
  for (int e = gt; e < 4097 * 32; e += NGT) { const int pi = e >> 5, i = e & 31; const float pos = (pi < 4096) ? (float)pi : 8192.f;
    const float ang = pos * INVF[i]; float sn, cs; sincosf(ang, &sn, &cs);
    tab[pi * 64 + i] = cs; tab[pi * 64 + 32 + i] = sn; }
}

DI void init_rows(KP p, unsigned* ctr) {
  const int tid = tid_get(); const int lane = tid & 63;
  unsigned char* ws = p->ws; const float* mods = (const float*)(ws + OFF_MODS); bf16_t* yout = (bf16_t*)(ws + OFF_H); float* rss = (float*)(ws + OFF_RSS);
  const float* g = p->norm1_g; const float* msc = mods + 1024;
#pragma unroll 1
  for (;;) {
    unsigned cidx = 0; if (lane == 0) cidx = __hip_atomic_fetch_add(ctr, 1u, __ATOMIC_RELAXED, __HIP_MEMORY_SCOPE_AGENT);
    cidx = __builtin_amdgcn_readfirstlane(cidx);
    if (cidx >= (unsigned)(T / 8)) break;
#pragma unroll 1
    for (int hh = 0; hh < 2; ++hh) { const int rb = (int)cidx * 8 + hh * 4;
      f32x4 v[4][4];
#pragma unroll
      for (int q = 0; q < 4; ++q) { const int r = rb + q; const float* xr = (r < TP) ? p->x_prompt + (size_t)r * D : p->x_sample + (size_t)(r - TP) * D;
#pragma unroll
        for (int jj = 0; jj < 4; ++jj) v[q][jj] = *(const f32x4*)(xr + lane * 4 + 256 * jj); }
#pragma unroll
      for (int q = 0; q < 4; ++q) { const int r = rb + q; float a = 0.f;
#pragma unroll
        for (int jj = 0; jj < 4; ++jj) a += v[q][jj][0] * v[q][jj][0] + v[q][jj][1] * v[q][jj][1] + v[q][jj][2] * v[q][jj][2] + v[q][jj][3] * v[q][jj][3];
#pragma unroll
        for (int o = 1; o < 64; o <<= 1) a += __shfl_xor(a, o);
        if (lane == 0) rss[r] = a;
        const size_t mo = (size_t)modrow(r) * MODW;
#pragma unroll
        for (int jj = 0; jj < 4; ++jj) { const int c = lane * 4 + 256 * jj;
          const f32x4 gg = *(const f32x4*)(g + c), sc = *(const f32x4*)(msc + mo + c);
          const f32x4 h = v[q][jj] * gg * (sc + 1.f);
          *(u32x2*)(yout + (size_t)r * D + c) = (u32x2){pk2(h[0], h[1]), pk2(h[2], h[3])}; } } }
  }
}

struct HgBufs { const bf16_t *q, *k, *v, *g; const float* lf; float* o32; bf16_t* on; };

constexpr int SPAN = 256, NSPAN = SEQ / SPAN, CH = 32, NCH = SPAN / CH;
constexpr int L_CUM = 0, L_QT = 16896, L_KT = 25600, L_KE = 34304, L_VT = 44544, L_PS = 54784, L_DEC = 55808, L_HALF = 57344;
constexpr int CUS = 132, QS = 136, KES = 40;
DI bf16x8 pack8(const f32x16& x, const int s) {
  return __builtin_bit_cast(bf16x8, (u32x4){pk2(x[8 * s], x[8 * s + 1]), pk2(x[8 * s + 2], x[8 * s + 3]), pk2(x[8 * s + 4], x[8 * s + 5]), pk2(x[8 * s + 6], x[8 * s + 7])});
}
template <int MODE>
DI void scan_prompt(KP p, const int l, const HgBufs& B, unsigned char* shm) {
  const int tid = tid_get(), lane = tid & 63, wave = tid >> 6, hb = wave >> 2, th = tid & 255, vb = wave & 3, h5 = lane >> 5, l31 = lane & 31;
  unsigned char* base = shm + hb * L_HALF;
  float* cumb = (float*)(base + L_CUM); bf16_t* Qt = (bf16_t*)(base + L_QT); bf16_t* Kt = (bf16_t*)(base + L_KT);
  bf16_t* KeT = (bf16_t*)(base + L_KE); bf16_t* Vt = (bf16_t*)(base + L_VT); float* psum = (float*)(base + L_PS); float* dec = (float*)(base + L_DEC);
  float* dS = B.o32; float* Lsum = B.o32 + (size_t)512 * 16384;
#pragma unroll 1
  for (int it0 = blockIdx.x * 2; it0 < 32 * NSPAN; it0 += gridDim.x * 2) {
    const int item = it0 + hb, bh = item / NSPAN, span = item % NSPAN, b = bh >> 3, h = bh & 7;
    f32x16 S[4];
#pragma unroll
    for (int db = 0; db < 4; ++db)
#pragma unroll
      for (int r = 0; r < 16; ++r) S[db][r] = 0.f;
    if (MODE == 1) {
      const unsigned ob = (unsigned)item * 16384u + (unsigned)(vb * 32 + l31) + (unsigned)(4 * h5) * 128u;
#pragma unroll
      for (int db = 0; db < 4; ++db) {
#pragma unroll
        for (int r = 0; r < 16; ++r) S[db][r] = dS[ob + (unsigned)((32 * db + (r & 3) + 8 * (r >> 2)) * 128)];
        __builtin_amdgcn_sched_barrier(0); }
    }
    float Ltot = 0.f;
#define LBAR() do { asm volatile("s_waitcnt lgkmcnt(0)" ::: "memory"); __builtin_amdgcn_s_barrier(); asm volatile("" ::: "memory"); } while (0)
    const int d1 = th & 127, part = th >> 7, t2 = th >> 3, dg = th & 7;
    const size_t tokS = (size_t)b * SEQ + (size_t)span * SPAN;
    float lfr[16]; unsigned vr[16]; u32x4 q0, q1, g0, g1;
#define SCAN_LOAD(chx) do { const size_t o0_ = (tokS + (size_t)(chx) * CH + part * 16) * D + h * 128 + d1; \
      _Pragma("unroll") for (int i = 0; i < 16; ++i) { lfr[i] = B.lf[o0_ + (size_t)i * D]; vr[i] = B.v[o0_ + (size_t)i * D]; } \
      } while (0)
    __builtin_amdgcn_sched_barrier(0);
    SCAN_LOAD(0);
    __builtin_amdgcn_sched_barrier(0);
#pragma unroll 1
    for (int ch = 0; ch < NCH; ++ch) {
      const size_t tok0 = tokS + (size_t)ch * CH;
      if (MODE == 1) { const size_t o_ = (tok0 + t2) * D + h * 128 + dg * 16;
        q0 = *(const u32x4*)(B.q + o_); q1 = *(const u32x4*)(B.q + o_ + 8);
        g0 = *(const u32x4*)(B.g + o_); g1 = *(const u32x4*)(B.g + o_ + 8); }
      { const int d = d1;
        float c[16]; float run = 0.f;
#pragma unroll
        for (int i = 0; i < 16; ++i) { run += lfr[i]; c[i] = run; }
        psum[part * 128 + d] = run;
        LBAR();
        const float t0 = psum[d], t1 = psum[128 + d]; const float off = part ? t0 : 0.f; const float Lc = t0 + t1;
        float ke[16];
#pragma unroll
        for (int i = 0; i < 16; ++i) { const float cu = off + c[i]; if (MODE == 1) cumb[(part * 16 + i) * CUS + d] = cu; ke[i] = (1.f - __expf(lfr[i])) * __expf(Lc - cu); }
        *(u32x4*)(KeT + d * KES + part * 16) = (u32x4){pk2(ke[0], ke[1]), pk2(ke[2], ke[3]), pk2(ke[4], ke[5]), pk2(ke[6], ke[7])};
        *(u32x4*)(KeT + d * KES + part * 16 + 8) = (u32x4){pk2(ke[8], ke[9]), pk2(ke[10], ke[11]), pk2(ke[12], ke[13]), pk2(ke[14], ke[15])};
        *(u32x4*)(Vt + d * KES + part * 16) = (u32x4){vr[0] | (vr[1] << 16), vr[2] | (vr[3] << 16), vr[4] | (vr[5] << 16), vr[6] | (vr[7] << 16)};
        *(u32x4*)(Vt + d * KES + part * 16 + 8) = (u32x4){vr[8] | (vr[9] << 16), vr[10] | (vr[11] << 16), vr[12] | (vr[13] << 16), vr[14] | (vr[15] << 16)};
        if (part == 0) { dec[d] = __expf(Lc); Ltot += Lc; }
      }
      LBAR();
      if (MODE == 1) {
        const int t = t2;
        unsigned qo[8], ko[8];
#pragma unroll
        for (int g4 = 0; g4 < 4; ++g4) { const f32x4 cv = *(const f32x4*)(cumb + t * CUS + dg * 16 + 4 * g4);
          f32x4 cp = (f32x4){0.f, 0.f, 0.f, 0.f}; if (t > 0) cp = *(const f32x4*)(cumb + (t - 1) * CUS + dg * 16 + 4 * g4);
#pragma unroll
          for (int e2 = 0; e2 < 2; ++e2) { const int w = g4 * 2 + e2; const unsigned qw = (w < 4) ? q0[w & 3] : q1[w & 3];
            const float ca = cv[2 * e2], cb = cv[2 * e2 + 1];
            const float ka = 1.f - __expf(ca - cp[2 * e2]), kb = 1.f - __expf(cb - cp[2 * e2 + 1]);
            qo[w] = pk2(bf2f(qw & 0xffffu) * __expf(ca), bf2f(qw >> 16) * __expf(cb));
            ko[w] = pk2(ka * __expf(fminf(-ca, 80.f)), kb * __expf(fminf(-cb, 80.f))); } }
        *(u32x4*)(Qt + t * QS + dg * 16) = (u32x4){qo[0], qo[1], qo[2], qo[3]}; *(u32x4*)(Qt + t * QS + dg * 16 + 8) = (u32x4){qo[4], qo[5], qo[6], qo[7]};
        *(u32x4*)(Kt + t * QS + dg * 16) = (u32x4){ko[0], ko[1], ko[2], ko[3]}; *(u32x4*)(Kt + t * QS + dg * 16 + 8) = (u32x4){ko[4], ko[5], ko[6], ko[7]};
        LBAR();
      }
      { const int chn = (ch + 1 < NCH) ? ch + 1 : ch; SCAN_LOAD(chn); }
      f32x16 O;
      if (MODE == 1) {
        f32x16 X;
#pragma unroll
        for (int r = 0; r < 16; ++r) { X[r] = 0.f; O[r] = 0.f; }
#pragma unroll
        for (int ks = 0; ks < 8; ++ks) { const bf16x8 a = *(const bf16x8*)(Kt + l31 * QS + 16 * ks + 8 * h5), bq = *(const bf16x8*)(Qt + l31 * QS + 16 * ks + 8 * h5);
          X = __builtin_amdgcn_mfma_f32_32x32x16_bf16(a, bq, X, 0, 0, 0); }
#pragma unroll
        for (int r = 0; r < 16; ++r) if (crow(r, h5) > l31) X[r] = 0.f;
#pragma unroll
        for (int st = 0; st < 2; ++st) { const bf16_t* vp = Vt + (vb * 32 + l31) * KES + 16 * st + 4 * h5; const u32x2 lo = *(const u32x2*)vp, hi = *(const u32x2*)(vp + 8);
          O = __builtin_amdgcn_mfma_f32_32x32x16_bf16(pack8(X, st), __builtin_bit_cast(bf16x8, (u32x4){lo[0], lo[1], hi[0], hi[1]}), O, 0, 0, 0); }
#pragma unroll
        for (int db = 0; db < 4; ++db)
#pragma unroll
          for (int st = 0; st < 2; ++st) { const bf16_t* qp = Qt + l31 * QS + 32 * db + 16 * st + 4 * h5; const u32x2 lo = *(const u32x2*)qp, hi = *(const u32x2*)(qp + 8);
            O = __builtin_amdgcn_mfma_f32_32x32x16_bf16(__builtin_bit_cast(bf16x8, (u32x4){lo[0], lo[1], hi[0], hi[1]}), pack8(S[db], st), O, 0, 0, 0); }
      }
#pragma unroll
      for (int db = 0; db < 4; ++db) {
#pragma unroll
        for (int r4 = 0; r4 < 4; ++r4) { const f32x4 dv = *(const f32x4*)(dec + 32 * db + 8 * r4 + 4 * h5);
#pragma unroll
          for (int e = 0; e < 4; ++e) S[db][4 * r4 + e] *= dv[e]; }
#pragma unroll
        for (int st = 0; st < 2; ++st) { const bf16x8 a = *(const bf16x8*)(KeT + (32 * db + l31) * KES + 16 * st + 8 * h5), bv = *(const bf16x8*)(Vt + (vb * 32 + l31) * KES + 16 * st + 8 * h5);
          S[db] = __builtin_amdgcn_mfma_f32_32x32x16_bf16(a, bv, S[db], 0, 0, 0); } }
      if (MODE == 1) {
#pragma unroll
        for (int r = 0; r < 16; ++r) cumb[crow(r, h5) * CUS + vb * 32 + l31] = O[r];
        LBAR();
        const int t = t2, vg = dg; const size_t o = (tok0 + t) * D + h * 128 + vg * 16;
        f32x4 ov[4]; float ss = 0.f;
#pragma unroll
        for (int g4 = 0; g4 < 4; ++g4) { ov[g4] = *(const f32x4*)(cumb + t * CUS + vg * 16 + 4 * g4); ss += ov[g4][0] * ov[g4][0] + ov[g4][1] * ov[g4][1] + ov[g4][2] * ov[g4][2] + ov[g4][3] * ov[g4][3]; }
        ss += __shfl_xor(ss, 1); ss += __shfl_xor(ss, 2); ss += __shfl_xor(ss, 4);
        const float rstd = rsqrtf(ss * (1.f / 128.f) + EPS);
        unsigned w[8];
#pragma unroll
        for (int g4 = 0; g4 < 4; ++g4) { const f32x4 gn = *(const f32x4*)(p->hg_gn_g + l * 128 + vg * 16 + 4 * g4);
#pragma unroll
          for (int e2 = 0; e2 < 2; ++e2) { const int wi = g4 * 2 + e2; const unsigned gw = (wi < 4) ? g0[wi & 3] : g1[wi & 3];
            w[wi] = pk2(ov[g4][2 * e2] * rstd * gn[2 * e2] * bf2f(gw & 0xffffu), ov[g4][2 * e2 + 1] * rstd * gn[2 * e2 + 1] * bf2f(gw >> 16)); } }
        *(u32x4*)(B.on + o) = (u32x4){w[0], w[1], w[2], w[3]}; *(u32x4*)(B.on + o + 8) = (u32x4){w[4], w[5], w[6], w[7]};
      } else {
        LBAR();
      }
    }
    if (MODE == 0) {
      float* dSo = dS + (size_t)item * 16384 + vb * 32 + l31;
#pragma unroll
      for (int db = 0; db < 4; ++db)
#pragma unroll
        for (int r = 0; r < 16; ++r) dSo[(size_t)(32 * db + crow(r, h5)) * 128] = S[db][r];
      if (th < 128) Lsum[(size_t)item * 128 + th] = Ltot;
    } else if (span == NSPAN - 1) {
      float* so = p->out + O_HGP + ((size_t)((l * 4 + b) * 8 + h)) * 16384 + vb * 32 + l31;
#pragma unroll
      for (int db = 0; db < 4; ++db)
#pragma unroll
        for (int r = 0; r < 16; ++r) so[(size_t)(32 * db + crow(r, h5)) * 128] = S[db][r];
    }
    __syncthreads();
  }
}

DI void scan_passB(const HgBufs& B) {
  const int tid = tid_get();
  float* dS = B.o32; const float* Lsum = B.o32 + (size_t)512 * 16384;
  const int gt = blockIdx.x * NTHREADS + tid, NGT = gridDim.x * NTHREADS;
#pragma unroll 1
  for (int e = gt; e < 32 * 4096; e += NGT) { const int bh = e >> 12, q4 = e & 4095, d = q4 >> 5;
    float* base = dS + (size_t)bh * NSPAN * 16384 + (size_t)q4 * 4; const float* Lb = Lsum + (size_t)bh * NSPAN * 128 + d;
    f32x4 v[NSPAN]; float lv[NSPAN];
#pragma unroll
    for (int sp = 0; sp < NSPAN; ++sp) { v[sp] = *(const f32x4*)(base + (size_t)sp * 16384); lv[sp] = Lb[sp * 128]; }
    f32x4 run = (f32x4){0.f, 0.f, 0.f, 0.f};
#pragma unroll
    for (int sp = 0; sp < NSPAN; ++sp) { *(f32x4*)(base + (size_t)sp * 16384) = run; run = run * __expf(lv[sp]) + v[sp]; }
  }
}

DI void scan_phase(KP p, const int l, const HgBufs& B, unsigned char* shm) {
  const bool sample_first = (blockIdx.x & 1) != 0;
  if (!sample_first) scan_prompt<0>(p, l, B, shm);
  const int tid = tid_get(), lane = tid & 63, wave = tid >> 6;
  {
    float* ps = (float*)shm;
    const int v4 = (tid & 31) * 4, dq = tid >> 5;
    f32x4 sv[8], svn[8]; float lfv[8], lfn[8]; unsigned kq[8], kqn[8]; u32x2 vw, vwn;
#define SMP_LOAD(IT, SV, LF, KQ, VW) do { const int bs_ = (IT) >> 3, h_ = (IT) & 7; const size_t r_ = TP + bs_; \
      const float* s0_ = p->state_hgrn + ((size_t)((l * 128 + bs_) * 8 + h_)) * 16384; \
      VW = *(const u32x2*)(B.v + r_ * D + h_ * 128 + v4); \
      _Pragma("unroll") for (int i = 0; i < 8; ++i) { const int d_ = dq * 8 + i; const size_t o_ = r_ * D + h_ * 128 + d_; \
        LF[i] = B.lf[o_]; KQ[i] = (unsigned)B.q[o_]; SV[i] = __builtin_nontemporal_load((const f32x4*)(s0_ + d_ * 128 + v4)); } } while (0)
    int item = blockIdx.x, par = 0;
    if (item < 1024) SMP_LOAD(item, sv, lfv, kq, vw);
#pragma unroll 1
    for (; item < 1024; item += gridDim.x, par ^= 1) {
      const int bs = item >> 3, h = item & 7; const size_t r = TP + bs;
      const int nitem = item + gridDim.x;
      if (nitem < 1024) SMP_LOAD(nitem, svn, lfn, kqn, vwn);
      float* s1 = p->out + O_HGS + ((size_t)((l * 128 + bs) * 8 + h)) * 16384;
      const f32x4 vv = (f32x4){bf2f(vw[0] & 0xffffu), bf2f(vw[0] >> 16), bf2f(vw[1] & 0xffffu), bf2f(vw[1] >> 16)};
      f32x4 op = (f32x4){0.f, 0.f, 0.f, 0.f};
#pragma unroll
      for (int i = 0; i < 8; ++i) { const int d = dq * 8 + i;
        const float f = __expf(lfv[i]), kk = 1.f - f, qq = bf2f(kq[i]);
        const f32x4 sn = sv[i] * f + vv * kk;
        __builtin_nontemporal_store(sn, (f32x4*)(s1 + d * 128 + v4)); op += sn * qq; }
#pragma unroll
      for (int jx = 0; jx < 4; ++jx) op[jx] += __shfl_xor(op[jx], 32);
      float* psb = ps + par * 1024;
      if (lane < 32) *(f32x4*)(psb + wave * 128 + v4) = op;
      __syncthreads();
      if (tid < 64) { float o0 = 0.f, o1 = 0.f;
#pragma unroll
        for (int w = 0; w < 8; ++w) { const f32x2 x = *(const f32x2*)(psb + w * 128 + tid * 2); o0 += x[0]; o1 += x[1]; }
        float ss = o0 * o0 + o1 * o1;
#pragma unroll
        for (int o = 1; o < 64; o <<= 1) ss += __shfl_xor(ss, o);
        const float rstd = rsqrtf(ss * (1.f / 128.f) + EPS);
        const int vv2 = tid * 2; const size_t o = r * D + h * 128 + vv2;
        const float g0 = p->hg_gn_g[l * 128 + vv2], g1 = p->hg_gn_g[l * 128 + vv2 + 1];
        *(unsigned*)(B.on + o) = pk2(o0 * rstd * g0 * bf2f(B.g[o]), o1 * rstd * g1 * bf2f(B.g[o + 1])); }
#pragma unroll
      for (int i = 0; i < 8; ++i) { sv[i] = svn[i]; lfv[i] = lfn[i]; kq[i] = kqn[i]; }
      vw = vwn;
    }
    __syncthreads();
  }
  if (sample_first) scan_prompt<0>(p, l, B, shm);
}

constexpr int KN_STRIDE = 72, VT_STRIDE = 260;
constexpr int KN_BYTES = 256 * KN_STRIDE * 2;
struct AtBufs { const bf16_t* qraw; const float* kvraw; bf16_t* on; const float* tab; };

DI void attn_phase(KP p, const int l, const AtBufs& B, unsigned char* shm) {
  const int tid = tid_get(), lane = tid & 63, wave = tid >> 6;
  const int j = l - 2;
  const float* qg = p->q_norm_g + j * 64; const float* sinkp = p->sinks + j * 16;
  const bool write_cache = (l == 2);
  const int nitems = 512 + 512;
#pragma unroll 1
  for (int item = blockIdx.x; item < 512; item += gridDim.x) {
    {
      const int b = item >> 7, qb = (item >> 2) & 31, kvh = item & 3;
      bf16_t* Kn = (bf16_t*)shm; bf16_t* Vt = (bf16_t*)(shm + KN_BYTES);
      const int band0 = (qb - 1) * 128;
      {
        const int key = tid >> 1, part = tid & 1; const int pos = band0 + key; const bool valid = pos >= 0;
        float x1[16], x2[16];
        if (valid) { const float* kp = B.kvraw + ((size_t)b * SEQ + pos) * 512 + kvh * 64 + part * 16;
#pragma unroll
          for (int i = 0; i < 4; ++i) { const f32x4 a = *(const f32x4*)(kp + 4 * i), c = *(const f32x4*)(kp + 32 + 4 * i);
#pragma unroll
            for (int e = 0; e < 4; ++e) { x1[4 * i + e] = a[e]; x2[4 * i + e] = c[e]; } }
        } else {
#pragma unroll
          for (int i = 0; i < 16; ++i) { x1[i] = 0.f; x2[i] = 0.f; } }
        float ss = 0.f;
#pragma unroll
        for (int i = 0; i < 16; ++i) ss += x1[i] * x1[i] + x2[i] * x2[i];
        ss += __shfl_xor(ss, 1);
        const float rstd = rsqrtf(ss * (1.f / 64.f) + EPS);
        const float* tb = B.tab + (size_t)(valid ? pos : 0) * 64 + part * 16;
        float o1[16], o2[16];
#pragma unroll
        for (int i = 0; i < 16; ++i) { const float a = x1[i] * rstd * p->k_norm_g[part * 16 + i], c = x2[i] * rstd * p->k_norm_g[32 + part * 16 + i];
          const float cs = tb[i], sn = tb[32 + i]; o1[i] = a * cs - c * sn; o2[i] = c * cs + a * sn; }
        u32x4 w;
        w = (u32x4){pk2(o1[0], o1[1]), pk2(o1[2], o1[3]), pk2(o1[4], o1[5]), pk2(o1[6], o1[7])}; *(u32x4*)(Kn + key * KN_STRIDE + part * 16) = w;
        w = (u32x4){pk2(o1[8], o1[9]), pk2(o1[10], o1[11]), pk2(o1[12], o1[13]), pk2(o1[14], o1[15])}; *(u32x4*)(Kn + key * KN_STRIDE + part * 16 + 8) = w;
        w = (u32x4){pk2(o2[0], o2[1]), pk2(o2[2], o2[3]), pk2(o2[4], o2[5]), pk2(o2[6], o2[7])}; *(u32x4*)(Kn + key * KN_STRIDE + 32 + part * 16) = w;
        w = (u32x4){pk2(o2[8], o2[9]), pk2(o2[10], o2[11]), pk2(o2[12], o2[13]), pk2(o2[14], o2[15])}; *(u32x4*)(Kn + key * KN_STRIDE + 32 + part * 16 + 8) = w;
        if (write_cache && qb == 31 && key >= 128) { float* ko = p->out + O_KP + ((size_t)(b * 128 + key - 128) * 4 + kvh) * 64 + part * 16;
#pragma unroll
          for (int i = 0; i < 4; ++i) { *(f32x4*)(ko + 4 * i) = (f32x4){o1[4 * i], o1[4 * i + 1], o1[4 * i + 2], o1[4 * i + 3]};
            *(f32x4*)(ko + 32 + 4 * i) = (f32x4){o2[4 * i], o2[4 * i + 1], o2[4 * i + 2], o2[4 * i + 3]}; } }
      }
      {
        const int key = tid & 255, dh = tid >> 8; const int pos = band0 + key; const bool valid = pos >= 0;
        const float* vp = B.kvraw + ((size_t)b * SEQ + (valid ? pos : 0)) * 512 + 256 + kvh * 64 + dh * 32;
#pragma unroll
        for (int i = 0; i < 8; ++i) { f32x4 a = *(const f32x4*)(vp + 4 * i); if (!valid) a = (f32x4){0.f, 0.f, 0.f, 0.f};
#pragma unroll
          for (int e = 0; e < 4; ++e) Vt[(dh * 32 + 4 * i + e) * VT_STRIDE + key] = (bf16_t)f2bf(a[e]);
          if (write_cache && qb == 31 && key >= 128) *(f32x4*)(p->out + O_VP + ((size_t)(b * 128 + key - 128) * 4 + kvh) * 64 + dh * 32 + 4 * i) = a; }
      }
      __syncthreads();
      const int g = wave & 3, qhalf = wave >> 2, hq = kvh * 4 + g, h = lane >> 5, l31 = lane & 31;
      const float sink = sinkp[hq] * 1.4426950408889634f;
#pragma unroll 1
      for (int sub = 0; sub < 2; ++sub) {
        const int Q0 = 128 + qhalf * 64 + sub * 32, qi = Q0 + l31, pos = band0 + qi;
        const size_t tok = (size_t)b * SEQ + pos;
        float x[4][8];
        { const bf16_t* qp = B.qraw + tok * D + hq * 64 + 8 * h;
#pragma unroll
          for (int s = 0; s < 4; ++s) { const u32x4 w = *(const u32x4*)(qp + 16 * s);
#pragma unroll
            for (int e = 0; e < 4; ++e) { x[s][2 * e] = bf2f(w[e] & 0xffffu); x[s][2 * e + 1] = bf2f(w[e] >> 16); } } }
        float ss = 0.f;
#pragma unroll
        for (int s = 0; s < 4; ++s)
#pragma unroll
          for (int e = 0; e < 8; ++e) ss += x[s][e] * x[s][e];
        ss += __shfl_xor(ss, 32);
        const float rstd = rsqrtf(ss * (1.f / 64.f) + EPS) ;
#pragma unroll
        for (int s = 0; s < 4; ++s)
#pragma unroll
          for (int e = 0; e < 8; ++e) x[s][e] *= rstd * qg[16 * s + 8 * h + e];
        const float* tb = B.tab + (size_t)pos * 64;
        bf16x8 qf[4];
#pragma unroll
        for (int s = 0; s < 2; ++s) { unsigned lo[4], hi[4]; float r1[8], r2[8];
#pragma unroll
          for (int e = 0; e < 8; ++e) { const int i = 16 * s + 8 * h + e; const float cs = tb[i], sn = tb[32 + i]; const float a = x[s][e], c = x[s + 2][e];
            r1[e] = (a * cs - c * sn) * (0.125f * 1.4426950408889634f); r2[e] = (c * cs + a * sn) * (0.125f * 1.4426950408889634f); }
#pragma unroll
          for (int e = 0; e < 4; ++e) { lo[e] = pk2(r1[2 * e], r1[2 * e + 1]); hi[e] = pk2(r2[2 * e], r2[2 * e + 1]); }
          qf[s] = __builtin_bit_cast(bf16x8, (u32x4){lo[0], lo[1], lo[2], lo[3]}); qf[s + 2] = __builtin_bit_cast(bf16x8, (u32x4){hi[0], hi[1], hi[2], hi[3]}); }
        const int kb0 = (Q0 - 128) >> 5;
        f32x16 sacc[5]; float mx = sink;
#pragma unroll
        for (int i = 0; i < 5; ++i) { const int kb = kb0 + i; f32x16 a16;
#pragma unroll
          for (int r = 0; r < 16; ++r) a16[r] = 0.f;
          bf16x8 ka[4];
#pragma unroll
          for (int s = 0; s < 4; ++s) ka[s] = *(const bf16x8*)(Kn + (kb * 32 + l31) * KN_STRIDE + 16 * s + 8 * h);
#pragma unroll
          for (int s = 0; s < 4; ++s) a16 = __builtin_amdgcn_mfma_f32_32x32x16_bf16(ka[s], qf[s], a16, 0, 0, 0);
#pragma unroll
          for (int r = 0; r < 16; ++r) { const int key = kb * 32 + crow(r, h); const int rel = qi - key; const bool ok = (rel >= 0) && (rel < 128) && (qb > 0 || key >= 128);
            const float sv = ok ? a16[r] : -1e30f; a16[r] = sv; mx = fmaxf(mx, sv); }
          sacc[i] = a16; }
        mx = fmaxf(mx, __shfl_xor(mx, 32));
        float sum = 0.f; bf16x8 pf[5][2];
#pragma unroll
        for (int i = 0; i < 5; ++i) { float e[16];
#pragma unroll
          for (int r = 0; r < 16; ++r) { e[r] = __builtin_amdgcn_exp2f(sacc[i][r] - mx); sum += e[r]; }
#pragma unroll
          for (int st = 0; st < 2; ++st) pf[i][st] = __builtin_bit_cast(bf16x8, (u32x4){pk2(e[8 * st], e[8 * st + 1]), pk2(e[8 * st + 2], e[8 * st + 3]), pk2(e[8 * st + 4], e[8 * st + 5]), pk2(e[8 * st + 6], e[8 * st + 7])}); }
        sum += __shfl_xor(sum, 32);
        const float inv = 1.f / (sum + __builtin_amdgcn_exp2f(sink - mx));
#pragma unroll
        for (int db = 0; db < 2; ++db) { f32x16 o16;
#pragma unroll
          for (int r = 0; r < 16; ++r) o16[r] = 0.f;
          bf16x8 va[10];
#pragma unroll
          for (int i = 0; i < 5; ++i)
#pragma unroll
            for (int st = 0; st < 2; ++st) { const bf16_t* vp = Vt + (db * 32 + l31) * VT_STRIDE + (kb0 + i) * 32 + 16 * st + 4 * h;
              const u32x2 lo = *(const u32x2*)vp, hi = *(const u32x2*)(vp + 8);
              va[i * 2 + st] = __builtin_bit_cast(bf16x8, (u32x4){lo[0], lo[1], hi[0], hi[1]}); }
          f32x16 o16b;
#pragma unroll
          for (int r = 0; r < 16; ++r) o16b[r] = 0.f;
#pragma unroll
          for (int i = 0; i < 5; ++i) { o16 = __builtin_amdgcn_mfma_f32_32x32x16_bf16(va[i * 2], pf[i][0], o16, 0, 0, 0); o16b = __builtin_amdgcn_mfma_f32_32x32x16_bf16(va[i * 2 + 1], pf[i][1], o16b, 0, 0, 0); }
#pragma unroll
          for (int r = 0; r < 16; ++r) o16[r] += o16b[r];
          bf16_t* op = B.on + tok * D + hq * 64 + db * 32 + 4 * h;
#pragma unroll
          for (int r4 = 0; r4 < 4; ++r4) *(u32x2*)(op + 8 * r4) = (u32x2){pk2(o16[4 * r4] * inv, o16[4 * r4 + 1] * inv), pk2(o16[4 * r4 + 2] * inv, o16[4 * r4 + 3] * inv)}; }
      }
      __syncthreads();
    }
  }
  {
    const int tid = tid_get(), lane = tid & 63, wave = tid >> 6;
#pragma unroll 1
    for (int item = 512 + blockIdx.x; item < nitems; item += gridDim.x) {
      const int sidx = item - 512, bs = sidx >> 2, kvh = sidx & 3; const size_t r = TP + bs;
      float* Ks = (float*)shm; float* Vs = Ks + 128 * 68; float* q_s = Vs + 128 * 64; float* p_s = q_s + 256; float* redm = p_s + 512; float* reds = redm + 8; float* po = reds + 8;
      const float* tb = B.tab + (size_t)4096 * 64;
      f32x4 kreg[4], vreg[4];
#pragma unroll
      for (int i = 0; i < 4; ++i) { const int e = tid + 512 * i, jr = e >> 4, c4 = (e & 15) * 4;
        if (jr < 127) { const size_t o = (((size_t)bs * 128 + jr + 1) * 4 + kvh) * 64 + c4; kreg[i] = __builtin_nontemporal_load((const f32x4*)(p->cache_k + o)); vreg[i] = __builtin_nontemporal_load((const f32x4*)(p->cache_v + o)); } }
      if (tid < 128) { const int g = tid >> 5, i = tid & 31, hq = kvh * 4 + g;
        float a = bf2f(B.qraw[r * D + hq * 64 + i]), c = bf2f(B.qraw[r * D + hq * 64 + 32 + i]);
        float ss = a * a + c * c;
#pragma unroll
        for (int o = 1; o < 32; o <<= 1) ss += __shfl_xor(ss, o);
        const float rstd = rsqrtf(ss * (1.f / 64.f) + EPS); a *= rstd * qg[i]; c *= rstd * qg[32 + i];
        const float cs = tb[i], sn = tb[32 + i];
        q_s[g * 64 + i] = (a * cs - c * sn) * 0.125f; q_s[g * 64 + 32 + i] = (c * cs + a * sn) * 0.125f;
      } else if (tid < 160) { const int i = tid & 31;
        float a = B.kvraw[r * 512 + kvh * 64 + i], c = B.kvraw[r * 512 + kvh * 64 + 32 + i];
        float ss = a * a + c * c;
#pragma unroll
        for (int o = 1; o < 32; o <<= 1) ss += __shfl_xor(ss, o);
        const float rstd = rsqrtf(ss * (1.f / 64.f) + EPS); a *= rstd * p->k_norm_g[i]; c *= rstd * p->k_norm_g[32 + i];
        const float cs = tb[i], sn = tb[32 + i];
        const float k1 = a * cs - c * sn, k2 = c * cs + a * sn, v1 = B.kvraw[r * 512 + 256 + kvh * 64 + i], v2 = B.kvraw[r * 512 + 256 + kvh * 64 + 32 + i];
        Ks[127 * 68 + i] = k1; Ks[127 * 68 + 32 + i] = k2; Vs[127 * 64 + i] = v1; Vs[127 * 64 + 32 + i] = v2;
        if (write_cache) { float* ok = p->out + O_KS + (((size_t)bs * 128 + 127) * 4 + kvh) * 64; float* ov = p->out + O_VS + (((size_t)bs * 128 + 127) * 4 + kvh) * 64;
          ok[i] = k1; ok[32 + i] = k2; ov[i] = v1; ov[32 + i] = v2; } }
#pragma unroll
      for (int i = 0; i < 4; ++i) { const int e = tid + 512 * i, jr = e >> 4, c4 = (e & 15) * 4;
        if (jr < 127) { *(f32x4*)(Ks + jr * 68 + c4) = kreg[i]; *(f32x4*)(Vs + jr * 64 + c4) = vreg[i];
          if (write_cache) { const size_t o = (((size_t)bs * 128 + jr) * 4 + kvh) * 64 + c4; __builtin_nontemporal_store(kreg[i], (f32x4*)(p->out + O_KS + o)); __builtin_nontemporal_store(vreg[i], (f32x4*)(p->out + O_VS + o)); } } }
      __syncthreads();
      const int g = tid >> 7, jk = tid & 127, hq = kvh * 4 + g; const float sink = sinkp[hq];
      float sc = 0.f;
#pragma unroll
      for (int d4 = 0; d4 < 16; ++d4) { const f32x4 kv = *(const f32x4*)(Ks + jk * 68 + 4 * d4), qv = *(const f32x4*)(q_s + g * 64 + 4 * d4); sc += kv[0] * qv[0] + kv[1] * qv[1] + kv[2] * qv[2] + kv[3] * qv[3]; }
      float mx = sc;
#pragma unroll
      for (int o = 1; o < 64; o <<= 1) mx = fmaxf(mx, __shfl_xor(mx, o));
      if (lane == 0) redm[wave] = mx;
      __syncthreads();
      mx = fmaxf(fmaxf(redm[2 * g], redm[2 * g + 1]), sink);
      const float ev = __expf(sc - mx); float sum = ev;
#pragma unroll
      for (int o = 1; o < 64; o <<= 1) sum += __shfl_xor(sum, o);
      if (lane == 0) reds[wave] = sum;
      p_s[g * 128 + jk] = ev;
      __syncthreads();
      const float inv = 1.f / (reds[2 * g] + reds[2 * g + 1] + __expf(sink - mx));
      { const int d = jk & 63, jh = jk >> 6; float o = 0.f;
#pragma unroll 8
        for (int jx = 0; jx < 64; ++jx) o += p_s[g * 128 + jh * 64 + jx] * Vs[(jh * 64 + jx) * 64 + d];
        po[tid] = o;
        __syncthreads();
        if (jh == 0) { const float tot = (o + po[tid + 64]) * inv; B.on[r * D + hq * 64 + d] = (bf16_t)f2bf(tot); } }
      __syncthreads();
    }
  }
}

#define XB_TMO      128
#define XB_XCNT(j)  (256  + 64 * (j))
#define XB_XSUB(j)  (1280 + 64 * (j))
#define XB_XGEN(j)  (2304 + 64 * (j))
#define XB_TOP      3328
#define XB_TOPGEN   3392
#define XCD_BAR_WORDS 3456
#define XB_SPIN_CAP (1u << 18)

__device__ __forceinline__ unsigned xb_ld(unsigned* p)              { return __hip_atomic_load(p, __ATOMIC_RELAXED, __HIP_MEMORY_SCOPE_AGENT); }
__device__ __forceinline__ unsigned xb_add(unsigned* p, unsigned v) { return __hip_atomic_fetch_add(p, v, __ATOMIC_RELAXED, __HIP_MEMORY_SCOPE_AGENT); }
__device__ __forceinline__ unsigned xb_xcc_id() { return (unsigned)__builtin_amdgcn_s_getreg((3 << 11) | 20) & 0xFu; }
#define XB_SPIN(cond, bar) do { unsigned _sp = 0; while (cond) { __builtin_amdgcn_s_sleep(1); \
    if ((++_sp & 255u) == 0u) { if (xb_ld(&(bar)[XB_TMO])) break; if (_sp > XB_SPIN_CAP) { atomicAdd(&(bar)[XB_TMO], 1u); break; } } } } while (0)

struct XcdBarrier {
    unsigned* bar; unsigned x;
    volatile LAS unsigned* st;
};

__device__ __forceinline__ XcdBarrier xcd_barrier_post(unsigned* bar, volatile LAS unsigned* st) {
    XcdBarrier b; b.bar = bar; b.x = xb_xcc_id(); b.st = st;
    if (threadIdx.x == 0) (void)xb_add(&bar[XB_XCNT(b.x)], 1u);
    return b;
}
__device__ __forceinline__ void xcd_barrier_complete(unsigned* bar, unsigned x, unsigned& nloc, unsigned& nx) {
    const unsigned G = gridDim.x * gridDim.y * gridDim.z;
    unsigned sum, cnt, mine, sp = 0u;
    for (;;) {
        sum = 0u; cnt = 0u; mine = 0u;
#pragma unroll
        for (unsigned j = 0; j < 16; ++j) { const unsigned c = xb_ld(&bar[XB_XCNT(j)]); sum += c; cnt += (c > 0u) ? 1u : 0u; mine = (j == x) ? c : mine; }
        if (sum == G) break;
        __builtin_amdgcn_s_sleep(1);
        if ((++sp & 255u) == 0u) { if (xb_ld(&bar[XB_TMO])) break; if (sp > XB_SPIN_CAP) { atomicAdd(&bar[XB_TMO], 1u); break; } }
    }
    nloc = mine > 0u ? mine : 1u; nx = cnt > 0u ? cnt : 1u;
}

__device__ __forceinline__ void xcd_barrier(const XcdBarrier& b) {
    asm volatile("s_waitcnt vmcnt(0)" ::: "memory");
    __syncthreads();
    if (threadIdx.x == 0) {
        unsigned* bar = b.bar;
        __builtin_amdgcn_s_waitcnt(0);
        unsigned nloc = b.st[0], nx = b.st[1];
        if (nloc == 0u) { xcd_barrier_complete(bar, b.x, nloc, nx); b.st[0] = nloc; b.st[1] = nx; }
        const unsigned old = xb_add(&bar[XB_XSUB(b.x)], 1u);
        const unsigned gen = old / nloc;
        if (old + 1u == (gen + 1u) * nloc) {
            __builtin_amdgcn_fence(__ATOMIC_RELEASE, "agent");
            asm volatile("s_waitcnt vmcnt(0)" ::: "memory");
            const unsigned og = xb_add(&bar[XB_TOP], 1u);
            const unsigned tg = og / nx;
            if (og + 1u == (tg + 1u) * nx) xb_add(&bar[XB_TOPGEN], 1u);
            else XB_SPIN(xb_ld(&bar[XB_TOPGEN]) == tg, bar);
            __builtin_amdgcn_fence(__ATOMIC_ACQUIRE, "agent");
            xb_add(&bar[XB_XGEN(b.x)], 1u);
            asm volatile("s_waitcnt vmcnt(0)" ::: "memory");
        } else {
            XB_SPIN(xb_ld(&bar[XB_XGEN(b.x)]) == gen, bar);
            __builtin_amdgcn_fence(__ATOMIC_ACQUIRE, "agent");
            asm volatile("s_waitcnt vmcnt(0)" ::: "memory");
        }
    }
    __syncthreads();
}


__global__ void __launch_bounds__(NTHREADS, 2) yoco_fwd(P parg) {
  extern __shared__ __attribute__((aligned(16))) unsigned char shm[];
  cg::grid_group grid = cg::this_grid();
  volatile LAS unsigned* xst = (volatile LAS unsigned*)((LAS unsigned char*)shm + 131072);
  if (threadIdx.x < 4) xst[threadIdx.x] = 0u;
  __syncthreads();
  const int nMt = TP / BM;
#pragma unroll 1
  for (int step = -2; step < 32; ++step) {
    const int l = (step < 0) ? 0 : (step >> 3), sub = (step < 0) ? (8 + step + 2) : (step & 7); const bool hg = (l < 2);
    if (sub == 3 && !hg) continue;
    if (sub == 5 || (sub == 0 && l > 0)) continue;
    KP p = kp_get(); unsigned char* ws = p->ws;
#ifndef PROBE_REPS
#define PROBE_REPS 1
#endif
#ifndef PROBE_GREPS
#define PROBE_GREPS 1
#endif
    const bool is_gemm = (sub == 0 || sub == 1 || sub == 4 || sub == 6 || sub == 7 || sub == 9);
#ifndef PROBE_MASK
#define PROBE_MASK 0
#endif
    const int pcode = (sub == 2 && !hg) ? 10 : sub;
    const int reps = (((PROBE_MASK >> pcode) & 1) && !(sub == 4 || sub == 7)) ? 2 : 1;
#pragma unroll 1
    for (int rep = 0; rep < reps; ++rep) {
    if (sub == 8) {
      prep_phase(p, shm);
    } else if (sub == 0 || sub == 1 || sub == 4 || sub == 6 || sub == 7 || sub == 9) {
      float* mods = (float*)(ws + OFF_MODS);
      bf16_t* hbuf = (bf16_t*)(ws + OFF_H); bf16_t* onbuf = (bf16_t*)(ws + OFF_ON); bf16_t* ubuf = (bf16_t*)(ws + OFF_U);
      GemmJob j0, j1; EpiArgs E{}; int nj = 1; E.layer = l; E.first = 0;
      float* rssb = (float*)(ws + OFF_RSS); const float* biasb = (const float*)(ws + OFF_BIAS);
      j1.A = (const bf16_t*)(ws + OFF_X); j1.Bt = (const bf16_t*)(ws + OFF_WKV); j1.nM = nMt; j1.nN = 2; j1.K = D; j1.epi = EPI_KVRAW;
      j0.nM = nMt; j0.K = D;
      if (sub == 0) { j0.A = (const bf16_t*)(ws + OFF_ASH); j0.Bt = (const bf16_t*)ws; j0.nM = 1; j0.nN = 106; j0.epi = EPI_BIAS; j1.A = (const bf16_t*)(ws + OFF_BIAS); }
      else if (sub == 9) { j0.A = (const bf16_t*)(ws + OFF_X + (size_t)MODW * D * 2); j0.Bt = (const bf16_t*)(ws + OFF_X); j0.nM = 1; j0.nN = MODW / BM; j0.epi = EPI_ADA; E.f0 = mods; E.ash = (bf16_t*)(ws + OFF_ASH); }
      else if (sub == 1 && hg) { E.rss = rssb + (size_t)(2 * l) * T; E.bias = biasb + (size_t)132 * site_prefN(l); E.bN = 4096; j0.A = hbuf; j0.Bt = (const bf16_t*)(ws + OFF_WIN) + (size_t)l * 4096 * D; j0.nN = 16; j0.epi = EPI_HGIN;
        E.f0 = (float*)(ws + OFF_X); E.b0 = (bf16_t*)(ws + OFF_U); E.b1 = (bf16_t*)(ws + OFF_U + SZ_ACT); E.b2 = (bf16_t*)(ws + OFF_U + 2 * SZ_ACT); E.b3 = (bf16_t*)(ws + OFF_U + 3 * SZ_ACT); }
      else if (sub == 1) { E.rss = rssb + (size_t)(2 * l) * T; E.bias = biasb + (size_t)132 * site_prefN(l); E.bN = 1024; E.bias1 = biasb + (size_t)132 * site_prefN(4); E.bN1 = 512; j0.A = hbuf; j0.Bt = (const bf16_t*)(ws + OFF_WQ) + (size_t)(l - 2) * D * D; j0.nN = 4; j0.epi = EPI_QRAW;
        E.b1 = (bf16_t*)(ws + OFF_X + SZ_ACT); E.f2 = (float*)(ws + OFF_X + 2 * SZ_ACT); nj = (l == 2) ? 2 : 1; }
      else if (sub == 4) { E.rss_out = rssb + (size_t)(1 + 2 * l) * T; E.ng = p->norm2_g + l * D; E.nsc = mods + l * 6144 + 4096; E.yout = hbuf; j0.A = onbuf; j0.Bt = hg ? (const bf16_t*)(ws + OFF_WOUT) + (size_t)l * D * D : (const bf16_t*)(ws + OFF_WO) + (size_t)(l - 2) * D * D; j0.nN = 4; j0.epi = EPI_RESID;
        E.f0 = p->out + O_Y; E.f1 = mods + l * 6144 + 2048; E.first = (l == 0); }
      else if (sub == 6) { E.rss = rssb + (size_t)(1 + 2 * l) * T; E.bias = biasb + (size_t)132 * site_prefN(5 + l); E.bN = 4096; j0.A = hbuf; j0.Bt = (const bf16_t*)(ws + OFF_WUP) + (size_t)l * D * FF; j0.nN = 16; j0.epi = EPI_UP; E.b0 = ubuf; }
      else { if (l < 3) { E.rss_out = rssb + (size_t)(2 * (l + 1)) * T; E.ng = p->norm1_g + (l + 1) * D; E.nsc = mods + (l + 1) * 6144 + 1024; E.yout = hbuf;
          if (l == 1) { E.ngkv = p->kv_norm_g; E.nsckv = mods + 24576 + 1024; E.ykv = (bf16_t*)(ws + OFF_X); } }
        j0.A = ubuf; j0.Bt = (const bf16_t*)(ws + OFF_WDN) + (size_t)l * D * FF; j0.nN = 4; j0.K = FF; j0.epi = EPI_RESID; E.f0 = p->out + O_Y; E.f1 = mods + l * 6144 + 5120; }
      gemm_phase(p, (LAS unsigned char*)shm, shm, j0, j1, nj, E, sub != 9 && sub != 0);
      if (sub == 0) init_rows(p, (unsigned*)(ws + OFF_BAR) + XCD_BAR_WORDS + 100);
    } else if (sub == 2 && hg) {
      HgBufs HB; HB.q = (bf16_t*)(ws + OFF_U); HB.k = (bf16_t*)(ws + OFF_U + SZ_ACT); HB.v = (bf16_t*)(ws + OFF_U + 2 * SZ_ACT); HB.g = (bf16_t*)(ws + OFF_U + 3 * SZ_ACT);
      HB.lf = (float*)(ws + OFF_X); HB.o32 = (float*)(ws + OFF_X + 2 * SZ_ACT); HB.on = (bf16_t*)(ws + OFF_ON);
      scan_phase(p, l, HB, shm);
    } else if (sub == 2) {
      AtBufs AB; AB.qraw = (bf16_t*)(ws + OFF_X + SZ_ACT); AB.kvraw = (float*)(ws + OFF_X + 2 * SZ_ACT); AB.on = (bf16_t*)(ws + OFF_ON); AB.tab = (const float*)(ws + OFF_TAB);
      attn_phase(p, l, AB, shm);
    } else {
      HgBufs HB; HB.q = (bf16_t*)(ws + OFF_U); HB.k = (bf16_t*)(ws + OFF_U + SZ_ACT); HB.v = (bf16_t*)(ws + OFF_U + 2 * SZ_ACT); HB.g = (bf16_t*)(ws + OFF_U + 3 * SZ_ACT);
      HB.lf = (float*)(ws + OFF_X); HB.o32 = (float*)(ws + OFF_X + 2 * SZ_ACT); HB.on = (bf16_t*)(ws + OFF_ON);
      scan_passB(HB);
      { KP pb = kp_get(); XcdBarrier xb; xb.bar = (unsigned*)(pb->ws + OFF_BAR); xb.x = xb_xcc_id(); xb.st = xst; xcd_barrier(xb); }
      scan_prompt<1>(p, l, HB, shm);
    }
    }
    if (step == 31) break;
    if (step == -2) { grid.sync(); KP p0 = kp_get(); if (tid_get() == 0) (void)xb_add((unsigned*)(p0->ws + OFF_BAR) + XB_XCNT(xb_xcc_id()), 1u); }
    else { KP pb = kp_get(); XcdBarrier xb; xb.bar = (unsigned*)(pb->ws + OFF_BAR); xb.x = xb_xcc_id(); xb.st = xst; xcd_barrier(xb); }
  }
}

extern "C" void kernel_launch(void* const* d_in, const int* in_sizes, int n_in, void* d_out, int out_size, void* d_ws, size_t ws_size, hipStream_t stream) {
  static int grid_blocks = 0;
  if (!grid_blocks) {
    int dev = 0, cus = 0, per_cu = 0;
    hipGetDevice(&dev);
    hipDeviceGetAttribute(&cus, hipDeviceAttributeMultiprocessorCount, dev);
    if (hipFuncSetAttribute((const void*)yoco_fwd, hipFuncAttributeMaxDynamicSharedMemorySize, LDS_BYTES) != hipSuccess) fprintf(stderr, "hipFuncSetAttribute failed\n");
    if (hipOccupancyMaxActiveBlocksPerMultiprocessor(&per_cu, (const void*)yoco_fwd, NTHREADS, LDS_BYTES) != hipSuccess || per_cu < 1) { fprintf(stderr, "occupancy query failed\n"); per_cu = 1; }
    grid_blocks = cus * per_cu;
    if (ws_size < WS_NEED) fprintf(stderr, "workspace too small: %zu < %zu\n", ws_size, (size_t)WS_NEED);
  }
  P p{};
  const float** pp = (const float**)&p;
  for (int i = 0; i < 26; ++i) pp[i] = (const float*)d_in[i];
  p.out = (float*)d_out; p.ws = (unsigned char*)d_ws;
  void* args[] = {&p};
  hipError_t e = hipLaunchCooperativeKernel((const void*)yoco_fwd, dim3(grid_blocks), dim3(NTHREADS), args, LDS_BYTES, stream);
  if (e != hipSuccess) fprintf(stderr, "cooperative launch failed: %s (grid %d)\n", hipGetErrorString(e), grid_blocks);
}
```

```cpp
#include <hip/hip_runtime.h>
#include <hip/hip_cooperative_groups.h>
#include <cstdio>
#include <cstdint>
namespace cg = cooperative_groups;

#define DI __device__ __forceinline__
typedef unsigned short bf16_t;
typedef short bf16x8 __attribute__((ext_vector_type(8)));
typedef float f32x4 __attribute__((ext_vector_type(4)));
typedef float f32x2 __attribute__((ext_vector_type(2)));
typedef float f32x16 __attribute__((ext_vector_type(16)));
typedef unsigned u32x4 __attribute__((ext_vector_type(4)));
typedef unsigned u32x2 __attribute__((ext_vector_type(2)));
#define LAS __attribute__((address_space(3)))

constexpr int D = 1024, FF = 4096, TP = 16384, TS = 128, T = TP + TS, TPAD = 16640, SEQ = 4096;
constexpr int NMOD = 132, MODW = 4 * 6144 + 2048;
constexpr float EPS = 1e-6f;
constexpr int NTHREADS = 512, NWAVES = 8;
constexpr int LDS_BYTES = 131072 + 16;

constexpr size_t O_Y = 0;
constexpr size_t O_HGP = (size_t)T * D;
constexpr size_t O_KP = O_HGP + (size_t)2 * 4 * 8 * 128 * 128;
constexpr size_t O_VP = O_KP + (size_t)4 * 128 * 4 * 64;
constexpr size_t O_HGS = O_VP + (size_t)4 * 128 * 4 * 64;
constexpr size_t O_KS = O_HGS + (size_t)2 * 128 * 8 * 128 * 128;
constexpr size_t O_VS = O_KS + (size_t)128 * 128 * 4 * 64;

constexpr size_t SZ_ACT = (size_t)TPAD * D * 2;
constexpr size_t OFF_WIN = 0;
constexpr size_t OFF_WOUT = OFF_WIN + (size_t)2 * 4096 * 1024 * 2;
constexpr size_t OFF_WKV = OFF_WOUT + (size_t)2 * 1024 * 1024 * 2;
constexpr size_t OFF_WQ = OFF_WKV + (size_t)512 * 1024 * 2;
constexpr size_t OFF_WO = OFF_WQ + (size_t)2 * 1024 * 1024 * 2;
constexpr size_t OFF_WUP = OFF_WO + (size_t)2 * 1024 * 1024 * 2;
constexpr size_t OFF_WDN = OFF_WUP + (size_t)4 * 4096 * 1024 * 2;
constexpr size_t OFF_MODS = OFF_WDN + (size_t)4 * 4096 * 1024 * 2;
constexpr size_t OFF_TAB = OFF_MODS + (((size_t)NMOD * MODW * 4 + 4095) & ~(size_t)4095);
constexpr size_t OFF_H = OFF_TAB + (((size_t)4097 * 64 * 4 + 4095) & ~(size_t)4095);
constexpr size_t OFF_ON = OFF_H + SZ_ACT;
constexpr size_t OFF_U = OFF_ON + SZ_ACT;
constexpr size_t OFF_X = OFF_U + 4 * SZ_ACT;
constexpr size_t OFF_BAR = OFF_X + 4 * SZ_ACT;
constexpr size_t BAR_BYTES = 16384;
constexpr size_t OFF_RSS = OFF_BAR + BAR_BYTES;
constexpr size_t ZERO_BYTES = BAR_BYTES + (size_t)9 * T * 4;
constexpr size_t OFF_ASH = OFF_BAR + ((ZERO_BYTES + 4095) & ~(size_t)4095);
constexpr size_t OFF_BIAS = OFF_ASH + (size_t)9 * 256 * 1024 * 2;
constexpr size_t WS_NEED = OFF_BIAS + (size_t)132 * 27136 * 4;

struct P {
  const float *x_prompt, *x_sample, *c_prompt, *c_sample, *state_hgrn, *cache_k, *cache_v;
  const float *w_ada, *b_ada, *norm1_g, *norm2_g, *hg_w_in, *hg_w_out, *hg_lbp, *hg_gn_g;
  const float *kv_w_ada, *kv_b_ada, *kv_norm_g, *w_kv, *k_norm_g, *w_q, *q_norm_g, *sinks, *w_o, *w_up, *w_down;
  float* out; unsigned char* ws;
};

typedef const P __attribute__((address_space(4)))* KP;
DI KP kp_get() { KP q = (KP)__builtin_amdgcn_kernarg_segment_ptr(); asm volatile("" : "+s"(q)); return q; }
DI int tid_get() { int t = threadIdx.x; asm volatile("" : "+v"(t)); return t; }
DI unsigned f2bf(float f) { unsigned u = __float_as_uint(f); return (u + 0x7fffu + ((u >> 16) & 1u)) >> 16; }
typedef __bf16 bf16x2_n __attribute__((ext_vector_type(2)));
DI unsigned pk2(float lo, float hi) { return __builtin_bit_cast(unsigned, __builtin_convertvector((f32x2){lo, hi}, bf16x2_n)); }
DI float bf2f(unsigned b) { return __uint_as_float(b << 16); }
DI float silu_f(float x) { return x * __builtin_amdgcn_rcpf(1.f + __expf(-x)); }
DI int modrow(int r) { return r < TP ? (r >> 12) : (4 + r - TP); }
DI int crow(int reg, int h) { return (reg & 3) + 8 * (reg >> 2) + 4 * h; }

constexpr int BM = 256, BK = 64, HALF = 128, HTB = HALF * BK * 2;
DI int lds_byte(int r, int c) { const int st = (r >> 4) * 2 + (c >> 5), rr = r & 15, cc = c & 31, ob = rr * 64 + cc * 2; return st * 1024 + (ob ^ (((ob >> 9) & 1) << 5)); }
DI void stage_rc(int b, int& R, int& C) { const int st = b / 1024, sb = b % 1024, swz = sb ^ (((sb >> 9) & 1) << 5); R = (st >> 1) * 16 + swz / 64; C = (st & 1) * 32 + (swz % 64) / 2; }

enum { EPI_ADA = 0, EPI_HGIN = 1, EPI_RESID = 2, EPI_UP = 3, EPI_QRAW = 4, EPI_KVRAW = 5, EPI_NOP = 6, EPI_BIAS = 7 };
struct GemmJob { const bf16_t* A; const bf16_t* Bt; int nM, nN, K, epi; };
struct EpiArgs {
  float* f0; const float* f1; float* f2; bf16_t* b0; bf16_t* b1; bf16_t* b2; bf16_t* b3; int layer; int first;
  const float* rss; const float* bias; const float* bias1; int bN, bN1;
  float* rss_out; const float* ng; const float* nsc; bf16_t* yout; const float* ngkv; const float* nsckv; bf16_t* ykv;
  bf16_t* ash;
};
DI int site_N(const int s) { return (s == 2 || s == 3) ? 1024 : (s == 4 ? 512 : 4096); }
DI int site_prefN(const int s) { return s == 0 ? 0 : s == 1 ? 4096 : s == 2 ? 8192 : s == 3 ? 9216 : s == 4 ? 10240 : 10752 + (s - 5) * 4096; }

DI void tile_of(int L, int nM, int nN, int& pm, int& pn) {
  const int nwg = nM * nN; int wgid = L;
  { const int q = nwg / 8, r = nwg % 8, xcd = wgid % 8, off = wgid / 8; wgid = (xcd < r ? xcd * (q + 1) : r * (q + 1) + (xcd - r) * q) + off; }
  const int nig = 8 * nN, gid = wgid / nig, fm = gid * 8, gsz = (nM - fm) < 8 ? (nM - fm) : 8;
  pm = fm + ((wgid % nig) % gsz); pn = (wgid % nig) / gsz;
}

DI void epi_frag(KP p, const int epi, const EpiArgs& E, const int r, const int c, const f32x4 vin) {
  if (epi == EPI_NOP) return;
  f32x4 v = vin;
  if (epi == EPI_HGIN || epi == EPI_UP || epi == EPI_QRAW || epi == EPI_KVRAW) {
    const float rstd = rsqrtf(E.rss[r] * (1.f / D) + EPS);
    const float* bp = ((epi == EPI_KVRAW) ? E.bias1 + (size_t)modrow(r) * E.bN1 : E.bias + (size_t)modrow(r) * E.bN) + c;
    v = v * rstd + *(const f32x4*)bp; }
  if (epi == EPI_HGIN) {
    const int sec = c >> 10, cc = c & 1023; const size_t o = (size_t)r * D + cc;
    if (sec == 1) { f32x4 lb = (f32x4){0.f, 0.f, 0.f, 0.f};
      if (E.layer == 1) { const f32x4 l0 = *(const f32x4*)(p->hg_lbp + cc), l1 = *(const f32x4*)(p->hg_lbp + D + cc);
#pragma unroll
        for (int j = 0; j < 4; ++j) lb[j] = __builtin_amdgcn_rcpf(1.f + __expf(l0[j] - l1[j])); }
      f32x4 lf;
#pragma unroll
      for (int j = 0; j < 4; ++j) { const float sg = __builtin_amdgcn_rcpf(1.f + __expf(-v[j])); const float fg = lb[j] + (1.f - lb[j]) * sg; lf[j] = __builtin_amdgcn_logf(fg);     }
      *(f32x4*)(E.f0 + o) = lf;
    } else if (sec == 2) { *(u32x2*)(E.b2 + o) = (u32x2){pk2(v[0], v[1]), pk2(v[2], v[3])};
    } else { bf16_t* dst = (sec == 0) ? E.b0 : E.b3; *(u32x2*)(dst + o) = (u32x2){pk2(silu_f(v[0]), silu_f(v[1])), pk2(silu_f(v[2]), silu_f(v[3]))}; }
  } else if (epi == EPI_RESID) {
    const float* xin = E.first ? (r < TP ? p->x_prompt + (size_t)r * D : p->x_sample + (size_t)(r - TP) * D) : (E.f0 + (size_t)r * D);
    const size_t mo = (size_t)modrow(r) * MODW;
    const f32x4 xv = *(const f32x4*)(xin + c), gv = *(const f32x4*)(E.f1 + mo + c);
    const f32x4 yn = xv + gv * v;
    *(f32x4*)(E.f0 + (size_t)r * D + c) = yn;
    if (E.yout) {
      const f32x4 g = *(const f32x4*)(E.ng + c), sc = *(const f32x4*)(E.nsc + mo + c); const f32x4 y = yn * g * (sc + 1.f);
      *(u32x2*)(E.yout + (size_t)r * D + c) = (u32x2){pk2(y[0], y[1]), pk2(y[2], y[3])};
      if (E.ykv) { const f32x4 g2 = *(const f32x4*)(E.ngkv + c), sc2 = *(const f32x4*)(E.nsckv + mo + c); const f32x4 y2 = yn * g2 * (sc2 + 1.f);
        *(u32x2*)(E.ykv + (size_t)r * D + c) = (u32x2){pk2(y2[0], y2[1]), pk2(y2[2], y2[3])}; }
      float ss = yn[0] * yn[0] + yn[1] * yn[1] + yn[2] * yn[2] + yn[3] * yn[3];
      ss += __shfl_xor(ss, 1); ss += __shfl_xor(ss, 2);
      if ((tid_get() & 3) == 0) atomicAdd(E.rss_out + r, ss); }
  } else if (epi == EPI_UP) {
    f32x4 u;
#pragma unroll
    for (int j = 0; j < 4; ++j) { const float t = fmaxf(v[j], 0.f); u[j] = t * t; }
    *(u32x2*)(E.b0 + (size_t)r * FF + c) = (u32x2){pk2(u[0], u[1]), pk2(u[2], u[3])};
  } else if (epi == EPI_QRAW) { *(u32x2*)(E.b1 + (size_t)r * D + c) = (u32x2){pk2(v[0], v[1]), pk2(v[2], v[3])};
  } else if (epi == EPI_KVRAW) { *(f32x4*)(E.f2 + (size_t)r * 512 + c) = v; }
}

DI void epi_frag8(KP p, const int epi, const EpiArgs& E, const int r, const int c, const f32x4 v0, const f32x4 v1, const f32x4 lbA = (f32x4){0.f, 0.f, 0.f, 0.f}, const f32x4 lbB = (f32x4){0.f, 0.f, 0.f, 0.f}) {
  if (epi == EPI_NOP) return;
  if (epi == EPI_ADA) { if (r < NMOD) { const float* bp = (c < 24576) ? (p->b_ada + c) : (p->kv_b_ada + (c - 24576)); float* o = E.f0 + (size_t)r * MODW + c;
      const f32x4 m0 = v0 + *(const f32x4*)bp, m1 = v1 + *(const f32x4*)(bp + 4);
      *(f32x4*)o = m0; *(f32x4*)(o + 4) = m1;
      int site = -1;
      if (c < 24576) { const int l = c / 6144, part = (c - l * 6144) >> 10; site = (part == 0) ? l : (part == 3 ? 5 + l : -1); } else if (c < 25600) site = 4;
      if (site >= 0) *(u32x4*)(E.ash + ((size_t)site * 256 + r) * 1024 + (c & 1023)) = (u32x4){pk2(m0[0], m0[1]), pk2(m0[2], m0[3]), pk2(m1[0], m1[1]), pk2(m1[2], m1[3])}; }
  } else if (epi == EPI_HGIN) {
    const int sec = c >> 10, cc = c & 1023; const size_t o = (size_t)r * D + cc;
    if (sec == 1) { float lb[8];
#pragma unroll
      for (int j = 0; j < 4; ++j) { lb[j] = lbA[j]; lb[4 + j] = lbB[j]; }
      float lf[8];
#pragma unroll
      for (int j = 0; j < 8; ++j) { const float x = (j < 4) ? v0[j & 3] : v1[j & 3]; const float sg = __builtin_amdgcn_rcpf(1.f + __expf(-x)); const float fg = lb[j] + (1.f - lb[j]) * sg;
        lf[j] = __builtin_amdgcn_logf(fg); }
      *(f32x4*)(E.f0 + o) = (f32x4){lf[0], lf[1], lf[2], lf[3]}; *(f32x4*)(E.f0 + o + 4) = (f32x4){lf[4], lf[5], lf[6], lf[7]};
    } else if (sec == 2) { *(u32x4*)(E.b2 + o) = (u32x4){pk2(v0[0], v0[1]), pk2(v0[2], v0[3]), pk2(v1[0], v1[1]), pk2(v1[2], v1[3])};
    } else { bf16_t* dst = (sec == 0) ? E.b0 : E.b3;
      *(u32x4*)(dst + o) = (u32x4){pk2(silu_f(v0[0]), silu_f(v0[1])), pk2(silu_f(v0[2]), silu_f(v0[3])), pk2(silu_f(v1[0]), silu_f(v1[1])), pk2(silu_f(v1[2]), silu_f(v1[3]))}; }
  } else if (epi == EPI_RESID) {
    const float* xin = E.first ? (r < TP ? p->x_prompt + (size_t)r * D : p->x_sample + (size_t)(r - TP) * D) : (E.f0 + (size_t)r * D);
    const size_t mo = (size_t)modrow(r) * MODW;
    const float* gm = E.f1 + mo + c; float* o = E.f0 + (size_t)r * D + c;
    const f32x4 xa = *(const f32x4*)(xin + c), xb = *(const f32x4*)(xin + c + 4), ga = *(const f32x4*)gm, gb = *(const f32x4*)(gm + 4);
    const f32x4 ya = xa + ga * v0, yb = xb + gb * v1;
    *(f32x4*)o = ya; *(f32x4*)(o + 4) = yb;
    if (E.yout) {
      const f32x4 g0 = *(const f32x4*)(E.ng + c), g1 = *(const f32x4*)(E.ng + c + 4), s0 = *(const f32x4*)(E.nsc + mo + c), s1 = *(const f32x4*)(E.nsc + mo + c + 4);
      const f32x4 y0 = ya * g0 * (s0 + 1.f), y1 = yb * g1 * (s1 + 1.f);
      *(u32x4*)(E.yout + (size_t)r * D + c) = (u32x4){pk2(y0[0], y0[1]), pk2(y0[2], y0[3]), pk2(y1[0], y1[1]), pk2(y1[2], y1[3])};
      if (E.ykv) { const f32x4 h0 = *(const f32x4*)(E.ngkv + c), h1 = *(const f32x4*)(E.ngkv + c + 4), t0 = *(const f32x4*)(E.nsckv + mo + c), t1 = *(const f32x4*)(E.nsckv + mo + c + 4);
        const f32x4 z0 = ya * h0 * (t0 + 1.f), z1 = yb * h1 * (t1 + 1.f);
        *(u32x4*)(E.ykv + (size_t)r * D + c) = (u32x4){pk2(z0[0], z0[1]), pk2(z0[2], z0[3]), pk2(z1[0], z1[1]), pk2(z1[2], z1[3])}; }
      float ss = ya[0] * ya[0] + ya[1] * ya[1] + ya[2] * ya[2] + ya[3] * ya[3] + yb[0] * yb[0] + yb[1] * yb[1] + yb[2] * yb[2] + yb[3] * yb[3];
      ss += __shfl_xor(ss, 16); ss += __shfl_xor(ss, 32);
      if ((tid_get() & 63) < 16) atomicAdd(E.rss_out + r, ss); }
  } else if (epi == EPI_UP) {
    float u[8];
#pragma unroll
    for (int j = 0; j < 8; ++j) { const float t = fmaxf((j < 4) ? v0[j & 3] : v1[j & 3], 0.f); u[j] = t * t; }
    *(u32x4*)(E.b0 + (size_t)r * FF + c) = (u32x4){pk2(u[0], u[1]), pk2(u[2], u[3]), pk2(u[4], u[5]), pk2(u[6], u[7])};
  } else if (epi == EPI_QRAW) { *(u32x4*)(E.b1 + (size_t)r * D + c) = (u32x4){pk2(v0[0], v0[1]), pk2(v0[2], v0[3]), pk2(v1[0], v1[1]), pk2(v1[2], v1[3])};
  } else { float* o = E.f2 + (size_t)r * 512 + c; *(f32x4*)o = v0; *(f32x4*)(o + 4) = v1; }
}

template <int NMB>
DI void skinny_unit(KP p, unsigned char* shm, const bf16_t* A, const bf16_t* Bt, const int K, const int mrow0, const int n0, const int epi, const EpiArgs& E) {
  const int tid = tid_get(), lane = tid & 63, wave = tid >> 6, fr = lane & 15, fq = lane >> 4;
  const int ks = K >> 3;
  const bf16_t* ap = A + (size_t)(TP + mrow0 + fr) * K + wave * ks + fq * 8;
  const bf16_t* bp = Bt + (size_t)(n0 + fr) * K + wave * ks + fq * 8;
  f32x4 acc[NMB];
#pragma unroll
  for (int mb = 0; mb < NMB; ++mb) acc[mb] = (f32x4){0.f, 0.f, 0.f, 0.f};
#pragma unroll 2
  for (int k = 0; k < ks; k += 32) { const bf16x8 b = *(const bf16x8*)(bp + k);
#pragma unroll
    for (int mb = 0; mb < NMB; ++mb) { const bf16x8 a = *(const bf16x8*)(ap + (size_t)mb * 16 * K + k); acc[mb] = __builtin_amdgcn_mfma_f32_16x16x32_bf16(b, a, acc[mb], 0, 0, 0); } }
  float* red = (float*)shm;
#pragma unroll
  for (int mb = 0; mb < NMB; ++mb) *(f32x4*)(red + wave * (NMB * 256) + (mb * 16 + fr) * 16 + fq * 4) = acc[mb];
  __syncthreads();
  if (tid < NMB * 64) { const int row = tid >> 2, c4 = (tid & 3) * 4; f32x4 sum = (f32x4){0.f, 0.f, 0.f, 0.f};
#pragma unroll
    for (int w = 0; w < 8; ++w) sum += *(const f32x4*)(red + w * (NMB * 256) + row * 16 + c4);
    epi_frag(p, epi, E, TP + mrow0 + row, n0 + c4, sum); }
  __syncthreads();
}

DI int perm32(int rho) { const int n = rho >> 4, i = rho & 15; return 8 * (i >> 2) + 4 * n + (i & 3); }
struct UnitD { const char* A; const char* B; int pm, pn, epi; float* ob; int on; };
DI void unit_of(const int L, const GemmJob& j0, const GemmJob& j1, const int n0, const size_t tstep, UnitD& u) {
  if (j0.epi == EPI_BIAS) {
    const int st = L < 16 ? 0 : L < 32 ? 1 : L < 36 ? 2 : L < 40 ? 3 : L < 42 ? 4 : 5 + (L - 42) / 16;
    const int lb = st == 0 ? 0 : st == 1 ? 16 : st == 2 ? 32 : st == 3 ? 36 : st == 4 ? 40 : 42 + (st - 5) * 16;
    const unsigned char* wsb = (const unsigned char*)j0.Bt;
    const bf16_t* Bt = (st < 2) ? (const bf16_t*)(wsb + OFF_WIN) + (size_t)st * 4096 * D : (st < 4) ? (const bf16_t*)(wsb + OFF_WQ) + (size_t)(st - 2) * D * D
                     : (st == 4) ? (const bf16_t*)(wsb + OFF_WKV) : (const bf16_t*)(wsb + OFF_WUP) + (size_t)(st - 5) * D * FF;
    u.pm = 0; u.pn = L - lb; u.epi = EPI_BIAS; u.A = (const char*)(j0.A + (size_t)st * 256 * 1024); u.B = (const char*)Bt + (size_t)u.pn * tstep;
    u.ob = (float*)j1.A + (size_t)132 * site_prefN(st); u.on = site_N(st); return; }
  const bool second = (L >= n0); int pm, pn; tile_of(second ? L - n0 : L, second ? j1.nM : j0.nM, second ? j1.nN : j0.nN, pm, pn);
  u.pm = pm; u.pn = pn; u.epi = second ? j1.epi : j0.epi;
  u.A = (const char*)(second ? j1.A : j0.A) + (size_t)pm * tstep; u.B = (const char*)(second ? j1.Bt : j0.Bt) + (size_t)pn * tstep;
}
DI void gemm_phase(KP p, LAS unsigned char* lds, unsigned char* shm, const GemmJob& j0, const GemmJob& j1, const int njobs, const EpiArgs& E, const int skinny) {
  const int tid = tid_get(), wid = __builtin_amdgcn_readfirstlane(tid >> 6), lane = tid & 63, wr = wid >> 2, wc = wid & 3, fr = lane & 15, fq = lane >> 4;
  const int K = j0.K, nt = K / BK;
  const int n0 = j0.nM * j0.nN, n1 = (njobs > 1) ? j1.nM * j1.nN : 0, ntl = n0 + n1;
  if ((int)blockIdx.x < ntl) {
    unsigned voffA[2], voffB[2];
#pragma unroll
    for (int i = 0; i < 2; ++i) { int R, C; stage_rc(tid * 16 + i * 8192, R, C); const int Rb = (R & ~31) + perm32(R & 31);
      voffA[i] = (unsigned)(R * K + C) * 2u; voffB[i] = (unsigned)(Rb * K + C) * 2u; }
    const size_t kstep = (size_t)(BK * 2), hstep = (size_t)HALF * K * 2, tstep = 2 * hstep;
    const unsigned ldsw = (unsigned)wid * 1024u;
    const int aoff = lds_byte(wr * 64 + fr, fq * 8), boff = lds_byte(wc * 32 + fr, fq * 8);
#define G_SA(b, h) (((b) * 2 + (h)) * HTB)
#define G_SB(b, h) ((4 + (b) * 2 + (h)) * HTB)
#define G_STAGE(bufoff, gbase, voff) do { _Pragma("unroll") for (int _i = 0; _i < 2; ++_i) \
      __builtin_amdgcn_global_load_lds((const unsigned*)((const char*)(gbase) + (voff)[_i]), (LAS unsigned*)(lds + (bufoff) + ldsw + _i * 8192), 16, 0, 0); } while (0)
#define G_LDA(dst, b, h) do { _Pragma("unroll") for (int m = 0; m < 4; ++m) _Pragma("unroll") for (int k = 0; k < 2; ++k) dst[m][k] = *(const LAS bf16x8*)(lds + G_SA(b, h) + aoff + m * 2048 + k * 1024); } while (0)
#define G_LDB(dst, b, h) do { _Pragma("unroll") for (int n = 0; n < 2; ++n) _Pragma("unroll") for (int k = 0; k < 2; ++k) dst[n][k] = *(const LAS bf16x8*)(lds + G_SB(b, h) + boff + n * 2048 + k * 1024); } while (0)
#define G_MMA(ai, bj, At, Bt) do { __builtin_amdgcn_s_setprio(1); _Pragma("unroll") for (int m = 0; m < 4; ++m) _Pragma("unroll") for (int n = 0; n < 2; ++n) _Pragma("unroll") for (int k = 0; k < 2; ++k) \
      acc[ai][bj][m][n] = __builtin_amdgcn_mfma_f32_16x16x32_bf16(Bt[n][k], At[m][k], acc[ai][bj][m][n], 0, 0, 0); __builtin_amdgcn_s_setprio(0); } while (0)
#define G_WAIT_V(n) asm volatile("s_waitcnt vmcnt(" #n ")" ::: "memory")
#define G_WAIT_L(n) asm volatile("s_waitcnt lgkmcnt(" #n ")" ::: "memory")
#define G_BAR __builtin_amdgcn_s_barrier()
#define G_SCHED __builtin_amdgcn_sched_barrier(0)
    int L = blockIdx.x;
    UnitD cur, nxt; unit_of(L, j0, j1, n0, tstep, cur);
    f32x4 acc[2][2][4][2];
#pragma unroll
    for (int a = 0; a < 2; ++a)
#pragma unroll
      for (int b = 0; b < 2; ++b)
#pragma unroll
        for (int m = 0; m < 4; ++m)
#pragma unroll
          for (int n = 0; n < 2; ++n) acc[a][b][m][n] = (f32x4){0.f, 0.f, 0.f, 0.f};
    bf16x8 At[4][2], B0[2][2], B1[2][2];
    const char* cA = cur.A; const char* cB = cur.B;
    G_STAGE(G_SB(0, 0), cB, voffB); G_STAGE(G_SB(0, 1), cB + hstep, voffB); G_STAGE(G_SA(0, 0), cA, voffA); G_STAGE(G_SA(0, 1), cA + hstep, voffA);
    if (wr == 1) G_BAR;
    G_WAIT_V(2); G_BAR;
    G_STAGE(G_SB(1, 0), cB + kstep, voffB); G_STAGE(G_SA(1, 0), cA + kstep, voffA); G_STAGE(G_SB(1, 1), cB + hstep + kstep, voffB);
    G_WAIT_V(6); G_BAR;
#pragma unroll 1
    for (;;) {
      const int Ln = L + (int)gridDim.x; const bool has_next = (Ln < ntl);
      if (has_next) unit_of(Ln, j0, j1, n0, tstep, nxt);
      const char* nA = has_next ? nxt.A : cA; const char* nB = has_next ? nxt.B : cB;
#pragma unroll 1
      for (int t = 0; t < nt; t += 2) {
        const bool last = (t == nt - 2);
        const bool tail = last && !has_next;
        const char* a1 = cA + (size_t)(t + 1) * kstep;
        const char* a2 = last ? nA : cA + (size_t)(t + 2) * kstep; const char* b2 = last ? nB : cB + (size_t)(t + 2) * kstep;
        const char* a3 = a2 + kstep; const char* b3 = b2 + kstep;
        G_LDB(B0, 0, 0); G_LDB(B1, 0, 1); G_SCHED; G_LDA(At, 0, 0); G_STAGE(G_SA(1, 1), a1 + hstep, voffA);
        G_WAIT_V(8); G_WAIT_L(0); G_BAR; G_MMA(0, 0, At, B0); G_MMA(0, 1, At, B1); G_BAR; G_SCHED;
        G_LDA(At, 0, 1); if (!tail) { G_STAGE(G_SB(0, 0), b2, voffB); G_STAGE(G_SB(0, 1), b2 + hstep, voffB); G_STAGE(G_SA(0, 0), a2, voffA); }
        if (tail) G_WAIT_V(2); else G_WAIT_V(8);
        G_WAIT_L(0); G_BAR; G_MMA(1, 0, At, B0); G_MMA(1, 1, At, B1); G_BAR; G_SCHED;
        G_LDB(B0, 1, 0); G_LDB(B1, 1, 1); G_SCHED; G_LDA(At, 1, 0); if (!tail) G_STAGE(G_SA(0, 1), a2 + hstep, voffA);
        if (tail) G_WAIT_V(0); else G_WAIT_V(8);
        G_WAIT_L(0); G_BAR; G_MMA(0, 0, At, B0); G_MMA(0, 1, At, B1); G_BAR; G_SCHED;
        G_LDA(At, 1, 1); if (!tail) { G_STAGE(G_SB(1, 0), b3, voffB); G_STAGE(G_SB(1, 1), b3 + hstep, voffB); G_STAGE(G_SA(1, 0), a3, voffA); }
        if (tail) G_WAIT_V(0); else G_WAIT_V(8);
        G_WAIT_L(0); G_BAR; G_MMA(1, 0, At, B0); G_MMA(1, 1, At, B1); G_BAR; G_SCHED;
      }
      if (wr == 0) G_BAR;
      { const int r0 = cur.pm * BM + wr * 64 + fr, c0 = cur.pn * BM + wc * 32 + fq * 8; const int epi = cur.epi;
#define EPI_LOOP(MODE) { _Pragma("unroll") for (int ai = 0; ai < 2; ++ai) _Pragma("unroll") for (int m = 0; m < 4; ++m) _Pragma("unroll") for (int bj = 0; bj < 2; ++bj) \
          epi_frag8(p, MODE, E, r0 + ai * 128 + m * 16, c0 + bj * 128, acc[ai][bj][m][0], acc[ai][bj][m][1]); }
        if (epi == EPI_ADA) EPI_LOOP(EPI_ADA)
        else if (epi == EPI_BIAS) {
#pragma unroll
          for (int ai = 0; ai < 2; ++ai)
#pragma unroll
            for (int m = 0; m < 4; ++m) { const int r = r0 + ai * 128 + m * 16; if (r < NMOD) {
#pragma unroll
              for (int bj = 0; bj < 2; ++bj) { float* o = cur.ob + (size_t)r * cur.on + (c0 + bj * 128); *(f32x4*)o = acc[ai][bj][m][0]; *(f32x4*)(o + 4) = acc[ai][bj][m][1]; } } }
        } else if (epi == EPI_RESID) {
          const size_t mo = (size_t)modrow(r0) * MODW;
#pragma unroll
          for (int bj = 0; bj < 2; ++bj) { const int c = c0 + bj * 128;
            const f32x4 ga = *(const f32x4*)(E.f1 + mo + c), gb = *(const f32x4*)(E.f1 + mo + c + 4);
            f32x4 m0 = (f32x4){0.f, 0.f, 0.f, 0.f}, m1 = m0, k0 = m0, k1 = m0;
            if (E.yout) { const f32x4 g0 = *(const f32x4*)(E.ng + c), g1 = *(const f32x4*)(E.ng + c + 4), s0 = *(const f32x4*)(E.nsc + mo + c), s1 = *(const f32x4*)(E.nsc + mo + c + 4);
              m0 = g0 * (s0 + 1.f); m1 = g1 * (s1 + 1.f);
              if (E.ykv) { const f32x4 h0 = *(const f32x4*)(E.ngkv + c), h1 = *(const f32x4*)(E.ngkv + c + 4), t0 = *(const f32x4*)(E.nsckv + mo + c), t1 = *(const f32x4*)(E.nsckv + mo + c + 4);
                k0 = h0 * (t0 + 1.f); k1 = h1 * (t1 + 1.f); } }
#pragma unroll
            for (int ah = 0; ah < 2; ++ah) { const int ai = ah, mb = 0;
              f32x4 ya[4], yb[4];
              const float* xbase = E.first ? p->x_prompt : E.f0;
#pragma unroll
              for (int m = mb; m < mb + 4; ++m) { const unsigned off = (unsigned)(r0 + ai * 128 + m * 16) * (unsigned)D + (unsigned)c;
                ya[m] = __builtin_nontemporal_load((const f32x4*)(xbase + off)); yb[m] = __builtin_nontemporal_load((const f32x4*)(xbase + off + 4)); }
#pragma unroll
              for (int m = mb; m < mb + 4; ++m) { const int r = r0 + ai * 128 + m * 16; const unsigned off = (unsigned)r * (unsigned)D + (unsigned)c;
                const f32x4 xa = ya[m] + ga * acc[ai][bj][m][0], xb = yb[m] + gb * acc[ai][bj][m][1];
                __builtin_nontemporal_store(xa, (f32x4*)(E.f0 + off)); __builtin_nontemporal_store(xb, (f32x4*)(E.f0 + off + 4));
                if (E.yout) { const f32x4 y0 = xa * m0, y1 = xb * m1;
                  *(u32x4*)(E.yout + off) = (u32x4){pk2(y0[0], y0[1]), pk2(y0[2], y0[3]), pk2(y1[0], y1[1]), pk2(y1[2], y1[3])};
                  if (E.ykv) { const f32x4 z0 = xa * k0, z1 = xb * k1;
                    *(u32x4*)(E.ykv + off) = (u32x4){pk2(z0[0], z0[1]), pk2(z0[2], z0[3]), pk2(z1[0], z1[1]), pk2(z1[2], z1[3])}; }
                  float ss = xa[0] * xa[0] + xa[1] * xa[1] + xa[2] * xa[2] + xa[3] * xa[3] + xb[0] * xb[0] + xb[1] * xb[1] + xb[2] * xb[2] + xb[3] * xb[3];
                  ss += __shfl_xor(ss, 16); ss += __shfl_xor(ss, 32);
                  if (fq == 0) atomicAdd(E.rss_out + (unsigned)r, ss); } } } }
        } else if (epi != EPI_NOP) {
          float rstd8[8];
#pragma unroll
          for (int q = 0; q < 8; ++q) rstd8[q] = rsqrtf(E.rss[r0 + (q >> 2) * 128 + (q & 3) * 16] * (1.f / D) + EPS);
          const float* bb = (epi == EPI_KVRAW) ? E.bias1 + (size_t)modrow(r0) * E.bN1 : E.bias + (size_t)modrow(r0) * E.bN;
          f32x4 bv[2][2], lbv[2][2];
#pragma unroll
          for (int bj = 0; bj < 2; ++bj) { const int c = c0 + bj * 128; bv[bj][0] = *(const f32x4*)(bb + c); bv[bj][1] = *(const f32x4*)(bb + c + 4);
            lbv[bj][0] = (f32x4){0.f, 0.f, 0.f, 0.f}; lbv[bj][1] = (f32x4){0.f, 0.f, 0.f, 0.f};
            if (epi == EPI_HGIN && (c >> 10) == 1 && E.layer == 1) { const int cc = c & 1023;
              const f32x4 l0 = *(const f32x4*)(p->hg_lbp + cc), l1 = *(const f32x4*)(p->hg_lbp + D + cc), l2 = *(const f32x4*)(p->hg_lbp + cc + 4), l3 = *(const f32x4*)(p->hg_lbp + D + cc + 4);
#pragma unroll
              for (int jj = 0; jj < 4; ++jj) { lbv[bj][0][jj] = __builtin_amdgcn_rcpf(1.f + __expf(l0[jj] - l1[jj])); lbv[bj][1][jj] = __builtin_amdgcn_rcpf(1.f + __expf(l2[jj] - l3[jj])); } } }
#define CONS_LOOP(MODE) { _Pragma("unroll") for (int ai = 0; ai < 2; ++ai) _Pragma("unroll") for (int m = 0; m < 4; ++m) _Pragma("unroll") for (int bj = 0; bj < 2; ++bj) \
            epi_frag8(p, MODE, E, r0 + ai * 128 + m * 16, c0 + bj * 128, acc[ai][bj][m][0] * rstd8[ai * 4 + m] + bv[bj][0], acc[ai][bj][m][1] * rstd8[ai * 4 + m] + bv[bj][1], lbv[bj][0], lbv[bj][1]); }
          if (epi == EPI_HGIN) CONS_LOOP(EPI_HGIN) else if (epi == EPI_UP) CONS_LOOP(EPI_UP) else if (epi == EPI_QRAW) CONS_LOOP(EPI_QRAW) else CONS_LOOP(EPI_KVRAW)
        }
      }
      if (!has_next) break;
#pragma unroll
      for (int a = 0; a < 2; ++a)
#pragma unroll
        for (int b = 0; b < 2; ++b)
#pragma unroll
          for (int m = 0; m < 4; ++m)
#pragma unroll
            for (int n = 0; n < 2; ++n) acc[a][b][m][n] = (f32x4){0.f, 0.f, 0.f, 0.f};
      cur = nxt; cA = nA; cB = nB; L = Ln;
      if (wr == 1) G_BAR;
    }
    G_WAIT_V(0);
    G_BAR;
  }
  if (skinny) {
    __syncthreads();
    const int u0 = j0.nN * 16, u1 = (njobs > 1) ? j1.nN * 16 : 0;
    const int rs = ((u0 + u1) * 4 <= (int)gridDim.x) ? 4 : (((u0 + u1) * 2 <= (int)gridDim.x) ? 2 : 1);
#pragma unroll 1
    for (int uu = (int)gridDim.x - 1 - (int)blockIdx.x; uu < (u0 + u1) * rs; uu += gridDim.x) {
      const int u = uu / rs, rg = uu - u * rs;
      const bool second = (u >= u0);
      const bf16_t* sa = second ? j1.A : j0.A; const bf16_t* sb = second ? j1.Bt : j0.Bt; const int sk = second ? j1.K : j0.K, sn = (second ? u - u0 : u) * 16, se = second ? j1.epi : j0.epi;
      if (rs == 4) skinny_unit<2>(p, shm, sa, sb, sk, rg * 32, sn, se, E);
      else if (rs == 2) skinny_unit<4>(p, shm, sa, sb, sk, rg * 64, sn, se, E);
      else skinny_unit<8>(p, shm, sa, sb, sk, 0, sn, se, E);
    }
  }
}

__device__ const float INVF[32] = {1.000000000e+00f, 7.498942614e-01f, 5.623413324e-01f, 4.216965139e-01f, 3.162277639e-01f, 2.371373773e-01f, 1.778279394e-01f, 1.333521307e-01f, 1.000000015e-01f, 7.498941571e-02f, 5.623413250e-02f, 4.216965288e-02f, 3.162277490e-02f, 2.371373773e-02f, 1.778279431e-02f, 1.333521493e-02f, 9.999999776e-03f, 7.498941850e-03f, 5.623413250e-03f, 4.216964822e-03f, 3.162277630e-03f, 2.371373586e-03f, 1.778279431e-03f, 1.333521446e-03f, 1.000000047e-03f, 7.498942432e-04f, 5.623413017e-04f, 4.216965172e-04f, 3.162277571e-04f, 2.371373703e-04f, 1.778279402e-04f, 1.333521504e-04f};
DI void transpose_item(const float* W, int K, int N, bf16_t* WT, int row_off, float* scr, int item, int lane) {
  const int nblk = N / 32, kb = item / nblk, nb = item % nblk, k0 = 64 * kb, n0 = 32 * nb;
#pragma unroll 8
  for (int i = 0; i < 32; ++i) { const int kk = 2 * i + (lane >> 5); scr[kk * 33 + (lane & 31)] = __builtin_nontemporal_load(W + (size_t)(k0 + kk) * N + n0 + (lane & 31)); }
  asm volatile("s_waitcnt lgkmcnt(0)" ::: "memory");
  const int c = lane & 7;
#pragma unroll
  for (int j = 0; j < 4; ++j) { const int n = (lane >> 3) + 8 * j; const float* s = scr + (8 * c) * 33 + n;
    u32x4 o; o.x = pk2(s[0 * 33], s[1 * 33]); o.y = pk2(s[2 * 33], s[3 * 33]); o.z = pk2(s[4 * 33], s[5 * 33]); o.w = pk2(s[6 * 33], s[7 * 33]);
    *(u32x4*)(WT + (size_t)(row_off + n0 + n) * K + k0 + 8 * c) = o; }
  asm volatile("s_waitcnt lgkmcnt(0)" ::: "memory");
}

DI void prep_phase(KP p, unsigned char* shm) {
  const int tid = tid_get(), lane = tid & 63, wave = tid >> 6;
  const int gw = blockIdx.x * NWAVES + wave, NGW = gridDim.x * NWAVES;
  float* scr = (float*)(shm + wave * 16384);
  unsigned char* ws = p->ws;
  int base = 0;
  for (int mi = 0; mi < 22; ++mi) {
    const float* W; int K, N, row_off; bf16_t* WT;
    if (mi < 2) { W = p->hg_w_in + (size_t)mi * D * 4096; K = D; N = 4096; WT = (bf16_t*)(ws + OFF_WIN) + (size_t)mi * 4096 * D; row_off = 0; }
    else if (mi < 4) { W = p->hg_w_out + (size_t)(mi - 2) * D * D; K = D; N = D; WT = (bf16_t*)(ws + OFF_WOUT) + (size_t)(mi - 2) * D * D; row_off = 0; }
    else if (mi < 5) { W = p->w_kv; K = D; N = 512; WT = (bf16_t*)(ws + OFF_WKV); row_off = 0; }
    else if (mi < 7) { W = p->w_q + (size_t)(mi - 5) * D * D; K = D; N = D; WT = (bf16_t*)(ws + OFF_WQ) + (size_t)(mi - 5) * D * D; row_off = 0; }
    else if (mi < 9) { W = p->w_o + (size_t)(mi - 7) * D * D; K = D; N = D; WT = (bf16_t*)(ws + OFF_WO) + (size_t)(mi - 7) * D * D; row_off = 0; }
    else if (mi < 13) { W = p->w_up + (size_t)(mi - 9) * D * FF; K = D; N = FF; WT = (bf16_t*)(ws + OFF_WUP) + (size_t)(mi - 9) * D * FF; row_off = 0; }
    else if (mi < 17) { W = p->w_down + (size_t)(mi - 13) * D * FF; K = FF; N = D; WT = (bf16_t*)(ws + OFF_WDN) + (size_t)(mi - 13) * D * FF; row_off = 0; }
    else if (mi < 21) { W = p->w_ada + (size_t)(mi - 17) * D * 6144; K = D; N = 6144; WT = (bf16_t*)(ws + OFF_X); row_off = (mi - 17) * 6144; }
    else { W = p->kv_w_ada; K = D; N = 2048; WT = (bf16_t*)(ws + OFF_X); row_off = 24576; }
    const int nitems = (K / 64) * (N / 32);
    int first = (gw - (base % NGW) + NGW) % NGW;
    for (int it = first; it < nitems; it += NGW) transpose_item(W, K, N, WT, row_off, scr, it, lane);
    base += nitems;
  }
  bf16_t* Ac = (bf16_t*)(ws + OFF_X + (size_t)MODW * D * 2);
  const int gt = blockIdx.x * NTHREADS + tid, NGT = gridDim.x * NTHREADS;
  { unsigned* z = (unsigned*)(ws + OFF_BAR); for (int e = gt; e < (int)(ZERO_BYTES / 4); e += NGT) z[e] = 0u; }
  for (int e = gt; e < 256 * D / 2; e += NGT) { const int r = e / (D / 2), c = (e % (D / 2)) * 2; float a = 0.f, b = 0.f;
    if (r < NMOD) { const float* cp = (r < 4) ? p->c_prompt + (size_t)r * D : p->c_sample + (size_t)(r - 4) * D; a = silu_f(cp[c]); b = silu_f(cp[c + 1]); }
    *(unsigned*)(Ac + (size_t)r * D + c) = pk2(a, b); }
  float* tab = (float*)(ws + OFF_TAB);
  for (int e = gt; e < 4097 * 32; e += NGT) { const int pi = e >> 5, i = e & 31; const float pos = (pi < 4096) ? (float)pi : 8192.f;
    const float ang = pos * INVF[i]; float sn, cs; sincosf(ang, &sn, &cs);
    tab[pi * 64 + i] = cs; tab[pi * 64 + 32 + i] = sn; }
}

DI void init_rows(KP p, unsigned* ctr) {
  const int tid = tid_get(); const int lane = tid & 63;
  unsigned char* ws = p->ws; const float* mods = (const float*)(ws + OFF_MODS); bf16_t* yout = (bf16_t*)(ws + OFF_H); float* rss = (float*)(ws + OFF_RSS);
  const float* g = p->norm1_g; const float* msc = mods + 1024;
#pragma unroll 1
  for (;;) {
    unsigned cidx = 0; if (lane == 0) cidx = __hip_atomic_fetch_add(ctr, 1u, __ATOMIC_RELAXED, __HIP_MEMORY_SCOPE_AGENT);
    cidx = __builtin_amdgcn_readfirstlane(cidx);
    if (cidx >= (unsigned)(T / 8)) break;
#pragma unroll 1
    for (int hh = 0; hh < 2; ++hh) { const int rb = (int)cidx * 8 + hh * 4;
      f32x4 v[4][4];
#pragma unroll
      for (int q = 0; q < 4; ++q) { const int r = rb + q; const float* xr = (r < TP) ? p->x_prompt + (size_t)r * D : p->x_sample + (size_t)(r - TP) * D;
#pragma unroll
        for (int jj = 0; jj < 4; ++jj) v[q][jj] = *(const f32x4*)(xr + lane * 4 + 256 * jj); }
#pragma unroll
      for (int q = 0; q < 4; ++q) { const int r = rb + q; float a = 0.f;
#pragma unroll
        for (int jj = 0; jj < 4; ++jj) a += v[q][jj][0] * v[q][jj][0] + v[q][jj][1] * v[q][jj][1] + v[q][jj][2] * v[q][jj][2] + v[q][jj][3] * v[q][jj][3];
#pragma unroll
        for (int o = 1; o < 64; o <<= 1) a += __shfl_xor(a, o);
        if (lane == 0) rss[r] = a;
        const size_t mo = (size_t)modrow(r) * MODW;
#pragma unroll
        for (int jj = 0; jj < 4; ++jj) { const int c = lane * 4 + 256 * jj;
          const f32x4 gg = *(const f32x4*)(g + c), sc = *(const f32x4*)(msc + mo + c);
          const f32x4 h = v[q][jj] * gg * (sc + 1.f);
          *(u32x2*)(yout + (size_t)r * D + c) = (u32x2){pk2(h[0], h[1]), pk2(h[2], h[3])}; } } }
  }
}

struct HgBufs { const bf16_t *q, *k, *v, *g; const float* lf; float* o32; bf16_t* on; };

constexpr int SPAN = 256, NSPAN = SEQ / SPAN, CH = 32, NCH = SPAN / CH;
constexpr int L_CUM = 0, L_QT = 16896, L_KT = 25600, L_KE = 34304, L_VT = 44544, L_PS = 54784, L_DEC = 55808, L_HALF = 57344;
constexpr int CUS = 132, QS = 136, KES = 40;
DI bf16x8 pack8(const f32x16& x, const int s) {
  return __builtin_bit_cast(bf16x8, (u32x4){pk2(x[8 * s], x[8 * s + 1]), pk2(x[8 * s + 2], x[8 * s + 3]), pk2(x[8 * s + 4], x[8 * s + 5]), pk2(x[8 * s + 6], x[8 * s + 7])});
}
template <int MODE>
DI void scan_prompt(KP p, const int l, const HgBufs& B, unsigned char* shm) {
  const int tid = tid_get(), lane = tid & 63, wave = tid >> 6, hb = wave >> 2, th = tid & 255, vb = wave & 3, h5 = lane >> 5, l31 = lane & 31;
  unsigned char* base = shm + hb * L_HALF;
  float* cumb = (float*)(base + L_CUM); bf16_t* Qt = (bf16_t*)(base + L_QT); bf16_t* Kt = (bf16_t*)(base + L_KT);
  bf16_t* KeT = (bf16_t*)(base + L_KE); bf16_t* Vt = (bf16_t*)(base + L_VT); float* psum = (float*)(base + L_PS); float* dec = (float*)(base + L_DEC);
  float* dS = B.o32; float* Lsum = B.o32 + (size_t)512 * 16384;
#pragma unroll 1
  for (int it0 = blockIdx.x * 2; it0 < 32 * NSPAN; it0 += gridDim.x * 2) {
    const int item = it0 + hb, bh = item / NSPAN, span = item % NSPAN, b = bh >> 3, h = bh & 7;
    f32x16 S[4];
#pragma unroll
    for (int db = 0; db < 4; ++db)
#pragma unroll
      for (int r = 0; r < 16; ++r) S[db][r] = 0.f;
    if (MODE == 1) {
      const unsigned ob = (unsigned)item * 16384u + (unsigned)(vb * 32 + l31) + (unsigned)(4 * h5) * 128u;
#pragma unroll
      for (int db = 0; db < 4; ++db) {
#pragma unroll
        for (int r = 0; r < 16; ++r) S[db][r] = dS[ob + (unsigned)((32 * db + (r & 3) + 8 * (r >> 2)) * 128)];
        __builtin_amdgcn_sched_barrier(0); }
    }
    float Ltot = 0.f;
#define LBAR() do { asm volatile("s_waitcnt lgkmcnt(0)" ::: "memory"); __builtin_amdgcn_s_barrier(); asm volatile("" ::: "memory"); } while (0)
    const int d1 = th & 127, part = th >> 7, t2 = th >> 3, dg = th & 7;
    const size_t tokS = (size_t)b * SEQ + (size_t)span * SPAN;
    float lfr[16]; unsigned vr[16]; u32x4 q0, q1, g0, g1;
#define SCAN_LOAD(chx) do { const size_t o0_ = (tokS + (size_t)(chx) * CH + part * 16) * D + h * 128 + d1; \
      _Pragma("unroll") for (int i = 0; i < 16; ++i) { lfr[i] = B.lf[o0_ + (size_t)i * D]; vr[i] = B.v[o0_ + (size_t)i * D]; } \
      } while (0)
    __builtin_amdgcn_sched_barrier(0);
    SCAN_LOAD(0);
    __builtin_amdgcn_sched_barrier(0);
#pragma unroll 1
    for (int ch = 0; ch < NCH; ++ch) {
      const size_t tok0 = tokS + (size_t)ch * CH;
      if (MODE == 1) { const size_t o_ = (tok0 + t2) * D + h * 128 + dg * 16;
        q0 = *(const u32x4*)(B.q + o_); q1 = *(const u32x4*)(B.q + o_ + 8);
        g0 = *(const u32x4*)(B.g + o_); g1 = *(const u32x4*)(B.g + o_ + 8); }
      { const int d = d1;
        float c[16]; float run = 0.f;
#pragma unroll
        for (int i = 0; i < 16; ++i) { run += lfr[i]; c[i] = run; }
        psum[part * 128 + d] = run;
        LBAR();
        const float t0 = psum[d], t1 = psum[128 + d]; const float off = part ? t0 : 0.f; const float Lc = t0 + t1;
        float ke[16];
#pragma unroll
        for (int i = 0; i < 16; ++i) { const float cu = off + c[i]; if (MODE == 1) cumb[(part * 16 + i) * CUS + d] = cu; ke[i] = (1.f - __builtin_amdgcn_exp2f(lfr[i])) * __builtin_amdgcn_exp2f(Lc - cu); }
        *(u32x4*)(KeT + d * KES + part * 16) = (u32x4){pk2(ke[0], ke[1]), pk2(ke[2], ke[3]), pk2(ke[4], ke[5]), pk2(ke[6], ke[7])};
        *(u32x4*)(KeT + d * KES + part * 16 + 8) = (u32x4){pk2(ke[8], ke[9]), pk2(ke[10], ke[11]), pk2(ke[12], ke[13]), pk2(ke[14], ke[15])};
        *(u32x4*)(Vt + d * KES + part * 16) = (u32x4){vr[0] | (vr[1] << 16), vr[2] | (vr[3] << 16), vr[4] | (vr[5] << 16), vr[6] | (vr[7] << 16)};
        *(u32x4*)(Vt + d * KES + part * 16 + 8) = (u32x4){vr[8] | (vr[9] << 16), vr[10] | (vr[11] << 16), vr[12] | (vr[13] << 16), vr[14] | (vr[15] << 16)};
        if (part == 0) { dec[d] = __builtin_amdgcn_exp2f(Lc); Ltot += Lc; }
      }
      LBAR();
      if (MODE == 1) {
        const int t = t2;
        unsigned qo[8], ko[8];
#pragma unroll
        for (int g4 = 0; g4 < 4; ++g4) { const f32x4 cv = *(const f32x4*)(cumb + t * CUS + dg * 16 + 4 * g4);
          f32x4 cp = (f32x4){0.f, 0.f, 0.f, 0.f}; if (t > 0) cp = *(const f32x4*)(cumb + (t - 1) * CUS + dg * 16 + 4 * g4);
#pragma unroll
          for (int e2 = 0; e2 < 2; ++e2) { const int w = g4 * 2 + e2; const unsigned qw = (w < 4) ? q0[w & 3] : q1[w & 3];
            const float ca = cv[2 * e2], cb = cv[2 * e2 + 1];
            const float ka = 1.f - __builtin_amdgcn_exp2f(ca - cp[2 * e2]), kb = 1.f - __builtin_amdgcn_exp2f(cb - cp[2 * e2 + 1]);
            qo[w] = pk2(bf2f(qw & 0xffffu) * __builtin_amdgcn_exp2f(ca), bf2f(qw >> 16) * __builtin_amdgcn_exp2f(cb));
            ko[w] = pk2(ka * __builtin_amdgcn_exp2f(fminf(-ca, 115.f)), kb * __builtin_amdgcn_exp2f(fminf(-cb, 115.f))); } }
        *(u32x4*)(Qt + t * QS + dg * 16) = (u32x4){qo[0], qo[1], qo[2], qo[3]}; *(u32x4*)(Qt + t * QS + dg * 16 + 8) = (u32x4){qo[4], qo[5], qo[6], qo[7]};
        *(u32x4*)(Kt + t * QS + dg * 16) = (u32x4){ko[0], ko[1], ko[2], ko[3]}; *(u32x4*)(Kt + t * QS + dg * 16 + 8) = (u32x4){ko[4], ko[5], ko[6], ko[7]};
        LBAR();
      }
      { const int chn = (ch + 1 < NCH) ? ch + 1 : ch; SCAN_LOAD(chn); }
      f32x16 O;
      if (MODE == 1) {
        f32x16 X;
#pragma unroll
        for (int r = 0; r < 16; ++r) { X[r] = 0.f; O[r] = 0.f; }
#pragma unroll
        for (int ks = 0; ks < 8; ++ks) { const bf16x8 a = *(const bf16x8*)(Kt + l31 * QS + 16 * ks + 8 * h5), bq = *(const bf16x8*)(Qt + l31 * QS + 16 * ks + 8 * h5);
          X = __builtin_amdgcn_mfma_f32_32x32x16_bf16(a, bq, X, 0, 0, 0); }
#pragma unroll
        for (int r = 0; r < 16; ++r) if (crow(r, h5) > l31) X[r] = 0.f;
#pragma unroll
        for (int st = 0; st < 2; ++st) { const bf16_t* vp = Vt + (vb * 32 + l31) * KES + 16 * st + 4 * h5; const u32x2 lo = *(const u32x2*)vp, hi = *(const u32x2*)(vp + 8);
          O = __builtin_amdgcn_mfma_f32_32x32x16_bf16(pack8(X, st), __builtin_bit_cast(bf16x8, (u32x4){lo[0], lo[1], hi[0], hi[1]}), O, 0, 0, 0); }
#pragma unroll
        for (int db = 0; db < 4; ++db)
#pragma unroll
          for (int st = 0; st < 2; ++st) { const bf16_t* qp = Qt + l31 * QS + 32 * db + 16 * st + 4 * h5; const u32x2 lo = *(const u32x2*)qp, hi = *(const u32x2*)(qp + 8);
            O = __builtin_amdgcn_mfma_f32_32x32x16_bf16(__builtin_bit_cast(bf16x8, (u32x4){lo[0], lo[1], hi[0], hi[1]}), pack8(S[db], st), O, 0, 0, 0); }
      }
#pragma unroll
      for (int db = 0; db < 4; ++db) {
#pragma unroll
        for (int r4 = 0; r4 < 4; ++r4) { const f32x4 dv = *(const f32x4*)(dec + 32 * db + 8 * r4 + 4 * h5);
#pragma unroll
          for (int e = 0; e < 4; ++e) S[db][4 * r4 + e] *= dv[e]; }
#pragma unroll
        for (int st = 0; st < 2; ++st) { const bf16x8 a = *(const bf16x8*)(KeT + (32 * db + l31) * KES + 16 * st + 8 * h5), bv = *(const bf16x8*)(Vt + (vb * 32 + l31) * KES + 16 * st + 8 * h5);
          S[db] = __builtin_amdgcn_mfma_f32_32x32x16_bf16(a, bv, S[db], 0, 0, 0); } }
      if (MODE == 1) {
#pragma unroll
        for (int r = 0; r < 16; ++r) cumb[crow(r, h5) * CUS + vb * 32 + l31] = O[r];
        LBAR();
        const int t = t2, vg = dg; const size_t o = (tok0 + t) * D + h * 128 + vg * 16;
        f32x4 ov[4]; float ss = 0.f;
#pragma unroll
        for (int g4 = 0; g4 < 4; ++g4) { ov[g4] = *(const f32x4*)(cumb + t * CUS + vg * 16 + 4 * g4); ss += ov[g4][0] * ov[g4][0] + ov[g4][1] * ov[g4][1] + ov[g4][2] * ov[g4][2] + ov[g4][3] * ov[g4][3]; }
        ss += __shfl_xor(ss, 1); ss += __shfl_xor(ss, 2); ss += __shfl_xor(ss, 4);
        const float rstd = rsqrtf(ss * (1.f / 128.f) + EPS);
        unsigned w[8];
#pragma unroll
        for (int g4 = 0; g4 < 4; ++g4) { const f32x4 gn = *(const f32x4*)(p->hg_gn_g + l * 128 + vg * 16 + 4 * g4);
#pragma unroll
          for (int e2 = 0; e2 < 2; ++e2) { const int wi = g4 * 2 + e2; const unsigned gw = (wi < 4) ? g0[wi & 3] : g1[wi & 3];
            w[wi] = pk2(ov[g4][2 * e2] * rstd * gn[2 * e2] * bf2f(gw & 0xffffu), ov[g4][2 * e2 + 1] * rstd * gn[2 * e2 + 1] * bf2f(gw >> 16)); } }
        *(u32x4*)(B.on + o) = (u32x4){w[0], w[1], w[2], w[3]}; *(u32x4*)(B.on + o + 8) = (u32x4){w[4], w[5], w[6], w[7]};
      } else {
        LBAR();
      }
    }
    if (MODE == 0) {
      float* dSo = dS + (size_t)item * 16384 + vb * 32 + l31;
#pragma unroll
      for (int db = 0; db < 4; ++db)
#pragma unroll
        for (int r = 0; r < 16; ++r) dSo[(size_t)(32 * db + crow(r, h5)) * 128] = S[db][r];
      if (th < 128) Lsum[(size_t)item * 128 + th] = Ltot;
    } else if (span == NSPAN - 1) {
      float* so = p->out + O_HGP + ((size_t)((l * 4 + b) * 8 + h)) * 16384 + vb * 32 + l31;
#pragma unroll
      for (int db = 0; db < 4; ++db)
#pragma unroll
        for (int r = 0; r < 16; ++r) so[(size_t)(32 * db + crow(r, h5)) * 128] = S[db][r];
    }
    __syncthreads();
  }
}

DI void scan_passB(const HgBufs& B) {
  const int tid = tid_get();
  float* dS = B.o32; const float* Lsum = B.o32 + (size_t)512 * 16384;
  const int gt = blockIdx.x * NTHREADS + tid, NGT = gridDim.x * NTHREADS;
#pragma unroll 1
  for (int e = gt; e < 32 * 4096; e += NGT) { const int bh = e >> 12, q4 = e & 4095, d = q4 >> 5;
    float* base = dS + (size_t)bh * NSPAN * 16384 + (size_t)q4 * 4; const float* Lb = Lsum + (size_t)bh * NSPAN * 128 + d;
    f32x4 v[NSPAN]; float lv[NSPAN];
#pragma unroll
    for (int sp = 0; sp < NSPAN; ++sp) { v[sp] = *(const f32x4*)(base + (size_t)sp * 16384); lv[sp] = Lb[sp * 128]; }
    f32x4 run = (f32x4){0.f, 0.f, 0.f, 0.f};
#pragma unroll
    for (int sp = 0; sp < NSPAN; ++sp) { *(f32x4*)(base + (size_t)sp * 16384) = run; run = run * __builtin_amdgcn_exp2f(lv[sp]) + v[sp]; }
  }
}

DI void scan_phase(KP p, const int l, const HgBufs& B, unsigned char* shm) {
  const bool sample_first = (blockIdx.x & 1) != 0;
  if (!sample_first) scan_prompt<0>(p, l, B, shm);
  const int tid = tid_get(), lane = tid & 63, wave = tid >> 6;
  {
    float* ps = (float*)shm;
    const int v4 = (tid & 31) * 4, dq = tid >> 5;
    f32x4 sv[8], svn[8]; float lfv[8], lfn[8]; unsigned kq[8], kqn[8]; u32x2 vw, vwn;
#define SMP_LOAD(IT, SV, LF, KQ, VW) do { const int bs_ = (IT) >> 3, h_ = (IT) & 7; const size_t r_ = TP + bs_; \
      const float* s0_ = p->state_hgrn + ((size_t)((l * 128 + bs_) * 8 + h_)) * 16384; \
      VW = *(const u32x2*)(B.v + r_ * D + h_ * 128 + v4); \
      _Pragma("unroll") for (int i = 0; i < 8; ++i) { const int d_ = dq * 8 + i; const size_t o_ = r_ * D + h_ * 128 + d_; \
        LF[i] = B.lf[o_]; KQ[i] = (unsigned)B.q[o_]; SV[i] = __builtin_nontemporal_load((const f32x4*)(s0_ + d_ * 128 + v4)); } } while (0)
    int item = blockIdx.x, par = 0;
    if (item < 1024) SMP_LOAD(item, sv, lfv, kq, vw);
#pragma unroll 1
    for (; item < 1024; item += gridDim.x, par ^= 1) {
      const int bs = item >> 3, h = item & 7; const size_t r = TP + bs;
      const int nitem = item + gridDim.x;
      if (nitem < 1024) SMP_LOAD(nitem, svn, lfn, kqn, vwn);
      float* s1 = p->out + O_HGS + ((size_t)((l * 128 + bs) * 8 + h)) * 16384;
      const f32x4 vv = (f32x4){bf2f(vw[0] & 0xffffu), bf2f(vw[0] >> 16), bf2f(vw[1] & 0xffffu), bf2f(vw[1] >> 16)};
      f32x4 op = (f32x4){0.f, 0.f, 0.f, 0.f};
#pragma unroll
      for (int i = 0; i < 8; ++i) { const int d = dq * 8 + i;
        const float f = __builtin_amdgcn_exp2f(lfv[i]), kk = 1.f - f, qq = bf2f(kq[i]);
        const f32x4 sn = sv[i] * f + vv * kk;
        __builtin_nontemporal_store(sn, (f32x4*)(s1 + d * 128 + v4)); op += sn * qq; }
#pragma unroll
      for (int jx = 0; jx < 4; ++jx) op[jx] += __shfl_xor(op[jx], 32);
      float* psb = ps + par * 1024;
      if (lane < 32) *(f32x4*)(psb + wave * 128 + v4) = op;
      __syncthreads();
      if (tid < 64) { float o0 = 0.f, o1 = 0.f;
#pragma unroll
        for (int w = 0; w < 8; ++w) { const f32x2 x = *(const f32x2*)(psb + w * 128 + tid * 2); o0 += x[0]; o1 += x[1]; }
        float ss = o0 * o0 + o1 * o1;
#pragma unroll
        for (int o = 1; o < 64; o <<= 1) ss += __shfl_xor(ss, o);
        const float rstd = rsqrtf(ss * (1.f / 128.f) + EPS);
        const int vv2 = tid * 2; const size_t o = r * D + h * 128 + vv2;
        const float g0 = p->hg_gn_g[l * 128 + vv2], g1 = p->hg_gn_g[l * 128 + vv2 + 1];
        *(unsigned*)(B.on + o) = pk2(o0 * rstd * g0 * bf2f(B.g[o]), o1 * rstd * g1 * bf2f(B.g[o + 1])); }
#pragma unroll
      for (int i = 0; i < 8; ++i) { sv[i] = svn[i]; lfv[i] = lfn[i]; kq[i] = kqn[i]; }
      vw = vwn;
    }
    __syncthreads();
  }
  if (sample_first) scan_prompt<0>(p, l, B, shm);
}

constexpr int KN_STRIDE = 72, VT_STRIDE = 260;
constexpr int KN_BYTES = 256 * KN_STRIDE * 2;
struct AtBufs { const bf16_t* qraw; const float* kvraw; bf16_t* on; const float* tab; };

DI void attn_phase(KP p, const int l, const AtBufs& B, unsigned char* shm) {
  const int tid = tid_get(), lane = tid & 63, wave = tid >> 6;
  const int j = l - 2;
  const float* qg = p->q_norm_g + j * 64; const float* sinkp = p->sinks + j * 16;
  const bool write_cache = (l == 2);
  const int nitems = 512 + 512;
#pragma unroll 1
  for (int item = blockIdx.x; item < 512; item += gridDim.x) {
    {
      const int b = item >> 7, qb = (item >> 2) & 31, kvh = item & 3;
      bf16_t* Kn = (bf16_t*)shm; bf16_t* Vt = (bf16_t*)(shm + KN_BYTES);
      const int band0 = (qb - 1) * 128;
      {
        const int key = tid >> 1, part = tid & 1; const int pos = band0 + key; const bool valid = pos >= 0;
        float x1[16], x2[16];
        if (valid) { const float* kp = B.kvraw + ((size_t)b * SEQ + pos) * 512 + kvh * 64 + part * 16;
#pragma unroll
          for (int i = 0; i < 4; ++i) { const f32x4 a = *(const f32x4*)(kp + 4 * i), c = *(const f32x4*)(kp + 32 + 4 * i);
#pragma unroll
            for (int e = 0; e < 4; ++e) { x1[4 * i + e] = a[e]; x2[4 * i + e] = c[e]; } }
        } else {
#pragma unroll
          for (int i = 0; i < 16; ++i) { x1[i] = 0.f; x2[i] = 0.f; } }
        float ss = 0.f;
#pragma unroll
        for (int i = 0; i < 16; ++i) ss += x1[i] * x1[i] + x2[i] * x2[i];
        ss += __shfl_xor(ss, 1);
        const float rstd = rsqrtf(ss * (1.f / 64.f) + EPS);
        const float* tb = B.tab + (size_t)(valid ? pos : 0) * 64 + part * 16;
        float o1[16], o2[16];
#pragma unroll
        for (int i = 0; i < 16; ++i) { const float a = x1[i] * rstd * p->k_norm_g[part * 16 + i], c = x2[i] * rstd * p->k_norm_g[32 + part * 16 + i];
          const float cs = tb[i], sn = tb[32 + i]; o1[i] = a * cs - c * sn; o2[i] = c * cs + a * sn; }
        u32x4 w;
        w = (u32x4){pk2(o1[0], o1[1]), pk2(o1[2], o1[3]), pk2(o1[4], o1[5]), pk2(o1[6], o1[7])}; *(u32x4*)(Kn + key * KN_STRIDE + part * 16) = w;
        w = (u32x4){pk2(o1[8], o1[9]), pk2(o1[10], o1[11]), pk2(o1[12], o1[13]), pk2(o1[14], o1[15])}; *(u32x4*)(Kn + key * KN_STRIDE + part * 16 + 8) = w;
        w = (u32x4){pk2(o2[0], o2[1]), pk2(o2[2], o2[3]), pk2(o2[4], o2[5]), pk2(o2[6], o2[7])}; *(u32x4*)(Kn + key * KN_STRIDE + 32 + part * 16) = w;
        w = (u32x4){pk2(o2[8], o2[9]), pk2(o2[10], o2[11]), pk2(o2[12], o2[13]), pk2(o2[14], o2[15])}; *(u32x4*)(Kn + key * KN_STRIDE + 32 + part * 16 + 8) = w;
        if (write_cache && qb == 31 && key >= 128) { float* ko = p->out + O_KP + ((size_t)(b * 128 + key - 128) * 4 + kvh) * 64 + part * 16;
#pragma unroll
          for (int i = 0; i < 4; ++i) { *(f32x4*)(ko + 4 * i) = (f32x4){o1[4 * i], o1[4 * i + 1], o1[4 * i + 2], o1[4 * i + 3]};
            *(f32x4*)(ko + 32 + 4 * i) = (f32x4){o2[4 * i], o2[4 * i + 1], o2[4 * i + 2], o2[4 * i + 3]}; } }
      }
      {
        const int key = tid & 255, dh = tid >> 8; const int pos = band0 + key; const bool valid = pos >= 0;
        const float* vp = B.kvraw + ((size_t)b * SEQ + (valid ? pos : 0)) * 512 + 256 + kvh * 64 + dh * 32;
#pragma unroll
        for (int i = 0; i < 8; ++i) { f32x4 a = *(const f32x4*)(vp + 4 * i); if (!valid) a = (f32x4){0.f, 0.f, 0.f, 0.f};
#pragma unroll
          for (int e = 0; e < 4; ++e) Vt[(dh * 32 + 4 * i + e) * VT_STRIDE + key] = (bf16_t)f2bf(a[e]);
          if (write_cache && qb == 31 && key >= 128) *(f32x4*)(p->out + O_VP + ((size_t)(b * 128 + key - 128) * 4 + kvh) * 64 + dh * 32 + 4 * i) = a; }
      }
      __syncthreads();
      const int g = wave & 3, qhalf = wave >> 2, hq = kvh * 4 + g, h = lane >> 5, l31 = lane & 31;
      const float sink = sinkp[hq] * 1.4426950408889634f;
#pragma unroll 1
      for (int sub = 0; sub < 2; ++sub) {
        const int Q0 = 128 + qhalf * 64 + sub * 32, qi = Q0 + l31, pos = band0 + qi;
        const size_t tok = (size_t)b * SEQ + pos;
        float x[4][8];
        { const bf16_t* qp = B.qraw + tok * D + hq * 64 + 8 * h;
#pragma unroll
          for (int s = 0; s < 4; ++s) { const u32x4 w = *(const u32x4*)(qp + 16 * s);
#pragma unroll
            for (int e = 0; e < 4; ++e) { x[s][2 * e] = bf2f(w[e] & 0xffffu); x[s][2 * e + 1] = bf2f(w[e] >> 16); } } }
        float ss = 0.f;
#pragma unroll
        for (int s = 0; s < 4; ++s)
#pragma unroll
          for (int e = 0; e < 8; ++e) ss += x[s][e] * x[s][e];
        ss += __shfl_xor(ss, 32);
        const float rstd = rsqrtf(ss * (1.f / 64.f) + EPS) ;
#pragma unroll
        for (int s = 0; s < 4; ++s)
#pragma unroll
          for (int e = 0; e < 8; ++e) x[s][e] *= rstd * qg[16 * s + 8 * h + e];
        const float* tb = B.tab + (size_t)pos * 64;
        bf16x8 qf[4];
#pragma unroll
        for (int s = 0; s < 2; ++s) { unsigned lo[4], hi[4]; float r1[8], r2[8];
#pragma unroll
          for (int e = 0; e < 8; ++e) { const int i = 16 * s + 8 * h + e; const float cs = tb[i], sn = tb[32 + i]; const float a = x[s][e], c = x[s + 2][e];
            r1[e] = (a * cs - c * sn) * (0.125f * 1.4426950408889634f); r2[e] = (c * cs + a * sn) * (0.125f * 1.4426950408889634f); }
#pragma unroll
          for (int e = 0; e < 4; ++e) { lo[e] = pk2(r1[2 * e], r1[2 * e + 1]); hi[e] = pk2(r2[2 * e], r2[2 * e + 1]); }
          qf[s] = __builtin_bit_cast(bf16x8, (u32x4){lo[0], lo[1], lo[2], lo[3]}); qf[s + 2] = __builtin_bit_cast(bf16x8, (u32x4){hi[0], hi[1], hi[2], hi[3]}); }
        const int kb0 = (Q0 - 128) >> 5;
        f32x16 sacc[5]; float mx = sink;
#pragma unroll
        for (int i = 0; i < 5; ++i) { const int kb = kb0 + i; f32x16 a16;
#pragma unroll
          for (int r = 0; r < 16; ++r) a16[r] = 0.f;
          bf16x8 ka[4];
#pragma unroll
          for (int s = 0; s < 4; ++s) ka[s] = *(const bf16x8*)(Kn + (kb * 32 + l31) * KN_STRIDE + 16 * s + 8 * h);
#pragma unroll
          for (int s = 0; s < 4; ++s) a16 = __builtin_amdgcn_mfma_f32_32x32x16_bf16(ka[s], qf[s], a16, 0, 0, 0);
#pragma unroll
          for (int r = 0; r < 16; ++r) { const int key = kb * 32 + crow(r, h); const int rel = qi - key; const bool ok = (rel >= 0) && (rel < 128) && (qb > 0 || key >= 128);
            const float sv = ok ? a16[r] : -1e30f; a16[r] = sv; mx = fmaxf(mx, sv); }
          sacc[i] = a16; }
        mx = fmaxf(mx, __shfl_xor(mx, 32));
        float sum = 0.f; bf16x8 pf[5][2];
#pragma unroll
        for (int i = 0; i < 5; ++i) { float e[16];
#pragma unroll
          for (int r = 0; r < 16; ++r) { e[r] = __builtin_amdgcn_exp2f(sacc[i][r] - mx); sum += e[r]; }
#pragma unroll
          for (int st = 0; st < 2; ++st) pf[i][st] = __builtin_bit_cast(bf16x8, (u32x4){pk2(e[8 * st], e[8 * st + 1]), pk2(e[8 * st + 2], e[8 * st + 3]), pk2(e[8 * st + 4], e[8 * st + 5]), pk2(e[8 * st + 6], e[8 * st + 7])}); }
        sum += __shfl_xor(sum, 32);
        const float inv = 1.f / (sum + __builtin_amdgcn_exp2f(sink - mx));
#pragma unroll
        for (int db = 0; db < 2; ++db) { f32x16 o16;
#pragma unroll
          for (int r = 0; r < 16; ++r) o16[r] = 0.f;
          bf16x8 va[10];
#pragma unroll
          for (int i = 0; i < 5; ++i)
#pragma unroll
            for (int st = 0; st < 2; ++st) { const bf16_t* vp = Vt + (db * 32 + l31) * VT_STRIDE + (kb0 + i) * 32 + 16 * st + 4 * h;
              const u32x2 lo = *(const u32x2*)vp, hi = *(const u32x2*)(vp + 8);
              va[i * 2 + st] = __builtin_bit_cast(bf16x8, (u32x4){lo[0], lo[1], hi[0], hi[1]}); }
          f32x16 o16b;
#pragma unroll
          for (int r = 0; r < 16; ++r) o16b[r] = 0.f;
#pragma unroll
          for (int i = 0; i < 5; ++i) { o16 = __builtin_amdgcn_mfma_f32_32x32x16_bf16(va[i * 2], pf[i][0], o16, 0, 0, 0); o16b = __builtin_amdgcn_mfma_f32_32x32x16_bf16(va[i * 2 + 1], pf[i][1], o16b, 0, 0, 0); }
#pragma unroll
          for (int r = 0; r < 16; ++r) o16[r] += o16b[r];
          bf16_t* op = B.on + tok * D + hq * 64 + db * 32 + 4 * h;
#pragma unroll
          for (int r4 = 0; r4 < 4; ++r4) *(u32x2*)(op + 8 * r4) = (u32x2){pk2(o16[4 * r4] * inv, o16[4 * r4 + 1] * inv), pk2(o16[4 * r4 + 2] * inv, o16[4 * r4 + 3] * inv)}; }
      }
      __syncthreads();
    }
  }
  {
    const int tid = tid_get(), lane = tid & 63, wave = tid >> 6;
#pragma unroll 1
    for (int item = 512 + blockIdx.x; item < nitems; item += gridDim.x) {
      const int sidx = item - 512, bs = sidx >> 2, kvh = sidx & 3; const size_t r = TP + bs;
      float* Ks = (float*)shm; float* Vs = Ks + 128 * 68; float* q_s = Vs + 128 * 64; float* p_s = q_s + 256; float* redm = p_s + 512; float* reds = redm + 8; float* po = reds + 8;
      const float* tb = B.tab + (size_t)4096 * 64;
      f32x4 kreg[4], vreg[4];
#pragma unroll
      for (int i = 0; i < 4; ++i) { const int e = tid + 512 * i, jr = e >> 4, c4 = (e & 15) * 4;
        if (jr < 127) { const size_t o = (((size_t)bs * 128 + jr + 1) * 4 + kvh) * 64 + c4; kreg[i] = __builtin_nontemporal_load((const f32x4*)(p->cache_k + o)); vreg[i] = __builtin_nontemporal_load((const f32x4*)(p->cache_v + o)); } }
      if (tid < 128) { const int g = tid >> 5, i = tid & 31, hq = kvh * 4 + g;
        float a = bf2f(B.qraw[r * D + hq * 64 + i]), c = bf2f(B.qraw[r * D + hq * 64 + 32 + i]);
        float ss = a * a + c * c;
#pragma unroll
        for (int o = 1; o < 32; o <<= 1) ss += __shfl_xor(ss, o);
        const float rstd = rsqrtf(ss * (1.f / 64.f) + EPS); a *= rstd * qg[i]; c *= rstd * qg[32 + i];
        const float cs = tb[i], sn = tb[32 + i];
        q_s[g * 64 + i] = (a * cs - c * sn) * 0.125f; q_s[g * 64 + 32 + i] = (c * cs + a * sn) * 0.125f;
      } else if (tid < 160) { const int i = tid & 31;
        float a = B.kvraw[r * 512 + kvh * 64 + i], c = B.kvraw[r * 512 + kvh * 64 + 32 + i];
        float ss = a * a + c * c;
#pragma unroll
        for (int o = 1; o < 32; o <<= 1) ss += __shfl_xor(ss, o);
        const float rstd = rsqrtf(ss * (1.f / 64.f) + EPS); a *= rstd * p->k_norm_g[i]; c *= rstd * p->k_norm_g[32 + i];
        const float cs = tb[i], sn = tb[32 + i];
        const float k1 = a * cs - c * sn, k2 = c * cs + a * sn, v1 = B.kvraw[r * 512 + 256 + kvh * 64 + i], v2 = B.kvraw[r * 512 + 256 + kvh * 64 + 32 + i];
        Ks[127 * 68 + i] = k1; Ks[127 * 68 + 32 + i] = k2; Vs[127 * 64 + i] = v1; Vs[127 * 64 + 32 + i] = v2;
        if (write_cache) { float* ok = p->out + O_KS + (((size_t)bs * 128 + 127) * 4 + kvh) * 64; float* ov = p->out + O_VS + (((size_t)bs * 128 + 127) * 4 + kvh) * 64;
          ok[i] = k1; ok[32 + i] = k2; ov[i] = v1; ov[32 + i] = v2; } }
#pragma unroll
      for (int i = 0; i < 4; ++i) { const int e = tid + 512 * i, jr = e >> 4, c4 = (e & 15) * 4;
        if (jr < 127) { *(f32x4*)(Ks + jr * 68 + c4) = kreg[i]; *(f32x4*)(Vs + jr * 64 + c4) = vreg[i];
          if (write_cache) { const size_t o = (((size_t)bs * 128 + jr) * 4 + kvh) * 64 + c4; __builtin_nontemporal_store(kreg[i], (f32x4*)(p->out + O_KS + o)); __builtin_nontemporal_store(vreg[i], (f32x4*)(p->out + O_VS + o)); } } }
      __syncthreads();
      const int g = tid >> 7, jk = tid & 127, hq = kvh * 4 + g; const float sink = sinkp[hq];
      float sc = 0.f;
#pragma unroll
      for (int d4 = 0; d4 < 16; ++d4) { const f32x4 kv = *(const f32x4*)(Ks + jk * 68 + 4 * d4), qv = *(const f32x4*)(q_s + g * 64 + 4 * d4); sc += kv[0] * qv[0] + kv[1] * qv[1] + kv[2] * qv[2] + kv[3] * qv[3]; }
      float mx = sc;
#pragma unroll
      for (int o = 1; o < 64; o <<= 1) mx = fmaxf(mx, __shfl_xor(mx, o));
      if (lane == 0) redm[wave] = mx;
      __syncthreads();
      mx = fmaxf(fmaxf(redm[2 * g], redm[2 * g + 1]), sink);
      const float ev = __expf(sc - mx); float sum = ev;
#pragma unroll
      for (int o = 1; o < 64; o <<= 1) sum += __shfl_xor(sum, o);
      if (lane == 0) reds[wave] = sum;
      p_s[g * 128 + jk] = ev;
      __syncthreads();
      const float inv = 1.f / (reds[2 * g] + reds[2 * g + 1] + __expf(sink - mx));
      { const int d = jk & 63, jh = jk >> 6; float o = 0.f;
#pragma unroll 8
        for (int jx = 0; jx < 64; ++jx) o += p_s[g * 128 + jh * 64 + jx] * Vs[(jh * 64 + jx) * 64 + d];
        po[tid] = o;
        __syncthreads();
        if (jh == 0) { const float tot = (o + po[tid + 64]) * inv; B.on[r * D + hq * 64 + d] = (bf16_t)f2bf(tot); } }
      __syncthreads();
    }
  }
}

#define XB_TMO      128
#define XB_XCNT(j)  (256  + 64 * (j))
#define XB_XSUB(j)  (1280 + 64 * (j))
#define XB_XGEN(j)  (2304 + 64 * (j))
#define XB_TOP      3328
#define XB_TOPGEN   3392
#define XCD_BAR_WORDS 3456
#define XB_SPIN_CAP (1u << 18)

__device__ __forceinline__ unsigned xb_ld(unsigned* p)              { return __hip_atomic_load(p, __ATOMIC_RELAXED, __HIP_MEMORY_SCOPE_AGENT); }
__device__ __forceinline__ unsigned xb_add(unsigned* p, unsigned v) { return __hip_atomic_fetch_add(p, v, __ATOMIC_RELAXED, __HIP_MEMORY_SCOPE_AGENT); }
__device__ __forceinline__ unsigned xb_xcc_id() { return (unsigned)__builtin_amdgcn_s_getreg((3 << 11) | 20) & 0xFu; }
#define XB_SPIN(cond, bar) do { unsigned _sp = 0; while (cond) { __builtin_amdgcn_s_sleep(1); \
    if ((++_sp & 255u) == 0u) { if (xb_ld(&(bar)[XB_TMO])) break; if (_sp > XB_SPIN_CAP) { atomicAdd(&(bar)[XB_TMO], 1u); break; } } } } while (0)

struct XcdBarrier {
    unsigned* bar; unsigned x;
    volatile LAS unsigned* st;
};

__device__ __forceinline__ XcdBarrier xcd_barrier_post(unsigned* bar, volatile LAS unsigned* st) {
    XcdBarrier b; b.bar = bar; b.x = xb_xcc_id(); b.st = st;
    if (threadIdx.x == 0) (void)xb_add(&bar[XB_XCNT(b.x)], 1u);
    return b;
}
__device__ __forceinline__ void xcd_barrier_complete(unsigned* bar, unsigned x, unsigned& nloc, unsigned& nx) {
    const unsigned G = gridDim.x * gridDim.y * gridDim.z;
    unsigned sum, cnt, mine, sp = 0u;
    for (;;) {
        sum = 0u; cnt = 0u; mine = 0u;
#pragma unroll
        for (unsigned j = 0; j < 16; ++j) { const unsigned c = xb_ld(&bar[XB_XCNT(j)]); sum += c; cnt += (c > 0u) ? 1u : 0u; mine = (j == x) ? c : mine; }
        if (sum == G) break;
        __builtin_amdgcn_s_sleep(1);
        if ((++sp & 255u) == 0u) { if (xb_ld(&bar[XB_TMO])) break; if (sp > XB_SPIN_CAP) { atomicAdd(&bar[XB_TMO], 1u); break; } }
    }
    nloc = mine > 0u ? mine : 1u; nx = cnt > 0u ? cnt : 1u;
}

__device__ __forceinline__ void xcd_barrier(const XcdBarrier& b) {
    asm volatile("s_waitcnt vmcnt(0)" ::: "memory");
    __syncthreads();
    if (threadIdx.x == 0) {
        unsigned* bar = b.bar;
        __builtin_amdgcn_s_waitcnt(0);
        unsigned nloc = b.st[0], nx = b.st[1];
        if (nloc == 0u) { xcd_barrier_complete(bar, b.x, nloc, nx); b.st[0] = nloc; b.st[1] = nx; }
        const unsigned old = xb_add(&bar[XB_XSUB(b.x)], 1u);
        const unsigned gen = old / nloc;
        if (old + 1u == (gen + 1u) * nloc) {
            __builtin_amdgcn_fence(__ATOMIC_RELEASE, "agent");
            asm volatile("s_waitcnt vmcnt(0)" ::: "memory");
            const unsigned og = xb_add(&bar[XB_TOP], 1u);
            const unsigned tg = og / nx;
            if (og + 1u == (tg + 1u) * nx) xb_add(&bar[XB_TOPGEN], 1u);
            else XB_SPIN(xb_ld(&bar[XB_TOPGEN]) == tg, bar);
            __builtin_amdgcn_fence(__ATOMIC_ACQUIRE, "agent");
            xb_add(&bar[XB_XGEN(b.x)], 1u);
            asm volatile("s_waitcnt vmcnt(0)" ::: "memory");
        } else {
            XB_SPIN(xb_ld(&bar[XB_XGEN(b.x)]) == gen, bar);
            __builtin_amdgcn_fence(__ATOMIC_ACQUIRE, "agent");
            asm volatile("s_waitcnt vmcnt(0)" ::: "memory");
        }
    }
    __syncthreads();
}


__global__ void __launch_bounds__(NTHREADS, 2) yoco_fwd(P parg) {
  extern __shared__ __attribute__((aligned(16))) unsigned char shm[];
  cg::grid_group grid = cg::this_grid();
  volatile LAS unsigned* xst = (volatile LAS unsigned*)((LAS unsigned char*)shm + 131072);
  if (threadIdx.x < 4) xst[threadIdx.x] = 0u;
  __syncthreads();
  const int nMt = TP / BM;
#pragma unroll 1
  for (int step = -2; step < 32; ++step) {
    const int l = (step < 0) ? 0 : (step >> 3), sub = (step < 0) ? (8 + step + 2) : (step & 7); const bool hg = (l < 2);
    if (sub == 3 && !hg) continue;
    if (sub == 5 || (sub == 0 && l > 0)) continue;
    KP p = kp_get(); unsigned char* ws = p->ws;
#ifndef PROBE_REPS
#define PROBE_REPS 1
#endif
#ifndef PROBE_GREPS
#define PROBE_GREPS 1
#endif
    const bool is_gemm = (sub == 0 || sub == 1 || sub == 4 || sub == 6 || sub == 7 || sub == 9);
#ifndef PROBE_MASK
#define PROBE_MASK 0
#endif
    const int pcode = (sub == 2 && !hg) ? 10 : sub;
    const int reps = (((PROBE_MASK >> pcode) & 1) && !(sub == 4 || sub == 7)) ? 2 : 1;
#pragma unroll 1
    for (int rep = 0; rep < reps; ++rep) {
    if (sub == 8) {
      prep_phase(p, shm);
    } else if (sub == 0 || sub == 1 || sub == 4 || sub == 6 || sub == 7 || sub == 9) {
      float* mods = (float*)(ws + OFF_MODS);
      bf16_t* hbuf = (bf16_t*)(ws + OFF_H); bf16_t* onbuf = (bf16_t*)(ws + OFF_ON); bf16_t* ubuf = (bf16_t*)(ws + OFF_U);
      GemmJob j0, j1; EpiArgs E{}; int nj = 1; E.layer = l; E.first = 0;
      float* rssb = (float*)(ws + OFF_RSS); const float* biasb = (const float*)(ws + OFF_BIAS);
      j1.A = (const bf16_t*)(ws + OFF_X); j1.Bt = (const bf16_t*)(ws + OFF_WKV); j1.nM = nMt; j1.nN = 2; j1.K = D; j1.epi = EPI_KVRAW;
      j0.nM = nMt; j0.K = D;
      if (sub == 0) { j0.A = (const bf16_t*)(ws + OFF_ASH); j0.Bt = (const bf16_t*)ws; j0.nM = 1; j0.nN = 106; j0.epi = EPI_BIAS; j1.A = (const bf16_t*)(ws + OFF_BIAS); }
      else if (sub == 9) { j0.A = (const bf16_t*)(ws + OFF_X + (size_t)MODW * D * 2); j0.Bt = (const bf16_t*)(ws + OFF_X); j0.nM = 1; j0.nN = MODW / BM; j0.epi = EPI_ADA; E.f0 = mods; E.ash = (bf16_t*)(ws + OFF_ASH); }
      else if (sub == 1 && hg) { E.rss = rssb + (size_t)(2 * l) * T; E.bias = biasb + (size_t)132 * site_prefN(l); E.bN = 4096; j0.A = hbuf; j0.Bt = (const bf16_t*)(ws + OFF_WIN) + (size_t)l * 4096 * D; j0.nN = 16; j0.epi = EPI_HGIN;
        E.f0 = (float*)(ws + OFF_X); E.b0 = (bf16_t*)(ws + OFF_U); E.b1 = (bf16_t*)(ws + OFF_U + SZ_ACT); E.b2 = (bf16_t*)(ws + OFF_U + 2 * SZ_ACT); E.b3 = (bf16_t*)(ws + OFF_U + 3 * SZ_ACT); }
      else if (sub == 1) { E.rss = rssb + (size_t)(2 * l) * T; E.bias = biasb + (size_t)132 * site_prefN(l); E.bN = 1024; E.bias1 = biasb + (size_t)132 * site_prefN(4); E.bN1 = 512; j0.A = hbuf; j0.Bt = (const bf16_t*)(ws + OFF_WQ) + (size_t)(l - 2) * D * D; j0.nN = 4; j0.epi = EPI_QRAW;
        E.b1 = (bf16_t*)(ws + OFF_X + SZ_ACT); E.f2 = (float*)(ws + OFF_X + 2 * SZ_ACT); nj = (l == 2) ? 2 : 1; }
      else if (sub == 4) { E.rss_out = rssb + (size_t)(1 + 2 * l) * T; E.ng = p->norm2_g + l * D; E.nsc = mods + l * 6144 + 4096; E.yout = hbuf; j0.A = onbuf; j0.Bt = hg ? (const bf16_t*)(ws + OFF_WOUT) + (size_t)l * D * D : (const bf16_t*)(ws + OFF_WO) + (size_t)(l - 2) * D * D; j0.nN = 4; j0.epi = EPI_RESID;
        E.f0 = p->out + O_Y; E.f1 = mods + l * 6144 + 2048; E.first = (l == 0); }
      else if (sub == 6) { E.rss = rssb + (size_t)(1 + 2 * l) * T; E.bias = biasb + (size_t)132 * site_prefN(5 + l); E.bN = 4096; j0.A = hbuf; j0.Bt = (const bf16_t*)(ws + OFF_WUP) + (size_t)l * D * FF; j0.nN = 16; j0.epi = EPI_UP; E.b0 = ubuf; }
      else { if (l < 3) { E.rss_out = rssb + (size_t)(2 * (l + 1)) * T; E.ng = p->norm1_g + (l + 1) * D; E.nsc = mods + (l + 1) * 6144 + 1024; E.yout = hbuf;
          if (l == 1) { E.ngkv = p->kv_norm_g; E.nsckv = mods + 24576 + 1024; E.ykv = (bf16_t*)(ws + OFF_X); } }
        j0.A = ubuf; j0.Bt = (const bf16_t*)(ws + OFF_WDN) + (size_t)l * D * FF; j0.nN = 4; j0.K = FF; j0.epi = EPI_RESID; E.f0 = p->out + O_Y; E.f1 = mods + l * 6144 + 5120; }
      gemm_phase(p, (LAS unsigned char*)shm, shm, j0, j1, nj, E, sub != 9 && sub != 0);
      if (sub == 0) init_rows(p, (unsigned*)(ws + OFF_BAR) + XCD_BAR_WORDS + 100);
    } else if (sub == 2 && hg) {
      HgBufs HB; HB.q = (bf16_t*)(ws + OFF_U); HB.k = (bf16_t*)(ws + OFF_U + SZ_ACT); HB.v = (bf16_t*)(ws + OFF_U + 2 * SZ_ACT); HB.g = (bf16_t*)(ws + OFF_U + 3 * SZ_ACT);
      HB.lf = (float*)(ws + OFF_X); HB.o32 = (float*)(ws + OFF_X + 2 * SZ_ACT); HB.on = (bf16_t*)(ws + OFF_ON);
      scan_phase(p, l, HB, shm);
    } else if (sub == 2) {
      AtBufs AB; AB.qraw = (bf16_t*)(ws + OFF_X + SZ_ACT); AB.kvraw = (float*)(ws + OFF_X + 2 * SZ_ACT); AB.on = (bf16_t*)(ws + OFF_ON); AB.tab = (const float*)(ws + OFF_TAB);
      attn_phase(p, l, AB, shm);
    } else {
      HgBufs HB; HB.q = (bf16_t*)(ws + OFF_U); HB.k = (bf16_t*)(ws + OFF_U + SZ_ACT); HB.v = (bf16_t*)(ws + OFF_U + 2 * SZ_ACT); HB.g = (bf16_t*)(ws + OFF_U + 3 * SZ_ACT);
      HB.lf = (float*)(ws + OFF_X); HB.o32 = (float*)(ws + OFF_X + 2 * SZ_ACT); HB.on = (bf16_t*)(ws + OFF_ON);
      scan_passB(HB);
      { KP pb = kp_get(); XcdBarrier xb; xb.bar = (unsigned*)(pb->ws + OFF_BAR); xb.x = xb_xcc_id(); xb.st = xst; xcd_barrier(xb); }
      scan_prompt<1>(p, l, HB, shm);
    }
    }
    if (step == 31) break;
    if (step == -2) { grid.sync(); KP p0 = kp_get(); if (tid_get() == 0) (void)xb_add((unsigned*)(p0->ws + OFF_BAR) + XB_XCNT(xb_xcc_id()), 1u); }
    else { KP pb = kp_get(); XcdBarrier xb; xb.bar = (unsigned*)(pb->ws + OFF_BAR); xb.x = xb_xcc_id(); xb.st = xst; xcd_barrier(xb); }
  }
}

extern "C" void kernel_launch(void* const* d_in, const int* in_sizes, int n_in, void* d_out, int out_size, void* d_ws, size_t ws_size, hipStream_t stream) {
  static int grid_blocks = 0;
  if (!grid_blocks) {
    int dev = 0, cus = 0, per_cu = 0;
    hipGetDevice(&dev);
    hipDeviceGetAttribute(&cus, hipDeviceAttributeMultiprocessorCount, dev);
    if (hipFuncSetAttribute((const void*)yoco_fwd, hipFuncAttributeMaxDynamicSharedMemorySize, LDS_BYTES) != hipSuccess) fprintf(stderr, "hipFuncSetAttribute failed\n");
    if (hipOccupancyMaxActiveBlocksPerMultiprocessor(&per_cu, (const void*)yoco_fwd, NTHREADS, LDS_BYTES) != hipSuccess || per_cu < 1) { fprintf(stderr, "occupancy query failed\n"); per_cu = 1; }
    grid_blocks = cus * per_cu;
    if (ws_size < WS_NEED) fprintf(stderr, "workspace too small: %zu < %zu\n", ws_size, (size_t)WS_NEED);
  }
  P p{};
  const float** pp = (const float**)&p;
  for (int i = 0; i < 26; ++i) pp[i] = (const float*)d_in[i];
  p.out = (float*)d_out; p.ws = (unsigned char*)d_ws;
  void* args[] = {&p};
  hipError_t e = hipLaunchCooperativeKernel((const void*)yoco_fwd, dim3(grid_blocks), dim3(NTHREADS), args, LDS_BYTES, stream);
  if (e != hipSuccess) fprintf(stderr, "cooperative launch failed: %s (grid %d)\n", hipGetErrorString(e), grid_blocks);
}
```

```cpp
#include <hip/hip_runtime.h>
#include <hip/hip_cooperative_groups.h>
#include <cstdio>
#include <cstdint>
namespace cg = cooperative_groups;

#define DI __device__ __forceinline__
typedef unsigned short bf16_t;
typedef short bf16x8 __attribute__((ext_vector_type(8)));
typedef float f32x4 __attribute__((ext_vector_type(4)));
typedef float f32x2 __attribute__((ext_vector_type(2)));
typedef float f32x16 __attribute__((ext_vector_type(16)));
typedef unsigned u32x4 __attribute__((ext_vector_type(4)));
typedef unsigned u32x2 __attribute__((ext_vector_type(2)));
#define LAS __attribute__((address_space(3)))

constexpr int D = 1024, FF = 4096, TP = 16384, TS = 128, T = TP + TS, TPAD = 16640, SEQ = 4096;
constexpr int NMOD = 132, MODW = 4 * 6144 + 2048;
constexpr float EPS = 1e-6f;
constexpr int NTHREADS = 512, NWAVES = 8;
constexpr int LDS_BYTES = 131072 + 16;

constexpr size_t O_Y = 0;
constexpr size_t O_HGP = (size_t)T * D;
constexpr size_t O_KP = O_HGP + (size_t)2 * 4 * 8 * 128 * 128;
constexpr size_t O_VP = O_KP + (size_t)4 * 128 * 4 * 64;
constexpr size_t O_HGS = O_VP + (size_t)4 * 128 * 4 * 64;
constexpr size_t O_KS = O_HGS + (size_t)2 * 128 * 8 * 128 * 128;
constexpr size_t O_VS = O_KS + (size_t)128 * 128 * 4 * 64;

constexpr size_t SZ_ACT = (size_t)TPAD * D * 2;
constexpr size_t OFF_WIN = 0;
constexpr size_t OFF_WOUT = OFF_WIN + (size_t)2 * 4096 * 1024 * 2;
constexpr size_t OFF_WKV = OFF_WOUT + (size_t)2 * 1024 * 1024 * 2;
constexpr size_t OFF_WQ = OFF_WKV + (size_t)512 * 1024 * 2;
constexpr size_t OFF_WO = OFF_WQ + (size_t)2 * 1024 * 1024 * 2;
constexpr size_t OFF_WUP = OFF_WO + (size_t)2 * 1024 * 1024 * 2;
constexpr size_t OFF_WDN = OFF_WUP + (size_t)4 * 4096 * 1024 * 2;
constexpr size_t OFF_MODS = OFF_WDN + (size_t)4 * 4096 * 1024 * 2;
constexpr size_t OFF_TAB = OFF_MODS + (((size_t)NMOD * MODW * 4 + 4095) & ~(size_t)4095);
constexpr size_t OFF_H = OFF_TAB + (((size_t)4097 * 64 * 4 + 4095) & ~(size_t)4095);
constexpr size_t OFF_ON = OFF_H + SZ_ACT;
constexpr size_t OFF_U = OFF_ON + SZ_ACT;
constexpr size_t OFF_X = OFF_U + 4 * SZ_ACT;
constexpr size_t OFF_BAR = OFF_X + 4 * SZ_ACT;
constexpr size_t BAR_BYTES = 16384;
constexpr size_t OFF_RSS = OFF_BAR + BAR_BYTES;
constexpr size_t ZERO_BYTES = BAR_BYTES + (size_t)9 * T * 4;
constexpr size_t OFF_ASH = OFF_BAR + ((ZERO_BYTES + 4095) & ~(size_t)4095);
constexpr size_t OFF_BIAS = OFF_ASH + (size_t)9 * 256 * 1024 * 2;
constexpr size_t WS_NEED = OFF_BIAS + (size_t)132 * 27136 * 4;

struct P {
  const float *x_prompt, *x_sample, *c_prompt, *c_sample, *state_hgrn, *cache_k, *cache_v;
  const float *w_ada, *b_ada, *norm1_g, *norm2_g, *hg_w_in, *hg_w_out, *hg_lbp, *hg_gn_g;
  const float *kv_w_ada, *kv_b_ada, *kv_norm_g, *w_kv, *k_norm_g, *w_q, *q_norm_g, *sinks, *w_o, *w_up, *w_down;
  float* out; unsigned char* ws;
};

typedef const P __attribute__((address_space(4)))* KP;
DI KP kp_get() { KP q = (KP)__builtin_amdgcn_kernarg_segment_ptr(); asm volatile("" : "+s"(q)); return q; }
DI int tid_get() { int t = threadIdx.x; asm volatile("" : "+v"(t)); return t; }
DI unsigned f2bf(float f) { unsigned u = __float_as_uint(f); return (u + 0x7fffu + ((u >> 16) & 1u)) >> 16; }
typedef __bf16 bf16x2_n __attribute__((ext_vector_type(2)));
DI unsigned pk2(float lo, float hi) { return __builtin_bit_cast(unsigned, __builtin_convertvector((f32x2){lo, hi}, bf16x2_n)); }
DI float bf2f(unsigned b) { return __uint_as_float(b << 16); }
DI float silu_f(float x) { return x * __builtin_amdgcn_rcpf(1.f + __expf(-x)); }
DI int modrow(int r) { return r < TP ? (r >> 12) : (4 + r - TP); }
DI int crow(int reg, int h) { return (reg & 3) + 8 * (reg >> 2) + 4 * h; }

constexpr int BM = 256, BK = 64, HALF = 128, HTB = HALF * BK * 2;
DI int lds_byte(int r, int c) { const int st = (r >> 4) * 2 + (c >> 5), rr = r & 15, cc = c & 31, ob = rr * 64 + cc * 2; return st * 1024 + (ob ^ (((ob >> 9) & 1) << 5)); }
DI void stage_rc(int b, int& R, int& C) { const int st = b / 1024, sb = b % 1024, swz = sb ^ (((sb >> 9) & 1) << 5); R = (st >> 1) * 16 + swz / 64; C = (st & 1) * 32 + (swz % 64) / 2; }

enum { EPI_ADA = 0, EPI_HGIN = 1, EPI_RESID = 2, EPI_UP = 3, EPI_QRAW = 4, EPI_KVRAW = 5, EPI_NOP = 6, EPI_BIAS = 7 };
struct GemmJob { const bf16_t* A; const bf16_t* Bt; int nM, nN, K, epi; };
struct EpiArgs {
  float* f0; const float* f1; float* f2; bf16_t* b0; bf16_t* b1; bf16_t* b2; bf16_t* b3; int layer; int first;
  const float* rss; const float* bias; const float* bias1; int bN, bN1;
  float* rss_out; const float* ng; const float* nsc; bf16_t* yout; const float* ngkv; const float* nsckv; bf16_t* ykv;
  bf16_t* ash;
};
DI int site_N(const int s) { return (s == 2 || s == 3) ? 1024 : (s == 4 ? 512 : 4096); }
DI int site_prefN(const int s) { return s == 0 ? 0 : s == 1 ? 4096 : s == 2 ? 8192 : s == 3 ? 9216 : s == 4 ? 10240 : 10752 + (s - 5) * 4096; }

DI void tile_of(int L, int nM, int nN, int& pm, int& pn) {
  const int nwg = nM * nN; int wgid = L;
  { const int q = nwg / 8, r = nwg % 8, xcd = wgid % 8, off = wgid / 8; wgid = (xcd < r ? xcd * (q + 1) : r * (q + 1) + (xcd - r) * q) + off; }
  const int nig = 8 * nN, gid = wgid / nig, fm = gid * 8, gsz = (nM - fm) < 8 ? (nM - fm) : 8;
  pm = fm + ((wgid % nig) % gsz); pn = (wgid % nig) / gsz;
}

DI void epi_frag(KP p, const int epi, const EpiArgs& E, const int r, const int c, const f32x4 vin) {
  if (epi == EPI_NOP) return;
  f32x4 v = vin;
  if (epi == EPI_HGIN || epi == EPI_UP || epi == EPI_QRAW || epi == EPI_KVRAW) {
    const float rstd = rsqrtf(E.rss[r] * (1.f / D) + EPS);
    const float* bp = ((epi == EPI_KVRAW) ? E.bias1 + (size_t)modrow(r) * E.bN1 : E.bias + (size_t)modrow(r) * E.bN) + c;
    v = v * rstd + *(const f32x4*)bp; }
  if (epi == EPI_HGIN) {
    const int sec = c >> 10, cc = c & 1023; const size_t o = (size_t)r * D + cc;
    if (sec == 1) { f32x4 lb = (f32x4){0.f, 0.f, 0.f, 0.f};
      if (E.layer == 1) { const f32x4 l0 = *(const f32x4*)(p->hg_lbp + cc), l1 = *(const f32x4*)(p->hg_lbp + D + cc);
#pragma unroll
        for (int j = 0; j < 4; ++j) lb[j] = __builtin_amdgcn_rcpf(1.f + __expf(l0[j] - l1[j])); }
      f32x4 lf;
#pragma unroll
      for (int j = 0; j < 4; ++j) { const float sg = __builtin_amdgcn_rcpf(1.f + __expf(-v[j])); const float fg = lb[j] + (1.f - lb[j]) * sg; lf[j] = __builtin_amdgcn_logf(fg);     }
      *(f32x4*)(E.f0 + o) = lf;
    } else if (sec == 2) { *(u32x2*)(E.b2 + o) = (u32x2){pk2(v[0], v[1]), pk2(v[2], v[3])};
    } else { bf16_t* dst = (sec == 0) ? E.b0 : E.b3; *(u32x2*)(dst + o) = (u32x2){pk2(silu_f(v[0]), silu_f(v[1])), pk2(silu_f(v[2]), silu_f(v[3]))}; }
  } else if (epi == EPI_RESID) {
    const float* xin = E.first ? (r < TP ? p->x_prompt + (size_t)r * D : p->x_sample + (size_t)(r - TP) * D) : (E.f0 + (size_t)r * D);
    const size_t mo = (size_t)modrow(r) * MODW;
    const f32x4 xv = *(const f32x4*)(xin + c), gv = *(const f32x4*)(E.f1 + mo + c);
    const f32x4 yn = xv + gv * v;
    *(f32x4*)(E.f0 + (size_t)r * D + c) = yn;
    if (E.yout) {
      const f32x4 g = *(const f32x4*)(E.ng + c), sc = *(const f32x4*)(E.nsc + mo + c); const f32x4 y = yn * g * (sc + 1.f);
      *(u32x2*)(E.yout + (size_t)r * D + c) = (u32x2){pk2(y[0], y[1]), pk2(y[2], y[3])};
      if (E.ykv) { const f32x4 g2 = *(const f32x4*)(E.ngkv + c), sc2 = *(const f32x4*)(E.nsckv + mo + c); const f32x4 y2 = yn * g2 * (sc2 + 1.f);
        *(u32x2*)(E.ykv + (size_t)r * D + c) = (u32x2){pk2(y2[0], y2[1]), pk2(y2[2], y2[3])}; }
      float ss = yn[0] * yn[0] + yn[1] * yn[1] + yn[2] * yn[2] + yn[3] * yn[3];
      ss += __shfl_xor(ss, 1); ss += __shfl_xor(ss, 2);
      if ((tid_get() & 3) == 0) atomicAdd(E.rss_out + r, ss); }
  } else if (epi == EPI_UP) {
    f32x4 u;
#pragma unroll
    for (int j = 0; j < 4; ++j) { const float t = fmaxf(v[j], 0.f); u[j] = t * t; }
    *(u32x2*)(E.b0 + (size_t)r * FF + c) = (u32x2){pk2(u[0], u[1]), pk2(u[2], u[3])};
  } else if (epi == EPI_QRAW) { *(u32x2*)(E.b1 + (size_t)r * D + c) = (u32x2){pk2(v[0], v[1]), pk2(v[2], v[3])};
  } else if (epi == EPI_KVRAW) { *(f32x4*)(E.f2 + (size_t)r * 512 + c) = v; }
}

DI void epi_frag8(KP p, const int epi, const EpiArgs& E, const int r, const int c, const f32x4 v0, const f32x4 v1, const f32x4 lbA = (f32x4){0.f, 0.f, 0.f, 0.f}, const f32x4 lbB = (f32x4){0.f, 0.f, 0.f, 0.f}) {
  if (epi == EPI_NOP) return;
  if (epi == EPI_ADA) { if (r < NMOD) { const float* bp = (c < 24576) ? (p->b_ada + c) : (p->kv_b_ada + (c - 24576)); float* o = E.f0 + (size_t)r * MODW + c;
      const f32x4 m0 = v0 + *(const f32x4*)bp, m1 = v1 + *(const f32x4*)(bp + 4);
      *(f32x4*)o = m0; *(f32x4*)(o + 4) = m1;
      int site = -1;
      if (c < 24576) { const int l = c / 6144, part = (c - l * 6144) >> 10; site = (part == 0) ? l : (part == 3 ? 5 + l : -1); } else if (c < 25600) site = 4;
      if (site >= 0) *(u32x4*)(E.ash + ((size_t)site * 256 + r) * 1024 + (c & 1023)) = (u32x4){pk2(m0[0], m0[1]), pk2(m0[2], m0[3]), pk2(m1[0], m1[1]), pk2(m1[2], m1[3])}; }
  } else if (epi == EPI_HGIN) {
    const int sec = c >> 10, cc = c & 1023; const size_t o = (size_t)r * D + cc;
    if (sec == 1) { float lb[8];
#pragma unroll
      for (int j = 0; j < 4; ++j) { lb[j] = lbA[j]; lb[4 + j] = lbB[j]; }
      float lf[8];
#pragma unroll
      for (int j = 0; j < 8; ++j) { const float x = (j < 4) ? v0[j & 3] : v1[j & 3]; const float sg = __builtin_amdgcn_rcpf(1.f + __expf(-x)); const float fg = lb[j] + (1.f - lb[j]) * sg;
        lf[j] = __builtin_amdgcn_logf(fg); }
      *(f32x4*)(E.f0 + o) = (f32x4){lf[0], lf[1], lf[2], lf[3]}; *(f32x4*)(E.f0 + o + 4) = (f32x4){lf[4], lf[5], lf[6], lf[7]};
    } else if (sec == 2) { *(u32x4*)(E.b2 + o) = (u32x4){pk2(v0[0], v0[1]), pk2(v0[2], v0[3]), pk2(v1[0], v1[1]), pk2(v1[2], v1[3])};
    } else { bf16_t* dst = (sec == 0) ? E.b0 : E.b3;
      *(u32x4*)(dst + o) = (u32x4){pk2(silu_f(v0[0]), silu_f(v0[1])), pk2(silu_f(v0[2]), silu_f(v0[3])), pk2(silu_f(v1[0]), silu_f(v1[1])), pk2(silu_f(v1[2]), silu_f(v1[3]))}; }
  } else if (epi == EPI_RESID) {
    const float* xin = E.first ? (r < TP ? p->x_prompt + (size_t)r * D : p->x_sample + (size_t)(r - TP) * D) : (E.f0 + (size_t)r * D);
    const size_t mo = (size_t)modrow(r) * MODW;
    const float* gm = E.f1 + mo + c; float* o = E.f0 + (size_t)r * D + c;
    const f32x4 xa = *(const f32x4*)(xin + c), xb = *(const f32x4*)(xin + c + 4), ga = *(const f32x4*)gm, gb = *(const f32x4*)(gm + 4);
    const f32x4 ya = xa + ga * v0, yb = xb + gb * v1;
    *(f32x4*)o = ya; *(f32x4*)(o + 4) = yb;
    if (E.yout) {
      const f32x4 g0 = *(const f32x4*)(E.ng + c), g1 = *(const f32x4*)(E.ng + c + 4), s0 = *(const f32x4*)(E.nsc + mo + c), s1 = *(const f32x4*)(E.nsc + mo + c + 4);
      const f32x4 y0 = ya * g0 * (s0 + 1.f), y1 = yb * g1 * (s1 + 1.f);
      *(u32x4*)(E.yout + (size_t)r * D + c) = (u32x4){pk2(y0[0], y0[1]), pk2(y0[2], y0[3]), pk2(y1[0], y1[1]), pk2(y1[2], y1[3])};
      if (E.ykv) { const f32x4 h0 = *(const f32x4*)(E.ngkv + c), h1 = *(const f32x4*)(E.ngkv + c + 4), t0 = *(const f32x4*)(E.nsckv + mo + c), t1 = *(const f32x4*)(E.nsckv + mo + c + 4);
        const f32x4 z0 = ya * h0 * (t0 + 1.f), z1 = yb * h1 * (t1 + 1.f);
        *(u32x4*)(E.ykv + (size_t)r * D + c) = (u32x4){pk2(z0[0], z0[1]), pk2(z0[2], z0[3]), pk2(z1[0], z1[1]), pk2(z1[2], z1[3])}; }
      float ss = ya[0] * ya[0] + ya[1] * ya[1] + ya[2] * ya[2] + ya[3] * ya[3] + yb[0] * yb[0] + yb[1] * yb[1] + yb[2] * yb[2] + yb[3] * yb[3];
      ss += __shfl_xor(ss, 16); ss += __shfl_xor(ss, 32);
      if ((tid_get() & 63) < 16) atomicAdd(E.rss_out + r, ss); }
  } else if (epi == EPI_UP) {
    float u[8];
#pragma unroll
    for (int j = 0; j < 8; ++j) { const float t = fmaxf((j < 4) ? v0[j & 3] : v1[j & 3], 0.f); u[j] = t * t; }
    *(u32x4*)(E.b0 + (size_t)r * FF + c) = (u32x4){pk2(u[0], u[1]), pk2(u[2], u[3]), pk2(u[4], u[5]), pk2(u[6], u[7])};
  } else if (epi == EPI_QRAW) { *(u32x4*)(E.b1 + (size_t)r * D + c) = (u32x4){pk2(v0[0], v0[1]), pk2(v0[2], v0[3]), pk2(v1[0], v1[1]), pk2(v1[2], v1[3])};
  } else { float* o = E.f2 + (size_t)r * 512 + c; *(f32x4*)o = v0; *(f32x4*)(o + 4) = v1; }
}

template <int NMB>
DI void skinny_unit(KP p, unsigned char* shm, const bf16_t* A, const bf16_t* Bt, const int K, const int mrow0, const int n0, const int epi, const EpiArgs& E) {
  const int tid = tid_get(), lane = tid & 63, wave = tid >> 6, fr = lane & 15, fq = lane >> 4;
  const int ks = K >> 3;
  const bf16_t* ap = A + (size_t)(TP + mrow0 + fr) * K + wave * ks + fq * 8;
  const bf16_t* bp = Bt + (size_t)(n0 + fr) * K + wave * ks + fq * 8;
  f32x4 acc[NMB];
#pragma unroll
  for (int mb = 0; mb < NMB; ++mb) acc[mb] = (f32x4){0.f, 0.f, 0.f, 0.f};
#pragma unroll 2
  for (int k = 0; k < ks; k += 32) { const bf16x8 b = *(const bf16x8*)(bp + k);
#pragma unroll
    for (int mb = 0; mb < NMB; ++mb) { const bf16x8 a = *(const bf16x8*)(ap + (size_t)mb * 16 * K + k); acc[mb] = __builtin_amdgcn_mfma_f32_16x16x32_bf16(b, a, acc[mb], 0, 0, 0); } }
  float* red = (float*)shm;
#pragma unroll
  for (int mb = 0; mb < NMB; ++mb) *(f32x4*)(red + wave * (NMB * 256) + (mb * 16 + fr) * 16 + fq * 4) = acc[mb];
  __syncthreads();
  if (tid < NMB * 64) { const int row = tid >> 2, c4 = (tid & 3) * 4; f32x4 sum = (f32x4){0.f, 0.f, 0.f, 0.f};
#pragma unroll
    for (int w = 0; w < 8; ++w) sum += *(const f32x4*)(red + w * (NMB * 256) + row * 16 + c4);
    epi_frag(p, epi, E, TP + mrow0 + row, n0 + c4, sum); }
  __syncthreads();
}

DI int perm32(int rho) { const int n = rho >> 4, i = rho & 15; return 8 * (i >> 2) + 4 * n + (i & 3); }
struct UnitD { const char* A; const char* B; int pm, pn, epi; float* ob; int on; };
DI void unit_of(const int L, const GemmJob& j0, const GemmJob& j1, const int n0, const size_t tstep, UnitD& u) {
  if (j0.epi == EPI_BIAS) {
    const int st = L < 16 ? 0 : L < 32 ? 1 : L < 36 ? 2 : L < 40 ? 3 : L < 42 ? 4 : 5 + (L - 42) / 16;
    const int lb = st == 0 ? 0 : st == 1 ? 16 : st == 2 ? 32 : st == 3 ? 36 : st == 4 ? 40 : 42 + (st - 5) * 16;
    const unsigned char* wsb = (const unsigned char*)j0.Bt;
    const bf16_t* Bt = (st < 2) ? (const bf16_t*)(wsb + OFF_WIN) + (size_t)st * 4096 * D : (st < 4) ? (const bf16_t*)(wsb + OFF_WQ) + (size_t)(st - 2) * D * D
                     : (st == 4) ? (const bf16_t*)(wsb + OFF_WKV) : (const bf16_t*)(wsb + OFF_WUP) + (size_t)(st - 5) * D * FF;
    u.pm = 0; u.pn = L - lb; u.epi = EPI_BIAS; u.A = (const char*)(j0.A + (size_t)st * 256 * 1024); u.B = (const char*)Bt + (size_t)u.pn * tstep;
    u.ob = (float*)j1.A + (size_t)132 * site_prefN(st); u.on = site_N(st); return; }
  const bool second = (L >= n0); int pm, pn; tile_of(second ? L - n0 : L, second ? j1.nM : j0.nM, second ? j1.nN : j0.nN, pm, pn);
  u.pm = pm; u.pn = pn; u.epi = second ? j1.epi : j0.epi;
  u.A = (const char*)(second ? j1.A : j0.A) + (size_t)pm * tstep; u.B = (const char*)(second ? j1.Bt : j0.Bt) + (size_t)pn * tstep;
}
DI void gemm_phase(KP p, LAS unsigned char* lds, unsigned char* shm, const GemmJob& j0, const GemmJob& j1, const int njobs, const EpiArgs& E, const int skinny) {
  const int tid = tid_get(), wid = __builtin_amdgcn_readfirstlane(tid >> 6), lane = tid & 63, wr = wid >> 2, wc = wid & 3, fr = lane & 15, fq = lane >> 4;
  const int K = j0.K, nt = K / BK;
  const int n0 = j0.nM * j0.nN, n1 = (njobs > 1) ? j1.nM * j1.nN : 0, ntl = n0 + n1;
  if ((int)blockIdx.x < ntl) {
    unsigned voffA[2], voffB[2];
#pragma unroll
    for (int i = 0; i < 2; ++i) { int R, C; stage_rc(tid * 16 + i * 8192, R, C); const int Rb = (R & ~31) + perm32(R & 31);
      voffA[i] = (unsigned)(R * K + C) * 2u; voffB[i] = (unsigned)(Rb * K + C) * 2u; }
    const size_t kstep = (size_t)(BK * 2), hstep = (size_t)HALF * K * 2, tstep = 2 * hstep;
    const unsigned ldsw = (unsigned)wid * 1024u;
    const int aoff = lds_byte(wr * 64 + fr, fq * 8), boff = lds_byte(wc * 32 + fr, fq * 8);
#define G_SA(b, h) (((b) * 2 + (h)) * HTB)
#define G_SB(b, h) ((4 + (b) * 2 + (h)) * HTB)
#define G_STAGE(bufoff, gbase, voff) do { _Pragma("unroll") for (int _i = 0; _i < 2; ++_i) \
      __builtin_amdgcn_global_load_lds((const unsigned*)((const char*)(gbase) + (voff)[_i]), (LAS unsigned*)(lds + (bufoff) + ldsw + _i * 8192), 16, 0, 0); } while (0)
#define G_LDA(dst, b, h) do { _Pragma("unroll") for (int m = 0; m < 4; ++m) _Pragma("unroll") for (int k = 0; k < 2; ++k) dst[m][k] = *(const LAS bf16x8*)(lds + G_SA(b, h) + aoff + m * 2048 + k * 1024); } while (0)
#define G_LDB(dst, b, h) do { _Pragma("unroll") for (int n = 0; n < 2; ++n) _Pragma("unroll") for (int k = 0; k < 2; ++k) dst[n][k] = *(const LAS bf16x8*)(lds + G_SB(b, h) + boff + n * 2048 + k * 1024); } while (0)
#define G_MMA(ai, bj, At, Bt) do { __builtin_amdgcn_s_setprio(1); _Pragma("unroll") for (int m = 0; m < 4; ++m) _Pragma("unroll") for (int n = 0; n < 2; ++n) _Pragma("unroll") for (int k = 0; k < 2; ++k) \
      acc[ai][bj][m][n] = __builtin_amdgcn_mfma_f32_16x16x32_bf16(Bt[n][k], At[m][k], acc[ai][bj][m][n], 0, 0, 0); __builtin_amdgcn_s_setprio(0); } while (0)
#define G_WAIT_V(n) asm volatile("s_waitcnt vmcnt(" #n ")" ::: "memory")
#define G_WAIT_L(n) asm volatile("s_waitcnt lgkmcnt(" #n ")" ::: "memory")
#define G_BAR __builtin_amdgcn_s_barrier()
#define G_SCHED __builtin_amdgcn_sched_barrier(0)
    int L = blockIdx.x;
    UnitD cur, nxt; unit_of(L, j0, j1, n0, tstep, cur);
    f32x4 acc[2][2][4][2];
#pragma unroll
    for (int a = 0; a < 2; ++a)
#pragma unroll
      for (int b = 0; b < 2; ++b)
#pragma unroll
        for (int m = 0; m < 4; ++m)
#pragma unroll
          for (int n = 0; n < 2; ++n) acc[a][b][m][n] = (f32x4){0.f, 0.f, 0.f, 0.f};
    bf16x8 At[4][2], B0[2][2], B1[2][2];
    const char* cA = cur.A; const char* cB = cur.B;
    G_STAGE(G_SB(0, 0), cB, voffB); G_STAGE(G_SB(0, 1), cB + hstep, voffB); G_STAGE(G_SA(0, 0), cA, voffA); G_STAGE(G_SA(0, 1), cA + hstep, voffA);
    if (wr == 1) G_BAR;
    G_WAIT_V(2); G_BAR;
    G_STAGE(G_SB(1, 0), cB + kstep, voffB); G_STAGE(G_SA(1, 0), cA + kstep, voffA); G_STAGE(G_SB(1, 1), cB + hstep + kstep, voffB);
    G_WAIT_V(6); G_BAR;
#pragma unroll 1
    for (;;) {
      const int Ln = L + (int)gridDim.x; const bool has_next = (Ln < ntl);
      if (has_next) unit_of(Ln, j0, j1, n0, tstep, nxt);
      const char* nA = has_next ? nxt.A : cA; const char* nB = has_next ? nxt.B : cB;
#pragma unroll 1
      for (int t = 0; t < nt; t += 2) {
        const bool last = (t == nt - 2);
        const bool tail = last && !has_next;
        const char* a1 = cA + (size_t)(t + 1) * kstep;
        const char* a2 = last ? nA : cA + (size_t)(t + 2) * kstep; const char* b2 = last ? nB : cB + (size_t)(t + 2) * kstep;
        const char* a3 = a2 + kstep; const char* b3 = b2 + kstep;
        G_LDB(B0, 0, 0); G_LDB(B1, 0, 1); G_SCHED; G_LDA(At, 0, 0); G_STAGE(G_SA(1, 1), a1 + hstep, voffA);
        G_WAIT_V(8); G_WAIT_L(0); G_BAR; G_MMA(0, 0, At, B0); G_MMA(0, 1, At, B1); G_BAR; G_SCHED;
        G_LDA(At, 0, 1); if (!tail) { G_STAGE(G_SB(0, 0), b2, voffB); G_STAGE(G_SB(0, 1), b2 + hstep, voffB); G_STAGE(G_SA(0, 0), a2, voffA); }
        if (tail) G_WAIT_V(2); else G_WAIT_V(8);
        G_WAIT_L(0); G_BAR; G_MMA(1, 0, At, B0); G_MMA(1, 1, At, B1); G_BAR; G_SCHED;
        G_LDB(B0, 1, 0); G_LDB(B1, 1, 1); G_SCHED; G_LDA(At, 1, 0); if (!tail) G_STAGE(G_SA(0, 1), a2 + hstep, voffA);
        if (tail) G_WAIT_V(0); else G_WAIT_V(8);
        G_WAIT_L(0); G_BAR; G_MMA(0, 0, At, B0); G_MMA(0, 1, At, B1); G_BAR; G_SCHED;
        G_LDA(At, 1, 1); if (!tail) { G_STAGE(G_SB(1, 0), b3, voffB); G_STAGE(G_SB(1, 1), b3 + hstep, voffB); G_STAGE(G_SA(1, 0), a3, voffA); }
        if (tail) G_WAIT_V(0); else G_WAIT_V(8);
        G_WAIT_L(0); G_BAR; G_MMA(1, 0, At, B0); G_MMA(1, 1, At, B1); G_BAR; G_SCHED;
      }
      if (wr == 0) G_BAR;
      { const int r0 = cur.pm * BM + wr * 64 + fr, c0 = cur.pn * BM + wc * 32 + fq * 8; const int epi = cur.epi;
#define EPI_LOOP(MODE) { _Pragma("unroll") for (int ai = 0; ai < 2; ++ai) _Pragma("unroll") for (int m = 0; m < 4; ++m) _Pragma("unroll") for (int bj = 0; bj < 2; ++bj) \
          epi_frag8(p, MODE, E, r0 + ai * 128 + m * 16, c0 + bj * 128, acc[ai][bj][m][0], acc[ai][bj][m][1]); }
        if (epi == EPI_ADA) EPI_LOOP(EPI_ADA)
        else if (epi == EPI_BIAS) {
#pragma unroll
          for (int ai = 0; ai < 2; ++ai)
#pragma unroll
            for (int m = 0; m < 4; ++m) { const int r = r0 + ai * 128 + m * 16; if (r < NMOD) {
#pragma unroll
              for (int bj = 0; bj < 2; ++bj) { float* o = cur.ob + (size_t)r * cur.on + (c0 + bj * 128); *(f32x4*)o = acc[ai][bj][m][0]; *(f32x4*)(o + 4) = acc[ai][bj][m][1]; } } }
        } else if (epi == EPI_RESID) {
          const size_t mo = (size_t)modrow(r0) * MODW;
#pragma unroll
          for (int bj = 0; bj < 2; ++bj) { const int c = c0 + bj * 128;
            const f32x4 ga = *(const f32x4*)(E.f1 + mo + c), gb = *(const f32x4*)(E.f1 + mo + c + 4);
            f32x4 m0 = (f32x4){0.f, 0.f, 0.f, 0.f}, m1 = m0, k0 = m0, k1 = m0;
            if (E.yout) { const f32x4 g0 = *(const f32x4*)(E.ng + c), g1 = *(const f32x4*)(E.ng + c + 4), s0 = *(const f32x4*)(E.nsc + mo + c), s1 = *(const f32x4*)(E.nsc + mo + c + 4);
              m0 = g0 * (s0 + 1.f); m1 = g1 * (s1 + 1.f);
              if (E.ykv) { const f32x4 h0 = *(const f32x4*)(E.ngkv + c), h1 = *(const f32x4*)(E.ngkv + c + 4), t0 = *(const f32x4*)(E.nsckv + mo + c), t1 = *(const f32x4*)(E.nsckv + mo + c + 4);
                k0 = h0 * (t0 + 1.f); k1 = h1 * (t1 + 1.f); } }
#pragma unroll
            for (int ah = 0; ah < 2; ++ah) { const int ai = ah, mb = 0;
              f32x4 ya[4], yb[4];
              const float* xbase = E.first ? p->x_prompt : E.f0;
#pragma unroll
              for (int m = mb; m < mb + 4; ++m) { const unsigned off = (unsigned)(r0 + ai * 128 + m * 16) * (unsigned)D + (unsigned)c;
                ya[m] = __builtin_nontemporal_load((const f32x4*)(xbase + off)); yb[m] = __builtin_nontemporal_load((const f32x4*)(xbase + off + 4)); }
#pragma unroll
              for (int m = mb; m < mb + 4; ++m) { const int r = r0 + ai * 128 + m * 16; const unsigned off = (unsigned)r * (unsigned)D + (unsigned)c;
                const f32x4 xa = ya[m] + ga * acc[ai][bj][m][0], xb = yb[m] + gb * acc[ai][bj][m][1];
                __builtin_nontemporal_store(xa, (f32x4*)(E.f0 + off)); __builtin_nontemporal_store(xb, (f32x4*)(E.f0 + off + 4));
                if (E.yout) { const f32x4 y0 = xa * m0, y1 = xb * m1;
                  *(u32x4*)(E.yout + off) = (u32x4){pk2(y0[0], y0[1]), pk2(y0[2], y0[3]), pk2(y1[0], y1[1]), pk2(y1[2], y1[3])};
                  if (E.ykv) { const f32x4 z0 = xa * k0, z1 = xb * k1;
                    *(u32x4*)(E.ykv + off) = (u32x4){pk2(z0[0], z0[1]), pk2(z0[2], z0[3]), pk2(z1[0], z1[1]), pk2(z1[2], z1[3])}; }
                  float ss = xa[0] * xa[0] + xa[1] * xa[1] + xa[2] * xa[2] + xa[3] * xa[3] + xb[0] * xb[0] + xb[1] * xb[1] + xb[2] * xb[2] + xb[3] * xb[3];
                  ss += __shfl_xor(ss, 16); ss += __shfl_xor(ss, 32);
                  if (fq == 0) atomicAdd(E.rss_out + (unsigned)r, ss); } } } }
        } else if (epi != EPI_NOP) {
          float rstd8[8];
#pragma unroll
          for (int q = 0; q < 8; ++q) rstd8[q] = rsqrtf(E.rss[r0 + (q >> 2) * 128 + (q & 3) * 16] * (1.f / D) + EPS);
          const float* bb = (epi == EPI_KVRAW) ? E.bias1 + (size_t)modrow(r0) * E.bN1 : E.bias + (size_t)modrow(r0) * E.bN;
          f32x4 bv[2][2], lbv[2][2];
#pragma unroll
          for (int bj = 0; bj < 2; ++bj) { const int c = c0 + bj * 128; bv[bj][0] = *(const f32x4*)(bb + c); bv[bj][1] = *(const f32x4*)(bb + c + 4);
            lbv[bj][0] = (f32x4){0.f, 0.f, 0.f, 0.f}; lbv[bj][1] = (f32x4){0.f, 0.f, 0.f, 0.f};
            if (epi == EPI_HGIN && (c >> 10) == 1 && E.layer == 1) { const int cc = c & 1023;
              const f32x4 l0 = *(const f32x4*)(p->hg_lbp + cc), l1 = *(const f32x4*)(p->hg_lbp + D + cc), l2 = *(const f32x4*)(p->hg_lbp + cc + 4), l3 = *(const f32x4*)(p->hg_lbp + D + cc + 4);
#pragma unroll
              for (int jj = 0; jj < 4; ++jj) { lbv[bj][0][jj] = __builtin_amdgcn_rcpf(1.f + __expf(l0[jj] - l1[jj])); lbv[bj][1][jj] = __builtin_amdgcn_rcpf(1.f + __expf(l2[jj] - l3[jj])); } } }
#define CONS_LOOP(MODE) { _Pragma("unroll") for (int ai = 0; ai < 2; ++ai) _Pragma("unroll") for (int m = 0; m < 4; ++m) _Pragma("unroll") for (int bj = 0; bj < 2; ++bj) \
            epi_frag8(p, MODE, E, r0 + ai * 128 + m * 16, c0 + bj * 128, acc[ai][bj][m][0] * rstd8[ai * 4 + m] + bv[bj][0], acc[ai][bj][m][1] * rstd8[ai * 4 + m] + bv[bj][1], lbv[bj][0], lbv[bj][1]); }
          if (epi == EPI_HGIN) CONS_LOOP(EPI_HGIN) else if (epi == EPI_UP) CONS_LOOP(EPI_UP) else if (epi == EPI_QRAW) CONS_LOOP(EPI_QRAW) else CONS_LOOP(EPI_KVRAW)
        }
      }
      if (!has_next) break;
#pragma unroll
      for (int a = 0; a < 2; ++a)
#pragma unroll
        for (int b = 0; b < 2; ++b)
#pragma unroll
          for (int m = 0; m < 4; ++m)
#pragma unroll
            for (int n = 0; n < 2; ++n) acc[a][b][m][n] = (f32x4){0.f, 0.f, 0.f, 0.f};
      cur = nxt; cA = nA; cB = nB; L = Ln;
      if (wr == 1) G_BAR;
    }
    G_WAIT_V(0);
    G_BAR;
  }
  if (skinny) {
    __syncthreads();
    const int u0 = j0.nN * 16, u1 = (njobs > 1) ? j1.nN * 16 : 0;
    const int rs = ((u0 + u1) * 4 <= (int)gridDim.x) ? 4 : (((u0 + u1) * 2 <= (int)gridDim.x) ? 2 : 1);
#pragma unroll 1
    for (int uu = (int)gridDim.x - 1 - (int)blockIdx.x; uu < (u0 + u1) * rs; uu += gridDim.x) {
      const int u = uu / rs, rg = uu - u * rs;
      const bool second = (u >= u0);
      const bf16_t* sa = second ? j1.A : j0.A; const bf16_t* sb = second ? j1.Bt : j0.Bt; const int sk = second ? j1.K : j0.K, sn = (second ? u - u0 : u) * 16, se = second ? j1.epi : j0.epi;
      if (rs == 4) skinny_unit<2>(p, shm, sa, sb, sk, rg * 32, sn, se, E);
      else if (rs == 2) skinny_unit<4>(p, shm, sa, sb, sk, rg * 64, sn, se, E);
      else skinny_unit<8>(p, shm, sa, sb, sk, 0, sn, se, E);
    }
  }
}

__device__ const float INVF[32] = {1.000000000e+00f, 7.498942614e-01f, 5.623413324e-01f, 4.216965139e-01f, 3.162277639e-01f, 2.371373773e-01f, 1.778279394e-01f, 1.333521307e-01f, 1.000000015e-01f, 7.498941571e-02f, 5.623413250e-02f, 4.216965288e-02f, 3.162277490e-02f, 2.371373773e-02f, 1.778279431e-02f, 1.333521493e-02f, 9.999999776e-03f, 7.498941850e-03f, 5.623413250e-03f, 4.216964822e-03f, 3.162277630e-03f, 2.371373586e-03f, 1.778279431e-03f, 1.333521446e-03f, 1.000000047e-03f, 7.498942432e-04f, 5.623413017e-04f, 4.216965172e-04f, 3.162277571e-04f, 2.371373703e-04f, 1.778279402e-04f, 1.333521504e-04f};
DI void transpose_item(const float* W, int K, int N, bf16_t* WT, int row_off, float* scr, int item, int lane) {
  const int nblk = N / 32, kb = item / nblk, nb = item % nblk, k0 = 64 * kb, n0 = 32 * nb;
#pragma unroll 8
  for (int i = 0; i < 32; ++i) { const int kk = 2 * i + (lane >> 5); scr[kk * 33 + (lane & 31)] = __builtin_nontemporal_load(W + (size_t)(k0 + kk) * N + n0 + (lane & 31)); }
  asm volatile("s_waitcnt lgkmcnt(0)" ::: "memory");
  const int c = lane & 7;
#pragma unroll
  for (int j = 0; j < 4; ++j) { const int n = (lane >> 3) + 8 * j; const float* s = scr + (8 * c) * 33 + n;
    u32x4 o; o.x = pk2(s[0 * 33], s[1 * 33]); o.y = pk2(s[2 * 33], s[3 * 33]); o.z = pk2(s[4 * 33], s[5 * 33]); o.w = pk2(s[6 * 33], s[7 * 33]);
    *(u32x4*)(WT + (size_t)(row_off + n0 + n) * K + k0 + 8 * c) = o; }
  asm volatile("s_waitcnt lgkmcnt(0)" ::: "memory");
}

DI void prep_phase(KP p, unsigned char* shm) {
  const int tid = tid_get(), lane = tid & 63, wave = tid >> 6;
  const int gw = blockIdx.x * NWAVES + wave, NGW = gridDim.x * NWAVES;
  float* scr = (float*)(shm + wave * 16384);
  unsigned char* ws = p->ws;
  int base = 0;
  for (int mi = 0; mi < 22; ++mi) {
    const float* W; int K, N, row_off; bf16_t* WT;
    if (mi < 2) { W = p->hg_w_in + (size_t)mi * D * 4096; K = D; N = 4096; WT = (bf16_t*)(ws + OFF_WIN) + (size_t)mi * 4096 * D; row_off = 0; }
    else if (mi < 4) { W = p->hg_w_out + (size_t)(mi - 2) * D * D; K = D; N = D; WT = (bf16_t*)(ws + OFF_WOUT) + (size_t)(mi - 2) * D * D; row_off = 0; }
    else if (mi < 5) { W = p->w_kv; K = D; N = 512; WT = (bf16_t*)(ws + OFF_WKV); row_off = 0; }
    else if (mi < 7) { W = p->w_q + (size_t)(mi - 5) * D * D; K = D; N = D; WT = (bf16_t*)(ws + OFF_WQ) + (size_t)(mi - 5) * D * D; row_off = 0; }
    else if (mi < 9) { W = p->w_o + (size_t)(mi - 7) * D * D; K = D; N = D; WT = (bf16_t*)(ws + OFF_WO) + (size_t)(mi - 7) * D * D; row_off = 0; }
    else if (mi < 13) { W = p->w_up + (size_t)(mi - 9) * D * FF; K = D; N = FF; WT = (bf16_t*)(ws + OFF_WUP) + (size_t)(mi - 9) * D * FF; row_off = 0; }
    else if (mi < 17) { W = p->w_down + (size_t)(mi - 13) * D * FF; K = FF; N = D; WT = (bf16_t*)(ws + OFF_WDN) + (size_t)(mi - 13) * D * FF; row_off = 0; }
    else if (mi < 21) { W = p->w_ada + (size_t)(mi - 17) * D * 6144; K = D; N = 6144; WT = (bf16_t*)(ws + OFF_X); row_off = (mi - 17) * 6144; }
    else { W = p->kv_w_ada; K = D; N = 2048; WT = (bf16_t*)(ws + OFF_X); row_off = 24576; }
    const int nitems = (K / 64) * (N / 32);
    int first = (gw - (base % NGW) + NGW) % NGW;
    for (int it = first; it < nitems; it += NGW) transpose_item(W, K, N, WT, row_off, scr, it, lane);
    base += nitems;
  }
  bf16_t* Ac = (bf16_t*)(ws + OFF_X + (size_t)MODW * D * 2);
  const int gt = blockIdx.x * NTHREADS + tid, NGT = gridDim.x * NTHREADS;
  { unsigned* z = (unsigned*)(ws + OFF_BAR); for (int e = gt; e < (int)(ZERO_BYTES / 4); e += NGT) z[e] = 0u; }
  for (int e = gt; e < 256 * D / 2; e += NGT) { const int r = e / (D / 2), c = (e % (D / 2)) * 2; float a = 0.f, b = 0.f;
    if (r < NMOD) { const float* cp = (r < 4) ? p->c_prompt + (size_t)r * D : p->c_sample + (size_t)(r - 4) * D; a = silu_f(cp[c]); b = silu_f(cp[c + 1]); }
    *(unsigned*)(Ac + (size_t)r * D + c) = pk2(a, b); }
  float* tab = (float*)(ws + OFF_TAB);
  for (int e = gt; e < 4097 * 32; e += NGT) { const int pi = e >> 5, i = e & 31; const float pos = (pi < 4096) ? (float)pi : 8192.f;
    const float ang = pos * INVF[i]; float sn, cs; sincosf(ang, &sn, &cs);
    tab[pi * 64 + i] = cs; tab[pi * 64 + 32 + i] = sn; }
}

DI void init_rows(KP p, unsigned* ctr) {
  const int tid = tid_get(); const int lane = tid & 63;
  unsigned char* ws = p->ws; const float* mods = (const float*)(ws + OFF_MODS); bf16_t* yout = (bf16_t*)(ws + OFF_H); float* rss = (float*)(ws + OFF_RSS);
  const float* g = p->norm1_g; const float* msc = mods + 1024;
#pragma unroll 1
  for (;;) {
    unsigned cidx = 0; if (lane == 0) cidx = __hip_atomic_fetch_add(ctr, 1u, __ATOMIC_RELAXED, __HIP_MEMORY_SCOPE_AGENT);
    cidx = __builtin_amdgcn_readfirstlane(cidx);
    if (cidx >= (unsigned)(T / 8)) break;
#pragma unroll 1
    for (int hh = 0; hh < 2; ++hh) { const int rb = (int)cidx * 8 + hh * 4;
      f32x4 v[4][4];
#pragma unroll
      for (int q = 0; q < 4; ++q) { const int r = rb + q; const float* xr = (r < TP) ? p->x_prompt + (size_t)r * D : p->x_sample + (size_t)(r - TP) * D;
#pragma unroll
        for (int jj = 0; jj < 4; ++jj) v[q][jj] = *(const f32x4*)(xr + lane * 4 + 256 * jj); }
#pragma unroll
      for (int q = 0; q < 4; ++q) { const int r = rb + q; float a = 0.f;
#pragma unroll
        for (int jj = 0; jj < 4; ++jj) a += v[q][jj][0] * v[q][jj][0] + v[q][jj][1] * v[q][jj][1] + v[q][jj][2] * v[q][jj][2] + v[q][jj][3] * v[q][jj][3];
#pragma unroll
        for (int o = 1; o < 64; o <<= 1) a += __shfl_xor(a, o);
        if (lane == 0) rss[r] = a;
        const size_t mo = (size_t)modrow(r) * MODW;
#pragma unroll
        for (int jj = 0; jj < 4; ++jj) { const int c = lane * 4 + 256 * jj;
          const f32x4 gg = *(const f32x4*)(g + c), sc = *(const f32x4*)(msc + mo + c);
          const f32x4 h = v[q][jj] * gg * (sc + 1.f);
          *(u32x2*)(yout + (size_t)r * D + c) = (u32x2){pk2(h[0], h[1]), pk2(h[2], h[3])}; } } }
  }
}

struct HgBufs { const bf16_t *q, *k, *v, *g; const float* lf; float* o32; bf16_t* on; };

constexpr int SPAN = 256, NSPAN = SEQ / SPAN, CH = 32, NCH = SPAN / CH;
constexpr int L_CUM = 0, L_QT = 16896, L_KT = 25600, L_KE = 34304, L_VT = 44544, L_PS = 54784, L_DEC = 55808, L_HALF = 57344;
constexpr int CUS = 132, QS = 136, KES = 40;
DI bf16x8 pack8(const f32x16& x, const int s) {
  return __builtin_bit_cast(bf16x8, (u32x4){pk2(x[8 * s], x[8 * s + 1]), pk2(x[8 * s + 2], x[8 * s + 3]), pk2(x[8 * s + 4], x[8 * s + 5]), pk2(x[8 * s + 6], x[8 * s + 7])});
}
template <int MODE>
DI void scan_prompt(KP p, const int l, const HgBufs& B, unsigned char* shm) {
  const int tid = tid_get(), lane = tid & 63, wave = tid >> 6, hb = wave >> 2, th = tid & 255, vb = wave & 3, h5 = lane >> 5, l31 = lane & 31;
  unsigned char* base = shm + hb * L_HALF;
  float* cumb = (float*)(base + L_CUM); bf16_t* Qt = (bf16_t*)(base + L_QT); bf16_t* Kt = (bf16_t*)(base + L_KT);
  bf16_t* KeT = (bf16_t*)(base + L_KE); bf16_t* Vt = (bf16_t*)(base + L_VT); float* psum = (float*)(base + L_PS); float* dec = (float*)(base + L_DEC);
  float* dS = B.o32; float* Lsum = B.o32 + (size_t)512 * 16384;
#pragma unroll 1
  for (int it0 = blockIdx.x * 2; it0 < 32 * NSPAN; it0 += gridDim.x * 2) {
    const int item = it0 + hb, bh = item / NSPAN, span = item % NSPAN, b = bh >> 3, h = bh & 7;
    f32x16 S[4];
#pragma unroll
    for (int db = 0; db < 4; ++db)
#pragma unroll
      for (int r = 0; r < 16; ++r) S[db][r] = 0.f;
    if (MODE == 1) {
      const unsigned ob = (unsigned)item * 16384u + (unsigned)(vb * 32 + l31) + (unsigned)(4 * h5) * 128u;
#pragma unroll
      for (int db = 0; db < 4; ++db) {
#pragma unroll
        for (int r = 0; r < 16; ++r) S[db][r] = dS[ob + (unsigned)((32 * db + (r & 3) + 8 * (r >> 2)) * 128)];
        __builtin_amdgcn_sched_barrier(0); }
    }
    float Ltot = 0.f;
#define LBAR() do { asm volatile("s_waitcnt lgkmcnt(0)" ::: "memory"); __builtin_amdgcn_s_barrier(); asm volatile("" ::: "memory"); } while (0)
    const int d1 = th & 127, part = th >> 7, t2 = th >> 3, dg = th & 7;
    const size_t tokS = (size_t)b * SEQ + (size_t)span * SPAN;
    float lfr[16]; unsigned vr[16]; u32x4 q0, q1, g0, g1;
#define SCAN_LOAD(chx) do { const size_t o0_ = (tokS + (size_t)(chx) * CH + part * 16) * D + h * 128 + d1; \
      _Pragma("unroll") for (int i = 0; i < 16; ++i) { lfr[i] = B.lf[o0_ + (size_t)i * D]; vr[i] = B.v[o0_ + (size_t)i * D]; } \
      } while (0)
    __builtin_amdgcn_sched_barrier(0);
    SCAN_LOAD(0);
    __builtin_amdgcn_sched_barrier(0);
#pragma unroll 1
    for (int ch = 0; ch < NCH; ++ch) {
      const size_t tok0 = tokS + (size_t)ch * CH;
      if (MODE == 1) { const size_t o_ = (tok0 + t2) * D + h * 128 + dg * 16;
        q0 = *(const u32x4*)(B.q + o_); q1 = *(const u32x4*)(B.q + o_ + 8);
        g0 = *(const u32x4*)(B.g + o_); g1 = *(const u32x4*)(B.g + o_ + 8); }
      { const int d = d1;
        float c[16]; float run = 0.f;
#pragma unroll
        for (int i = 0; i < 16; ++i) { run += lfr[i]; c[i] = run; }
        psum[part * 128 + d] = run;
        LBAR();
        const float t0 = psum[d], t1 = psum[128 + d]; const float off = part ? t0 : 0.f; const float Lc = t0 + t1;
        float ke[16];
#pragma unroll
        for (int i = 0; i < 16; ++i) { const float cu = off + c[i]; if (MODE == 1) cumb[(part * 16 + i) * CUS + d] = cu; ke[i] = (1.f - __builtin_amdgcn_exp2f(lfr[i])) * __builtin_amdgcn_exp2f(Lc - cu); }
        *(u32x4*)(KeT + d * KES + part * 16) = (u32x4){pk2(ke[0], ke[1]), pk2(ke[2], ke[3]), pk2(ke[4], ke[5]), pk2(ke[6], ke[7])};
        *(u32x4*)(KeT + d * KES + part * 16 + 8) = (u32x4){pk2(ke[8], ke[9]), pk2(ke[10], ke[11]), pk2(ke[12], ke[13]), pk2(ke[14], ke[15])};
        *(u32x4*)(Vt + d * KES + part * 16) = (u32x4){vr[0] | (vr[1] << 16), vr[2] | (vr[3] << 16), vr[4] | (vr[5] << 16), vr[6] | (vr[7] << 16)};
        *(u32x4*)(Vt + d * KES + part * 16 + 8) = (u32x4){vr[8] | (vr[9] << 16), vr[10] | (vr[11] << 16), vr[12] | (vr[13] << 16), vr[14] | (vr[15] << 16)};
        if (part == 0) { dec[d] = __builtin_amdgcn_exp2f(Lc); Ltot += Lc; }
      }
      LBAR();
      if (MODE == 1) {
        const int t = t2;
        unsigned qo[8], ko[8];
#pragma unroll
        for (int g4 = 0; g4 < 4; ++g4) { const f32x4 cv = *(const f32x4*)(cumb + t * CUS + dg * 16 + 4 * g4);
          f32x4 cp = (f32x4){0.f, 0.f, 0.f, 0.f}; if (t > 0) cp = *(const f32x4*)(cumb + (t - 1) * CUS + dg * 16 + 4 * g4);
#pragma unroll
          for (int e2 = 0; e2 < 2; ++e2) { const int w = g4 * 2 + e2; const unsigned qw = (w < 4) ? q0[w & 3] : q1[w & 3];
            const float ca = cv[2 * e2], cb = cv[2 * e2 + 1];
            const float ka = 1.f - __builtin_amdgcn_exp2f(ca - cp[2 * e2]), kb = 1.f - __builtin_amdgcn_exp2f(cb - cp[2 * e2 + 1]);
            qo[w] = pk2(bf2f(qw & 0xffffu) * __builtin_amdgcn_exp2f(ca), bf2f(qw >> 16) * __builtin_amdgcn_exp2f(cb));
            ko[w] = pk2(ka * __builtin_amdgcn_exp2f(fminf(-ca, 115.f)), kb * __builtin_amdgcn_exp2f(fminf(-cb, 115.f))); } }
        *(u32x4*)(Qt + t * QS + dg * 16) = (u32x4){qo[0], qo[1], qo[2], qo[3]}; *(u32x4*)(Qt + t * QS + dg * 16 + 8) = (u32x4){qo[4], qo[5], qo[6], qo[7]};
        *(u32x4*)(Kt + t * QS + dg * 16) = (u32x4){ko[0], ko[1], ko[2], ko[3]}; *(u32x4*)(Kt + t * QS + dg * 16 + 8) = (u32x4){ko[4], ko[5], ko[6], ko[7]};
        LBAR();
      }
      { const int chn = (ch + 1 < NCH) ? ch + 1 : ch; SCAN_LOAD(chn); }
      f32x16 O;
      if (MODE == 1) {
        f32x16 X;
#pragma unroll
        for (int r = 0; r < 16; ++r) { X[r] = 0.f; O[r] = 0.f; }
#pragma unroll
        for (int ks = 0; ks < 8; ++ks) { const bf16x8 a = *(const bf16x8*)(Kt + l31 * QS + 16 * ks + 8 * h5), bq = *(const bf16x8*)(Qt + l31 * QS + 16 * ks + 8 * h5);
          X = __builtin_amdgcn_mfma_f32_32x32x16_bf16(a, bq, X, 0, 0, 0); }
#pragma unroll
        for (int r = 0; r < 16; ++r) if (crow(r, h5) > l31) X[r] = 0.f;
#pragma unroll
        for (int st = 0; st < 2; ++st) { const bf16_t* vp = Vt + (vb * 32 + l31) * KES + 16 * st + 4 * h5; const u32x2 lo = *(const u32x2*)vp, hi = *(const u32x2*)(vp + 8);
          O = __builtin_amdgcn_mfma_f32_32x32x16_bf16(pack8(X, st), __builtin_bit_cast(bf16x8, (u32x4){lo[0], lo[1], hi[0], hi[1]}), O, 0, 0, 0); }
#pragma unroll
        for (int db = 0; db < 4; ++db)
#pragma unroll
          for (int st = 0; st < 2; ++st) { const bf16_t* qp = Qt + l31 * QS + 32 * db + 16 * st + 4 * h5; const u32x2 lo = *(const u32x2*)qp, hi = *(const u32x2*)(qp + 8);
            O = __builtin_amdgcn_mfma_f32_32x32x16_bf16(__builtin_bit_cast(bf16x8, (u32x4){lo[0], lo[1], hi[0], hi[1]}), pack8(S[db], st), O, 0, 0, 0); }
      }
#pragma unroll
      for (int db = 0; db < 4; ++db) {
#pragma unroll
        for (int r4 = 0; r4 < 4; ++r4) { const f32x4 dv = *(const f32x4*)(dec + 32 * db + 8 * r4 + 4 * h5);
#pragma unroll
          for (int e = 0; e < 4; ++e) S[db][4 * r4 + e] *= dv[e]; }
#pragma unroll
        for (int st = 0; st < 2; ++st) { const bf16x8 a = *(const bf16x8*)(KeT + (32 * db + l31) * KES + 16 * st + 8 * h5), bv = *(const bf16x8*)(Vt + (vb * 32 + l31) * KES + 16 * st + 8 * h5);
          S[db] = __builtin_amdgcn_mfma_f32_32x32x16_bf16(a, bv, S[db], 0, 0, 0); } }
      if (MODE == 1) {
#pragma unroll
        for (int r = 0; r < 16; ++r) cumb[crow(r, h5) * CUS + vb * 32 + l31] = O[r];
        LBAR();
        const int t = t2, vg = dg; const size_t o = (tok0 + t) * D + h * 128 + vg * 16;
        f32x4 ov[4]; float ss = 0.f;
#pragma unroll
        for (int g4 = 0; g4 < 4; ++g4) { ov[g4] = *(const f32x4*)(cumb + t * CUS + vg * 16 + 4 * g4); ss += ov[g4][0] * ov[g4][0] + ov[g4][1] * ov[g4][1] + ov[g4][2] * ov[g4][2] + ov[g4][3] * ov[g4][3]; }
        ss += __shfl_xor(ss, 1); ss += __shfl_xor(ss, 2); ss += __shfl_xor(ss, 4);
        const float rstd = rsqrtf(ss * (1.f / 128.f) + EPS);
        unsigned w[8];
#pragma unroll
        for (int g4 = 0; g4 < 4; ++g4) { const f32x4 gn = *(const f32x4*)(p->hg_gn_g + l * 128 + vg * 16 + 4 * g4);
#pragma unroll
          for (int e2 = 0; e2 < 2; ++e2) { const int wi = g4 * 2 + e2; const unsigned gw = (wi < 4) ? g0[wi & 3] : g1[wi & 3];
            w[wi] = pk2(ov[g4][2 * e2] * rstd * gn[2 * e2] * bf2f(gw & 0xffffu), ov[g4][2 * e2 + 1] * rstd * gn[2 * e2 + 1] * bf2f(gw >> 16)); } }
        *(u32x4*)(B.on + o) = (u32x4){w[0], w[1], w[2], w[3]}; *(u32x4*)(B.on + o + 8) = (u32x4){w[4], w[5], w[6], w[7]};
      } else {
        LBAR();
      }
    }
    if (MODE == 0) {
      float* dSo = dS + (size_t)item * 16384 + vb * 32 + l31;
#pragma unroll
      for (int db = 0; db < 4; ++db)
#pragma unroll
        for (int r = 0; r < 16; ++r) dSo[(size_t)(32 * db + crow(r, h5)) * 128] = S[db][r];
      if (th < 128) Lsum[(size_t)item * 128 + th] = Ltot;
    } else if (span == NSPAN - 1) {
      float* so = p->out + O_HGP + ((size_t)((l * 4 + b) * 8 + h)) * 16384 + vb * 32 + l31;
#pragma unroll
      for (int db = 0; db < 4; ++db)
#pragma unroll
        for (int r = 0; r < 16; ++r) so[(size_t)(32 * db + crow(r, h5)) * 128] = S[db][r];
    }
    __syncthreads();
  }
}

DI void scan_passB(const HgBufs& B) {
  const int tid = tid_get();
  float* dS = B.o32; const float* Lsum = B.o32 + (size_t)512 * 16384;
  const int gt = blockIdx.x * NTHREADS + tid, NGT = gridDim.x * NTHREADS;
#pragma unroll 1
  for (int e = gt; e < 32 * 4096; e += NGT) { const int bh = e >> 12, q4 = e & 4095, d = q4 >> 5;
    float* base = dS + (size_t)bh * NSPAN * 16384 + (size_t)q4 * 4; const float* Lb = Lsum + (size_t)bh * NSPAN * 128 + d;
    f32x4 v[NSPAN]; float lv[NSPAN];
#pragma unroll
    for (int sp = 0; sp < NSPAN; ++sp) { v[sp] = *(const f32x4*)(base + (size_t)sp * 16384); lv[sp] = Lb[sp * 128]; }
    f32x4 run = (f32x4){0.f, 0.f, 0.f, 0.f};
#pragma unroll
    for (int sp = 0; sp < NSPAN; ++sp) { *(f32x4*)(base + (size_t)sp * 16384) = run; run = run * __builtin_amdgcn_exp2f(lv[sp]) + v[sp]; }
  }
}

DI void scan_phase(KP p, const int l, const HgBufs& B, unsigned char* shm) {
  const bool sample_first = (blockIdx.x & 1) != 0;
  if (!sample_first) scan_prompt<0>(p, l, B, shm);
  const int tid = tid_get(), lane = tid & 63, wave = tid >> 6;
  {
    float* ps = (float*)shm;
    const int v4 = (tid & 31) * 4, dq = tid >> 5;
    f32x4 sv[8], svn[8]; float lfv[8], lfn[8]; unsigned kq[8], kqn[8]; u32x2 vw, vwn;
#define SMP_LOAD(IT, SV, LF, KQ, VW) do { const int bs_ = (IT) >> 3, h_ = (IT) & 7; const size_t r_ = TP + bs_; \
      const float* s0_ = p->state_hgrn + ((size_t)((l * 128 + bs_) * 8 + h_)) * 16384; \
      VW = *(const u32x2*)(B.v + r_ * D + h_ * 128 + v4); \
      _Pragma("unroll") for (int i = 0; i < 8; ++i) { const int d_ = dq * 8 + i; const size_t o_ = r_ * D + h_ * 128 + d_; \
        LF[i] = B.lf[o_]; KQ[i] = (unsigned)B.q[o_]; SV[i] = __builtin_nontemporal_load((const f32x4*)(s0_ + d_ * 128 + v4)); } } while (0)
    int item = blockIdx.x, par = 0;
    if (item < 1024) SMP_LOAD(item, sv, lfv, kq, vw);
#pragma unroll 1
    for (; item < 1024; item += gridDim.x, par ^= 1) {
      const int bs = item >> 3, h = item & 7; const size_t r = TP + bs;
      const int nitem = item + gridDim.x;
      if (nitem < 1024) SMP_LOAD(nitem, svn, lfn, kqn, vwn);
      float* s1 = p->out + O_HGS + ((size_t)((l * 128 + bs) * 8 + h)) * 16384;
      const f32x4 vv = (f32x4){bf2f(vw[0] & 0xffffu), bf2f(vw[0] >> 16), bf2f(vw[1] & 0xffffu), bf2f(vw[1] >> 16)};
      f32x4 op = (f32x4){0.f, 0.f, 0.f, 0.f};
#pragma unroll
      for (int i = 0; i < 8; ++i) { const int d = dq * 8 + i;
        const float f = __builtin_amdgcn_exp2f(lfv[i]), kk = 1.f - f, qq = bf2f(kq[i]);
        const f32x4 sn = sv[i] * f + vv * kk;
        __builtin_nontemporal_store(sn, (f32x4*)(s1 + d * 128 + v4)); op += sn * qq; }
#pragma unroll
      for (int jx = 0; jx < 4; ++jx) op[jx] += __shfl_xor(op[jx], 32);
      float* psb = ps + par * 1024;
      if (lane < 32) *(f32x4*)(psb + wave * 128 + v4) = op;
      __syncthreads();
      if (tid < 64) { float o0 = 0.f, o1 = 0.f;
#pragma unroll
        for (int w = 0; w < 8; ++w) { const f32x2 x = *(const f32x2*)(psb + w * 128 + tid * 2); o0 += x[0]; o1 += x[1]; }
        float ss = o0 * o0 + o1 * o1;
#pragma unroll
        for (int o = 1; o < 64; o <<= 1) ss += __shfl_xor(ss, o);
        const float rstd = rsqrtf(ss * (1.f / 128.f) + EPS);
        const int vv2 = tid * 2; const size_t o = r * D + h * 128 + vv2;
        const float g0 = p->hg_gn_g[l * 128 + vv2], g1 = p->hg_gn_g[l * 128 + vv2 + 1];
        *(unsigned*)(B.on + o) = pk2(o0 * rstd * g0 * bf2f(B.g[o]), o1 * rstd * g1 * bf2f(B.g[o + 1])); }
#pragma unroll
      for (int i = 0; i < 8; ++i) { sv[i] = svn[i]; lfv[i] = lfn[i]; kq[i] = kqn[i]; }
      vw = vwn;
    }
    __syncthreads();
  }
  if (sample_first) scan_prompt<0>(p, l, B, shm);
}

constexpr int KN_STRIDE = 72, VT_STRIDE = 260;
constexpr int KN_BYTES = 256 * KN_STRIDE * 2;
struct AtBufs { const bf16_t* qraw; const float* kvraw; bf16_t* on; const float* tab; };

DI void attn_phase(KP p, const int l, const AtBufs& B, unsigned char* shm) {
  const int tid = tid_get(), lane = tid & 63, wave = tid >> 6;
  const int j = l - 2;
  const float* qg = p->q_norm_g + j * 64; const float* sinkp = p->sinks + j * 16;
  const bool write_cache = (l == 2);
  const int nitems = 512 + 512;
#pragma unroll 1
  for (int item = blockIdx.x; item < 512; item += gridDim.x) {
    {
      const int b = item >> 7, qb = (item >> 2) & 31, kvh = item & 3;
      bf16_t* Kn = (bf16_t*)shm; bf16_t* Vt = (bf16_t*)(shm + KN_BYTES);
      const int band0 = (qb - 1) * 128;
      {
        const int key = tid >> 1, part = tid & 1; const int pos = band0 + key; const bool valid = pos >= 0;
        float x1[16], x2[16];
        if (valid) { const float* kp = B.kvraw + ((size_t)b * SEQ + pos) * 512 + kvh * 64 + part * 16;
#pragma unroll
          for (int i = 0; i < 4; ++i) { const f32x4 a = *(const f32x4*)(kp + 4 * i), c = *(const f32x4*)(kp + 32 + 4 * i);
#pragma unroll
            for (int e = 0; e < 4; ++e) { x1[4 * i + e] = a[e]; x2[4 * i + e] = c[e]; } }
        } else {
#pragma unroll
          for (int i = 0; i < 16; ++i) { x1[i] = 0.f; x2[i] = 0.f; } }
        float ss = 0.f;
#pragma unroll
        for (int i = 0; i < 16; ++i) ss += x1[i] * x1[i] + x2[i] * x2[i];
        ss += __shfl_xor(ss, 1);
        const float rstd = rsqrtf(ss * (1.f / 64.f) + EPS);
        const float* tb = B.tab + (size_t)(valid ? pos : 0) * 64 + part * 16;
        float o1[16], o2[16];
#pragma unroll
        for (int i = 0; i < 16; ++i) { const float a = x1[i] * rstd * p->k_norm_g[part * 16 + i], c = x2[i] * rstd * p->k_norm_g[32 + part * 16 + i];
          const float cs = tb[i], sn = tb[32 + i]; o1[i] = a * cs - c * sn; o2[i] = c * cs + a * sn; }
        u32x4 w;
        w = (u32x4){pk2(o1[0], o1[1]), pk2(o1[2], o1[3]), pk2(o1[4], o1[5]), pk2(o1[6], o1[7])}; *(u32x4*)(Kn + key * KN_STRIDE + part * 16) = w;
        w = (u32x4){pk2(o1[8], o1[9]), pk2(o1[10], o1[11]), pk2(o1[12], o1[13]), pk2(o1[14], o1[15])}; *(u32x4*)(Kn + key * KN_STRIDE + part * 16 + 8) = w;
        w = (u32x4){pk2(o2[0], o2[1]), pk2(o2[2], o2[3]), pk2(o2[4], o2[5]), pk2(o2[6], o2[7])}; *(u32x4*)(Kn + key * KN_STRIDE + 32 + part * 16) = w;
        w = (u32x4){pk2(o2[8], o2[9]), pk2(o2[10], o2[11]), pk2(o2[12], o2[13]), pk2(o2[14], o2[15])}; *(u32x4*)(Kn + key * KN_STRIDE + 32 + part * 16 + 8) = w;
        if (write_cache && qb == 31 && key >= 128) { float* ko = p->out + O_KP + ((size_t)(b * 128 + key - 128) * 4 + kvh) * 64 + part * 16;
#pragma unroll
          for (int i = 0; i < 4; ++i) { *(f32x4*)(ko + 4 * i) = (f32x4){o1[4 * i], o1[4 * i + 1], o1[4 * i + 2], o1[4 * i + 3]};
            *(f32x4*)(ko + 32 + 4 * i) = (f32x4){o2[4 * i], o2[4 * i + 1], o2[4 * i + 2], o2[4 * i + 3]}; } }
      }
      {
        const int key = tid & 255, dh = tid >> 8; const int pos = band0 + key; const bool valid = pos >= 0;
        const float* vp = B.kvraw + ((size_t)b * SEQ + (valid ? pos : 0)) * 512 + 256 + kvh * 64 + dh * 32;
#pragma unroll
        for (int i = 0; i < 8; ++i) { f32x4 a = *(const f32x4*)(vp + 4 * i); if (!valid) a = (f32x4){0.f, 0.f, 0.f, 0.f};
#pragma unroll
          for (int e = 0; e < 4; ++e) Vt[(dh * 32 + 4 * i + e) * VT_STRIDE + key] = (bf16_t)f2bf(a[e]);
          if (write_cache && qb == 31 && key >= 128) *(f32x4*)(p->out + O_VP + ((size_t)(b * 128 + key - 128) * 4 + kvh) * 64 + dh * 32 + 4 * i) = a; }
      }
      __syncthreads();
      const int g = wave & 3, qhalf = wave >> 2, hq = kvh * 4 + g, h = lane >> 5, l31 = lane & 31;
      const float sink = sinkp[hq] * 1.4426950408889634f;
#pragma unroll 1
      for (int sub = 0; sub < 2; ++sub) {
        const int Q0 = 128 + qhalf * 64 + sub * 32, qi = Q0 + l31, pos = band0 + qi;
        const size_t tok = (size_t)b * SEQ + pos;
        float x[4][8];
        { const bf16_t* qp = B.qraw + tok * D + hq * 64 + 8 * h;
#pragma unroll
          for (int s = 0; s < 4; ++s) { const u32x4 w = *(const u32x4*)(qp + 16 * s);
#pragma unroll
            for (int e = 0; e < 4; ++e) { x[s][2 * e] = bf2f(w[e] & 0xffffu); x[s][2 * e + 1] = bf2f(w[e] >> 16); } } }
        float ss = 0.f;
#pragma unroll
        for (int s = 0; s < 4; ++s)
#pragma unroll
          for (int e = 0; e < 8; ++e) ss += x[s][e] * x[s][e];
        ss += __shfl_xor(ss, 32);
        const float rstd = rsqrtf(ss * (1.f / 64.f) + EPS) ;
#pragma unroll
        for (int s = 0; s < 4; ++s)
#pragma unroll
          for (int e = 0; e < 8; ++e) x[s][e] *= rstd * qg[16 * s + 8 * h + e];
        const float* tb = B.tab + (size_t)pos * 64;
        bf16x8 qf[4];
#pragma unroll
        for (int s = 0; s < 2; ++s) { unsigned lo[4], hi[4]; float r1[8], r2[8];
#pragma unroll
          for (int e = 0; e < 8; ++e) { const int i = 16 * s + 8 * h + e; const float cs = tb[i], sn = tb[32 + i]; const float a = x[s][e], c = x[s + 2][e];
            r1[e] = (a * cs - c * sn) * (0.125f * 1.4426950408889634f); r2[e] = (c * cs + a * sn) * (0.125f * 1.4426950408889634f); }
#pragma unroll
          for (int e = 0; e < 4; ++e) { lo[e] = pk2(r1[2 * e], r1[2 * e + 1]); hi[e] = pk2(r2[2 * e], r2[2 * e + 1]); }
          qf[s] = __builtin_bit_cast(bf16x8, (u32x4){lo[0], lo[1], lo[2], lo[3]}); qf[s + 2] = __builtin_bit_cast(bf16x8, (u32x4){hi[0], hi[1], hi[2], hi[3]}); }
        const int kb0 = (Q0 - 128) >> 5;
        f32x16 sacc[5]; float mx = sink;
#pragma unroll
        for (int i = 0; i < 5; ++i) { const int kb = kb0 + i; f32x16 a16;
#pragma unroll
          for (int r = 0; r < 16; ++r) a16[r] = 0.f;
          bf16x8 ka[4];
#pragma unroll
          for (int s = 0; s < 4; ++s) ka[s] = *(const bf16x8*)(Kn + (kb * 32 + l31) * KN_STRIDE + 16 * s + 8 * h);
#pragma unroll
          for (int s = 0; s < 4; ++s) a16 = __builtin_amdgcn_mfma_f32_32x32x16_bf16(ka[s], qf[s], a16, 0, 0, 0);
          const bool okb = (qb > 0) || (kb >= 4);
#pragma unroll
          for (int r = 0; r < 16; ++r) { const int cr = crow(r, h);
            const bool ok = (i == 0) ? (okb && (l31 < cr)) : ((i == 4) ? (cr <= l31) : okb);
            const float sv = ok ? a16[r] : -1e30f; a16[r] = sv; mx = fmaxf(mx, sv); }
          sacc[i] = a16; }
        mx = fmaxf(mx, __shfl_xor(mx, 32));
        float sum = 0.f; bf16x8 pf[5][2];
#pragma unroll
        for (int i = 0; i < 5; ++i) { float e[16];
#pragma unroll
          for (int r = 0; r < 16; ++r) { e[r] = __builtin_amdgcn_exp2f(sacc[i][r] - mx); sum += e[r]; }
#pragma unroll
          for (int st = 0; st < 2; ++st) pf[i][st] = __builtin_bit_cast(bf16x8, (u32x4){pk2(e[8 * st], e[8 * st + 1]), pk2(e[8 * st + 2], e[8 * st + 3]), pk2(e[8 * st + 4], e[8 * st + 5]), pk2(e[8 * st + 6], e[8 * st + 7])}); }
        sum += __shfl_xor(sum, 32);
        const float inv = 1.f / (sum + __builtin_amdgcn_exp2f(sink - mx));
#pragma unroll
        for (int db = 0; db < 2; ++db) { f32x16 o16;
#pragma unroll
          for (int r = 0; r < 16; ++r) o16[r] = 0.f;
          bf16x8 va[10];
#pragma unroll
          for (int i = 0; i < 5; ++i)
#pragma unroll
            for (int st = 0; st < 2; ++st) { const bf16_t* vp = Vt + (db * 32 + l31) * VT_STRIDE + (kb0 + i) * 32 + 16 * st + 4 * h;
              const u32x2 lo = *(const u32x2*)vp, hi = *(const u32x2*)(vp + 8);
              va[i * 2 + st] = __builtin_bit_cast(bf16x8, (u32x4){lo[0], lo[1], hi[0], hi[1]}); }
          f32x16 o16b;
#pragma unroll
          for (int r = 0; r < 16; ++r) o16b[r] = 0.f;
#pragma unroll
          for (int i = 0; i < 5; ++i) { o16 = __builtin_amdgcn_mfma_f32_32x32x16_bf16(va[i * 2], pf[i][0], o16, 0, 0, 0); o16b = __builtin_amdgcn_mfma_f32_32x32x16_bf16(va[i * 2 + 1], pf[i][1], o16b, 0, 0, 0); }
#pragma unroll
          for (int r = 0; r < 16; ++r) o16[r] += o16b[r];
          bf16_t* op = B.on + tok * D + hq * 64 + db * 32 + 4 * h;
#pragma unroll
          for (int r4 = 0; r4 < 4; ++r4) *(u32x2*)(op + 8 * r4) = (u32x2){pk2(o16[4 * r4] * inv, o16[4 * r4 + 1] * inv), pk2(o16[4 * r4 + 2] * inv, o16[4 * r4 + 3] * inv)}; }
      }
      __syncthreads();
    }
  }
  {
    const int tid = tid_get(), lane = tid & 63, wave = tid >> 6;
#pragma unroll 1
    for (int item = 512 + blockIdx.x; item < nitems; item += gridDim.x) {
      const int sidx = item - 512, bs = sidx >> 2, kvh = sidx & 3; const size_t r = TP + bs;
      float* Ks = (float*)shm; float* Vs = Ks + 128 * 68; float* q_s = Vs + 128 * 64; float* p_s = q_s + 256; float* redm = p_s + 512; float* reds = redm + 8; float* po = reds + 8;
      const float* tb = B.tab + (size_t)4096 * 64;
      f32x4 kreg[4], vreg[4];
#pragma unroll
      for (int i = 0; i < 4; ++i) { const int e = tid + 512 * i, jr = e >> 4, c4 = (e & 15) * 4;
        if (jr < 127) { const size_t o = (((size_t)bs * 128 + jr + 1) * 4 + kvh) * 64 + c4; kreg[i] = __builtin_nontemporal_load((const f32x4*)(p->cache_k + o)); vreg[i] = __builtin_nontemporal_load((const f32x4*)(p->cache_v + o)); } }
      if (tid < 128) { const int g = tid >> 5, i = tid & 31, hq = kvh * 4 + g;
        float a = bf2f(B.qraw[r * D + hq * 64 + i]), c = bf2f(B.qraw[r * D + hq * 64 + 32 + i]);
        float ss = a * a + c * c;
#pragma unroll
        for (int o = 1; o < 32; o <<= 1) ss += __shfl_xor(ss, o);
        const float rstd = rsqrtf(ss * (1.f / 64.f) + EPS); a *= rstd * qg[i]; c *= rstd * qg[32 + i];
        const float cs = tb[i], sn = tb[32 + i];
        q_s[g * 64 + i] = (a * cs - c * sn) * 0.125f; q_s[g * 64 + 32 + i] = (c * cs + a * sn) * 0.125f;
      } else if (tid < 160) { const int i = tid & 31;
        float a = B.kvraw[r * 512 + kvh * 64 + i], c = B.kvraw[r * 512 + kvh * 64 + 32 + i];
        float ss = a * a + c * c;
#pragma unroll
        for (int o = 1; o < 32; o <<= 1) ss += __shfl_xor(ss, o);
        const float rstd = rsqrtf(ss * (1.f / 64.f) + EPS); a *= rstd * p->k_norm_g[i]; c *= rstd * p->k_norm_g[32 + i];
        const float cs = tb[i], sn = tb[32 + i];
        const float k1 = a * cs - c * sn, k2 = c * cs + a * sn, v1 = B.kvraw[r * 512 + 256 + kvh * 64 + i], v2 = B.kvraw[r * 512 + 256 + kvh * 64 + 32 + i];
        Ks[127 * 68 + i] = k1; Ks[127 * 68 + 32 + i] = k2; Vs[127 * 64 + i] = v1; Vs[127 * 64 + 32 + i] = v2;
        if (write_cache) { float* ok = p->out + O_KS + (((size_t)bs * 128 + 127) * 4 + kvh) * 64; float* ov = p->out + O_VS + (((size_t)bs * 128 + 127) * 4 + kvh) * 64;
          ok[i] = k1; ok[32 + i] = k2; ov[i] = v1; ov[32 + i] = v2; } }
#pragma unroll
      for (int i = 0; i < 4; ++i) { const int e = tid + 512 * i, jr = e >> 4, c4 = (e & 15) * 4;
        if (jr < 127) { *(f32x4*)(Ks + jr * 68 + c4) = kreg[i]; *(f32x4*)(Vs + jr * 64 + c4) = vreg[i];
          if (write_cache) { const size_t o = (((size_t)bs * 128 + jr) * 4 + kvh) * 64 + c4; __builtin_nontemporal_store(kreg[i], (f32x4*)(p->out + O_KS + o)); __builtin_nontemporal_store(vreg[i], (f32x4*)(p->out + O_VS + o)); } } }
      __syncthreads();
      const int g = tid >> 7, jk = tid & 127, hq = kvh * 4 + g; const float sink = sinkp[hq];
      float sc = 0.f;
#pragma unroll
      for (int d4 = 0; d4 < 16; ++d4) { const f32x4 kv = *(const f32x4*)(Ks + jk * 68 + 4 * d4), qv = *(const f32x4*)(q_s + g * 64 + 4 * d4); sc += kv[0] * qv[0] + kv[1] * qv[1] + kv[2] * qv[2] + kv[3] * qv[3]; }
      float mx = sc;
#pragma unroll
      for (int o = 1; o < 64; o <<= 1) mx = fmaxf(mx, __shfl_xor(mx, o));
      if (lane == 0) redm[wave] = mx;
      __syncthreads();
      mx = fmaxf(fmaxf(redm[2 * g], redm[2 * g + 1]), sink);
      const float ev = __expf(sc - mx); float sum = ev;
#pragma unroll
      for (int o = 1; o < 64; o <<= 1) sum += __shfl_xor(sum, o);
      if (lane == 0) reds[wave] = sum;
      p_s[g * 128 + jk] = ev;
      __syncthreads();
      const float inv = 1.f / (reds[2 * g] + reds[2 * g + 1] + __expf(sink - mx));
      { const int d = jk & 63, jh = jk >> 6; float o = 0.f;
#pragma unroll 8
        for (int jx = 0; jx < 64; ++jx) o += p_s[g * 128 + jh * 64 + jx] * Vs[(jh * 64 + jx) * 64 + d];
        po[tid] = o;
        __syncthreads();
        if (jh == 0) { const float tot = (o + po[tid + 64]) * inv; B.on[r * D + hq * 64 + d] = (bf16_t)f2bf(tot); } }
      __syncthreads();
    }
  }
}

#define XB_TMO      128
#define XB_XCNT(j)  (256  + 64 * (j))
#define XB_XSUB(j)  (1280 + 64 * (j))
#define XB_XGEN(j)  (2304 + 64 * (j))
#define XB_TOP      3328
#define XB_TOPGEN   3392
#define XCD_BAR_WORDS 3456
#define XB_SPIN_CAP (1u << 18)

__device__ __forceinline__ unsigned xb_ld(unsigned* p)              { return __hip_atomic_load(p, __ATOMIC_RELAXED, __HIP_MEMORY_SCOPE_AGENT); }
__device__ __forceinline__ unsigned xb_add(unsigned* p, unsigned v) { return __hip_atomic_fetch_add(p, v, __ATOMIC_RELAXED, __HIP_MEMORY_SCOPE_AGENT); }
__device__ __forceinline__ unsigned xb_xcc_id() { return (unsigned)__builtin_amdgcn_s_getreg((3 << 11) | 20) & 0xFu; }
#define XB_SPIN(cond, bar) do { unsigned _sp = 0; while (cond) { __builtin_amdgcn_s_sleep(1); \
    if ((++_sp & 255u) == 0u) { if (xb_ld(&(bar)[XB_TMO])) break; if (_sp > XB_SPIN_CAP) { atomicAdd(&(bar)[XB_TMO], 1u); break; } } } } while (0)

struct XcdBarrier {
    unsigned* bar; unsigned x;
    volatile LAS unsigned* st;
};

__device__ __forceinline__ XcdBarrier xcd_barrier_post(unsigned* bar, volatile LAS unsigned* st) {
    XcdBarrier b; b.bar = bar; b.x = xb_xcc_id(); b.st = st;
    if (threadIdx.x == 0) (void)xb_add(&bar[XB_XCNT(b.x)], 1u);
    return b;
}
__device__ __forceinline__ void xcd_barrier_complete(unsigned* bar, unsigned x, unsigned& nloc, unsigned& nx) {
    const unsigned G = gridDim.x * gridDim.y * gridDim.z;
    unsigned sum, cnt, mine, sp = 0u;
    for (;;) {
        sum = 0u; cnt = 0u; mine = 0u;
#pragma unroll
        for (unsigned j = 0; j < 16; ++j) { const unsigned c = xb_ld(&bar[XB_XCNT(j)]); sum += c; cnt += (c > 0u) ? 1u : 0u; mine = (j == x) ? c : mine; }
        if (sum == G) break;
        __builtin_amdgcn_s_sleep(1);
        if ((++sp & 255u) == 0u) { if (xb_ld(&bar[XB_TMO])) break; if (sp > XB_SPIN_CAP) { atomicAdd(&bar[XB_TMO], 1u); break; } }
    }
    nloc = mine > 0u ? mine : 1u; nx = cnt > 0u ? cnt : 1u;
}

__device__ __forceinline__ void xcd_barrier(const XcdBarrier& b) {
    asm volatile("s_waitcnt vmcnt(0)" ::: "memory");
    __syncthreads();
    if (threadIdx.x == 0) {
        unsigned* bar = b.bar;
        __builtin_amdgcn_s_waitcnt(0);
        unsigned nloc = b.st[0], nx = b.st[1];
        if (nloc == 0u) { xcd_barrier_complete(bar, b.x, nloc, nx); b.st[0] = nloc; b.st[1] = nx; }
        const unsigned old = xb_add(&bar[XB_XSUB(b.x)], 1u);
        const unsigned gen = old / nloc;
        if (old + 1u == (gen + 1u) * nloc) {
            __builtin_amdgcn_fence(__ATOMIC_RELEASE, "agent");
            asm volatile("s_waitcnt vmcnt(0)" ::: "memory");
            const unsigned og = xb_add(&bar[XB_TOP], 1u);
            const unsigned tg = og / nx;
            if (og + 1u == (tg + 1u) * nx) xb_add(&bar[XB_TOPGEN], 1u);
            else XB_SPIN(xb_ld(&bar[XB_TOPGEN]) == tg, bar);
            __builtin_amdgcn_fence(__ATOMIC_ACQUIRE, "agent");
            xb_add(&bar[XB_XGEN(b.x)], 1u);
            asm volatile("s_waitcnt vmcnt(0)" ::: "memory");
        } else {
            XB_SPIN(xb_ld(&bar[XB_XGEN(b.x)]) == gen, bar);
            __builtin_amdgcn_fence(__ATOMIC_ACQUIRE, "agent");
            asm volatile("s_waitcnt vmcnt(0)" ::: "memory");
        }
    }
    __syncthreads();
}


__global__ void __launch_bounds__(NTHREADS, 2) yoco_fwd(P parg) {
  extern __shared__ __attribute__((aligned(16))) unsigned char shm[];
  cg::grid_group grid = cg::this_grid();
  volatile LAS unsigned* xst = (volatile LAS unsigned*)((LAS unsigned char*)shm + 131072);
  if (threadIdx.x < 4) xst[threadIdx.x] = 0u;
  __syncthreads();
  const int nMt = TP / BM;
#pragma unroll 1
  for (int step = -2; step < 32; ++step) {
    const int l = (step < 0) ? 0 : (step >> 3), sub = (step < 0) ? (8 + step + 2) : (step & 7); const bool hg = (l < 2);
    if (sub == 3 && !hg) continue;
    if (sub == 5 || (sub == 0 && l > 0)) continue;
    KP p = kp_get(); unsigned char* ws = p->ws;
#ifndef PROBE_REPS
#define PROBE_REPS 1
#endif
#ifndef PROBE_GREPS
#define PROBE_GREPS 1
#endif
    const bool is_gemm = (sub == 0 || sub == 1 || sub == 4 || sub == 6 || sub == 7 || sub == 9);
#ifndef PROBE_MASK
#define PROBE_MASK 0
#endif
    const int pcode = (sub == 2 && !hg) ? 10 : sub;
    const int reps = (((PROBE_MASK >> pcode) & 1) && !(sub == 4 || sub == 7)) ? 2 : 1;
#pragma unroll 1
    for (int rep = 0; rep < reps; ++rep) {
    if (sub == 8) {
      prep_phase(p, shm);
    } else if (sub == 0 || sub == 1 || sub == 4 || sub == 6 || sub == 7 || sub == 9) {
      float* mods = (float*)(ws + OFF_MODS);
      bf16_t* hbuf = (bf16_t*)(ws + OFF_H); bf16_t* onbuf = (bf16_t*)(ws + OFF_ON); bf16_t* ubuf = (bf16_t*)(ws + OFF_U);
      GemmJob j0, j1; EpiArgs E{}; int nj = 1; E.layer = l; E.first = 0;
      float* rssb = (float*)(ws + OFF_RSS); const float* biasb = (const float*)(ws + OFF_BIAS);
      j1.A = (const bf16_t*)(ws + OFF_X); j1.Bt = (const bf16_t*)(ws + OFF_WKV); j1.nM = nMt; j1.nN = 2; j1.K = D; j1.epi = EPI_KVRAW;
      j0.nM = nMt; j0.K = D;
      if (sub == 0) { j0.A = (const bf16_t*)(ws + OFF_ASH); j0.Bt = (const bf16_t*)ws; j0.nM = 1; j0.nN = 106; j0.epi = EPI_BIAS; j1.A = (const bf16_t*)(ws + OFF_BIAS); }
      else if (sub == 9) { j0.A = (const bf16_t*)(ws + OFF_X + (size_t)MODW * D * 2); j0.Bt = (const bf16_t*)(ws + OFF_X); j0.nM = 1; j0.nN = MODW / BM; j0.epi = EPI_ADA; E.f0 = mods; E.ash = (bf16_t*)(ws + OFF_ASH); }
      else if (sub == 1 && hg) { E.rss = rssb + (size_t)(2 * l) * T; E.bias = biasb + (size_t)132 * site_prefN(l); E.bN = 4096; j0.A = hbuf; j0.Bt = (const bf16_t*)(ws + OFF_WIN) + (size_t)l * 4096 * D; j0.nN = 16; j0.epi = EPI_HGIN;
        E.f0 = (float*)(ws + OFF_X); E.b0 = (bf16_t*)(ws + OFF_U); E.b1 = (bf16_t*)(ws + OFF_U + SZ_ACT); E.b2 = (bf16_t*)(ws + OFF_U + 2 * SZ_ACT); E.b3 = (bf16_t*)(ws + OFF_U + 3 * SZ_ACT); }
      else if (sub == 1) { E.rss = rssb + (size_t)(2 * l) * T; E.bias = biasb + (size_t)132 * site_prefN(l); E.bN = 1024; E.bias1 = biasb + (size_t)132 * site_prefN(4); E.bN1 = 512; j0.A = hbuf; j0.Bt = (const bf16_t*)(ws + OFF_WQ) + (size_t)(l - 2) * D * D; j0.nN = 4; j0.epi = EPI_QRAW;
        E.b1 = (bf16_t*)(ws + OFF_X + SZ_ACT); E.f2 = (float*)(ws + OFF_X + 2 * SZ_ACT); nj = (l == 2) ? 2 : 1; }
      else if (sub == 4) { E.rss_out = rssb + (size_t)(1 + 2 * l) * T; E.ng = p->norm2_g + l * D; E.nsc = mods + l * 6144 + 4096; E.yout = hbuf; j0.A = onbuf; j0.Bt = hg ? (const bf16_t*)(ws + OFF_WOUT) + (size_t)l * D * D : (const bf16_t*)(ws + OFF_WO) + (size_t)(l - 2) * D * D; j0.nN = 4; j0.epi = EPI_RESID;
        E.f0 = p->out + O_Y; E.f1 = mods + l * 6144 + 2048; E.first = (l == 0); }
      else if (sub == 6) { E.rss = rssb + (size_t)(1 + 2 * l) * T; E.bias = biasb + (size_t)132 * site_prefN(5 + l); E.bN = 4096; j0.A = hbuf; j0.Bt = (const bf16_t*)(ws + OFF_WUP) + (size_t)l * D * FF; j0.nN = 16; j0.epi = EPI_UP; E.b0 = ubuf; }
      else { if (l < 3) { E.rss_out = rssb + (size_t)(2 * (l + 1)) * T; E.ng = p->norm1_g + (l + 1) * D; E.nsc = mods + (l + 1) * 6144 + 1024; E.yout = hbuf;
          if (l == 1) { E.ngkv = p->kv_norm_g; E.nsckv = mods + 24576 + 1024; E.ykv = (bf16_t*)(ws + OFF_X); } }
        j0.A = ubuf; j0.Bt = (const bf16_t*)(ws + OFF_WDN) + (size_t)l * D * FF; j0.nN = 4; j0.K = FF; j0.epi = EPI_RESID; E.f0 = p->out + O_Y; E.f1 = mods + l * 6144 + 5120; }
      gemm_phase(p, (LAS unsigned char*)shm, shm, j0, j1, nj, E, sub != 9 && sub != 0);
      if (sub == 0) init_rows(p, (unsigned*)(ws + OFF_BAR) + XCD_BAR_WORDS + 100);
    } else if (sub == 2 && hg) {
      HgBufs HB; HB.q = (bf16_t*)(ws + OFF_U); HB.k = (bf16_t*)(ws + OFF_U + SZ_ACT); HB.v = (bf16_t*)(ws + OFF_U + 2 * SZ_ACT); HB.g = (bf16_t*)(ws + OFF_U + 3 * SZ_ACT);
      HB.lf = (float*)(ws + OFF_X); HB.o32 = (float*)(ws + OFF_X + 2 * SZ_ACT); HB.on = (bf16_t*)(ws + OFF_ON);
      scan_phase(p, l, HB, shm);
    } else if (sub == 2) {
      AtBufs AB; AB.qraw = (bf16_t*)(ws + OFF_X + SZ_ACT); AB.kvraw = (float*)(ws + OFF_X + 2 * SZ_ACT); AB.on = (bf16_t*)(ws + OFF_ON); AB.tab = (const float*)(ws + OFF_TAB);
      attn_phase(p, l, AB, shm);
    } else {
      HgBufs HB; HB.q = (bf16_t*)(ws + OFF_U); HB.k = (bf16_t*)(ws + OFF_U + SZ_ACT); HB.v = (bf16_t*)(ws + OFF_U + 2 * SZ_ACT); HB.g = (bf16_t*)(ws + OFF_U + 3 * SZ_ACT);
      HB.lf = (float*)(ws + OFF_X); HB.o32 = (float*)(ws + OFF_X + 2 * SZ_ACT); HB.on = (bf16_t*)(ws + OFF_ON);
      scan_passB(HB);
      { KP pb = kp_get(); XcdBarrier xb; xb.bar = (unsigned*)(pb->ws + OFF_BAR); xb.x = xb_xcc_id(); xb.st = xst; xcd_barrier(xb); }
      scan_prompt<1>(p, l, HB, shm);
    }
    }
    if (step == 31) break;
    if (step == -2) { grid.sync(); KP p0 = kp_get(); if (tid_get() == 0) (void)xb_add((unsigned*)(p0->ws + OFF_BAR) + XB_XCNT(xb_xcc_id()), 1u); }
    else { KP pb = kp_get(); XcdBarrier xb; xb.bar = (unsigned*)(pb->ws + OFF_BAR); xb.x = xb_xcc_id(); xb.st = xst; xcd_barrier(xb); }
  }
}

extern "C" void kernel_launch(void* const* d_in, const int* in_sizes, int n_in, void* d_out, int out_size, void* d_ws, size_t ws_size, hipStream_t stream) {
  static int grid_blocks = 0;
  if (!grid_blocks) {
    int dev = 0, cus = 0, per_cu = 0;
    hipGetDevice(&dev);
    hipDeviceGetAttribute(&cus, hipDeviceAttributeMultiprocessorCount, dev);
    if (hipFuncSetAttribute((const void*)yoco_fwd, hipFuncAttributeMaxDynamicSharedMemorySize, LDS_BYTES) != hipSuccess) fprintf(stderr, "hipFuncSetAttribute failed\n");
    if (hipOccupancyMaxActiveBlocksPerMultiprocessor(&per_cu, (const void*)yoco_fwd, NTHREADS, LDS_BYTES) != hipSuccess || per_cu < 1) { fprintf(stderr, "occupancy query failed\n"); per_cu = 1; }
    grid_blocks = cus * per_cu;
    if (ws_size < WS_NEED) fprintf(stderr, "workspace too small: %zu < %zu\n", ws_size, (size_t)WS_NEED);
  }
  P p{};
  const float** pp = (const float**)&p;
  for (int i = 0; i < 26; ++i) pp[i] = (const float*)d_in[i];
  p.out = (float*)d_out; p.ws = (unsigned char*)d_ws;
  void* args[] = {&p};
  hipError_t e = hipLaunchCooperativeKernel((const void*)yoco_fwd, dim3(grid_blocks), dim3(NTHREADS), args, LDS_BYTES, stream);
  if (e != hipSuccess) fprintf(stderr, "cooperative launch failed: %s (grid %d)\n", hipGetErrorString(e), grid_blocks);
}
```
